# Optimizing an MI355X kernel written in HIP

```python
import math
import jax, jax.numpy as jnp
from jax import lax
import numpy as np

D_MODEL = 2048
BATCH = 8
SEQ = 4096
DEPTH = 2
DEC_BATCH = 16
DEC_SEQ = 2048
PAST_LEN = 128

HEAD_DIM = 128
ROPE_THETA = 500000.0
ROT_FRAC_DIV = 4
Q_BLOCK = 128
EPS = 1e-6
NEG = -1e30
GRID_W = 64
WIN_ROWS = 8
WIN_COLS = 16
NA_HEADS = 4
DIL_WINDOWS = (128, 512, 2048)
DILATIONS = (1, 4, 16)
DIL_GROUPS = 3
DIL_HEADS = 2
DIL_SPAN = DIL_WINDOWS[0] // (2 * DILATIONS[0])
DIFF_HEADS = 6
DIFF_QK_DIM = 64
DIFF_V_DIM = 2 * DIFF_QK_DIM
D_FF = 4 * D_MODEL
NA_W = NA_HEADS * HEAD_DIM
DIL_W = DIL_GROUPS * DIL_HEADS * HEAD_DIM
DIL_OUT_W = DIL_HEADS * HEAD_DIM
DIFF_QK_W = DIFF_HEADS * 2 * DIFF_QK_DIM
DIFF_V_W = DIFF_HEADS * DIFF_V_DIM
IN_COLS = 3 * NA_W + 3 * DIL_W + 2 * DIFF_QK_W + DIFF_V_W

kernel_name = "hybrid_na_dilated_diff_encoder"


def rms_norm(x, g):
    xf = x.astype(jnp.float32)
    y = xf * lax.rsqrt(jnp.mean(xf * xf, axis=-1, keepdims=True) + EPS)
    return (y * g.astype(jnp.float32)).astype(x.dtype)


def partial_rope(x, pos):
    rot = x.shape[-1] // ROT_FRAC_DIV
    half = rot // 2
    inv = ROPE_THETA ** (-jnp.arange(half, dtype=jnp.float32) / half)
    ang = pos.astype(jnp.float32)[:, None] * inv[None, :]
    cos, sin = jnp.cos(ang), jnp.sin(ang)
    xr = x[..., :rot].astype(jnp.float32)
    x1, x2 = xr[..., :half], xr[..., half:]
    xr = jnp.concatenate([x1 * cos - x2 * sin, x2 * cos + x1 * sin], axis=-1)
    return jnp.concatenate([xr.astype(x.dtype), x[..., rot:]], axis=-1)


def neighbourhood_attention(q, k, v, rpb):
    B, H, S, dh = q.shape
    rows = S // GRID_W
    kh, kw = min(WIN_ROWS, rows), WIN_COLS
    qg = q.reshape(B, H, rows, GRID_W, dh)
    kg = k.reshape(B, H, rows, GRID_W, dh)
    vg = v.reshape(B, H, rows, GRID_W, dh)
    r_ids = jnp.arange(rows)
    c_ids = jnp.arange(GRID_W)
    row_start = jnp.clip(r_ids - kh // 2, 0, rows - kh)
    col_start = jnp.clip(c_ids - kw // 2, 0, GRID_W - kw)
    col_idx = col_start[:, None] + jnp.arange(kw)[None, :]
    dc = col_idx - c_ids[:, None]
    bias_c = rpb[:, :, dc + WIN_COLS - 1]
    scale = dh ** -0.5

    def one_row(rr):
        rs = row_start[rr]
        q_row = lax.dynamic_index_in_dim(qg, rr, axis=2, keepdims=False)
        k_band = lax.dynamic_slice_in_dim(kg, rs, kh, axis=2)
        v_band = lax.dynamic_slice_in_dim(vg, rs, kh, axis=2)
        k_sel = k_band[:, :, :, col_idx]
        v_sel = v_band[:, :, :, col_idx]
        s = jnp.einsum('bhwd,bhrwkd->bhwrk', q_row, k_sel,
                       preferred_element_type=jnp.float32) * scale
        dr = rs + jnp.arange(kh) - rr
        bias = bias_c[:, dr + WIN_ROWS - 1].transpose(0, 2, 1, 3)
        s = s + bias[None].astype(jnp.float32)
        p = jax.nn.softmax(s.reshape(B, H, GRID_W, kh * kw), axis=-1)
        p = p.reshape(B, H, GRID_W, kh, kw).astype(v.dtype)
        return jnp.einsum('bhwrk,bhrwkd->bhwd', p, v_sel)

    out = lax.map(one_row, r_ids)
    return out.transpose(1, 2, 0, 3, 4).reshape(B, H, S, dh)


def dilated_attention(q, k, v):
    B, G, Hg, S, dh = q.shape
    nblk = S // Q_BLOCK
    offs = jnp.arange(-DIL_SPAN, DIL_SPAN + 1)
    dil = jnp.array(DILATIONS, dtype=jnp.int32)
    scale = dh ** -0.5
    take_g = jax.vmap(lambda kk, ii: jnp.take(kk, ii, axis=2), in_axes=(1, 0), out_axes=1)

    def one_block(i):
        t = i * Q_BLOCK + jnp.arange(Q_BLOCK)
        idx = t[None, :, None] + dil[:, None, None] * offs[None, None, :]
        valid = (idx >= 0) & (idx < S)
        idxc = jnp.clip(idx, 0, S - 1)
        qb = lax.dynamic_slice_in_dim(q, i * Q_BLOCK, Q_BLOCK, axis=3)
        kb = take_g(k, idxc)
        vb = take_g(v, idxc)
        s = jnp.einsum('bghqd,bghqnd->bghqn', qb, kb,
                       preferred_element_type=jnp.float32) * scale
        s = jnp.where(valid[None, :, None], s, NEG)
        lse = jax.nn.logsumexp(s, axis=-1)
        p = jnp.exp(s - lse[..., None])
        o = jnp.einsum('bghqn,bghqnd->bghqd', p.astype(v.dtype), vb,
                       preferred_element_type=jnp.float32)
        alpha = jax.nn.softmax(lse, axis=1)
        return jnp.sum(alpha[..., None] * o, axis=1).astype(v.dtype)

    out = lax.map(one_block, jnp.arange(nblk))
    return out.transpose(1, 2, 0, 3, 4).reshape(B, Hg, S, dh)


def diff_attention(q, k, v, lam):
    B, H, _, S, dc = q.shape
    nblk = S // Q_BLOCK
    scale = dc ** -0.5
    qblocks = jnp.moveaxis(q.reshape(B, H, 2, nblk, Q_BLOCK, dc), 3, 0)

    def one_block(qb):
        s = jnp.einsum('bhcqd,bhckd->bhcqk', qb, k,
                       preferred_element_type=jnp.float32) * scale
        p = jax.nn.softmax(s, axis=-1)
        a = p[:, :, 0] - lam * p[:, :, 1]
        return jnp.einsum('bhqk,bhkd->bhqd', a.astype(v.dtype), v)

    out = lax.map(one_block, qblocks)
    return out.transpose(1, 2, 0, 3, 4).reshape(B, H, S, v.shape[-1])


def encoder_layer(x, c, layer_idx, norm1_g, w_ada, b_ada, w_in, qn_a, kn_a, rpb_a,
                  qn_b, kn_b, qn_c, kn_c, lam_q1, lam_k1, lam_q2, lam_k2, subln_c,
                  w_br_a, w_br_b, w_br_c, w_gate, b_gate, w_out, norm2_g, w_ff1, w_ff2):
    B, S, _ = x.shape
    pos = jnp.arange(S)
    mod = (jax.nn.silu(c) @ w_ada + b_ada).astype(x.dtype)[:, None, :]
    sh1, sc1, g1, sh2, sc2, g2 = jnp.split(mod, 6, axis=-1)

    h = rms_norm(x, norm1_g) * (1 + sc1) + sh1
    z = h @ w_in
    widths = [NA_W, NA_W, NA_W, DIL_W, DIL_W, DIL_W, DIFF_QK_W, DIFF_QK_W]
    splits = [int(s) for s in np.cumsum(widths)]
    qa, ka, va, qb, kb, vb, qc, kc, vc = jnp.split(z, splits, axis=-1)

    to_na = lambda t: t.reshape(B, S, NA_HEADS, HEAD_DIM).transpose(0, 2, 1, 3)
    oa = neighbourhood_attention(rms_norm(to_na(qa), qn_a), rms_norm(to_na(ka), kn_a),
                                 to_na(va), rpb_a)

    to_dil = lambda t: t.reshape(B, S, DIL_GROUPS, DIL_HEADS, HEAD_DIM).transpose(0, 2, 3, 1, 4)
    ob = dilated_attention(partial_rope(rms_norm(to_dil(qb), qn_b), pos),
                           partial_rope(rms_norm(to_dil(kb), kn_b), pos),
                           to_dil(vb))

    to_diff = lambda t: t.reshape(B, S, DIFF_HEADS, 2, DIFF_QK_DIM).transpose(0, 2, 3, 1, 4)
    lam_init = 0.8 - 0.6 * math.exp(-0.3 * layer_idx)
    lam = (jnp.exp(jnp.sum(lam_q1.astype(jnp.float32) * lam_k1.astype(jnp.float32)))
           - jnp.exp(jnp.sum(lam_q2.astype(jnp.float32) * lam_k2.astype(jnp.float32)))
           + lam_init)
    vcs = vc.reshape(B, S, DIFF_HEADS, DIFF_V_DIM).transpose(0, 2, 1, 3)
    oc = diff_attention(partial_rope(rms_norm(to_diff(qc), qn_c), pos),
                        partial_rope(rms_norm(to_diff(kc), kn_c), pos), vcs, lam)
    oc = rms_norm(oc, subln_c) * (1.0 - lam_init)

    ya = oa.transpose(0, 2, 1, 3).reshape(B, S, NA_W) @ w_br_a
    yb = ob.transpose(0, 2, 1, 3).reshape(B, S, DIL_OUT_W) @ w_br_b
    yc = oc.transpose(0, 2, 1, 3).reshape(B, S, DIFF_V_W) @ w_br_c
    ga, gb, gc = jnp.split(jax.nn.sigmoid(h @ w_gate + b_gate), 3, axis=-1)
    x = x + g1 * ((ga * ya + gb * yb + gc * yc) @ w_out)

    h2 = rms_norm(x, norm2_g) * (1 + sc2) + sh2
    f = jnp.square(jax.nn.relu(h2 @ w_ff1)) @ w_ff2
    return x + g2 * f


def setup_inputs(seed: int = 0) -> dict:
    key = jax.random.key(seed)
    ks = jax.random.split(key, 29)

    def nrm(i, shape, scale):
        return jax.random.normal(ks[i], shape, jnp.float32) * scale

    D = D_MODEL
    return {
        "x_prompt": nrm(0, (BATCH, SEQ, D), 1.0),
        "x_sample": nrm(1, (DEC_BATCH, DEC_SEQ, D), 1.0),
        "c_prompt": nrm(2, (BATCH, D), 1.0),
        "c_sample": nrm(3, (DEC_BATCH, D), 1.0),
        "norm1_g": 1.0 + nrm(4, (DEPTH, D), 0.05),
        "w_ada": nrm(5, (DEPTH, D, 6 * D), 0.5 * D ** -0.5),
        "b_ada": nrm(6, (DEPTH, 6 * D), 0.02),
        "w_in": nrm(7, (DEPTH, D, IN_COLS), D ** -0.5),
        "qn_a": 1.0 + nrm(8, (DEPTH, HEAD_DIM), 0.05),
        "kn_a": 1.0 + nrm(9, (DEPTH, HEAD_DIM), 0.05),
        "rpb_a": nrm(10, (DEPTH, NA_HEADS, 2 * WIN_ROWS - 1, 2 * WIN_COLS - 1), 0.5),
        "qn_b": 1.0 + nrm(11, (DEPTH, HEAD_DIM), 0.05),
        "kn_b": 1.0 + nrm(12, (DEPTH, HEAD_DIM), 0.05),
        "qn_c": 1.0 + nrm(13, (DEPTH, DIFF_QK_DIM), 0.05),
        "kn_c": 1.0 + nrm(14, (DEPTH, DIFF_QK_DIM), 0.05),
        "lam_q1": nrm(15, (DEPTH, DIFF_QK_DIM), 0.1),
        "lam_k1": nrm(16, (DEPTH, DIFF_QK_DIM), 0.1),
        "lam_q2": nrm(17, (DEPTH, DIFF_QK_DIM), 0.1),
        "lam_k2": nrm(18, (DEPTH, DIFF_QK_DIM), 0.1),
        "subln_c": 1.0 + nrm(19, (DEPTH, DIFF_V_DIM), 0.05),
        "w_br_a": nrm(20, (DEPTH, NA_W, D), NA_W ** -0.5),
        "w_br_b": nrm(21, (DEPTH, DIL_OUT_W, D), DIL_OUT_W ** -0.5),
        "w_br_c": nrm(22, (DEPTH, DIFF_V_W, D), DIFF_V_W ** -0.5),
        "w_gate": nrm(23, (DEPTH, D, 3 * D), D ** -0.5),
        "b_gate": nrm(24, (DEPTH, 3 * D), 0.02),
        "w_out": nrm(25, (DEPTH, D, D), D ** -0.5),
        "norm2_g": 1.0 + nrm(26, (DEPTH, D), 0.05),
        "w_ff1": nrm(27, (DEPTH, D, D_FF), D ** -0.5),
        "w_ff2": nrm(28, (DEPTH, D_FF, D), D_FF ** -0.5),
    }


def reference(x_prompt, x_sample, c_prompt, c_sample, norm1_g, w_ada, b_ada, w_in,
              qn_a, kn_a, rpb_a, qn_b, kn_b, qn_c, kn_c, lam_q1, lam_k1, lam_q2, lam_k2,
              subln_c, w_br_a, w_br_b, w_br_c, w_gate, b_gate, w_out, norm2_g, w_ff1, w_ff2):
    y_prompt, y_sample = x_prompt, x_sample
    for l in range(DEPTH):
        p = (norm1_g[l], w_ada[l], b_ada[l], w_in[l], qn_a[l], kn_a[l], rpb_a[l],
             qn_b[l], kn_b[l], qn_c[l], kn_c[l], lam_q1[l], lam_k1[l], lam_q2[l], lam_k2[l],
             subln_c[l], w_br_a[l], w_br_b[l], w_br_c[l], w_gate[l], b_gate[l], w_out[l],
             norm2_g[l], w_ff1[l], w_ff2[l])
        y_prompt = encoder_layer(y_prompt, c_prompt, l, *p)
        y_sample = encoder_layer(y_sample, c_sample, l, *p)
    return (y_prompt, y_sample)
```

```cpp
#include <hip/hip_runtime.h>
#include <hip/hip_bf16.h>
#include <cstdio>
#include <cstdint>
#include <cmath>
namespace pg8 {
#define PG8_LAS __attribute__((address_space(3)))
typedef unsigned short bf16_t;
typedef short bf16x8 __attribute__((ext_vector_type(8)));
typedef float f32x4 __attribute__((ext_vector_type(4)));
typedef unsigned u32x4 __attribute__((ext_vector_type(4)));
constexpr int BM = 256, BK = 64, HALF = 128, HTB = HALF * BK * 2  , STAGE_BYTES = 8 * HTB, NXCD = 8, WGM = 8;

__host__ __device__ __forceinline__ int lds_byte(int r, int c) { const int st = (r >> 4) * 2 + (c >> 5), rr = r & 15, cc = c & 31, ob = rr * 64 + cc * 2; return st * 1024 + (ob ^ (((ob >> 9) & 1) << 5)); }
__host__ __device__ __forceinline__ void stage_rc(int b, int& R, int& C) { const int st = b / 1024, sb = b % 1024, swz = sb ^ (((sb >> 9) & 1) << 5); R = (st >> 1) * 16 + swz / 64; C = (st & 1) * 32 + (swz % 64) / 2; }
__host__ __device__ __forceinline__ int perm32(int rho) { const int n = rho >> 4, i = rho & 15; return 8 * (i >> 2) + 4 * n + (i & 3); }

struct Unit { int pm, pn; };
struct Gemm { const bf16_t* A; const bf16_t* Bt; int M, N, K; };

struct StaticOrder {
    int nM, nN, nwg, G, c;
    __host__ __device__ void init(int M, int N, int G_, int c_) { nM = M / BM; nN = N / BM; nwg = nM * nN; G = G_; c = c_; }
    __host__ __device__ bool next(int i, Unit& u) const {
        const long L = (long)i * G + c; if (L >= nwg) return false;
        int wgid = (int)L; { const int q = nwg / NXCD, r = nwg % NXCD, xcd = wgid % NXCD, off = wgid / NXCD; wgid = (xcd < r ? xcd * (q + 1) : r * (q + 1) + (xcd - r) * q) + off; }
        const int nig = WGM * nN, gid = wgid / nig, fm = gid * WGM, gsz = (nM - fm) < WGM ? (nM - fm) : WGM;
        u.pm = fm + ((wgid % nig) % gsz); u.pn = (wgid % nig) / gsz; return true;
    }
    __device__ __forceinline__ void a_ready(const Unit&) const {}
    __device__ __forceinline__ void done(const Unit&) const {}
};

typedef float f32x2 __attribute__((ext_vector_type(2)));
typedef __bf16 bf16x2v __attribute__((ext_vector_type(2)));
typedef unsigned u32x2 __attribute__((ext_vector_type(2)));
__device__ __forceinline__ unsigned cvt_pk_bf16(float lo, float hi) { f32x2 v = {lo, hi}; bf16x2v b = __builtin_convertvector(v, bf16x2v); return __builtin_bit_cast(unsigned, b); }
__device__ __forceinline__ float sigm(float x) { return __builtin_amdgcn_rcpf(1.0f + __expf(-x)); }

struct EpiIn {
    static constexpr bool PERM = true, AFTER_DRAIN = false;
    bf16_t* Z; bf16_t* G; const float* bgate;
    __device__ __forceinline__ void operator()(const f32x4 (&acc)[2][2][4][2], const Unit& u, int wr, int wc, int fr, int fq) const {
        const int row0 = u.pm * BM + wr * 64 + fr; const bool gate = u.pn >= 24;
        const int col0 = (gate ? u.pn - 24 : u.pn) * BM + wc * 32 + 8 * fq; bf16_t* base = gate ? G : Z;
        f32x4 bv[2][2];
#pragma unroll
        for (int bj = 0; bj < 2; ++bj)
#pragma unroll
            for (int n = 0; n < 2; ++n) bv[bj][n] = gate ? *(const f32x4*)(bgate + col0 + bj * HALF + 4 * n) : (f32x4){0.f, 0.f, 0.f, 0.f};
#pragma unroll
        for (int ai = 0; ai < 2; ++ai)
#pragma unroll
            for (int m = 0; m < 4; ++m) { bf16_t* rowp = base + (size_t)(row0 + ai * HALF + m * 16) * 6144 + col0;
#pragma unroll
                for (int bj = 0; bj < 2; ++bj) { f32x4 v0 = acc[ai][bj][m][0] + bv[bj][0], v1 = acc[ai][bj][m][1] + bv[bj][1];
                    if (gate) { v0 = (f32x4){sigm(v0[0]), sigm(v0[1]), sigm(v0[2]), sigm(v0[3])}; v1 = (f32x4){sigm(v1[0]), sigm(v1[1]), sigm(v1[2]), sigm(v1[3])}; }
                    u32x4 w; w.x = cvt_pk_bf16(v0[0], v0[1]); w.y = cvt_pk_bf16(v0[2], v0[3]); w.z = cvt_pk_bf16(v1[0], v1[1]); w.w = cvt_pk_bf16(v1[2], v1[3]);
                    *(u32x4*)(rowp + bj * HALF) = w; } }
    }
};
struct EpiRelu2 {
    static constexpr bool PERM = true, AFTER_DRAIN = false;
    bf16_t* O; int ldc;
    __device__ __forceinline__ void operator()(const f32x4 (&acc)[2][2][4][2], const Unit& u, int wr, int wc, int fr, int fq) const {
        const int row0 = u.pm * BM + wr * 64 + fr, col0 = u.pn * BM + wc * 32 + 8 * fq;
#pragma unroll
        for (int ai = 0; ai < 2; ++ai)
#pragma unroll
            for (int m = 0; m < 4; ++m) { bf16_t* rowp = O + (size_t)(row0 + ai * HALF + m * 16) * ldc + col0;
#pragma unroll
                for (int bj = 0; bj < 2; ++bj) { f32x4 v0 = acc[ai][bj][m][0], v1 = acc[ai][bj][m][1];
#pragma unroll
                    for (int e = 0; e < 4; ++e) { const float a0 = v0[e] > 0.f ? v0[e] : 0.f, a1 = v1[e] > 0.f ? v1[e] : 0.f; v0[e] = a0 * a0; v1[e] = a1 * a1; }
                    u32x4 w; w.x = cvt_pk_bf16(v0[0], v0[1]); w.y = cvt_pk_bf16(v0[2], v0[3]); w.z = cvt_pk_bf16(v1[0], v1[1]); w.w = cvt_pk_bf16(v1[2], v1[3]);
                    *(u32x4*)(rowp + bj * HALF) = w; } }
    }
};
struct EpiRes {
    static constexpr bool PERM = false, AFTER_DRAIN = false;
    const float* xin; float* xout; const float* gbase; int seq0, tshift;
    __device__ __forceinline__ void operator()(const f32x4 (&acc)[2][2][4][2], const Unit& u, int wr, int wc, int fr, int fq) const {
        const int row0 = u.pm * BM + wr * 64 + fr, col0 = u.pn * BM + wc * 32 + 4 * fq;
        const float* gp = gbase + (size_t)(seq0 + ((u.pm * BM) >> tshift)) * 12288 + col0;
        f32x4 gv[2][2];
#pragma unroll
        for (int bj = 0; bj < 2; ++bj)
#pragma unroll
            for (int n = 0; n < 2; ++n) gv[bj][n] = *(const f32x4*)(gp + bj * HALF + n * 16);
#pragma unroll
        for (int ai = 0; ai < 2; ++ai)
#pragma unroll
            for (int m = 0; m < 4; ++m) { const size_t off = (size_t)(row0 + ai * HALF + m * 16) * 2048 + col0;
#pragma unroll
                for (int bj = 0; bj < 2; ++bj)
#pragma unroll
                    for (int n = 0; n < 2; ++n) { const f32x4 xi = *(const f32x4*)(xin + off + bj * HALF + n * 16);
                        *(f32x4*)(xout + off + bj * HALF + n * 16) = xi + gv[bj][n] * acc[ai][bj][m][n]; } }
    }
};
template <int MODE> struct EpiBr {
    static constexpr bool PERM = false, AFTER_DRAIN = false;
    float* T; bf16_t* MRG; const bf16_t* Gt; int gcol0;
    __device__ __forceinline__ void operator()(const f32x4 (&acc)[2][2][4][2], const Unit& u, int wr, int wc, int fr, int fq) const {
        const int row0 = u.pm * BM + wr * 64 + fr, col0 = u.pn * BM + wc * 32 + 4 * fq;
#pragma unroll
        for (int ai = 0; ai < 2; ++ai)
#pragma unroll
            for (int m = 0; m < 4; ++m) { const size_t row = (size_t)(row0 + ai * HALF + m * 16);
#pragma unroll
                for (int bj = 0; bj < 2; ++bj)
#pragma unroll
                    for (int n = 0; n < 2; ++n) { const int col = col0 + bj * HALF + n * 16;
                        const u32x2 gw = *(const u32x2*)(Gt + row * 6144 + gcol0 + col);
                        const f32x4 g = {__uint_as_float(gw.x << 16), __uint_as_float(gw.x & 0xffff0000u), __uint_as_float(gw.y << 16), __uint_as_float(gw.y & 0xffff0000u)};
                        f32x4 v = g * acc[ai][bj][m][n];
                        if (MODE >= 1) v = v + *(const f32x4*)(T + row * 2048 + col);
                        if (MODE <= 1) *(f32x4*)(T + row * 2048 + col) = v;
                        else { u32x2 w; w.x = cvt_pk_bf16(v[0], v[1]); w.y = cvt_pk_bf16(v[2], v[3]); *(u32x2*)(MRG + row * 2048 + col) = w; } } }
    }
};

template <class Epi, class Sched, bool ALIGN_EPI = false, bool SP2 = false>
__device__ __forceinline__ void gemm_phase(PG8_LAS unsigned char* lds, const Gemm g, const Sched& S, const Epi& E) {
    int tid_ = threadIdx.x; asm volatile("" : "+v"(tid_));
    const int tid = tid_, wid = __builtin_amdgcn_readfirstlane(tid >> 6), lane = tid & 63, wr = wid >> 2, wc = wid & 3, fr = lane & 15, fq = lane >> 4;
    const int K = g.K, nt = K / BK;
    unsigned voffA[2], voffB[2];
#pragma unroll
    for (int i = 0; i < 2; ++i) { int R, C; stage_rc(tid * 16 + i * 8192, R, C); const int Rb = Epi::PERM ? ((R & ~31) + perm32(R & 31)) : R;
        voffA[i] = (unsigned)(R * K + C) * 2u; voffB[i] = (unsigned)(Rb * K + C) * 2u; }
    const size_t kstep = (size_t)(BK * 2);
    const size_t hstep = (size_t)HALF * K * 2;
    const size_t tstep = 2 * hstep;
    const unsigned ldsw = (unsigned)wid * 1024u;
    const int aoff = lds_byte(wr * 64 + fr, fq * 8), boff = lds_byte(wc * 32 + fr, fq * 8);
#define PG8_SA(b, h) (((b) * 2 + (h)) * HTB)
#define PG8_SB(b, h) ((4 + (b) * 2 + (h)) * HTB)
#define PG8_STAGE(bufoff, gbase, voff) do { _Pragma("unroll") for (int _i = 0; _i < 2; ++_i) \
        __builtin_amdgcn_global_load_lds((const unsigned*)((const char*)(gbase) + (voff)[_i]), (PG8_LAS unsigned*)(lds + (bufoff) + ldsw + _i * 8192), 16, 0, 0); } while (0)
#define PG8_LDA(dst, b, h) do { _Pragma("unroll") for (int m = 0; m < 4; ++m) _Pragma("unroll") for (int k = 0; k < 2; ++k) dst[m][k] = *(const PG8_LAS bf16x8*)(lds + PG8_SA(b, h) + aoff + m * 2048 + k * 1024); } while (0)
#define PG8_LDB(dst, b, h) do { _Pragma("unroll") for (int n = 0; n < 2; ++n) _Pragma("unroll") for (int k = 0; k < 2; ++k) dst[n][k] = *(const PG8_LAS bf16x8*)(lds + PG8_SB(b, h) + boff + n * 2048 + k * 1024); } while (0)
#define PG8_MMA(ai, bj, At, Bt) do { __builtin_amdgcn_s_setprio(1); _Pragma("unroll") for (int m = 0; m < 4; ++m) _Pragma("unroll") for (int n = 0; n < 2; ++n) _Pragma("unroll") for (int k = 0; k < 2; ++k) \
        acc[ai][bj][m][n] = __builtin_amdgcn_mfma_f32_16x16x32_bf16(Bt[n][k], At[m][k], acc[ai][bj][m][n], 0, 0, 0); __builtin_amdgcn_s_setprio(0); } while (0)
#define PG8_WAIT_V(n) asm volatile("s_waitcnt vmcnt(" #n ")" ::: "memory")
#define PG8_WAIT_L(n) asm volatile("s_waitcnt lgkmcnt(" #n ")" ::: "memory")
#define PG8_BAR __builtin_amdgcn_s_barrier()
#define PG8_SCHED __builtin_amdgcn_sched_barrier(0)
    Unit cur, nxt; int ui = 0;
    if (!S.next(0, cur)) return;
    f32x4 acc[2][2][4][2];
#pragma unroll
    for (int a = 0; a < 2; ++a)
#pragma unroll
        for (int b = 0; b < 2; ++b)
#pragma unroll
            for (int m = 0; m < 4; ++m)
#pragma unroll
                for (int n = 0; n < 2; ++n) acc[a][b][m][n] = (f32x4){0.f, 0.f, 0.f, 0.f};
    bf16x8 At[4][2], B0[2][2], B1[2][2];
    const char* cA = (const char*)g.A + (size_t)cur.pm * tstep; const char* cB = (const char*)g.Bt + (size_t)cur.pn * tstep;
    S.a_ready(cur);
    if constexpr (SP2) {
        PG8_STAGE(PG8_SB(0, 0), cB, voffB); PG8_STAGE(PG8_SB(0, 1), cB + hstep, voffB); PG8_STAGE(PG8_SA(0, 0), cA, voffA); PG8_STAGE(PG8_SA(0, 1), cA + hstep, voffA);
        if (wr == 1) PG8_BAR;
        PG8_WAIT_V(2); PG8_BAR;
        PG8_STAGE(PG8_SB(1, 0), cB + kstep, voffB); PG8_STAGE(PG8_SA(1, 0), cA + kstep, voffA); PG8_STAGE(PG8_SB(1, 1), cB + hstep + kstep, voffB);
        PG8_WAIT_V(6); PG8_BAR;
    } else {
        PG8_STAGE(PG8_SB(0, 0), cB, voffB); PG8_STAGE(PG8_SA(0, 0), cA, voffA); PG8_STAGE(PG8_SB(0, 1), cB + hstep, voffB); PG8_STAGE(PG8_SA(0, 1), cA + hstep, voffA);
        if (wr == 1) PG8_BAR;
        PG8_WAIT_V(4); PG8_BAR;
        PG8_STAGE(PG8_SB(1, 0), cB + kstep, voffB); PG8_STAGE(PG8_SA(1, 0), cA + kstep, voffA); PG8_STAGE(PG8_SB(1, 1), cB + hstep + kstep, voffB);
        PG8_WAIT_V(6); PG8_BAR;
    }
    for (;;) {
        const bool has_next = S.next(ui + 1, nxt);
        const char* nA = has_next ? (const char*)g.A + (size_t)nxt.pm * tstep : cA; const char* nB = has_next ? (const char*)g.Bt + (size_t)nxt.pn * tstep : cB;
#pragma unroll 1
        for (int t = 0; t < nt; t += 2) {
            const bool last = (t == nt - 2);
            const char* a1 = cA + (size_t)(t + 1) * kstep;
            const char* a2 = last ? nA : cA + (size_t)(t + 2) * kstep; const char* b2 = last ? nB : cB + (size_t)(t + 2) * kstep;
            const char* a3 = a2 + kstep; const char* b3 = b2 + kstep;
            if (last && has_next) S.a_ready(nxt);
            if constexpr (SP2) {
            PG8_LDB(B0, 0, 0); PG8_LDB(B1, 0, 1); PG8_SCHED; PG8_LDA(At, 0, 0); PG8_STAGE(PG8_SA(1, 1), a1 + hstep, voffA);
            PG8_WAIT_V(8); PG8_WAIT_L(0); PG8_BAR; PG8_MMA(0, 0, At, B0); PG8_MMA(0, 1, At, B1); PG8_BAR; PG8_SCHED;
            PG8_LDA(At, 0, 1); PG8_STAGE(PG8_SB(0, 0), b2, voffB); PG8_STAGE(PG8_SB(0, 1), b2 + hstep, voffB); PG8_STAGE(PG8_SA(0, 0), a2, voffA);
            PG8_WAIT_V(8); PG8_WAIT_L(0); PG8_BAR; PG8_MMA(1, 0, At, B0); PG8_MMA(1, 1, At, B1); PG8_BAR; PG8_SCHED;
            PG8_LDB(B0, 1, 0); PG8_LDB(B1, 1, 1); PG8_SCHED; PG8_LDA(At, 1, 0); PG8_STAGE(PG8_SA(0, 1), a2 + hstep, voffA);
            PG8_WAIT_V(8); PG8_WAIT_L(0); PG8_BAR; PG8_MMA(0, 0, At, B0); PG8_MMA(0, 1, At, B1); PG8_BAR; PG8_SCHED;
            PG8_LDA(At, 1, 1); PG8_STAGE(PG8_SB(1, 0), b3, voffB); PG8_STAGE(PG8_SB(1, 1), b3 + hstep, voffB); PG8_STAGE(PG8_SA(1, 0), a3, voffA);
            PG8_WAIT_V(8); PG8_WAIT_L(0); PG8_BAR; PG8_MMA(1, 0, At, B0); PG8_MMA(1, 1, At, B1); PG8_BAR; PG8_SCHED;
            } else {
            PG8_LDB(B0, 0, 0); PG8_SCHED; PG8_LDA(At, 0, 0); PG8_STAGE(PG8_SA(1, 1), a1 + hstep, voffA);
            PG8_WAIT_L(8); PG8_BAR; PG8_WAIT_L(0); PG8_MMA(0, 0, At, B0); PG8_BAR; PG8_SCHED;
            PG8_LDB(B1, 0, 1); PG8_STAGE(PG8_SB(0, 0), b2, voffB);
            PG8_BAR; PG8_WAIT_L(0); PG8_MMA(0, 1, At, B1); PG8_BAR;
            PG8_LDA(At, 0, 1); PG8_STAGE(PG8_SA(0, 0), a2, voffA);
            PG8_BAR; PG8_WAIT_L(0); PG8_MMA(1, 0, At, B0); PG8_BAR; PG8_SCHED;
            PG8_STAGE(PG8_SB(0, 1), b2 + hstep, voffB);
            PG8_WAIT_V(6); PG8_BAR; PG8_MMA(1, 1, At, B1); PG8_BAR;
            PG8_LDB(B0, 1, 0); PG8_SCHED; PG8_LDA(At, 1, 0); PG8_STAGE(PG8_SA(0, 1), a2 + hstep, voffA);
            PG8_WAIT_L(8); PG8_BAR; PG8_WAIT_L(0); PG8_MMA(0, 0, At, B0); PG8_BAR; PG8_SCHED;
            PG8_LDB(B1, 1, 1); PG8_STAGE(PG8_SB(1, 0), b3, voffB);
            PG8_BAR; PG8_WAIT_L(0); PG8_MMA(0, 1, At, B1); PG8_BAR;
            PG8_LDA(At, 1, 1); PG8_STAGE(PG8_SA(1, 0), a3, voffA);
            PG8_BAR; PG8_WAIT_L(0); PG8_MMA(1, 0, At, B0); PG8_BAR; PG8_SCHED;
            PG8_STAGE(PG8_SB(1, 1), b3 + hstep, voffB);
            PG8_WAIT_V(6); PG8_BAR; PG8_MMA(1, 1, At, B1); PG8_BAR;
            }
        }
        if constexpr (ALIGN_EPI) { if (wr == 0) PG8_BAR; }
        if constexpr (!Epi::AFTER_DRAIN) { E(acc, cur, wr, wc, fr, fq); S.done(cur); }
        if (!has_next) break;
#pragma unroll
        for (int a = 0; a < 2; ++a)
#pragma unroll
            for (int b = 0; b < 2; ++b)
#pragma unroll
                for (int m = 0; m < 4; ++m)
#pragma unroll
                    for (int n = 0; n < 2; ++n) acc[a][b][m][n] = (f32x4){0.f, 0.f, 0.f, 0.f};
        cur = nxt; cA = nA; cB = nB; ++ui;
        if constexpr (ALIGN_EPI) { if (wr == 1) PG8_BAR; }
    }
    PG8_WAIT_V(0);
    if constexpr (!ALIGN_EPI) { if (wr == 0) PG8_BAR; }
    PG8_BAR;
    if constexpr (Epi::AFTER_DRAIN) { E.fused(acc, cur, wr, wc, fr, fq, lds, wid, lane); S.done(cur); }
#undef PG8_SA
#undef PG8_SB
#undef PG8_STAGE
#undef PG8_LDA
#undef PG8_LDB
#undef PG8_MMA
#undef PG8_WAIT_V
#undef PG8_WAIT_L
#undef PG8_BAR
#undef PG8_SCHED
}
}

constexpr int NWAVES = 8;
constexpr int DM = 2048, NSEQ = 24, MTOT = 65536, DFF = 8192, INC = 6144;
#ifndef MK_CH
#define MK_CH 16384
#endif
constexpr int CH = MK_CH;
constexpr int NCHUNK = MTOT / CH;
constexpr float EPS = 1e-6f, LOG2E = 1.4426950408889634f, LN2 = 0.6931471805599453f;
constexpr float QS128 = 0.08838834764831845f * LOG2E, QS64 = 0.125f * LOG2E;
constexpr float NEGB = -1e30f;

constexpr size_t MiB = 1u << 20;
constexpr size_t WS_CTL = 0, CTL_ZERO_BYTES = 1 * MiB;
constexpr size_t WS_MOD = 1 * MiB;
constexpr size_t WS_ROPEB = 4 * MiB, WS_ROPEC = WS_ROPEB + 512 * 1024;
constexpr size_t WS_LAM = 5 * MiB;
constexpr size_t WS_MODP = 6 * MiB;
constexpr size_t WS_W = 48 * MiB, W_LAYER = 126 * MiB;
constexpr size_t WO_IG = 0, WO_BRA = 48 * MiB, WO_BRB = 50 * MiB, WO_BRC = 51 * MiB, WO_OUT = 54 * MiB, WO_FF1 = 62 * MiB, WO_FF2 = 94 * MiB;
constexpr size_t WS_ACT = 304 * MiB;
constexpr size_t CHS = (size_t)CH;
constexpr size_t A_H = WS_ACT;
constexpr size_t A_Z = A_H + CHS * 2048 * 2;
constexpr size_t A_QK = A_Z + CHS * 6144 * 2;
constexpr size_t A_VT = A_QK + CHS * 4096 * 2;
constexpr size_t A_G = A_VT + CHS * 2048 * 2;
constexpr size_t A_OA = A_G + CHS * 6144 * 2;
constexpr size_t A_OB = A_OA + CHS * 512 * 2;
constexpr size_t A_OC = A_OB + CHS * 256 * 2;
constexpr size_t WS_END = A_OC + CHS * 768 * 2;
constexpr size_t A_BTMP = A_Z;
constexpr size_t A_BLSE = A_BTMP + CHS * 768 * 2;
constexpr size_t A_CTMP = A_BLSE + CHS * 8 * 4;
static_assert(A_CTMP + CHS * 1536 * 4 <= A_QK, "attention temporaries fit in Z");
constexpr size_t A_TMPF = A_QK;
constexpr size_t A_U = A_Z;
static_assert(CHS * 8192 * 2 <= (A_VT - A_Z), "u fits in Z + QK");
constexpr int CW_BAR = 4096;
constexpr int CW_CHK = 65536;

constexpr int RING_OFF = 0, RING_BYTES = 131072;
constexpr int LDSCTL_OFF = RING_BYTES, MISC_OFF = LDSCTL_OFF + 320;
constexpr int LDS_BYTES = 147456;

#define GAS __attribute__((address_space(1)))
#define LAS __attribute__((address_space(3)))
typedef unsigned short bf16;
typedef unsigned v4u __attribute__((ext_vector_type(4)));
typedef unsigned v2u __attribute__((ext_vector_type(2)));
typedef float f32x4 __attribute__((ext_vector_type(4)));
typedef float f32x16 __attribute__((ext_vector_type(16)));
typedef short bf16x8 __attribute__((ext_vector_type(8)));
typedef GAS unsigned gu32;
#define LDS_WAIT() asm volatile("s_waitcnt lgkmcnt(0)" ::: "memory")
#define VM_WAIT() asm volatile("s_waitcnt vmcnt(0)" ::: "memory")
__device__ __forceinline__ unsigned pk2(float lo, float hi) { return pg8::cvt_pk_bf16(lo, hi); }
__device__ __forceinline__ float bflo(unsigned w) { return __uint_as_float(w << 16); }
__device__ __forceinline__ float bfhi(unsigned w) { return __uint_as_float(w & 0xffff0000u); }
__device__ __forceinline__ float bf1(bf16 b) { return __uint_as_float((unsigned)b << 16); }
__device__ __forceinline__ float wave_sum(float v) {
#pragma unroll
    for (int o = 1; o < 64; o <<= 1) v += __shfl_xor(v, o);
    return v;
}
#define XB_TMO      128
#define XB_XCNT(j)  (256  + 64 * (j))
#define XB_XSUB(j)  (1280 + 64 * (j))
#define XB_XGEN(j)  (2304 + 64 * (j))
#define XB_TOP      3328
#define XB_TOPGEN   3392
#define XCD_BAR_WORDS 3456
#define XB_SPIN_CAP (1u << 18)

__device__ __forceinline__ unsigned xb_ld(unsigned* p)              { return __hip_atomic_load(p, __ATOMIC_RELAXED, __HIP_MEMORY_SCOPE_AGENT); }
__device__ __forceinline__ unsigned xb_add(unsigned* p, unsigned v) { return __hip_atomic_fetch_add(p, v, __ATOMIC_RELAXED, __HIP_MEMORY_SCOPE_AGENT); }
__device__ __forceinline__ unsigned xb_xcc_id() { return (unsigned)__builtin_amdgcn_s_getreg((3 << 11) | 20) & 0xFu; }
#define XB_SPIN(cond, bar) do { unsigned _sp = 0; while (cond) { __builtin_amdgcn_s_sleep(1); \
    if ((++_sp & 255u) == 0u) { if (xb_ld(&(bar)[XB_TMO])) break; if (_sp > XB_SPIN_CAP) { atomicAdd(&(bar)[XB_TMO], 1u); break; } } } } while (0)

struct XcdBarrier {
    unsigned* bar; unsigned x;
    volatile LAS unsigned* st;
};

__device__ __forceinline__ XcdBarrier xcd_barrier_post(unsigned* bar, volatile LAS unsigned* st) {
    XcdBarrier b; b.bar = bar; b.x = xb_xcc_id(); b.st = st;
    if (threadIdx.x == 0) (void)xb_add(&bar[XB_XCNT(b.x)], 1u);
    return b;
}
__device__ __forceinline__ void xcd_barrier_complete(unsigned* bar, unsigned x, unsigned& nloc, unsigned& nx) {
    const unsigned G = gridDim.x * gridDim.y * gridDim.z;
    unsigned sum, cnt, mine, sp = 0u;
    for (;;) {
        sum = 0u; cnt = 0u; mine = 0u;
#pragma unroll
        for (unsigned j = 0; j < 16; ++j) { const unsigned c = xb_ld(&bar[XB_XCNT(j)]); sum += c; cnt += (c > 0u) ? 1u : 0u; mine = (j == x) ? c : mine; }
        if (sum == G) break;
        __builtin_amdgcn_s_sleep(1);
        if ((++sp & 255u) == 0u) { if (xb_ld(&bar[XB_TMO])) break; if (sp > XB_SPIN_CAP) { atomicAdd(&bar[XB_TMO], 1u); break; } }
    }
    nloc = mine > 0u ? mine : 1u; nx = cnt > 0u ? cnt : 1u;
}

__device__ __forceinline__ void xcd_barrier(const XcdBarrier& b) {
    asm volatile("s_waitcnt vmcnt(0)" ::: "memory");
    __syncthreads();
    if (threadIdx.x == 0) {
        unsigned* bar = b.bar;
        __builtin_amdgcn_s_waitcnt(0);
        unsigned nloc = b.st[0], nx = b.st[1];
        if (nloc == 0u) { xcd_barrier_complete(bar, b.x, nloc, nx); b.st[0] = nloc; b.st[1] = nx; }
        const unsigned old = xb_add(&bar[XB_XSUB(b.x)], 1u);
        const unsigned gen = old / nloc;
        if (old + 1u == (gen + 1u) * nloc) {
            __builtin_amdgcn_fence(__ATOMIC_RELEASE, "agent");
            asm volatile("s_waitcnt vmcnt(0)" ::: "memory");
            const unsigned og = xb_add(&bar[XB_TOP], 1u);
            const unsigned tg = og / nx;
            if (og + 1u == (tg + 1u) * nx) xb_add(&bar[XB_TOPGEN], 1u);
            else XB_SPIN(xb_ld(&bar[XB_TOPGEN]) == tg, bar);
            __builtin_amdgcn_fence(__ATOMIC_ACQUIRE, "agent");
            xb_add(&bar[XB_XGEN(b.x)], 1u);
            asm volatile("s_waitcnt vmcnt(0)" ::: "memory");
        } else {
            XB_SPIN(xb_ld(&bar[XB_XGEN(b.x)]) == gen, bar);
            __builtin_amdgcn_fence(__ATOMIC_ACQUIRE, "agent");
            asm volatile("s_waitcnt vmcnt(0)" ::: "memory");
        }
    }
    __syncthreads();
}

struct Args { const float* in[29]; float* out; unsigned char* ws; };
typedef const __attribute__((address_space(4))) unsigned long long* kargp_t;
struct AL {
    __device__ __forceinline__ static kargp_t kp() { kargp_t p = (kargp_t)__builtin_amdgcn_kernarg_segment_ptr(); asm volatile("" : "+s"(p)); return p; }
    __device__ __forceinline__ const float* in(int i) const { return (const float*)kp()[i]; }
    __device__ __forceinline__ float* out() const { return (float*)kp()[29]; }
    __device__ __forceinline__ unsigned char* ws() const { return (unsigned char*)kp()[30]; } };
enum { I_XP = 0, I_XS, I_CP, I_CS, I_N1G, I_WADA, I_BADA, I_WIN, I_QNA, I_KNA, I_RPB, I_QNB, I_KNB, I_QNC, I_KNC, I_LQ1, I_LK1, I_LQ2, I_LK2, I_SUBLN,
       I_WBRA, I_WBRB, I_WBRC, I_WGATE, I_BGATE, I_WOUT, I_N2G, I_WFF1, I_WFF2 };

__device__ __forceinline__ void phase_modp(const AL& a, LAS unsigned char* lds, int tid, int lane, int wave) {
    LAS float* sil = (LAS float*)lds;
    const float* wada = a.in(I_WADA); float* modp = (float*)(a.ws() + WS_MODP);
    for (int it = blockIdx.x; it < 256; it += gridDim.x) {
        const int l = it >> 7, ks = (it >> 3) & 15, cg = it & 7, k0 = ks * 128;
        for (int e = tid; e < 24 * 128; e += NWAVES * 64) { const int b = e >> 7, kk = e & 127;
            const float c = b < 8 ? a.in(I_CP)[b * 2048 + k0 + kk] : a.in(I_CS)[(b - 8) * 2048 + k0 + kk];
            sil[e] = c / (1.0f + __expf(-c)); }
        __syncthreads();
        const int n0 = cg * 1536 + wave * 192 + 3 * lane;
        float acc[24][3];
#pragma unroll
        for (int b = 0; b < 24; ++b) { acc[b][0] = 0.f; acc[b][1] = 0.f; acc[b][2] = 0.f; }
        const float* wp = wada + ((size_t)l * 2048 + k0) * 12288 + n0;
#pragma unroll 4
        for (int kk = 0; kk < 128; ++kk) {
            const float w0 = wp[(size_t)kk * 12288], w1 = wp[(size_t)kk * 12288 + 1], w2 = wp[(size_t)kk * 12288 + 2];
#pragma unroll
            for (int b = 0; b < 24; ++b) { const float s = sil[b * 128 + kk]; acc[b][0] += s * w0; acc[b][1] += s * w1; acc[b][2] += s * w2; }
        }
#pragma unroll
        for (int b = 0; b < 24; ++b) { float* o = modp + ((size_t)(ks * 2 + l) * 24 + b) * 12288 + n0; o[0] = acc[b][0]; o[1] = acc[b][1]; o[2] = acc[b][2]; }
        __syncthreads();
    }
}
__device__ __forceinline__ void p0_transpose_item(const float* W, int K, int N, bf16* WT, int row_off, LAS float* scr, int item, int lane) {
    const int nblk = N / 32, kb = item / nblk, nb = item % nblk, k0 = 64 * kb, n0 = 32 * nb;
#pragma unroll 8
    for (int i = 0; i < 32; ++i) { const int kk = 2 * i + (lane >> 5); scr[kk * 33 + (lane & 31)] = W[(size_t)(k0 + kk) * N + n0 + (lane & 31)]; }
    LDS_WAIT(); asm volatile("" ::: "memory");
    const int c = lane & 7;
#pragma unroll
    for (int j = 0; j < 4; ++j) { const int n = (lane >> 3) + 8 * j; const LAS float* s = scr + (8 * c) * 33 + n;
        v4u o; o.x = pk2(s[0 * 33], s[1 * 33]); o.y = pk2(s[2 * 33], s[3 * 33]); o.z = pk2(s[4 * 33], s[5 * 33]); o.w = pk2(s[6 * 33], s[7 * 33]);
        *(GAS v4u*)(WT + (size_t)(row_off + n0 + n) * K + k0 + 8 * c) = o; }
    LDS_WAIT(); asm volatile("" ::: "memory");
}
__device__ __forceinline__ void phase_pro2(const AL& a, LAS unsigned char* lds, int tid, int lane, int wave, int G) {
    const int gt = blockIdx.x * (NWAVES * 64) + tid, NGT = G * NWAVES * 64;
    { float* mod = (float*)(a.ws() + WS_MOD); const float* modp = (const float*)(a.ws() + WS_MODP); const float* bada = a.in(I_BADA);
      for (int i = gt; i < 2 * 24 * 12288; i += NGT) { const int l = i / (24 * 12288), n = i % 12288; float s = bada[l * 12288 + n];
#pragma unroll
          for (int ks = 0; ks < 16; ++ks) s += modp[(size_t)ks * (2 * 24 * 12288) + i];
          mod[i] = s; } }
    { float2* rb = (float2*)(a.ws() + WS_ROPEB); float2* rc = (float2*)(a.ws() + WS_ROPEC);
      for (int i = gt; i < 4096 * 24; i += NGT) { const int pos = i / 24, j = i % 24; const bool isb = j < 16; const int ii = isb ? j : j - 16; const double half = isb ? 16.0 : 8.0;
          const double inv = exp(-(double)ii / half * 13.122363377404328);
          const double rev = (double)pos * inv * 0.15915494309189535;
          const float fr = (float)(rev - floor(rev));
          const float2 v = make_float2(__builtin_amdgcn_cosf(fr), __builtin_amdgcn_sinf(fr));
          if (isb) rb[pos * 16 + ii] = v; else rc[pos * 8 + ii] = v; } }
    if (gt < 2) { const int l = gt; float s1 = 0.f, s2 = 0.f;
        for (int i = 0; i < 64; ++i) { s1 += a.in(I_LQ1)[l * 64 + i] * a.in(I_LK1)[l * 64 + i]; s2 += a.in(I_LQ2)[l * 64 + i] * a.in(I_LK2)[l * 64 + i]; }
        const float lam_init = 0.8f - 0.6f * expf(-0.3f * (float)l);
        ((float*)(a.ws() + WS_LAM))[l] = expf(s1) - expf(s2) + lam_init; }
    LAS float* scr = (LAS float*)(lds + RING_OFF + wave * 16384);
    const int gw = blockIdx.x * NWAVES + wave, NGW = G * NWAVES;
    constexpr int I_IN = 32 * 192, I_BA = 8 * 64, I_BB = 4 * 64, I_BC = 12 * 64, I_OU = 32 * 64, I_F1 = 32 * 256, I_F2 = 128 * 64;
    constexpr int PER_L = 2 * I_IN + I_BA + I_BB + I_BC + I_OU + I_F1 + I_F2;
    for (int it = gw; it < 2 * PER_L; it += NGW) {
        const int l = it / PER_L; int r = it % PER_L; unsigned char* wl = a.ws() + WS_W + (size_t)l * W_LAYER;
        if (r < I_IN) { p0_transpose_item(a.in(I_WIN) + (size_t)l * 2048 * 6144, 2048, 6144, (bf16*)(wl + WO_IG), 0, scr, r, lane); continue; } r -= I_IN;
        if (r < I_IN) { p0_transpose_item(a.in(I_WGATE) + (size_t)l * 2048 * 6144, 2048, 6144, (bf16*)(wl + WO_IG), 6144, scr, r, lane); continue; } r -= I_IN;
        if (r < I_BA) { p0_transpose_item(a.in(I_WBRA) + (size_t)l * 512 * 2048, 512, 2048, (bf16*)(wl + WO_BRA), 0, scr, r, lane); continue; } r -= I_BA;
        if (r < I_BB) { p0_transpose_item(a.in(I_WBRB) + (size_t)l * 256 * 2048, 256, 2048, (bf16*)(wl + WO_BRB), 0, scr, r, lane); continue; } r -= I_BB;
        if (r < I_BC) { p0_transpose_item(a.in(I_WBRC) + (size_t)l * 768 * 2048, 768, 2048, (bf16*)(wl + WO_BRC), 0, scr, r, lane); continue; } r -= I_BC;
        if (r < I_OU) { p0_transpose_item(a.in(I_WOUT) + (size_t)l * 2048 * 2048, 2048, 2048, (bf16*)(wl + WO_OUT), 0, scr, r, lane); continue; } r -= I_OU;
        if (r < I_F1) { p0_transpose_item(a.in(I_WFF1) + (size_t)l * 2048 * 8192, 2048, 8192, (bf16*)(wl + WO_FF1), 0, scr, r, lane); continue; } r -= I_F1;
        p0_transpose_item(a.in(I_WFF2) + (size_t)l * 8192 * 2048, 8192, 2048, (bf16*)(wl + WO_FF2), 0, scr, r, lane);
    }
}

__device__ __forceinline__ void phase_norm(const float* xsrc, const float* gn, const float* modl, int sh_off, int sc_off, int seq0, int tshift, bf16* H, int gw, int NGW, int lane) {
    for (int blk = gw; blk < CH / 8; blk += NGW) {
        const int r0 = blk * 8; const float* mo = modl + (size_t)(seq0 + (r0 >> tshift)) * 12288;
        f32x4 A[8], B[8];
#pragma unroll
        for (int j = 0; j < 8; ++j) { const int c = 4 * lane + 256 * j; const f32x4 g = *(const f32x4*)(gn + c), sc = *(const f32x4*)(mo + sc_off + c); A[j] = g * (1.0f + sc); B[j] = *(const f32x4*)(mo + sh_off + c); }
        for (int r = 0; r < 8; ++r) {
            const f32x4* xr = (const f32x4*)(xsrc + (size_t)(r0 + r) * 2048) + lane; f32x4 v[8]; float s = 0.f;
#pragma unroll
            for (int j = 0; j < 8; ++j) { v[j] = xr[64 * j]; s += (v[j].x * v[j].x + v[j].y * v[j].y) + (v[j].z * v[j].z + v[j].w * v[j].w); }
            const float rstd = rsqrtf(wave_sum(s) * (1.0f / 2048.0f) + EPS);
            v2u* o8 = (v2u*)(H + (size_t)(r0 + r) * 2048) + lane;
#pragma unroll
            for (int j = 0; j < 8; ++j) { const f32x4 o = v[j] * rstd * A[j] + B[j]; v2u w; w.x = pk2(o.x, o.y); w.y = pk2(o.z, o.w); o8[64 * j] = w; }
        }
    }
}
__device__ __forceinline__ int perm_tok(int p, int dsh, int Lsh) { return dsh == 0 ? p : (((p & ((1 << Lsh) - 1)) << dsh) + (p >> Lsh)); }
__device__ __forceinline__ void prep_qk_item(const bf16* Z, bf16* QK, const AL& a, int l, int item, int S, int tshift, int lane) {
    const int slot = item & 31, rb = item >> 5;
    int srccol, dstcol, dsh = 0, kind = 0; const float* gain; float scale = 1.f;
    if (slot < 4) { srccol = 128 * slot; dstcol = 128 * slot; gain = a.in(I_QNA) + l * 128; scale = QS128; }
    else if (slot < 8) { const int j = slot - 4; srccol = 512 + 128 * j; dstcol = 512 + 128 * j; gain = a.in(I_KNA) + l * 128; }
    else if (slot < 14) { const int j = slot - 8; srccol = 1536 + 128 * j; dstcol = 1024 + 128 * j; kind = 1; gain = a.in(I_QNB) + l * 128; scale = QS128; dsh = 2 * (j >> 1); }
    else if (slot < 20) { const int j = slot - 14; srccol = 2304 + 128 * j; dstcol = 1792 + 128 * j; kind = 1; gain = a.in(I_KNB) + l * 128; dsh = 2 * (j >> 1); }
    else if (slot < 26) { const int j = slot - 20; srccol = 3840 + 128 * j; dstcol = 2560 + 128 * j; kind = 2; gain = a.in(I_QNC) + l * 64; scale = QS64; }
    else { const int j = slot - 26; srccol = 4608 + 128 * j; dstcol = 3328 + 128 * j; kind = 2; gain = a.in(I_KNC) + l * 64; }
    const int sub = lane & 15, Lsh = tshift - dsh;
    float g[8];
#pragma unroll
    for (int e = 0; e < 8; ++e) g[e] = gain[((8 * sub) & (kind == 2 ? 63 : 127)) + e];
    const float2* ropeB = (const float2*)(a.ws() + WS_ROPEB); const float2* ropeC = (const float2*)(a.ws() + WS_ROPEC);
    for (int pass = 0; pass < 16; ++pass) {
        const int orow = rb * 64 + pass * 4 + (lane >> 4), sl = orow >> tshift, p = orow & (S - 1);
        const int t = perm_tok(p, dsh, Lsh);
        const v4u w = *(const v4u*)(Z + (size_t)((sl << tshift) + t) * 6144 + srccol + 8 * sub);
        float y[8] = {bflo(w.x), bfhi(w.x), bflo(w.y), bfhi(w.y), bflo(w.z), bfhi(w.z), bflo(w.w), bfhi(w.w)};
        float ss = 0.f;
#pragma unroll
        for (int e = 0; e < 8; ++e) ss += y[e] * y[e];
        ss += __shfl_xor(ss, 1); ss += __shfl_xor(ss, 2); ss += __shfl_xor(ss, 4);
        if (kind != 2) ss += __shfl_xor(ss, 8);
        const float rstd = rsqrtf(ss * (kind == 2 ? (1.0f / 64.0f) : (1.0f / 128.0f)) + EPS);
#pragma unroll
        for (int e = 0; e < 8; ++e) y[e] = y[e] * rstd * g[e];
        if (kind != 0) {
            const int RS = kind == 1 ? 2 : 1, subg = kind == 1 ? sub : (sub & 7);
            float pr[8];
#pragma unroll
            for (int e = 0; e < 8; ++e) pr[e] = __shfl_xor(y[e], RS);
            if (subg < 2 * RS) { const bool first = subg < RS; const int ib = 8 * (subg & (RS - 1));
                const float2* tab = kind == 1 ? ropeB + t * 16 + ib : ropeC + t * 8 + ib;
#pragma unroll
                for (int e = 0; e < 8; ++e) { const float2 cs = tab[e]; y[e] = first ? y[e] * cs.x - pr[e] * cs.y : y[e] * cs.x + pr[e] * cs.y; } }
        }
        v4u o; o.x = pk2(y[0] * scale, y[1] * scale); o.y = pk2(y[2] * scale, y[3] * scale); o.z = pk2(y[4] * scale, y[5] * scale); o.w = pk2(y[6] * scale, y[7] * scale);
        *(v4u*)(QK + (size_t)orow * 4096 + dstcol + 8 * sub) = o;
    }
}
__device__ __forceinline__ void prep_vt_item(const bf16* Z, bf16* VT, int item, int S, int tshift, LAS unsigned short* T, int lane) {
    const int dh = item & 1, vh = (item >> 1) & 15, pb = item >> 5;
    int srccol, dsh = 0;
    if (vh < 4) srccol = 1024 + 128 * vh; else if (vh < 10) { const int j = vh - 4; srccol = 3072 + 128 * j; dsh = 2 * (j >> 1); } else srccol = 5376 + 128 * (vh - 10);
    srccol += 64 * dh;
    const int o0 = pb * 64, sl = o0 >> tshift, p0 = o0 & (S - 1), Lsh = tshift - dsh;
#pragma unroll
    for (int pass = 0; pass < 8; ++pass) { const int i = pass * 8 + (lane >> 3), c8 = lane & 7, t = perm_tok(p0 + i, dsh, Lsh);
        const v4u w = *(const v4u*)(Z + (size_t)((sl << tshift) + t) * 6144 + srccol + 8 * c8);
        LAS unsigned short* tp = T + (8 * c8) * 68 + i;
        tp[0 * 68] = (unsigned short)(w.x & 0xffffu); tp[1 * 68] = (unsigned short)(w.x >> 16); tp[2 * 68] = (unsigned short)(w.y & 0xffffu); tp[3 * 68] = (unsigned short)(w.y >> 16);
        tp[4 * 68] = (unsigned short)(w.z & 0xffffu); tp[5 * 68] = (unsigned short)(w.z >> 16); tp[6 * 68] = (unsigned short)(w.w & 0xffffu); tp[7 * 68] = (unsigned short)(w.w >> 16); }
    LDS_WAIT(); asm volatile("" ::: "memory");
#pragma unroll
    for (int pass = 0; pass < 16; ++pass) { const int d = pass * 4 + (lane >> 4), c4 = lane & 15;
        const v2u v = *(const LAS v2u*)(T + d * 68 + 4 * c4);
        *(v2u*)(VT + (size_t)((sl * 16 + vh) * 128 + 64 * dh + d) * S + p0 + 4 * c4) = v; }
    LDS_WAIT(); asm volatile("" ::: "memory");
}
__device__ __forceinline__ void phase_prep(const AL& a, int l, LAS unsigned char* lds, int S, int tshift, int gw, int NGW, int wave, int lane) {
    const bf16* Z = (const bf16*)(a.ws() + A_Z); bf16* QK = (bf16*)(a.ws() + A_QK); bf16* VT = (bf16*)(a.ws() + A_VT);
    for (int it = gw; it < (CH / 64) * 32; it += NGW) prep_qk_item(Z, QK, a, l, it, S, tshift, lane);
    LAS unsigned short* T = (LAS unsigned short*)(lds + RING_OFF + wave * 16384);
    for (int it = gw; it < (CH / 64) * 32; it += NGW) prep_vt_item(Z, VT, it, S, tshift, T, lane);
}

namespace att {
#define MFMA32(a, b, c) __builtin_amdgcn_mfma_f32_32x32x16_bf16((a), (b), (c), 0, 0, 0)
__device__ __forceinline__ float ex2(float x) { return __builtin_amdgcn_exp2f(x); }
struct MaskNone { static constexpr bool MASKED = false; __device__ __forceinline__ float operator()(float v, int) const { return v; } };
struct MaskB { static constexpr bool MASKED = true; int dq;
    __device__ __forceinline__ float operator()(float v, int koff) const { const int d = dq + koff; return (d >= -64 && d <= 64) ? v : NEGB; } };
struct MaskA { static constexpr bool MASKED = true; const LAS float* brow; int kc0, qc, cs;
    __device__ __forceinline__ float operator()(float v, int koff) const { const int kc = kc0 + koff; int di = kc - qc + 15; di = di < 0 ? 0 : (di > 30 ? 30 : di);
        const float b = brow[di]; return (kc >= cs && kc < cs + 16) ? v + b : NEGB; } };

template <int NK, class MaskFn>
__device__ __forceinline__ void tile_step(const bf16* Kt, const bf16* VTt, int S, const bf16x8 (&qf)[NK], f32x16 (&o)[4], float& m, float& l, int lane, const MaskFn& mf) {
    const int r32 = lane & 31, hi = lane >> 5;
    const int pim = (r32 & 19) | ((r32 & 4) << 1) | ((r32 & 8) >> 1);
    const bf16* kp = Kt + (size_t)pim * 4096 + 8 * hi;
    bf16x8 kf[NK];
#pragma unroll
    for (int d0 = 0; d0 < NK; ++d0) kf[d0] = *(const bf16x8*)(kp + 16 * d0);
    bf16x8 vf[4][2];
    const bf16* vp = VTt + (size_t)r32 * S + 8 * hi;
#pragma unroll
    for (int db = 0; db < 4; ++db)
#pragma unroll
        for (int s2 = 0; s2 < 2; ++s2) vf[db][s2] = *(const bf16x8*)(vp + (size_t)(32 * db) * S + 16 * s2);
    f32x16 s;
#pragma unroll
    for (int r = 0; r < 16; ++r) s[r] = 0.f;
#pragma unroll
    for (int d0 = 0; d0 < NK; ++d0) s = MFMA32(kf[d0], qf[d0], s);
    float mx = NEGB;
#pragma unroll
    for (int r = 0; r < 16; ++r) { s[r] = mf(s[r], 16 * (r >> 3) + 8 * hi + (r & 7)); mx = fmaxf(mx, s[r]); }
    mx = fmaxf(mx, __shfl_xor(mx, 32));
    const float mn = fmaxf(m, mx), alpha = ex2(m - mn);
    float ps = 0.f;
#pragma unroll
    for (int r = 0; r < 16; ++r) { float p = ex2(s[r] - mn); if (MaskFn::MASKED) p = s[r] <= -1e29f ? 0.f : p; s[r] = p; ps += p; }
    l = l * alpha + ps; m = mn;
    if (!__all(alpha == 1.0f)) {
#pragma unroll
        for (int db = 0; db < 4; ++db)
#pragma unroll
            for (int r = 0; r < 16; ++r) o[db][r] *= alpha;
    }
    bf16x8 pf[2];
#pragma unroll
    for (int s2 = 0; s2 < 2; ++s2) { v4u w; w.x = pk2(s[8 * s2 + 0], s[8 * s2 + 1]); w.y = pk2(s[8 * s2 + 2], s[8 * s2 + 3]); w.z = pk2(s[8 * s2 + 4], s[8 * s2 + 5]); w.w = pk2(s[8 * s2 + 6], s[8 * s2 + 7]); pf[s2] = __builtin_bit_cast(bf16x8, w); }
#pragma unroll
    for (int db = 0; db < 4; ++db)
#pragma unroll
        for (int s2 = 0; s2 < 2; ++s2) o[db] = MFMA32(vf[db][s2], pf[s2], o[db]);
}
template <int NK> __device__ __forceinline__ void load_q(const bf16* Qp, bf16x8 (&qf)[NK], int lane) {
    const bf16* q = Qp + (size_t)(lane & 31) * 4096 + 8 * (lane >> 5);
#pragma unroll
    for (int d0 = 0; d0 < NK; ++d0) qf[d0] = *(const bf16x8*)(q + 16 * d0);
}
__device__ __forceinline__ void zero_o(f32x16 (&o)[4]) {
#pragma unroll
    for (int db = 0; db < 4; ++db)
#pragma unroll
        for (int r = 0; r < 16; ++r) o[db][r] = 0.f;
}
__device__ __forceinline__ void store_o_bf16(bf16* dst, const f32x16 (&o)[4], float inv, int hi) {
#pragma unroll
    for (int db = 0; db < 4; ++db)
#pragma unroll
        for (int g = 0; g < 4; ++g) { v2u w; w.x = pk2(o[db][4 * g] * inv, o[db][4 * g + 1] * inv); w.y = pk2(o[db][4 * g + 2] * inv, o[db][4 * g + 3] * inv);
            *(v2u*)(dst + 32 * db + 8 * g + 4 * hi) = w; }
}
__device__ __forceinline__ void store_o_f32(float* dst, const f32x16 (&o)[4], float inv, int hi) {
#pragma unroll
    for (int db = 0; db < 4; ++db)
#pragma unroll
        for (int g = 0; g < 4; ++g) { const f32x4 v = {o[db][4 * g] * inv, o[db][4 * g + 1] * inv, o[db][4 * g + 2] * inv, o[db][4 * g + 3] * inv};
            *(f32x4*)(dst + 32 * db + 8 * g + 4 * hi) = v; }
}
__device__ __forceinline__ void wave_c(const bf16* QK, const bf16* VT, float* CTMP, int sl, int map, int q0, int S, int tshift, int lane) {
    const size_t row0 = (size_t)sl << tshift; const int hi = lane >> 5;
    const bf16* Kp = QK + row0 * 4096 + 3328 + 64 * map;
    const bf16* Vp = VT + (size_t)((sl * 16 + 10 + (map >> 1)) * 128) * S;
    bf16x8 qf[4]; load_q<4>(QK + (row0 + q0) * 4096 + 2560 + 64 * map, qf, lane);
    f32x16 o[4]; zero_o(o); float m = NEGB, l = 0.f; const MaskNone mf;
    for (int kb = 0; kb < S; kb += 32) tile_step<4, MaskNone>(Kp + (size_t)kb * 4096, Vp + kb, S, qf, o, m, l, lane, mf);
    l += __shfl_xor(l, 32);
    store_o_f32(CTMP + (row0 + q0 + (lane & 31)) * 1536 + map * 128, o, 1.0f / l, hi);
}
__device__ __forceinline__ void wave_b(const bf16* QK, const bf16* VT, bf16* BTMP, float* BLSE, int sl, int slot, int p0, int S, int tshift, int lane) {
    const size_t row0 = (size_t)sl << tshift; const int hi = lane >> 5, dsh = 2 * (slot >> 1), Lsh = tshift - dsh;
    const bf16* Kp = QK + row0 * 4096 + 1792 + 128 * slot;
    const bf16* Vp = VT + (size_t)((sl * 16 + 4 + slot) * 128) * S;
    bf16x8 qf[8]; load_q<8>(QK + (row0 + p0) * 4096 + 1024 + 128 * slot, qf, lane);
    f32x16 o[4]; zero_o(o); float m = NEGB, l = 0.f;
    const int qp = p0 + (lane & 31);
#pragma unroll 1
    for (int ti = 0; ti < 5; ++ti) { const int kb = p0 - 64 + 32 * ti;
        if (kb < 0 || kb >= S || (kb >> Lsh) != (p0 >> Lsh)) continue;
        const MaskB mf{kb - qp};
        tile_step<8, MaskB>(Kp + (size_t)kb * 4096, Vp + kb, S, qf, o, m, l, lane, mf); }
    l += __shfl_xor(l, 32);
    const int t = perm_tok(qp, dsh, Lsh);
    store_o_bf16(BTMP + (row0 + t) * 768 + slot * 128, o, 1.0f / l, hi);
    if (hi == 0) BLSE[(row0 + t) * 8 + slot] = (__log2f(l) + m) * LN2;
}
__device__ __forceinline__ void wave_a(const bf16* QK, const bf16* VT, bf16* OA, const LAS float* btab, int sl, int h, int r, int qh, int S, int tshift, int lane) {
    const size_t row0 = (size_t)sl << tshift; const int hi = lane >> 5, rows = S >> 6;
    int rs = r - 4; rs = rs < 0 ? 0 : (rs > rows - 8 ? rows - 8 : rs);
    const bf16* Kp = QK + row0 * 4096 + 512 + 128 * h;
    const bf16* Vp = VT + (size_t)((sl * 16 + h) * 128) * S;
    const int q0 = r * 64 + 32 * qh, qc = 32 * qh + (lane & 31);
    int cs = qc - 8; cs = cs < 0 ? 0 : (cs > 48 ? 48 : cs);
    bf16x8 qf[8]; load_q<8>(QK + (row0 + q0) * 4096 + 128 * h, qf, lane);
    f32x16 o[4]; zero_o(o); float m = NEGB, l = 0.f;
#pragma unroll 1
    for (int ti = 0; ti < 16; ++ti) { const int j = ti >> 1, chh = ti & 1, kb = (rs + j) * 64 + 32 * chh;
        const MaskA mf{btab + (rs + j - r + 7) * 31, 32 * chh, qc, cs};
        tile_step<8, MaskA>(Kp + (size_t)kb * 4096, Vp + kb, S, qf, o, m, l, lane, mf); }
    l += __shfl_xor(l, 32);
    store_o_bf16(OA + (row0 + q0 + (lane & 31)) * 512 + h * 128, o, 1.0f / l, hi);
}
}

__device__ __forceinline__ void phase_attn(const AL& a, int l, LAS unsigned char* lds, int S, int tshift, int tid, int wave, int lane) {
    const bf16* QK = (const bf16*)(a.ws() + A_QK); const bf16* VT = (const bf16*)(a.ws() + A_VT);
    const int nqb = S >> 8, nseq = CH >> tshift;
    { float* CTMP = (float*)(a.ws() + A_CTMP);
      for (int u = blockIdx.x; u < nseq * 12 * nqb; u += gridDim.x) { const int qb = u % nqb, map = (u / nqb) % 12, sl = u / (nqb * 12);
          att::wave_c(QK, VT, CTMP, sl, map, qb * 256 + 32 * wave, S, tshift, lane); } }
    { bf16* OA = (bf16*)(a.ws() + A_OA); LAS float* btab = (LAS float*)(lds + RING_OFF);
      for (int u = blockIdx.x; u < nseq * 4 * nqb; u += gridDim.x) { const int qb = u % nqb, h = (u / nqb) % 4, sl = u / (nqb * 4);
          __syncthreads();
          for (int e = tid; e < 15 * 31; e += NWAVES * 64) btab[e] = a.in(I_RPB)[((size_t)(l * 4 + h) * 15) * 31 + e] * LOG2E;
          __syncthreads();
          att::wave_a(QK, VT, OA, btab, sl, h, 4 * qb + (wave >> 1), wave & 1, S, tshift, lane); } }
    { bf16* BTMP = (bf16*)(a.ws() + A_BTMP); float* BLSE = (float*)(a.ws() + A_BLSE);
      for (int u = blockIdx.x; u < nseq * 6 * nqb; u += gridDim.x) { const int pb = u % nqb, slot = (u / nqb) % 6, sl = u / (nqb * 6);
          att::wave_b(QK, VT, BTMP, BLSE, sl, slot, pb * 256 + 32 * wave, S, tshift, lane); } }
}
__device__ __forceinline__ void phase_combine(const AL& a, int l, int gw, int NGW, int lane) {
    const bf16* BTMP = (const bf16*)(a.ws() + A_BTMP); const float* BLSE = (const float*)(a.ws() + A_BLSE); const float* CTMP = (const float*)(a.ws() + A_CTMP);
    bf16* OB = (bf16*)(a.ws() + A_OB); bf16* OC = (bf16*)(a.ws() + A_OC);
    const float lam = ((const float*)(a.ws() + WS_LAM))[l], lam_init = 0.8f - 0.6f * expf(-0.3f * (float)l);
    const float* subln = a.in(I_SUBLN) + l * 128;
    const int sub = lane & 15, d0 = 8 * sub;
    for (int it = gw; it < (CH / 4) * 8; it += NGW) { const int slot = it & 7; const size_t row = (size_t)(it >> 3) * 4 + (lane >> 4);
        if (slot < 2) { const int hg = slot;
            const float l0 = BLSE[row * 8 + hg], l1 = BLSE[row * 8 + 2 + hg], l2 = BLSE[row * 8 + 4 + hg];
            const float mx = fmaxf(l0, fmaxf(l1, l2)); float w0 = __expf(l0 - mx), w1 = __expf(l1 - mx), w2 = __expf(l2 - mx);
            const float inv = 1.0f / (w0 + w1 + w2); w0 *= inv; w1 *= inv; w2 *= inv;
            const v4u a0 = *(const v4u*)(BTMP + row * 768 + (0 + hg) * 128 + d0), a1 = *(const v4u*)(BTMP + row * 768 + (2 + hg) * 128 + d0), a2 = *(const v4u*)(BTMP + row * 768 + (4 + hg) * 128 + d0);
            v4u o;
            o.x = pk2(w0 * bflo(a0.x) + w1 * bflo(a1.x) + w2 * bflo(a2.x), w0 * bfhi(a0.x) + w1 * bfhi(a1.x) + w2 * bfhi(a2.x));
            o.y = pk2(w0 * bflo(a0.y) + w1 * bflo(a1.y) + w2 * bflo(a2.y), w0 * bfhi(a0.y) + w1 * bfhi(a1.y) + w2 * bfhi(a2.y));
            o.z = pk2(w0 * bflo(a0.z) + w1 * bflo(a1.z) + w2 * bflo(a2.z), w0 * bfhi(a0.z) + w1 * bfhi(a1.z) + w2 * bfhi(a2.z));
            o.w = pk2(w0 * bflo(a0.w) + w1 * bflo(a1.w) + w2 * bflo(a2.w), w0 * bfhi(a0.w) + w1 * bfhi(a1.w) + w2 * bfhi(a2.w));
            *(v4u*)(OB + row * 256 + hg * 128 + d0) = o;
        } else { const int h = slot - 2;
            const float* p1 = CTMP + row * 1536 + (2 * h) * 128 + d0; const float* p2 = p1 + 128;
            const f32x4 x0 = *(const f32x4*)p1 - lam * *(const f32x4*)p2, x1 = *(const f32x4*)(p1 + 4) - lam * *(const f32x4*)(p2 + 4);
            float ss = (x0.x * x0.x + x0.y * x0.y) + (x0.z * x0.z + x0.w * x0.w) + (x1.x * x1.x + x1.y * x1.y) + (x1.z * x1.z + x1.w * x1.w);
            ss += __shfl_xor(ss, 1); ss += __shfl_xor(ss, 2); ss += __shfl_xor(ss, 4); ss += __shfl_xor(ss, 8);
            const float rstd = rsqrtf(ss * (1.0f / 128.0f) + EPS) * (1.0f - lam_init);
            const f32x4 g0 = *(const f32x4*)(subln + d0), g1 = *(const f32x4*)(subln + d0 + 4);
            v4u o; o.x = pk2(x0.x * rstd * g0.x, x0.y * rstd * g0.y); o.y = pk2(x0.z * rstd * g0.z, x0.w * rstd * g0.w);
            o.z = pk2(x1.x * rstd * g1.x, x1.y * rstd * g1.y); o.w = pk2(x1.z * rstd * g1.z, x1.w * rstd * g1.w);
            *(v4u*)(OC + row * 768 + h * 128 + d0) = o;
        }
    }
}
#define CHECK_HOOK(stage, c, l) do {} while (0)
#define CHECK_FINAL() do {} while (0)

#ifndef PHMASK
#define PHMASK 0xFFFF
#endif
#define PH(k) ((PHMASK >> (k)) & 1)
__global__ void __launch_bounds__(NWAVES * 64, 2) fwd(Args kargs) {
    extern __shared__ __attribute__((aligned(16))) unsigned char lds_raw[];
    LAS unsigned char* lds = (LAS unsigned char*)lds_raw;
    volatile LAS unsigned* MISC = (volatile LAS unsigned*)(lds + MISC_OFF);
    int tid = threadIdx.x, lane = tid & 63, wave = __builtin_amdgcn_readfirstlane(tid >> 6);
    for (int u = tid; u < (LDS_BYTES - LDSCTL_OFF) / 4; u += NWAVES * 64) ((LAS unsigned*)(lds + LDSCTL_OFF))[u] = 0u;
    __syncthreads();
    const AL a{};
    XcdBarrier bar = xcd_barrier_post((unsigned*)(a.ws() + WS_CTL) + CW_BAR, MISC + 8);
#define GRID_BAR() xcd_barrier(bar)
    int G = gridDim.x, bid = (int)blockIdx.x;
#define LAUNDER() do { asm volatile("" : "+s"(G), "+s"(bid)); tid = threadIdx.x; asm volatile("" : "+v"(tid)); lane = tid & 63; wave = __builtin_amdgcn_readfirstlane(tid >> 6); } while (0)
#define GW (bid * NWAVES + wave)
#define NGW_ (G * NWAVES)

    if (PH(0)) phase_modp(a, lds, tid, lane, wave);
    GRID_BAR();
    if (PH(1)) phase_pro2(a, lds, tid, lane, wave, G);
    GRID_BAR();
    CHECK_HOOK(0, 0, 0);

#pragma unroll 1
    for (int cl = 0; cl < NCHUNK * 2; ++cl) {
        int c = cl >> 1, l = cl & 1;
        asm volatile("" : "+s"(c), "+s"(l));
#define R0 (c * CH)
#define PROMPT (R0 < 32768)
#define S_ (PROMPT ? 4096 : 2048)
#define TSH (PROMPT ? 12 : 11)
#define SEQ0 (PROMPT ? (R0 >> 12) : 8 + ((R0 - 32768) >> 11))
#define XIN0 (PROMPT ? a.in(I_XP) + (size_t)R0 * DM : a.in(I_XS) + (size_t)(R0 - 32768) * DM)
#define XO (a.out() + (size_t)R0 * DM)
#define XCUR (l == 0 ? XIN0 : (const float*)XO)
#define MODL ((const float*)(a.ws() + WS_MOD) + (size_t)l * 24 * 12288)
#define WL (a.ws() + WS_W + (size_t)l * W_LAYER)
        if (PH(2)) { LAUNDER(); phase_norm(XCUR, a.in(I_N1G) + l * DM, MODL, 0, 2048, SEQ0, TSH, (bf16*)(a.ws() + A_H), GW, NGW_, lane); }
        GRID_BAR(); CHECK_HOOK(1, c, l);
        if (PH(3)) { LAUNDER(); unsigned char* ws = a.ws(); pg8::Gemm g{(const pg8::bf16_t*)(ws + A_H), (const pg8::bf16_t*)(WL + WO_IG), CH, 2 * INC, DM}; pg8::StaticOrder So; So.init(CH, 2 * INC, G, bid);
          pg8::EpiIn E{(pg8::bf16_t*)(ws + A_Z), (pg8::bf16_t*)(ws + A_G), a.in(I_BGATE) + l * INC};
          pg8::gemm_phase<pg8::EpiIn, pg8::StaticOrder, true, true>(lds + RING_OFF, g, So, E); }
        GRID_BAR(); CHECK_HOOK(2, c, l);
        if (PH(4)) { LAUNDER(); phase_prep(a, l, lds, S_, TSH, GW, NGW_, wave, lane); }
        GRID_BAR(); CHECK_HOOK(3, c, l);
        if (PH(5)) { LAUNDER(); phase_attn(a, l, lds, S_, TSH, tid, wave, lane); }
        GRID_BAR(); CHECK_HOOK(4, c, l);
        if (PH(6)) { LAUNDER(); phase_combine(a, l, GW, NGW_, lane); }
        GRID_BAR(); CHECK_HOOK(5, c, l);
        if (PH(7)) {
          { LAUNDER(); unsigned char* ws = a.ws(); pg8::StaticOrder So; So.init(CH, DM, G, bid);
            pg8::Gemm g{(const pg8::bf16_t*)(ws + A_OA), (const pg8::bf16_t*)(WL + WO_BRA), CH, DM, 512}; pg8::EpiBr<0> E{(float*)(ws + A_TMPF), (pg8::bf16_t*)(ws + A_H), (const pg8::bf16_t*)(ws + A_G), 0};
            pg8::gemm_phase<pg8::EpiBr<0>, pg8::StaticOrder, true, true>(lds + RING_OFF, g, So, E); }
          { LAUNDER(); unsigned char* ws = a.ws(); pg8::StaticOrder So; So.init(CH, DM, G, bid);
            pg8::Gemm g{(const pg8::bf16_t*)(ws + A_OB), (const pg8::bf16_t*)(WL + WO_BRB), CH, DM, 256}; pg8::EpiBr<1> E{(float*)(ws + A_TMPF), (pg8::bf16_t*)(ws + A_H), (const pg8::bf16_t*)(ws + A_G), 2048};
            pg8::gemm_phase<pg8::EpiBr<1>, pg8::StaticOrder, true, true>(lds + RING_OFF, g, So, E); }
          { LAUNDER(); unsigned char* ws = a.ws(); pg8::StaticOrder So; So.init(CH, DM, G, bid);
            pg8::Gemm g{(const pg8::bf16_t*)(ws + A_OC), (const pg8::bf16_t*)(WL + WO_BRC), CH, DM, 768}; pg8::EpiBr<2> E{(float*)(ws + A_TMPF), (pg8::bf16_t*)(ws + A_H), (const pg8::bf16_t*)(ws + A_G), 4096};
            pg8::gemm_phase<pg8::EpiBr<2>, pg8::StaticOrder, true, true>(lds + RING_OFF, g, So, E); } }
        GRID_BAR(); CHECK_HOOK(6, c, l);
        if (PH(8)) { LAUNDER(); unsigned char* ws = a.ws(); pg8::Gemm g{(const pg8::bf16_t*)(ws + A_H), (const pg8::bf16_t*)(WL + WO_OUT), CH, DM, DM}; pg8::StaticOrder So; So.init(CH, DM, G, bid);
          pg8::EpiRes E{XCUR, XO, MODL + 2 * 2048, SEQ0, TSH};
          pg8::gemm_phase<pg8::EpiRes, pg8::StaticOrder, true, true>(lds + RING_OFF, g, So, E); }
        GRID_BAR(); CHECK_HOOK(7, c, l);
        if (PH(9)) { LAUNDER(); phase_norm(XO, a.in(I_N2G) + l * DM, MODL, 3 * 2048, 4 * 2048, SEQ0, TSH, (bf16*)(a.ws() + A_H), GW, NGW_, lane); }
        GRID_BAR(); CHECK_HOOK(8, c, l);
        if (PH(10)) { LAUNDER(); unsigned char* ws = a.ws(); pg8::Gemm g{(const pg8::bf16_t*)(ws + A_H), (const pg8::bf16_t*)(WL + WO_FF1), CH, DFF, DM}; pg8::StaticOrder So; So.init(CH, DFF, G, bid);
          pg8::EpiRelu2 E{(pg8::bf16_t*)(ws + A_U), DFF};
          pg8::gemm_phase<pg8::EpiRelu2, pg8::StaticOrder, true, true>(lds + RING_OFF, g, So, E); }
        GRID_BAR(); CHECK_HOOK(9, c, l);
        if (PH(11)) { LAUNDER(); unsigned char* ws = a.ws(); pg8::Gemm g{(const pg8::bf16_t*)(ws + A_U), (const pg8::bf16_t*)(WL + WO_FF2), CH, DM, DFF}; pg8::StaticOrder So; So.init(CH, DM, G, bid);
          pg8::EpiRes E{XO, XO, MODL + 5 * 2048, SEQ0, TSH};
          pg8::gemm_phase<pg8::EpiRes, pg8::StaticOrder, true, true>(lds + RING_OFF, g, So, E); }
        GRID_BAR(); CHECK_HOOK(10, c, l);
    }
    CHECK_FINAL();
}

extern "C" void kernel_launch(void* const* d_in, const int* in_sizes, int n_in, void* d_out, int out_size, void* d_ws, size_t ws_size, hipStream_t stream) {
    static int grid = 0;
    if (grid == 0) {
        if (n_in != 29 || out_size != MTOT * DM || ws_size < WS_END) { fprintf(stderr, "kernel_launch: unexpected shapes (n_in %d out %d ws %zu need %zu)\n", n_in, out_size, ws_size, (size_t)WS_END); grid = -1; return; }
        int dev = 0, cus = 0, per_cu = 0;
        if (hipGetDevice(&dev) != hipSuccess || hipDeviceGetAttribute(&cus, hipDeviceAttributeMultiprocessorCount, dev) != hipSuccess) { grid = -1; return; }
        if (hipFuncSetAttribute((const void*)fwd, hipFuncAttributeMaxDynamicSharedMemorySize, LDS_BYTES) != hipSuccess) { grid = -1; return; }
        if (hipOccupancyMaxActiveBlocksPerMultiprocessor(&per_cu, (const void*)fwd, NWAVES * 64, LDS_BYTES) != hipSuccess || per_cu < 1) { fprintf(stderr, "kernel_launch: occupancy query says %d\n", per_cu); }
        (void)hipGetLastError();
        grid = cus;
    }
    if (grid < 0) return;
    if (hipMemsetAsync((char*)d_ws + WS_CTL, 0, CTL_ZERO_BYTES, stream) != hipSuccess) return;
    Args a{};
    for (int i = 0; i < 29; ++i) a.in[i] = (const float*)d_in[i];
    a.out = (float*)d_out; a.ws = (unsigned char*)d_ws;
    hipLaunchKernelGGL(fwd, dim3(grid), dim3(NWAVES * 64), LDS_BYTES, stream, a);
}
```

```cpp
#include <hip/hip_runtime.h>
#include <hip/hip_bf16.h>
#include <cstdio>
#include <cstdint>
#include <cmath>
namespace pg8 {
#define PG8_LAS __attribute__((address_space(3)))
typedef unsigned short bf16_t;
typedef short bf16x8 __attribute__((ext_vector_type(8)));
typedef float f32x4 __attribute__((ext_vector_type(4)));
typedef unsigned u32x4 __attribute__((ext_vector_type(4)));
constexpr int BM = 256, BK = 64, HALF = 128, HTB = HALF * BK * 2  , STAGE_BYTES = 8 * HTB, NXCD = 8, WGM = 8;

__host__ __device__ __forceinline__ int lds_byte(int r, int c) { const int st = (r >> 4) * 2 + (c >> 5), rr = r & 15, cc = c & 31, ob = rr * 64 + cc * 2; return st * 1024 + (ob ^ (((ob >> 9) & 1) << 5)); }
__host__ __device__ __forceinline__ void stage_rc(int b, int& R, int& C) { const int st = b / 1024, sb = b % 1024, swz = sb ^ (((sb >> 9) & 1) << 5); R = (st >> 1) * 16 + swz / 64; C = (st & 1) * 32 + (swz % 64) / 2; }
__host__ __device__ __forceinline__ int perm32(int rho) { const int n = rho >> 4, i = rho & 15; return 8 * (i >> 2) + 4 * n + (i & 3); }

struct Unit { int pm, pn; };
struct Gemm { const bf16_t* A; const bf16_t* Bt; int M, N, K; };

struct StaticOrder {
    int nM, nN, nwg, G, c;
    __host__ __device__ void init(int M, int N, int G_, int c_) { nM = M / BM; nN = N / BM; nwg = nM * nN; G = G_; c = c_; }
    __host__ __device__ bool next(int i, Unit& u) const {
        const long L = (long)i * G + c; if (L >= nwg) return false;
        int wgid = (int)L; { const int q = nwg / NXCD, r = nwg % NXCD, xcd = wgid % NXCD, off = wgid / NXCD; wgid = (xcd < r ? xcd * (q + 1) : r * (q + 1) + (xcd - r) * q) + off; }
        const int nig = WGM * nN, gid = wgid / nig, fm = gid * WGM, gsz = (nM - fm) < WGM ? (nM - fm) : WGM;
        u.pm = fm + ((wgid % nig) % gsz); u.pn = (wgid % nig) / gsz; return true;
    }
    __device__ __forceinline__ void a_ready(const Unit&) const {}
    __device__ __forceinline__ void done(const Unit&) const {}
};

typedef float f32x2 __attribute__((ext_vector_type(2)));
typedef __bf16 bf16x2v __attribute__((ext_vector_type(2)));
typedef unsigned u32x2 __attribute__((ext_vector_type(2)));
__device__ __forceinline__ unsigned cvt_pk_bf16(float lo, float hi) { f32x2 v = {lo, hi}; bf16x2v b = __builtin_convertvector(v, bf16x2v); return __builtin_bit_cast(unsigned, b); }
__device__ __forceinline__ float sigm(float x) { return __builtin_amdgcn_rcpf(1.0f + __expf(-x)); }

struct EpiIn {
    static constexpr bool PERM = true, AFTER_DRAIN = false;
    bf16_t* Z; bf16_t* G; const float* bgate;
    __device__ __forceinline__ void operator()(const f32x4 (&acc)[2][2][4][2], const Unit& u, int wr, int wc, int fr, int fq) const {
        const int row0 = u.pm * BM + wr * 64 + fr; const bool gate = u.pn >= 24;
        const int col0 = (gate ? u.pn - 24 : u.pn) * BM + wc * 32 + 8 * fq; bf16_t* base = gate ? G : Z;
        f32x4 bv[2][2];
#pragma unroll
        for (int bj = 0; bj < 2; ++bj)
#pragma unroll
            for (int n = 0; n < 2; ++n) bv[bj][n] = gate ? *(const f32x4*)(bgate + col0 + bj * HALF + 4 * n) : (f32x4){0.f, 0.f, 0.f, 0.f};
#pragma unroll
        for (int ai = 0; ai < 2; ++ai)
#pragma unroll
            for (int m = 0; m < 4; ++m) { bf16_t* rowp = base + (size_t)(row0 + ai * HALF + m * 16) * 6144 + col0;
#pragma unroll
                for (int bj = 0; bj < 2; ++bj) { f32x4 v0 = acc[ai][bj][m][0] + bv[bj][0], v1 = acc[ai][bj][m][1] + bv[bj][1];
                    if (gate) { v0 = (f32x4){sigm(v0[0]), sigm(v0[1]), sigm(v0[2]), sigm(v0[3])}; v1 = (f32x4){sigm(v1[0]), sigm(v1[1]), sigm(v1[2]), sigm(v1[3])}; }
                    u32x4 w; w.x = cvt_pk_bf16(v0[0], v0[1]); w.y = cvt_pk_bf16(v0[2], v0[3]); w.z = cvt_pk_bf16(v1[0], v1[1]); w.w = cvt_pk_bf16(v1[2], v1[3]);
                    *(u32x4*)(rowp + bj * HALF) = w; } }
    }
};
struct EpiRelu2 {
    static constexpr bool PERM = true, AFTER_DRAIN = false;
    bf16_t* O; int ldc;
    __device__ __forceinline__ void operator()(const f32x4 (&acc)[2][2][4][2], const Unit& u, int wr, int wc, int fr, int fq) const {
        const int row0 = u.pm * BM + wr * 64 + fr, col0 = u.pn * BM + wc * 32 + 8 * fq;
#pragma unroll
        for (int ai = 0; ai < 2; ++ai)
#pragma unroll
            for (int m = 0; m < 4; ++m) { bf16_t* rowp = O + (size_t)(row0 + ai * HALF + m * 16) * ldc + col0;
#pragma unroll
                for (int bj = 0; bj < 2; ++bj) { f32x4 v0 = acc[ai][bj][m][0], v1 = acc[ai][bj][m][1];
#pragma unroll
                    for (int e = 0; e < 4; ++e) { const float a0 = v0[e] > 0.f ? v0[e] : 0.f, a1 = v1[e] > 0.f ? v1[e] : 0.f; v0[e] = a0 * a0; v1[e] = a1 * a1; }
                    u32x4 w; w.x = cvt_pk_bf16(v0[0], v0[1]); w.y = cvt_pk_bf16(v0[2], v0[3]); w.z = cvt_pk_bf16(v1[0], v1[1]); w.w = cvt_pk_bf16(v1[2], v1[3]);
                    *(u32x4*)(rowp + bj * HALF) = w; } }
    }
};
struct EpiRes {
    static constexpr bool PERM = false, AFTER_DRAIN = false;
    const float* xin; float* xout; const float* gbase; int seq0, tshift;
    __device__ __forceinline__ void operator()(const f32x4 (&acc)[2][2][4][2], const Unit& u, int wr, int wc, int fr, int fq) const {
        const int row0 = u.pm * BM + wr * 64 + fr, col0 = u.pn * BM + wc * 32 + 4 * fq;
        const float* gp = gbase + (size_t)(seq0 + ((u.pm * BM) >> tshift)) * 12288 + col0;
        f32x4 gv[2][2];
#pragma unroll
        for (int bj = 0; bj < 2; ++bj)
#pragma unroll
            for (int n = 0; n < 2; ++n) gv[bj][n] = *(const f32x4*)(gp + bj * HALF + n * 16);
#pragma unroll
        for (int ai = 0; ai < 2; ++ai)
#pragma unroll
            for (int m = 0; m < 4; ++m) { const size_t off = (size_t)(row0 + ai * HALF + m * 16) * 2048 + col0;
#pragma unroll
                for (int bj = 0; bj < 2; ++bj)
#pragma unroll
                    for (int n = 0; n < 2; ++n) { const f32x4 xi = *(const f32x4*)(xin + off + bj * HALF + n * 16);
                        *(f32x4*)(xout + off + bj * HALF + n * 16) = xi + gv[bj][n] * acc[ai][bj][m][n]; } }
    }
};
template <int MODE> struct EpiBr {
    static constexpr bool PERM = false, AFTER_DRAIN = false;
    float* T; bf16_t* MRG; const bf16_t* Gt; int gcol0;
    __device__ __forceinline__ void operator()(const f32x4 (&acc)[2][2][4][2], const Unit& u, int wr, int wc, int fr, int fq) const {
        const int row0 = u.pm * BM + wr * 64 + fr, col0 = u.pn * BM + wc * 32 + 4 * fq;
#pragma unroll
        for (int ai = 0; ai < 2; ++ai)
#pragma unroll
            for (int m = 0; m < 4; ++m) { const size_t row = (size_t)(row0 + ai * HALF + m * 16);
#pragma unroll
                for (int bj = 0; bj < 2; ++bj)
#pragma unroll
                    for (int n = 0; n < 2; ++n) { const int col = col0 + bj * HALF + n * 16;
                        const u32x2 gw = *(const u32x2*)(Gt + row * 6144 + gcol0 + col);
                        const f32x4 g = {__uint_as_float(gw.x << 16), __uint_as_float(gw.x & 0xffff0000u), __uint_as_float(gw.y << 16), __uint_as_float(gw.y & 0xffff0000u)};
                        f32x4 v = g * acc[ai][bj][m][n];
                        if (MODE >= 1) v = v + *(const f32x4*)(T + row * 2048 + col);
                        if (MODE <= 1) *(f32x4*)(T + row * 2048 + col) = v;
                        else { u32x2 w; w.x = cvt_pk_bf16(v[0], v[1]); w.y = cvt_pk_bf16(v[2], v[3]); *(u32x2*)(MRG + row * 2048 + col) = w; } } }
    }
};

template <class Epi, class Sched, bool ALIGN_EPI = false, bool SP2 = false>
__device__ __forceinline__ void gemm_phase(PG8_LAS unsigned char* lds, const Gemm g, const Sched& S, const Epi& E) {
    int tid_ = threadIdx.x; asm volatile("" : "+v"(tid_));
    const int tid = tid_, wid = __builtin_amdgcn_readfirstlane(tid >> 6), lane = tid & 63, wr = wid >> 2, wc = wid & 3, fr = lane & 15, fq = lane >> 4;
    const int K = g.K, nt = K / BK;
    unsigned voffA[2], voffB[2];
#pragma unroll
    for (int i = 0; i < 2; ++i) { int R, C; stage_rc(tid * 16 + i * 8192, R, C); const int Rb = Epi::PERM ? ((R & ~31) + perm32(R & 31)) : R;
        voffA[i] = (unsigned)(R * K + C) * 2u; voffB[i] = (unsigned)(Rb * K + C) * 2u; }
    const size_t kstep = (size_t)(BK * 2);
    const size_t hstep = (size_t)HALF * K * 2;
    const size_t tstep = 2 * hstep;
    const unsigned ldsw = (unsigned)wid * 1024u;
    const int aoff = lds_byte(wr * 64 + fr, fq * 8), boff = lds_byte(wc * 32 + fr, fq * 8);
#define PG8_SA(b, h) (((b) * 2 + (h)) * HTB)
#define PG8_SB(b, h) ((4 + (b) * 2 + (h)) * HTB)
#define PG8_STAGE(bufoff, gbase, voff) do { _Pragma("unroll") for (int _i = 0; _i < 2; ++_i) \
        __builtin_amdgcn_global_load_lds((const unsigned*)((const char*)(gbase) + (voff)[_i]), (PG8_LAS unsigned*)(lds + (bufoff) + ldsw + _i * 8192), 16, 0, 0); } while (0)
#define PG8_LDA(dst, b, h) do { _Pragma("unroll") for (int m = 0; m < 4; ++m) _Pragma("unroll") for (int k = 0; k < 2; ++k) dst[m][k] = *(const PG8_LAS bf16x8*)(lds + PG8_SA(b, h) + aoff + m * 2048 + k * 1024); } while (0)
#define PG8_LDB(dst, b, h) do { _Pragma("unroll") for (int n = 0; n < 2; ++n) _Pragma("unroll") for (int k = 0; k < 2; ++k) dst[n][k] = *(const PG8_LAS bf16x8*)(lds + PG8_SB(b, h) + boff + n * 2048 + k * 1024); } while (0)
#define PG8_MMA(ai, bj, At, Bt) do { __builtin_amdgcn_s_setprio(1); _Pragma("unroll") for (int m = 0; m < 4; ++m) _Pragma("unroll") for (int n = 0; n < 2; ++n) _Pragma("unroll") for (int k = 0; k < 2; ++k) \
        acc[ai][bj][m][n] = __builtin_amdgcn_mfma_f32_16x16x32_bf16(Bt[n][k], At[m][k], acc[ai][bj][m][n], 0, 0, 0); __builtin_amdgcn_s_setprio(0); } while (0)
#define PG8_WAIT_V(n) asm volatile("s_waitcnt vmcnt(" #n ")" ::: "memory")
#define PG8_WAIT_L(n) asm volatile("s_waitcnt lgkmcnt(" #n ")" ::: "memory")
#define PG8_BAR __builtin_amdgcn_s_barrier()
#define PG8_SCHED __builtin_amdgcn_sched_barrier(0)
    Unit cur, nxt; int ui = 0;
    if (!S.next(0, cur)) return;
    f32x4 acc[2][2][4][2];
#pragma unroll
    for (int a = 0; a < 2; ++a)
#pragma unroll
        for (int b = 0; b < 2; ++b)
#pragma unroll
            for (int m = 0; m < 4; ++m)
#pragma unroll
                for (int n = 0; n < 2; ++n) acc[a][b][m][n] = (f32x4){0.f, 0.f, 0.f, 0.f};
    bf16x8 At[4][2], B0[2][2], B1[2][2];
    const char* cA = (const char*)g.A + (size_t)cur.pm * tstep; const char* cB = (const char*)g.Bt + (size_t)cur.pn * tstep;
    S.a_ready(cur);
    if constexpr (SP2) {
        PG8_STAGE(PG8_SB(0, 0), cB, voffB); PG8_STAGE(PG8_SB(0, 1), cB + hstep, voffB); PG8_STAGE(PG8_SA(0, 0), cA, voffA); PG8_STAGE(PG8_SA(0, 1), cA + hstep, voffA);
        if (wr == 1) PG8_BAR;
        PG8_WAIT_V(2); PG8_BAR;
        PG8_STAGE(PG8_SB(1, 0), cB + kstep, voffB); PG8_STAGE(PG8_SA(1, 0), cA + kstep, voffA); PG8_STAGE(PG8_SB(1, 1), cB + hstep + kstep, voffB);
        PG8_WAIT_V(6); PG8_BAR;
    } else {
        PG8_STAGE(PG8_SB(0, 0), cB, voffB); PG8_STAGE(PG8_SA(0, 0), cA, voffA); PG8_STAGE(PG8_SB(0, 1), cB + hstep, voffB); PG8_STAGE(PG8_SA(0, 1), cA + hstep, voffA);
        if (wr == 1) PG8_BAR;
        PG8_WAIT_V(4); PG8_BAR;
        PG8_STAGE(PG8_SB(1, 0), cB + kstep, voffB); PG8_STAGE(PG8_SA(1, 0), cA + kstep, voffA); PG8_STAGE(PG8_SB(1, 1), cB + hstep + kstep, voffB);
        PG8_WAIT_V(6); PG8_BAR;
    }
    for (;;) {
        const bool has_next = S.next(ui + 1, nxt);
        const char* nA = has_next ? (const char*)g.A + (size_t)nxt.pm * tstep : cA; const char* nB = has_next ? (const char*)g.Bt + (size_t)nxt.pn * tstep : cB;
#pragma unroll 1
        for (int t = 0; t < nt; t += 2) {
            const bool last = (t == nt - 2);
            const char* a1 = cA + (size_t)(t + 1) * kstep;
            const char* a2 = last ? nA : cA + (size_t)(t + 2) * kstep; const char* b2 = last ? nB : cB + (size_t)(t + 2) * kstep;
            const char* a3 = a2 + kstep; const char* b3 = b2 + kstep;
            if (last && has_next) S.a_ready(nxt);
            if constexpr (SP2) {
            PG8_LDB(B0, 0, 0); PG8_LDB(B1, 0, 1); PG8_SCHED; PG8_LDA(At, 0, 0); PG8_STAGE(PG8_SA(1, 1), a1 + hstep, voffA);
            PG8_WAIT_V(8); PG8_WAIT_L(0); PG8_BAR; PG8_MMA(0, 0, At, B0); PG8_MMA(0, 1, At, B1); PG8_BAR; PG8_SCHED;
            PG8_LDA(At, 0, 1); PG8_STAGE(PG8_SB(0, 0), b2, voffB); PG8_STAGE(PG8_SB(0, 1), b2 + hstep, voffB); PG8_STAGE(PG8_SA(0, 0), a2, voffA);
            PG8_WAIT_V(8); PG8_WAIT_L(0); PG8_BAR; PG8_MMA(1, 0, At, B0); PG8_MMA(1, 1, At, B1); PG8_BAR; PG8_SCHED;
            PG8_LDB(B0, 1, 0); PG8_LDB(B1, 1, 1); PG8_SCHED; PG8_LDA(At, 1, 0); PG8_STAGE(PG8_SA(0, 1), a2 + hstep, voffA);
            PG8_WAIT_V(8); PG8_WAIT_L(0); PG8_BAR; PG8_MMA(0, 0, At, B0); PG8_MMA(0, 1, At, B1); PG8_BAR; PG8_SCHED;
            PG8_LDA(At, 1, 1); PG8_STAGE(PG8_SB(1, 0), b3, voffB); PG8_STAGE(PG8_SB(1, 1), b3 + hstep, voffB); PG8_STAGE(PG8_SA(1, 0), a3, voffA);
            PG8_WAIT_V(8); PG8_WAIT_L(0); PG8_BAR; PG8_MMA(1, 0, At, B0); PG8_MMA(1, 1, At, B1); PG8_BAR; PG8_SCHED;
            } else {
            PG8_LDB(B0, 0, 0); PG8_SCHED; PG8_LDA(At, 0, 0); PG8_STAGE(PG8_SA(1, 1), a1 + hstep, voffA);
            PG8_WAIT_L(8); PG8_BAR; PG8_WAIT_L(0); PG8_MMA(0, 0, At, B0); PG8_BAR; PG8_SCHED;
            PG8_LDB(B1, 0, 1); PG8_STAGE(PG8_SB(0, 0), b2, voffB);
            PG8_BAR; PG8_WAIT_L(0); PG8_MMA(0, 1, At, B1); PG8_BAR;
            PG8_LDA(At, 0, 1); PG8_STAGE(PG8_SA(0, 0), a2, voffA);
            PG8_BAR; PG8_WAIT_L(0); PG8_MMA(1, 0, At, B0); PG8_BAR; PG8_SCHED;
            PG8_STAGE(PG8_SB(0, 1), b2 + hstep, voffB);
            PG8_WAIT_V(6); PG8_BAR; PG8_MMA(1, 1, At, B1); PG8_BAR;
            PG8_LDB(B0, 1, 0); PG8_SCHED; PG8_LDA(At, 1, 0); PG8_STAGE(PG8_SA(0, 1), a2 + hstep, voffA);
            PG8_WAIT_L(8); PG8_BAR; PG8_WAIT_L(0); PG8_MMA(0, 0, At, B0); PG8_BAR; PG8_SCHED;
            PG8_LDB(B1, 1, 1); PG8_STAGE(PG8_SB(1, 0), b3, voffB);
            PG8_BAR; PG8_WAIT_L(0); PG8_MMA(0, 1, At, B1); PG8_BAR;
            PG8_LDA(At, 1, 1); PG8_STAGE(PG8_SA(1, 0), a3, voffA);
            PG8_BAR; PG8_WAIT_L(0); PG8_MMA(1, 0, At, B0); PG8_BAR; PG8_SCHED;
            PG8_STAGE(PG8_SB(1, 1), b3 + hstep, voffB);
            PG8_WAIT_V(6); PG8_BAR; PG8_MMA(1, 1, At, B1); PG8_BAR;
            }
        }
        if constexpr (ALIGN_EPI) { if (wr == 0) PG8_BAR; }
        if constexpr (!Epi::AFTER_DRAIN) { E(acc, cur, wr, wc, fr, fq); S.done(cur); }
        if (!has_next) break;
#pragma unroll
        for (int a = 0; a < 2; ++a)
#pragma unroll
            for (int b = 0; b < 2; ++b)
#pragma unroll
                for (int m = 0; m < 4; ++m)
#pragma unroll
                    for (int n = 0; n < 2; ++n) acc[a][b][m][n] = (f32x4){0.f, 0.f, 0.f, 0.f};
        cur = nxt; cA = nA; cB = nB; ++ui;
        if constexpr (ALIGN_EPI) { if (wr == 1) PG8_BAR; }
    }
    PG8_WAIT_V(0);
    if constexpr (!ALIGN_EPI) { if (wr == 0) PG8_BAR; }
    PG8_BAR;
    if constexpr (Epi::AFTER_DRAIN) { E.fused(acc, cur, wr, wc, fr, fq, lds, wid, lane); S.done(cur); }
#undef PG8_SA
#undef PG8_SB
#undef PG8_STAGE
#undef PG8_LDA
#undef PG8_LDB
#undef PG8_MMA
#undef PG8_WAIT_V
#undef PG8_WAIT_L
#undef PG8_BAR
#undef PG8_SCHED
}
}

constexpr int NWAVES = 8;
constexpr int DM = 2048, NSEQ = 24, MTOT = 65536, DFF = 8192, INC = 6144;
#ifndef MK_CH
#define MK_CH 16384
#endif
constexpr int CH = MK_CH;
constexpr int NCHUNK = MTOT / CH;
constexpr float EPS = 1e-6f, LOG2E = 1.4426950408889634f, LN2 = 0.6931471805599453f;
constexpr float QS128 = 0.08838834764831845f * LOG2E, QS64 = 0.125f * LOG2E;
constexpr float NEGB = -1e30f;

constexpr size_t MiB = 1u << 20;
constexpr size_t WS_CTL = 0, CTL_ZERO_BYTES = 1 * MiB;
constexpr size_t WS_MOD = 1 * MiB;
constexpr size_t WS_ROPEB = 4 * MiB, WS_ROPEC = WS_ROPEB + 512 * 1024;
constexpr size_t WS_LAM = 5 * MiB;
constexpr size_t WS_MODP = 6 * MiB;
constexpr size_t WS_W = 48 * MiB, W_LAYER = 126 * MiB;
constexpr size_t WO_IG = 0, WO_BRA = 48 * MiB, WO_BRB = 50 * MiB, WO_BRC = 51 * MiB, WO_OUT = 54 * MiB, WO_FF1 = 62 * MiB, WO_FF2 = 94 * MiB;
constexpr size_t WS_ACT = 304 * MiB;
constexpr size_t CHS = (size_t)CH;
constexpr size_t A_H = WS_ACT;
constexpr size_t A_Z = A_H + CHS * 2048 * 2;
constexpr size_t A_QK = A_Z + CHS * 6144 * 2;
constexpr size_t A_VT = A_QK + CHS * 4096 * 2;
constexpr size_t A_G = A_VT + CHS * 2048 * 2;
constexpr size_t A_OA = A_G + CHS * 6144 * 2;
constexpr size_t A_OB = A_OA + CHS * 512 * 2;
constexpr size_t A_OC = A_OB + CHS * 256 * 2;
constexpr size_t WS_END = A_OC + CHS * 768 * 2;
constexpr size_t A_BTMP = A_Z;
constexpr size_t A_BLSE = A_BTMP + CHS * 768 * 2;
constexpr size_t A_CTMP = A_BLSE + CHS * 8 * 4;
static_assert(A_CTMP + CHS * 1536 * 4 <= A_QK, "attention temporaries fit in Z");
constexpr size_t A_TMPF = A_QK;
constexpr size_t A_U = A_Z;
static_assert(CHS * 8192 * 2 <= (A_VT - A_Z), "u fits in Z + QK");
constexpr int CW_BAR = 4096;
constexpr int CW_CHK = 65536;

constexpr int RING_OFF = 0, RING_BYTES = 131072;
constexpr int LDSCTL_OFF = RING_BYTES, MISC_OFF = LDSCTL_OFF + 320;
constexpr int LDS_BYTES = 147456;

#define GAS __attribute__((address_space(1)))
#define LAS __attribute__((address_space(3)))
typedef unsigned short bf16;
typedef unsigned v4u __attribute__((ext_vector_type(4)));
typedef unsigned v2u __attribute__((ext_vector_type(2)));
typedef float f32x4 __attribute__((ext_vector_type(4)));
typedef float f32x16 __attribute__((ext_vector_type(16)));
typedef short bf16x8 __attribute__((ext_vector_type(8)));
typedef GAS unsigned gu32;
#define LDS_WAIT() asm volatile("s_waitcnt lgkmcnt(0)" ::: "memory")
#define VM_WAIT() asm volatile("s_waitcnt vmcnt(0)" ::: "memory")
__device__ __forceinline__ unsigned pk2(float lo, float hi) { return pg8::cvt_pk_bf16(lo, hi); }
__device__ __forceinline__ float bflo(unsigned w) { return __uint_as_float(w << 16); }
__device__ __forceinline__ float bfhi(unsigned w) { return __uint_as_float(w & 0xffff0000u); }
__device__ __forceinline__ float bf1(bf16 b) { return __uint_as_float((unsigned)b << 16); }
__device__ __forceinline__ float wave_sum(float v) {
#pragma unroll
    for (int o = 1; o < 64; o <<= 1) v += __shfl_xor(v, o);
    return v;
}
#define XB_TMO      128
#define XB_XCNT(j)  (256  + 64 * (j))
#define XB_XSUB(j)  (1280 + 64 * (j))
#define XB_XGEN(j)  (2304 + 64 * (j))
#define XB_TOP      3328
#define XB_TOPGEN   3392
#define XCD_BAR_WORDS 3456
#define XB_SPIN_CAP (1u << 18)

__device__ __forceinline__ unsigned xb_ld(unsigned* p)              { return __hip_atomic_load(p, __ATOMIC_RELAXED, __HIP_MEMORY_SCOPE_AGENT); }
__device__ __forceinline__ unsigned xb_add(unsigned* p, unsigned v) { return __hip_atomic_fetch_add(p, v, __ATOMIC_RELAXED, __HIP_MEMORY_SCOPE_AGENT); }
__device__ __forceinline__ unsigned xb_xcc_id() { return (unsigned)__builtin_amdgcn_s_getreg((3 << 11) | 20) & 0xFu; }
#define XB_SPIN(cond, bar) do { unsigned _sp = 0; while (cond) { __builtin_amdgcn_s_sleep(1); \
    if ((++_sp & 255u) == 0u) { if (xb_ld(&(bar)[XB_TMO])) break; if (_sp > XB_SPIN_CAP) { atomicAdd(&(bar)[XB_TMO], 1u); break; } } } } while (0)

struct XcdBarrier {
    unsigned* bar; unsigned x;
    volatile LAS unsigned* st;
};

__device__ __forceinline__ XcdBarrier xcd_barrier_post(unsigned* bar, volatile LAS unsigned* st) {
    XcdBarrier b; b.bar = bar; b.x = xb_xcc_id(); b.st = st;
    if (threadIdx.x == 0) (void)xb_add(&bar[XB_XCNT(b.x)], 1u);
    return b;
}
__device__ __forceinline__ void xcd_barrier_complete(unsigned* bar, unsigned x, unsigned& nloc, unsigned& nx) {
    const unsigned G = gridDim.x * gridDim.y * gridDim.z;
    unsigned sum, cnt, mine, sp = 0u;
    for (;;) {
        sum = 0u; cnt = 0u; mine = 0u;
#pragma unroll
        for (unsigned j = 0; j < 16; ++j) { const unsigned c = xb_ld(&bar[XB_XCNT(j)]); sum += c; cnt += (c > 0u) ? 1u : 0u; mine = (j == x) ? c : mine; }
        if (sum == G) break;
        __builtin_amdgcn_s_sleep(1);
        if ((++sp & 255u) == 0u) { if (xb_ld(&bar[XB_TMO])) break; if (sp > XB_SPIN_CAP) { atomicAdd(&bar[XB_TMO], 1u); break; } }
    }
    nloc = mine > 0u ? mine : 1u; nx = cnt > 0u ? cnt : 1u;
}

__device__ __forceinline__ void xcd_barrier(const XcdBarrier& b) {
    asm volatile("s_waitcnt vmcnt(0)" ::: "memory");
    __syncthreads();
    if (threadIdx.x == 0) {
        unsigned* bar = b.bar;
        __builtin_amdgcn_s_waitcnt(0);
        unsigned nloc = b.st[0], nx = b.st[1];
        if (nloc == 0u) { xcd_barrier_complete(bar, b.x, nloc, nx); b.st[0] = nloc; b.st[1] = nx; }
        const unsigned old = xb_add(&bar[XB_XSUB(b.x)], 1u);
        const unsigned gen = old / nloc;
        if (old + 1u == (gen + 1u) * nloc) {
            __builtin_amdgcn_fence(__ATOMIC_RELEASE, "agent");
            asm volatile("s_waitcnt vmcnt(0)" ::: "memory");
            const unsigned og = xb_add(&bar[XB_TOP], 1u);
            const unsigned tg = og / nx;
            if (og + 1u == (tg + 1u) * nx) xb_add(&bar[XB_TOPGEN], 1u);
            else XB_SPIN(xb_ld(&bar[XB_TOPGEN]) == tg, bar);
            __builtin_amdgcn_fence(__ATOMIC_ACQUIRE, "agent");
            xb_add(&bar[XB_XGEN(b.x)], 1u);
            asm volatile("s_waitcnt vmcnt(0)" ::: "memory");
        } else {
            XB_SPIN(xb_ld(&bar[XB_XGEN(b.x)]) == gen, bar);
            __builtin_amdgcn_fence(__ATOMIC_ACQUIRE, "agent");
            asm volatile("s_waitcnt vmcnt(0)" ::: "memory");
        }
    }
    __syncthreads();
}

struct Args { const float* in[29]; float* out; unsigned char* ws; };
typedef const __attribute__((address_space(4))) unsigned long long* kargp_t;
struct AL {
    __device__ __forceinline__ static kargp_t kp() { kargp_t p = (kargp_t)__builtin_amdgcn_kernarg_segment_ptr(); asm volatile("" : "+s"(p)); return p; }
    __device__ __forceinline__ const float* in(int i) const { return (const float*)kp()[i]; }
    __device__ __forceinline__ float* out() const { return (float*)kp()[29]; }
    __device__ __forceinline__ unsigned char* ws() const { return (unsigned char*)kp()[30]; } };
enum { I_XP = 0, I_XS, I_CP, I_CS, I_N1G, I_WADA, I_BADA, I_WIN, I_QNA, I_KNA, I_RPB, I_QNB, I_KNB, I_QNC, I_KNC, I_LQ1, I_LK1, I_LQ2, I_LK2, I_SUBLN,
       I_WBRA, I_WBRB, I_WBRC, I_WGATE, I_BGATE, I_WOUT, I_N2G, I_WFF1, I_WFF2 };

__device__ __forceinline__ void phase_modp(const AL& a, LAS unsigned char* lds, int tid, int lane, int wave) {
    LAS float* sil = (LAS float*)lds;
    const float* wada = a.in(I_WADA); float* modp = (float*)(a.ws() + WS_MODP);
    for (int it = blockIdx.x; it < 256; it += gridDim.x) {
        const int l = it >> 7, ks = (it >> 3) & 15, cg = it & 7, k0 = ks * 128;
        for (int e = tid; e < 24 * 128; e += NWAVES * 64) { const int b = e >> 7, kk = e & 127;
            const float c = b < 8 ? a.in(I_CP)[b * 2048 + k0 + kk] : a.in(I_CS)[(b - 8) * 2048 + k0 + kk];
            sil[e] = c / (1.0f + __expf(-c)); }
        __syncthreads();
        const int n0 = cg * 1536 + wave * 192 + 3 * lane;
        float acc[24][3];
#pragma unroll
        for (int b = 0; b < 24; ++b) { acc[b][0] = 0.f; acc[b][1] = 0.f; acc[b][2] = 0.f; }
        const float* wp = wada + ((size_t)l * 2048 + k0) * 12288 + n0;
#pragma unroll 4
        for (int kk = 0; kk < 128; ++kk) {
            const float w0 = wp[(size_t)kk * 12288], w1 = wp[(size_t)kk * 12288 + 1], w2 = wp[(size_t)kk * 12288 + 2];
#pragma unroll
            for (int b = 0; b < 24; ++b) { const float s = sil[b * 128 + kk]; acc[b][0] += s * w0; acc[b][1] += s * w1; acc[b][2] += s * w2; }
        }
#pragma unroll
        for (int b = 0; b < 24; ++b) { float* o = modp + ((size_t)(ks * 2 + l) * 24 + b) * 12288 + n0; o[0] = acc[b][0]; o[1] = acc[b][1]; o[2] = acc[b][2]; }
        __syncthreads();
    }
}
__device__ __forceinline__ void p0_transpose_item(const float* W, int K, int N, bf16* WT, int row_off, LAS float* scr, int item, int lane) {
    const int nblk = N / 32, kb = item / nblk, nb = item % nblk, k0 = 64 * kb, n0 = 32 * nb;
#pragma unroll 8
    for (int i = 0; i < 32; ++i) { const int kk = 2 * i + (lane >> 5); scr[kk * 33 + (lane & 31)] = W[(size_t)(k0 + kk) * N + n0 + (lane & 31)]; }
    LDS_WAIT(); asm volatile("" ::: "memory");
    const int c = lane & 7;
#pragma unroll
    for (int j = 0; j < 4; ++j) { const int n = (lane >> 3) + 8 * j; const LAS float* s = scr + (8 * c) * 33 + n;
        v4u o; o.x = pk2(s[0 * 33], s[1 * 33]); o.y = pk2(s[2 * 33], s[3 * 33]); o.z = pk2(s[4 * 33], s[5 * 33]); o.w = pk2(s[6 * 33], s[7 * 33]);
        *(GAS v4u*)(WT + (size_t)(row_off + n0 + n) * K + k0 + 8 * c) = o; }
    LDS_WAIT(); asm volatile("" ::: "memory");
}
__device__ __forceinline__ void phase_pro2(const AL& a, LAS unsigned char* lds, int tid, int lane, int wave, int G) {
    const int gt = blockIdx.x * (NWAVES * 64) + tid, NGT = G * NWAVES * 64;
    { float* mod = (float*)(a.ws() + WS_MOD); const float* modp = (const float*)(a.ws() + WS_MODP); const float* bada = a.in(I_BADA);
      for (int i = gt; i < 2 * 24 * 12288; i += NGT) { const int l = i / (24 * 12288), n = i % 12288; float s = bada[l * 12288 + n];
#pragma unroll
          for (int ks = 0; ks < 16; ++ks) s += modp[(size_t)ks * (2 * 24 * 12288) + i];
          mod[i] = s; } }
    { float2* rb = (float2*)(a.ws() + WS_ROPEB); float2* rc = (float2*)(a.ws() + WS_ROPEC);
      for (int i = gt; i < 4096 * 24; i += NGT) { const int pos = i / 24, j = i % 24; const bool isb = j < 16; const int ii = isb ? j : j - 16; const double half = isb ? 16.0 : 8.0;
          const double inv = exp(-(double)ii / half * 13.122363377404328);
          const double rev = (double)pos * inv * 0.15915494309189535;
          const float fr = (float)(rev - floor(rev));
          const float2 v = make_float2(__builtin_amdgcn_cosf(fr), __builtin_amdgcn_sinf(fr));
          if (isb) rb[pos * 16 + ii] = v; else rc[pos * 8 + ii] = v; } }
    if (gt < 2) { const int l = gt; float s1 = 0.f, s2 = 0.f;
        for (int i = 0; i < 64; ++i) { s1 += a.in(I_LQ1)[l * 64 + i] * a.in(I_LK1)[l * 64 + i]; s2 += a.in(I_LQ2)[l * 64 + i] * a.in(I_LK2)[l * 64 + i]; }
        const float lam_init = 0.8f - 0.6f * expf(-0.3f * (float)l);
        ((float*)(a.ws() + WS_LAM))[l] = expf(s1) - expf(s2) + lam_init;
        float gq = 0.f, gk = 0.f;
        for (int i = 0; i < 64; ++i) { gq = fmaxf(gq, fabsf(a.in(I_QNC)[l * 64 + i])); gk = fmaxf(gk, fabsf(a.in(I_KNC)[l * 64 + i])); }
        ((float*)(a.ws() + WS_LAM))[2 + l] = 8.0f * LOG2E * gq * gk * 1.02f; }
    LAS float* scr = (LAS float*)(lds + RING_OFF + wave * 16384);
    const int gw = blockIdx.x * NWAVES + wave, NGW = G * NWAVES;
    constexpr int I_IN = 32 * 192, I_BA = 8 * 64, I_BB = 4 * 64, I_BC = 12 * 64, I_OU = 32 * 64, I_F1 = 32 * 256, I_F2 = 128 * 64;
    constexpr int PER_L = 2 * I_IN + I_BA + I_BB + I_BC + I_OU + I_F1 + I_F2;
    for (int it = gw; it < 2 * PER_L; it += NGW) {
        const int l = it / PER_L; int r = it % PER_L; unsigned char* wl = a.ws() + WS_W + (size_t)l * W_LAYER;
        if (r < I_IN) { p0_transpose_item(a.in(I_WIN) + (size_t)l * 2048 * 6144, 2048, 6144, (bf16*)(wl + WO_IG), 0, scr, r, lane); continue; } r -= I_IN;
        if (r < I_IN) { p0_transpose_item(a.in(I_WGATE) + (size_t)l * 2048 * 6144, 2048, 6144, (bf16*)(wl + WO_IG), 6144, scr, r, lane); continue; } r -= I_IN;
        if (r < I_BA) { p0_transpose_item(a.in(I_WBRA) + (size_t)l * 512 * 2048, 512, 2048, (bf16*)(wl + WO_BRA), 0, scr, r, lane); continue; } r -= I_BA;
        if (r < I_BB) { p0_transpose_item(a.in(I_WBRB) + (size_t)l * 256 * 2048, 256, 2048, (bf16*)(wl + WO_BRB), 0, scr, r, lane); continue; } r -= I_BB;
        if (r < I_BC) { p0_transpose_item(a.in(I_WBRC) + (size_t)l * 768 * 2048, 768, 2048, (bf16*)(wl + WO_BRC), 0, scr, r, lane); continue; } r -= I_BC;
        if (r < I_OU) { p0_transpose_item(a.in(I_WOUT) + (size_t)l * 2048 * 2048, 2048, 2048, (bf16*)(wl + WO_OUT), 0, scr, r, lane); continue; } r -= I_OU;
        if (r < I_F1) { p0_transpose_item(a.in(I_WFF1) + (size_t)l * 2048 * 8192, 2048, 8192, (bf16*)(wl + WO_FF1), 0, scr, r, lane); continue; } r -= I_F1;
        p0_transpose_item(a.in(I_WFF2) + (size_t)l * 8192 * 2048, 8192, 2048, (bf16*)(wl + WO_FF2), 0, scr, r, lane);
    }
}

__device__ __forceinline__ void phase_norm(const float* xsrc, const float* gn, const float* modl, int sh_off, int sc_off, int seq0, int tshift, bf16* H, int gw, int NGW, int lane) {
    for (int blk = gw; blk < CH / 8; blk += NGW) {
        const int r0 = blk * 8; const float* mo = modl + (size_t)(seq0 + (r0 >> tshift)) * 12288;
        f32x4 A[8], B[8];
#pragma unroll
        for (int j = 0; j < 8; ++j) { const int c = 4 * lane + 256 * j; const f32x4 g = *(const f32x4*)(gn + c), sc = *(const f32x4*)(mo + sc_off + c); A[j] = g * (1.0f + sc); B[j] = *(const f32x4*)(mo + sh_off + c); }
        for (int r = 0; r < 8; ++r) {
            const f32x4* xr = (const f32x4*)(xsrc + (size_t)(r0 + r) * 2048) + lane; f32x4 v[8]; float s = 0.f;
#pragma unroll
            for (int j = 0; j < 8; ++j) { v[j] = xr[64 * j]; s += (v[j].x * v[j].x + v[j].y * v[j].y) + (v[j].z * v[j].z + v[j].w * v[j].w); }
            const float rstd = rsqrtf(wave_sum(s) * (1.0f / 2048.0f) + EPS);
            v2u* o8 = (v2u*)(H + (size_t)(r0 + r) * 2048) + lane;
#pragma unroll
            for (int j = 0; j < 8; ++j) { const f32x4 o = v[j] * rstd * A[j] + B[j]; v2u w; w.x = pk2(o.x, o.y); w.y = pk2(o.z, o.w); o8[64 * j] = w; }
        }
    }
}
__device__ __forceinline__ int perm_tok(int p, int dsh, int Lsh) { return dsh == 0 ? p : (((p & ((1 << Lsh) - 1)) << dsh) + (p >> Lsh)); }
__device__ __forceinline__ void prep_qk_item(const bf16* Z, bf16* QK, const AL& a, int l, int item, int S, int tshift, int lane) {
    const int slot = item & 31, rb = item >> 5;
    int srccol, dstcol, dsh = 0, kind = 0; const float* gain; float scale = 1.f;
    if (slot < 4) { srccol = 128 * slot; dstcol = 128 * slot; gain = a.in(I_QNA) + l * 128; scale = QS128; }
    else if (slot < 8) { const int j = slot - 4; srccol = 512 + 128 * j; dstcol = 512 + 128 * j; gain = a.in(I_KNA) + l * 128; }
    else if (slot < 14) { const int j = slot - 8; srccol = 1536 + 128 * j; dstcol = 1024 + 128 * j; kind = 1; gain = a.in(I_QNB) + l * 128; scale = QS128; dsh = 2 * (j >> 1); }
    else if (slot < 20) { const int j = slot - 14; srccol = 2304 + 128 * j; dstcol = 1792 + 128 * j; kind = 1; gain = a.in(I_KNB) + l * 128; dsh = 2 * (j >> 1); }
    else if (slot < 26) { const int j = slot - 20; srccol = 3840 + 128 * j; dstcol = 2560 + 128 * j; kind = 2; gain = a.in(I_QNC) + l * 64; scale = QS64; }
    else { const int j = slot - 26; srccol = 4608 + 128 * j; dstcol = 3328 + 128 * j; kind = 2; gain = a.in(I_KNC) + l * 64; }
    const int sub = lane & 15, Lsh = tshift - dsh;
    float g[8];
#pragma unroll
    for (int e = 0; e < 8; ++e) g[e] = gain[((8 * sub) & (kind == 2 ? 63 : 127)) + e];
    const float2* ropeB = (const float2*)(a.ws() + WS_ROPEB); const float2* ropeC = (const float2*)(a.ws() + WS_ROPEC);
    for (int pass = 0; pass < 16; ++pass) {
        const int orow = rb * 64 + pass * 4 + (lane >> 4), sl = orow >> tshift, p = orow & (S - 1);
        const int t = perm_tok(p, dsh, Lsh);
        const v4u w = *(const v4u*)(Z + (size_t)((sl << tshift) + t) * 6144 + srccol + 8 * sub);
        float y[8] = {bflo(w.x), bfhi(w.x), bflo(w.y), bfhi(w.y), bflo(w.z), bfhi(w.z), bflo(w.w), bfhi(w.w)};
        float ss = 0.f;
#pragma unroll
        for (int e = 0; e < 8; ++e) ss += y[e] * y[e];
        ss += __shfl_xor(ss, 1); ss += __shfl_xor(ss, 2); ss += __shfl_xor(ss, 4);
        if (kind != 2) ss += __shfl_xor(ss, 8);
        const float rstd = rsqrtf(ss * (kind == 2 ? (1.0f / 64.0f) : (1.0f / 128.0f)) + EPS);
#pragma unroll
        for (int e = 0; e < 8; ++e) y[e] = y[e] * rstd * g[e];
        if (kind != 0) {
            const int RS = kind == 1 ? 2 : 1, subg = kind == 1 ? sub : (sub & 7);
            float pr[8];
#pragma unroll
            for (int e = 0; e < 8; ++e) pr[e] = __shfl_xor(y[e], RS);
            if (subg < 2 * RS) { const bool first = subg < RS; const int ib = 8 * (subg & (RS - 1));
                const float2* tab = kind == 1 ? ropeB + t * 16 + ib : ropeC + t * 8 + ib;
#pragma unroll
                for (int e = 0; e < 8; ++e) { const float2 cs = tab[e]; y[e] = first ? y[e] * cs.x - pr[e] * cs.y : y[e] * cs.x + pr[e] * cs.y; } }
        }
        v4u o; o.x = pk2(y[0] * scale, y[1] * scale); o.y = pk2(y[2] * scale, y[3] * scale); o.z = pk2(y[4] * scale, y[5] * scale); o.w = pk2(y[6] * scale, y[7] * scale);
        *(v4u*)(QK + (size_t)orow * 4096 + dstcol + 8 * sub) = o;
    }
}
__device__ __forceinline__ void prep_vt_item(const bf16* Z, bf16* VT, int item, int S, int tshift, LAS unsigned short* T, int lane) {
    const int dh = item & 1, vh = (item >> 1) & 15, pb = item >> 5;
    int srccol, dsh = 0;
    if (vh < 4) srccol = 1024 + 128 * vh; else if (vh < 10) { const int j = vh - 4; srccol = 3072 + 128 * j; dsh = 2 * (j >> 1); } else srccol = 5376 + 128 * (vh - 10);
    srccol += 64 * dh;
    const int o0 = pb * 64, sl = o0 >> tshift, p0 = o0 & (S - 1), Lsh = tshift - dsh;
#pragma unroll
    for (int pass = 0; pass < 8; ++pass) { const int i = pass * 8 + (lane >> 3), c8 = lane & 7, t = perm_tok(p0 + i, dsh, Lsh);
        const v4u w = *(const v4u*)(Z + (size_t)((sl << tshift) + t) * 6144 + srccol + 8 * c8);
        LAS unsigned short* tp = T + (8 * c8) * 68 + i;
        tp[0 * 68] = (unsigned short)(w.x & 0xffffu); tp[1 * 68] = (unsigned short)(w.x >> 16); tp[2 * 68] = (unsigned short)(w.y & 0xffffu); tp[3 * 68] = (unsigned short)(w.y >> 16);
        tp[4 * 68] = (unsigned short)(w.z & 0xffffu); tp[5 * 68] = (unsigned short)(w.z >> 16); tp[6 * 68] = (unsigned short)(w.w & 0xffffu); tp[7 * 68] = (unsigned short)(w.w >> 16); }
    LDS_WAIT(); asm volatile("" ::: "memory");
#pragma unroll
    for (int pass = 0; pass < 16; ++pass) { const int d = pass * 4 + (lane >> 4), c4 = lane & 15;
        const v2u v = *(const LAS v2u*)(T + d * 68 + 4 * c4);
        *(v2u*)(VT + (size_t)((sl * 16 + vh) * 128 + 64 * dh + d) * S + p0 + 4 * c4) = v; }
    LDS_WAIT(); asm volatile("" ::: "memory");
}
__device__ __forceinline__ void phase_prep(const AL& a, int l, LAS unsigned char* lds, int S, int tshift, int gw, int NGW, int wave, int lane) {
    const bf16* Z = (const bf16*)(a.ws() + A_Z); bf16* QK = (bf16*)(a.ws() + A_QK); bf16* VT = (bf16*)(a.ws() + A_VT);
    for (int it = gw; it < (CH / 64) * 32; it += NGW) prep_qk_item(Z, QK, a, l, it, S, tshift, lane);
    LAS unsigned short* T = (LAS unsigned short*)(lds + RING_OFF + wave * 16384);
    for (int it = gw; it < (CH / 64) * 32; it += NGW) prep_vt_item(Z, VT, it, S, tshift, T, lane);
}

namespace att {
#define MFMA32(a, b, c) __builtin_amdgcn_mfma_f32_32x32x16_bf16((a), (b), (c), 0, 0, 0)
__device__ __forceinline__ float ex2(float x) { return __builtin_amdgcn_exp2f(x); }
struct MaskNone { static constexpr bool MASKED = false; __device__ __forceinline__ float operator()(float v, int) const { return v; } };
struct MaskB { static constexpr bool MASKED = true; int dq;
    __device__ __forceinline__ float operator()(float v, int koff) const { const int d = dq + koff; return (d >= -64 && d <= 64) ? v : NEGB; } };
struct MaskA { static constexpr bool MASKED = true; const LAS float* brow; int kc0, qc, cs;
    __device__ __forceinline__ float operator()(float v, int koff) const { const int kc = kc0 + koff; int di = kc - qc + 15; di = di < 0 ? 0 : (di > 30 ? 30 : di);
        const float b = brow[di]; return (kc >= cs && kc < cs + 16) ? v + b : NEGB; } };

template <int NK, class MaskFn>
__device__ __forceinline__ void tile_step(const bf16* Kt, const bf16* VTt, int S, const bf16x8 (&qf)[NK], f32x16 (&o)[4], float& m, float& l, int lane, const MaskFn& mf) {
    const int r32 = lane & 31, hi = lane >> 5;
    const int pim = (r32 & 19) | ((r32 & 4) << 1) | ((r32 & 8) >> 1);
    const bf16* kp = Kt + (size_t)pim * 4096 + 8 * hi;
    bf16x8 kf[NK];
#pragma unroll
    for (int d0 = 0; d0 < NK; ++d0) kf[d0] = *(const bf16x8*)(kp + 16 * d0);
    bf16x8 vf[4][2];
    const bf16* vp = VTt + (size_t)r32 * S + 8 * hi;
#pragma unroll
    for (int db = 0; db < 4; ++db)
#pragma unroll
        for (int s2 = 0; s2 < 2; ++s2) vf[db][s2] = *(const bf16x8*)(vp + (size_t)(32 * db) * S + 16 * s2);
    f32x16 s;
#pragma unroll
    for (int r = 0; r < 16; ++r) s[r] = 0.f;
#pragma unroll
    for (int d0 = 0; d0 < NK; ++d0) s = MFMA32(kf[d0], qf[d0], s);
    float mx = NEGB;
#pragma unroll
    for (int r = 0; r < 16; ++r) { s[r] = mf(s[r], 16 * (r >> 3) + 8 * hi + (r & 7)); mx = fmaxf(mx, s[r]); }
    mx = fmaxf(mx, __shfl_xor(mx, 32));
    const float mn = fmaxf(m, mx), alpha = ex2(m - mn);
    float ps = 0.f;
#pragma unroll
    for (int r = 0; r < 16; ++r) { float p = ex2(s[r] - mn); if (MaskFn::MASKED) p = s[r] <= -1e29f ? 0.f : p; s[r] = p; ps += p; }
    l = l * alpha + ps; m = mn;
    if (!__all(alpha == 1.0f)) {
#pragma unroll
        for (int db = 0; db < 4; ++db)
#pragma unroll
            for (int r = 0; r < 16; ++r) o[db][r] *= alpha;
    }
    bf16x8 pf[2];
#pragma unroll
    for (int s2 = 0; s2 < 2; ++s2) { v4u w; w.x = pk2(s[8 * s2 + 0], s[8 * s2 + 1]); w.y = pk2(s[8 * s2 + 2], s[8 * s2 + 3]); w.z = pk2(s[8 * s2 + 4], s[8 * s2 + 5]); w.w = pk2(s[8 * s2 + 6], s[8 * s2 + 7]); pf[s2] = __builtin_bit_cast(bf16x8, w); }
#pragma unroll
    for (int db = 0; db < 4; ++db)
#pragma unroll
        for (int s2 = 0; s2 < 2; ++s2) o[db] = MFMA32(vf[db][s2], pf[s2], o[db]);
}
template <int NK> __device__ __forceinline__ void load_q(const bf16* Qp, bf16x8 (&qf)[NK], int lane) {
    const bf16* q = Qp + (size_t)(lane & 31) * 4096 + 8 * (lane >> 5);
#pragma unroll
    for (int d0 = 0; d0 < NK; ++d0) qf[d0] = *(const bf16x8*)(q + 16 * d0);
}
__device__ __forceinline__ void zero_o(f32x16 (&o)[4]) {
#pragma unroll
    for (int db = 0; db < 4; ++db)
#pragma unroll
        for (int r = 0; r < 16; ++r) o[db][r] = 0.f;
}
__device__ __forceinline__ void store_o_bf16(bf16* dst, const f32x16 (&o)[4], float inv, int hi) {
#pragma unroll
    for (int db = 0; db < 4; ++db)
#pragma unroll
        for (int g = 0; g < 4; ++g) { v2u w; w.x = pk2(o[db][4 * g] * inv, o[db][4 * g + 1] * inv); w.y = pk2(o[db][4 * g + 2] * inv, o[db][4 * g + 3] * inv);
            *(v2u*)(dst + 32 * db + 8 * g + 4 * hi) = w; }
}
__device__ __forceinline__ void store_o_f32(float* dst, const f32x16 (&o)[4], float inv, int hi) {
#pragma unroll
    for (int db = 0; db < 4; ++db)
#pragma unroll
        for (int g = 0; g < 4; ++g) { const f32x4 v = {o[db][4 * g] * inv, o[db][4 * g + 1] * inv, o[db][4 * g + 2] * inv, o[db][4 * g + 3] * inv};
            *(f32x4*)(dst + 32 * db + 8 * g + 4 * hi) = v; }
}
__device__ __forceinline__ void wave_c(const bf16* QK, const bf16* VT, float* CTMP, int sl, int map, int q0, int S, int tshift, int lane) {
    const size_t row0 = (size_t)sl << tshift; const int hi = lane >> 5;
    const bf16* Kp = QK + row0 * 4096 + 3328 + 64 * map;
    const bf16* Vp = VT + (size_t)((sl * 16 + 10 + (map >> 1)) * 128) * S;
    bf16x8 qf[4]; load_q<4>(QK + (row0 + q0) * 4096 + 2560 + 64 * map, qf, lane);
    f32x16 o[4]; zero_o(o); float m = NEGB, l = 0.f; const MaskNone mf;
    for (int kb = 0; kb < S; kb += 32) tile_step<4, MaskNone>(Kp + (size_t)kb * 4096, Vp + kb, S, qf, o, m, l, lane, mf);
    l += __shfl_xor(l, 32);
    store_o_f32(CTMP + (row0 + q0 + (lane & 31)) * 1536 + map * 128, o, 1.0f / l, hi);
}
__device__ __forceinline__ void wave_b(const bf16* QK, const bf16* VT, bf16* BTMP, float* BLSE, int sl, int slot, int p0, int S, int tshift, int lane) {
    const size_t row0 = (size_t)sl << tshift; const int hi = lane >> 5, dsh = 2 * (slot >> 1), Lsh = tshift - dsh;
    const bf16* Kp = QK + row0 * 4096 + 1792 + 128 * slot;
    const bf16* Vp = VT + (size_t)((sl * 16 + 4 + slot) * 128) * S;
    bf16x8 qf[8]; load_q<8>(QK + (row0 + p0) * 4096 + 1024 + 128 * slot, qf, lane);
    f32x16 o[4]; zero_o(o); float m = NEGB, l = 0.f;
    const int qp = p0 + (lane & 31);
#pragma unroll 1
    for (int ti = 0; ti < 5; ++ti) { const int kb = p0 - 64 + 32 * ti;
        if (kb < 0 || kb >= S || (kb >> Lsh) != (p0 >> Lsh)) continue;
        const MaskB mf{kb - qp};
        tile_step<8, MaskB>(Kp + (size_t)kb * 4096, Vp + kb, S, qf, o, m, l, lane, mf); }
    l += __shfl_xor(l, 32);
    const int t = perm_tok(qp, dsh, Lsh);
    store_o_bf16(BTMP + (row0 + t) * 768 + slot * 128, o, 1.0f / l, hi);
    if (hi == 0) BLSE[(row0 + t) * 8 + slot] = (__log2f(l) + m) * LN2;
}
__device__ __forceinline__ void wave_a(const bf16* QK, const bf16* VT, bf16* OA, const LAS float* btab, int sl, int h, int r, int qh, int S, int tshift, int lane) {
    const size_t row0 = (size_t)sl << tshift; const int hi = lane >> 5, rows = S >> 6;
    int rs = r - 4; rs = rs < 0 ? 0 : (rs > rows - 8 ? rows - 8 : rs);
    const bf16* Kp = QK + row0 * 4096 + 512 + 128 * h;
    const bf16* Vp = VT + (size_t)((sl * 16 + h) * 128) * S;
    const int q0 = r * 64 + 32 * qh, qc = 32 * qh + (lane & 31);
    int cs = qc - 8; cs = cs < 0 ? 0 : (cs > 48 ? 48 : cs);
    bf16x8 qf[8]; load_q<8>(QK + (row0 + q0) * 4096 + 128 * h, qf, lane);
    f32x16 o[4]; zero_o(o); float m = NEGB, l = 0.f;
#pragma unroll 1
    for (int ti = 0; ti < 16; ++ti) { const int j = ti >> 1, chh = ti & 1, kb = (rs + j) * 64 + 32 * chh;
        const MaskA mf{btab + (rs + j - r + 7) * 31, 32 * chh, qc, cs};
        tile_step<8, MaskA>(Kp + (size_t)kb * 4096, Vp + kb, S, qf, o, m, l, lane, mf); }
    l += __shfl_xor(l, 32);
    store_o_bf16(OA + (row0 + q0 + (lane & 31)) * 512 + h * 128, o, 1.0f / l, hi);
}

constexpr int CST = 24576;
__device__ __forceinline__ void glds16(const void* gsrc, unsigned lds_dst) { unsigned keep;
    asm volatile("s_mov_b32 %0, m0\n\ts_mov_b32 m0, %2\n\ts_nop 0\n\tglobal_load_lds_dwordx4 %1, off\n\ts_mov_b32 m0, %0" : "=&s"(keep) : "v"(gsrc), "s"(lds_dst) : "memory"); }
__device__ __forceinline__ void c_dma(const bf16* Kp, const bf16* Vp, int S, int kb, unsigned sb, int wave, int lane) {
    { const int row = 8 * wave + (lane >> 3), c = (lane & 7) ^ ((row >> 1) & 7);
      glds16(Kp + (size_t)(kb + row) * 4096 + 8 * c, (unsigned)__builtin_amdgcn_readfirstlane(sb + wave * 1024)); }
#pragma unroll
    for (int jj = 0; jj < 2; ++jj) { const int j = wave + 8 * jj, row = 8 * j + (lane >> 3), c = (lane & 7) ^ ((row >> 1) & 7);
      glds16(Vp + (size_t)row * S + kb + 8 * c, (unsigned)__builtin_amdgcn_readfirstlane(sb + 8192 + j * 1024)); }
}
#define C_WAIT_BAR(N) asm volatile("s_waitcnt vmcnt(" #N ")\n\ts_barrier" ::: "memory")
__device__ __forceinline__ void unit_c_fast(const bf16* QK, const bf16* VT, float* CTMP, LAS unsigned char* ring, int sl, int map, int qb, int S, int tshift, int wave, int lane) {
    const size_t row0 = (size_t)sl << tshift; const int r32 = lane & 31, hi = lane >> 5, q0 = qb * 256 + 32 * wave;
    const bf16* Kp = QK + row0 * 4096 + 3328 + 64 * map;
    const bf16* Vp = VT + (size_t)((sl * 16 + 10 + (map >> 1)) * 128) * S;
    bf16x8 qf[4]; load_q<4>(QK + (row0 + q0) * 4096 + 2560 + 64 * map, qf, lane);
    const int pim = (r32 & 19) | ((r32 & 4) << 1) | ((r32 & 8) >> 1);
    int ka[4], va[4];
#pragma unroll
    for (int d0 = 0; d0 < 4; ++d0) ka[d0] = pim * 128 + (((2 * d0 + hi) ^ ((pim >> 1) & 7)) << 4);
#pragma unroll
    for (int x = 0; x < 4; ++x) va[x] = 8192 + r32 * 128 + (((2 * x + hi) ^ ((r32 >> 1) & 7)) << 4);
    f32x16 o[4]; zero_o(o); float l = 0.f;
    const int NT = S >> 6;
#pragma unroll
    for (int d0 = 0; d0 < 4; ++d0) asm volatile("" : "+v"(qf[d0]));
    asm volatile("s_waitcnt vmcnt(0)\n\ts_barrier" ::: "memory");
    const unsigned ring_a = (unsigned)(size_t)ring;
    c_dma(Kp, Vp, S, 0, ring_a, wave, lane); c_dma(Kp, Vp, S, 64, ring_a + CST, wave, lane);
    int st_cur = 0, st_nxt2 = 2 * CST;
#pragma unroll 1
    for (int t = 0; t < NT; ++t) {
        if (t + 1 < NT) C_WAIT_BAR(3); else C_WAIT_BAR(0);
        if (t + 2 < NT) c_dma(Kp, Vp, S, (t + 2) * 64, ring_a + st_nxt2, wave, lane);
        const LAS unsigned char* sb = ring + st_cur;
#pragma unroll
        for (int st = 0; st < 2; ++st) {
            bf16x8 kf[4];
#pragma unroll
            for (int d0 = 0; d0 < 4; ++d0) kf[d0] = *(const LAS bf16x8*)(sb + st * 4096 + ka[d0]);
            f32x16 s;
#pragma unroll
            for (int r = 0; r < 16; ++r) s[r] = 0.f;
#pragma unroll
            for (int d0 = 0; d0 < 4; ++d0) s = MFMA32(kf[d0], qf[d0], s);
            bf16x8 vf[4][2];
#pragma unroll
            for (int db = 0; db < 4; ++db)
#pragma unroll
                for (int s2 = 0; s2 < 2; ++s2) vf[db][s2] = *(const LAS bf16x8*)(sb + db * 4096 + va[2 * st + s2]);
#pragma unroll
            for (int r = 0; r < 16; ++r) { s[r] = ex2(s[r]); l += s[r]; }
            bf16x8 pf[2];
#pragma unroll
            for (int s2 = 0; s2 < 2; ++s2) { v4u w; w.x = pk2(s[8 * s2 + 0], s[8 * s2 + 1]); w.y = pk2(s[8 * s2 + 2], s[8 * s2 + 3]); w.z = pk2(s[8 * s2 + 4], s[8 * s2 + 5]); w.w = pk2(s[8 * s2 + 6], s[8 * s2 + 7]); pf[s2] = __builtin_bit_cast(bf16x8, w); }
#pragma unroll
            for (int db = 0; db < 4; ++db)
#pragma unroll
                for (int s2 = 0; s2 < 2; ++s2) o[db] = MFMA32(vf[db][s2], pf[s2], o[db]);
        }
        st_cur = st_cur == 2 * CST ? 0 : st_cur + CST; st_nxt2 = st_nxt2 == 2 * CST ? 0 : st_nxt2 + CST;
    }
    l += __shfl_xor(l, 32);
    store_o_f32(CTMP + (row0 + q0 + r32) * 1536 + map * 128, o, 1.0f / l, hi);
}
}

__device__ __forceinline__ void phase_attn(const AL& a, int l, LAS unsigned char* lds, int S, int tshift, int tid, int wave, int lane) {
    const bf16* QK = (const bf16*)(a.ws() + A_QK); const bf16* VT = (const bf16*)(a.ws() + A_VT);
    const int nqb = S >> 8, nseq = CH >> tshift;
    { float* CTMP = (float*)(a.ws() + A_CTMP); const float cbound = ((const float*)(a.ws() + WS_LAM))[2 + l];
      const int G = gridDim.x, vid = (G % 8 == 0) ? (blockIdx.x % 8) * (G / 8) + blockIdx.x / 8 : blockIdx.x;
      if (cbound <= 64.0f) {
          for (int u = vid; u < nseq * 12 * nqb; u += G) { const int qb = u % nqb, map = (u / nqb) % 12, sl = u / (nqb * 12);
              att::unit_c_fast(QK, VT, CTMP, lds + RING_OFF, sl, map, qb, S, tshift, wave, lane); }
      } else {
          for (int u = vid; u < nseq * 12 * nqb; u += G) { const int qb = u % nqb, map = (u / nqb) % 12, sl = u / (nqb * 12);
              att::wave_c(QK, VT, CTMP, sl, map, qb * 256 + 32 * wave, S, tshift, lane); } } }
    { bf16* OA = (bf16*)(a.ws() + A_OA); LAS float* btab = (LAS float*)(lds + RING_OFF);
      for (int u = blockIdx.x; u < nseq * 4 * nqb; u += gridDim.x) { const int qb = u % nqb, h = (u / nqb) % 4, sl = u / (nqb * 4);
          __syncthreads();
          for (int e = tid; e < 15 * 31; e += NWAVES * 64) btab[e] = a.in(I_RPB)[((size_t)(l * 4 + h) * 15) * 31 + e] * LOG2E;
          __syncthreads();
          att::wave_a(QK, VT, OA, btab, sl, h, 4 * qb + (wave >> 1), wave & 1, S, tshift, lane); } }
    { bf16* BTMP = (bf16*)(a.ws() + A_BTMP); float* BLSE = (float*)(a.ws() + A_BLSE);
      for (int u = blockIdx.x; u < nseq * 6 * nqb; u += gridDim.x) { const int pb = u % nqb, slot = (u / nqb) % 6, sl = u / (nqb * 6);
          att::wave_b(QK, VT, BTMP, BLSE, sl, slot, pb * 256 + 32 * wave, S, tshift, lane); } }
}
__device__ __forceinline__ void phase_combine(const AL& a, int l, int gw, int NGW, int lane) {
    const bf16* BTMP = (const bf16*)(a.ws() + A_BTMP); const float* BLSE = (const float*)(a.ws() + A_BLSE); const float* CTMP = (const float*)(a.ws() + A_CTMP);
    bf16* OB = (bf16*)(a.ws() + A_OB); bf16* OC = (bf16*)(a.ws() + A_OC);
    const float lam = ((const float*)(a.ws() + WS_LAM))[l], lam_init = 0.8f - 0.6f * expf(-0.3f * (float)l);
    const float* subln = a.in(I_SUBLN) + l * 128;
    const int sub = lane & 15, d0 = 8 * sub;
    for (int it = gw; it < (CH / 4) * 8; it += NGW) { const int slot = it & 7; const size_t row = (size_t)(it >> 3) * 4 + (lane >> 4);
        if (slot < 2) { const int hg = slot;
            const float l0 = BLSE[row * 8 + hg], l1 = BLSE[row * 8 + 2 + hg], l2 = BLSE[row * 8 + 4 + hg];
            const float mx = fmaxf(l0, fmaxf(l1, l2)); float w0 = __expf(l0 - mx), w1 = __expf(l1 - mx), w2 = __expf(l2 - mx);
            const float inv = 1.0f / (w0 + w1 + w2); w0 *= inv; w1 *= inv; w2 *= inv;
            const v4u a0 = *(const v4u*)(BTMP + row * 768 + (0 + hg) * 128 + d0), a1 = *(const v4u*)(BTMP + row * 768 + (2 + hg) * 128 + d0), a2 = *(const v4u*)(BTMP + row * 768 + (4 + hg) * 128 + d0);
            v4u o;
            o.x = pk2(w0 * bflo(a0.x) + w1 * bflo(a1.x) + w2 * bflo(a2.x), w0 * bfhi(a0.x) + w1 * bfhi(a1.x) + w2 * bfhi(a2.x));
            o.y = pk2(w0 * bflo(a0.y) + w1 * bflo(a1.y) + w2 * bflo(a2.y), w0 * bfhi(a0.y) + w1 * bfhi(a1.y) + w2 * bfhi(a2.y));
            o.z = pk2(w0 * bflo(a0.z) + w1 * bflo(a1.z) + w2 * bflo(a2.z), w0 * bfhi(a0.z) + w1 * bfhi(a1.z) + w2 * bfhi(a2.z));
            o.w = pk2(w0 * bflo(a0.w) + w1 * bflo(a1.w) + w2 * bflo(a2.w), w0 * bfhi(a0.w) + w1 * bfhi(a1.w) + w2 * bfhi(a2.w));
            *(v4u*)(OB + row * 256 + hg * 128 + d0) = o;
        } else { const int h = slot - 2;
            const float* p1 = CTMP + row * 1536 + (2 * h) * 128 + d0; const float* p2 = p1 + 128;
            const f32x4 x0 = *(const f32x4*)p1 - lam * *(const f32x4*)p2, x1 = *(const f32x4*)(p1 + 4) - lam * *(const f32x4*)(p2 + 4);
            float ss = (x0.x * x0.x + x0.y * x0.y) + (x0.z * x0.z + x0.w * x0.w) + (x1.x * x1.x + x1.y * x1.y) + (x1.z * x1.z + x1.w * x1.w);
            ss += __shfl_xor(ss, 1); ss += __shfl_xor(ss, 2); ss += __shfl_xor(ss, 4); ss += __shfl_xor(ss, 8);
            const float rstd = rsqrtf(ss * (1.0f / 128.0f) + EPS) * (1.0f - lam_init);
            const f32x4 g0 = *(const f32x4*)(subln + d0), g1 = *(const f32x4*)(subln + d0 + 4);
            v4u o; o.x = pk2(x0.x * rstd * g0.x, x0.y * rstd * g0.y); o.y = pk2(x0.z * rstd * g0.z, x0.w * rstd * g0.w);
            o.z = pk2(x1.x * rstd * g1.x, x1.y * rstd * g1.y); o.w = pk2(x1.z * rstd * g1.z, x1.w * rstd * g1.w);
            *(v4u*)(OC + row * 768 + h * 128 + d0) = o;
        }
    }
}
#define CHECK_HOOK(stage, c, l) do {} while (0)
#define CHECK_FINAL() do {} while (0)

#ifndef PHMASK
#define PHMASK 0xFFFF
#endif
#define PH(k) ((PHMASK >> (k)) & 1)
#ifndef DUPMASK
#define DUPMASK 0
#endif
#define DUP(k) ((DUPMASK >> (k)) & 1)
#ifndef BARX
#define BARX 1
#endif
__global__ void __launch_bounds__(NWAVES * 64, 2) fwd(Args kargs) {
    extern __shared__ __attribute__((aligned(16))) unsigned char lds_raw[];
    LAS unsigned char* lds = (LAS unsigned char*)lds_raw;
    volatile LAS unsigned* MISC = (volatile LAS unsigned*)(lds + MISC_OFF);
    int tid = threadIdx.x, lane = tid & 63, wave = __builtin_amdgcn_readfirstlane(tid >> 6);
    for (int u = tid; u < (LDS_BYTES - LDSCTL_OFF) / 4; u += NWAVES * 64) ((LAS unsigned*)(lds + LDSCTL_OFF))[u] = 0u;
    __syncthreads();
    const AL a{};
    XcdBarrier bar = xcd_barrier_post((unsigned*)(a.ws() + WS_CTL) + CW_BAR, MISC + 8);
#define GRID_BAR() do { for (int b_ = 0; b_ < BARX; ++b_) xcd_barrier(bar); } while (0)
    int G = gridDim.x, bid = (int)blockIdx.x;
#define LAUNDER() do { asm volatile("" : "+s"(G), "+s"(bid)); tid = threadIdx.x; asm volatile("" : "+v"(tid)); lane = tid & 63; wave = __builtin_amdgcn_readfirstlane(tid >> 6); } while (0)
#define GW (bid * NWAVES + wave)
#define NGW_ (G * NWAVES)

    if (PH(0)) phase_modp(a, lds, tid, lane, wave);
    if (DUP(0)) { __syncthreads(); phase_modp(a, lds, tid, lane, wave); }
    GRID_BAR();
    if (PH(1)) phase_pro2(a, lds, tid, lane, wave, G);
    if (DUP(1)) { __syncthreads(); phase_pro2(a, lds, tid, lane, wave, G); }
    GRID_BAR();
    CHECK_HOOK(0, 0, 0);

#pragma unroll 1
    for (int cl = 0; cl < NCHUNK * 2; ++cl) {
        int c = cl >> 1, l = cl & 1;
        asm volatile("" : "+s"(c), "+s"(l));
#define R0 (c * CH)
#define PROMPT (R0 < 32768)
#define S_ (PROMPT ? 4096 : 2048)
#define TSH (PROMPT ? 12 : 11)
#define SEQ0 (PROMPT ? (R0 >> 12) : 8 + ((R0 - 32768) >> 11))
#define XIN0 (PROMPT ? a.in(I_XP) + (size_t)R0 * DM : a.in(I_XS) + (size_t)(R0 - 32768) * DM)
#define XO (a.out() + (size_t)R0 * DM)
#define XCUR (l == 0 ? XIN0 : (const float*)XO)
#define MODL ((const float*)(a.ws() + WS_MOD) + (size_t)l * 24 * 12288)
#define WL (a.ws() + WS_W + (size_t)l * W_LAYER)
        if (PH(2)) { LAUNDER(); phase_norm(XCUR, a.in(I_N1G) + l * DM, MODL, 0, 2048, SEQ0, TSH, (bf16*)(a.ws() + A_H), GW, NGW_, lane); }
        if (DUP(2)) { LAUNDER(); __syncthreads(); phase_norm(XCUR, a.in(I_N1G) + l * DM, MODL, 0, 2048, SEQ0, TSH, (bf16*)(a.ws() + A_H), GW, NGW_, lane); }
        GRID_BAR(); CHECK_HOOK(1, c, l);
        for (int rep_ = 0; rep_ < (PH(3) ? 1 + DUP(3) : 0); ++rep_) { LAUNDER(); unsigned char* ws = a.ws(); pg8::Gemm g{(const pg8::bf16_t*)(ws + A_H), (const pg8::bf16_t*)(WL + WO_IG), CH, 2 * INC, DM}; pg8::StaticOrder So; So.init(CH, 2 * INC, G, bid);
          pg8::EpiIn E{(pg8::bf16_t*)(ws + A_Z), (pg8::bf16_t*)(ws + A_G), a.in(I_BGATE) + l * INC};
          pg8::gemm_phase<pg8::EpiIn, pg8::StaticOrder, true, true>(lds + RING_OFF, g, So, E); }
        GRID_BAR(); CHECK_HOOK(2, c, l);
        if (PH(4)) { LAUNDER(); phase_prep(a, l, lds, S_, TSH, GW, NGW_, wave, lane); }
        if (DUP(4)) { LAUNDER(); __syncthreads(); phase_prep(a, l, lds, S_, TSH, GW, NGW_, wave, lane); }
        GRID_BAR(); CHECK_HOOK(3, c, l);
        if (PH(5)) { LAUNDER(); phase_attn(a, l, lds, S_, TSH, tid, wave, lane); }
        if (DUP(5)) { LAUNDER(); __syncthreads(); phase_attn(a, l, lds, S_, TSH, tid, wave, lane); }
        GRID_BAR(); CHECK_HOOK(4, c, l);
        if (PH(6)) { LAUNDER(); phase_combine(a, l, GW, NGW_, lane); }
        if (DUP(6)) { LAUNDER(); __syncthreads(); phase_combine(a, l, GW, NGW_, lane); }
        GRID_BAR(); CHECK_HOOK(5, c, l);
        for (int rep_ = 0; rep_ < (PH(7) ? 1 + DUP(7) : 0); ++rep_) {
          { LAUNDER(); unsigned char* ws = a.ws(); pg8::StaticOrder So; So.init(CH, DM, G, bid);
            pg8::Gemm g{(const pg8::bf16_t*)(ws + A_OA), (const pg8::bf16_t*)(WL + WO_BRA), CH, DM, 512}; pg8::EpiBr<0> E{(float*)(ws + A_TMPF), (pg8::bf16_t*)(ws + A_H), (const pg8::bf16_t*)(ws + A_G), 0};
            pg8::gemm_phase<pg8::EpiBr<0>, pg8::StaticOrder, true, true>(lds + RING_OFF, g, So, E); }
          { LAUNDER(); unsigned char* ws = a.ws(); pg8::StaticOrder So; So.init(CH, DM, G, bid);
            pg8::Gemm g{(const pg8::bf16_t*)(ws + A_OB), (const pg8::bf16_t*)(WL + WO_BRB), CH, DM, 256}; pg8::EpiBr<1> E{(float*)(ws + A_TMPF), (pg8::bf16_t*)(ws + A_H), (const pg8::bf16_t*)(ws + A_G), 2048};
            pg8::gemm_phase<pg8::EpiBr<1>, pg8::StaticOrder, true, true>(lds + RING_OFF, g, So, E); }
          { LAUNDER(); unsigned char* ws = a.ws(); pg8::StaticOrder So; So.init(CH, DM, G, bid);
            pg8::Gemm g{(const pg8::bf16_t*)(ws + A_OC), (const pg8::bf16_t*)(WL + WO_BRC), CH, DM, 768}; pg8::EpiBr<2> E{(float*)(ws + A_TMPF), (pg8::bf16_t*)(ws + A_H), (const pg8::bf16_t*)(ws + A_G), 4096};
            pg8::gemm_phase<pg8::EpiBr<2>, pg8::StaticOrder, true, true>(lds + RING_OFF, g, So, E); } }
        GRID_BAR(); CHECK_HOOK(6, c, l);
        if (PH(8)) { LAUNDER(); unsigned char* ws = a.ws(); pg8::Gemm g{(const pg8::bf16_t*)(ws + A_H), (const pg8::bf16_t*)(WL + WO_OUT), CH, DM, DM}; pg8::StaticOrder So; So.init(CH, DM, G, bid);
          if (DUP(8)) { pg8::EpiRes E0{XCUR, (float*)(ws + A_G), MODL + 2 * 2048, SEQ0, TSH}; pg8::gemm_phase<pg8::EpiRes, pg8::StaticOrder, true, true>(lds + RING_OFF, g, So, E0); }
          pg8::EpiRes E{XCUR, XO, MODL + 2 * 2048, SEQ0, TSH};
          pg8::gemm_phase<pg8::EpiRes, pg8::StaticOrder, true, true>(lds + RING_OFF, g, So, E); }
        GRID_BAR(); CHECK_HOOK(7, c, l);
        if (PH(9)) { LAUNDER(); phase_norm(XO, a.in(I_N2G) + l * DM, MODL, 3 * 2048, 4 * 2048, SEQ0, TSH, (bf16*)(a.ws() + A_H), GW, NGW_, lane); }
        if (DUP(9)) { LAUNDER(); __syncthreads(); phase_norm(XO, a.in(I_N2G) + l * DM, MODL, 3 * 2048, 4 * 2048, SEQ0, TSH, (bf16*)(a.ws() + A_H), GW, NGW_, lane); }
        GRID_BAR(); CHECK_HOOK(8, c, l);
        for (int rep_ = 0; rep_ < (PH(10) ? 1 + DUP(10) : 0); ++rep_) { LAUNDER(); unsigned char* ws = a.ws(); pg8::Gemm g{(const pg8::bf16_t*)(ws + A_H), (const pg8::bf16_t*)(WL + WO_FF1), CH, DFF, DM}; pg8::StaticOrder So; So.init(CH, DFF, G, bid);
          pg8::EpiRelu2 E{(pg8::bf16_t*)(ws + A_U), DFF};
          pg8::gemm_phase<pg8::EpiRelu2, pg8::StaticOrder, true, true>(lds + RING_OFF, g, So, E); }
        GRID_BAR(); CHECK_HOOK(9, c, l);
        if (PH(11)) { LAUNDER(); unsigned char* ws = a.ws(); pg8::Gemm g{(const pg8::bf16_t*)(ws + A_U), (const pg8::bf16_t*)(WL + WO_FF2), CH, DM, DFF}; pg8::StaticOrder So; So.init(CH, DM, G, bid);
          if (DUP(11)) { pg8::EpiRes E0{XO, (float*)(ws + A_G), MODL + 5 * 2048, SEQ0, TSH}; pg8::gemm_phase<pg8::EpiRes, pg8::StaticOrder, true, true>(lds + RING_OFF, g, So, E0); }
          pg8::EpiRes E{XO, XO, MODL + 5 * 2048, SEQ0, TSH};
          pg8::gemm_phase<pg8::EpiRes, pg8::StaticOrder, true, true>(lds + RING_OFF, g, So, E); }
        GRID_BAR(); CHECK_HOOK(10, c, l);
    }
    CHECK_FINAL();
}

extern "C" void kernel_launch(void* const* d_in, const int* in_sizes, int n_in, void* d_out, int out_size, void* d_ws, size_t ws_size, hipStream_t stream) {
    static int grid = 0;
    if (grid == 0) {
        if (n_in != 29 || out_size != MTOT * DM || ws_size < WS_END) { fprintf(stderr, "kernel_launch: unexpected shapes (n_in %d out %d ws %zu need %zu)\n", n_in, out_size, ws_size, (size_t)WS_END); grid = -1; return; }
        int dev = 0, cus = 0, per_cu = 0;
        if (hipGetDevice(&dev) != hipSuccess || hipDeviceGetAttribute(&cus, hipDeviceAttributeMultiprocessorCount, dev) != hipSuccess) { grid = -1; return; }
        if (hipFuncSetAttribute((const void*)fwd, hipFuncAttributeMaxDynamicSharedMemorySize, LDS_BYTES) != hipSuccess) { grid = -1; return; }
        if (hipOccupancyMaxActiveBlocksPerMultiprocessor(&per_cu, (const void*)fwd, NWAVES * 64, LDS_BYTES) != hipSuccess || per_cu < 1) { fprintf(stderr, "kernel_launch: occupancy query says %d\n", per_cu); }
        (void)hipGetLastError();
        grid = cus;
    }
    if (grid < 0) return;
    if (hipMemsetAsync((char*)d_ws + WS_CTL, 0, CTL_ZERO_BYTES, stream) != hipSuccess) return;
    Args a{};
    for (int i = 0; i < 29; ++i) a.in[i] = (const float*)d_in[i];
    a.out = (float*)d_out; a.ws = (unsigned char*)d_ws;
    hipLaunchKernelGGL(fwd, dim3(grid), dim3(NWAVES * 64), LDS_BYTES, stream, a);
}
```

```cpp
#include <hip/hip_runtime.h>
#include <hip/hip_bf16.h>
#include <cstdio>
#include <cstdint>
#include <cmath>
namespace pg8 {
#define PG8_LAS __attribute__((address_space(3)))
typedef unsigned short bf16_t;
typedef short bf16x8 __attribute__((ext_vector_type(8)));
typedef float f32x4 __attribute__((ext_vector_type(4)));
typedef unsigned u32x4 __attribute__((ext_vector_type(4)));
constexpr int BM = 256, BK = 64, HALF = 128, HTB = HALF * BK * 2  , STAGE_BYTES = 8 * HTB, NXCD = 8, WGM = 8;

__host__ __device__ __forceinline__ int lds_byte(int r, int c) { const int st = (r >> 4) * 2 + (c >> 5), rr = r & 15, cc = c & 31, ob = rr * 64 + cc * 2; return st * 1024 + (ob ^ (((ob >> 9) & 1) << 5)); }
__host__ __device__ __forceinline__ void stage_rc(int b, int& R, int& C) { const int st = b / 1024, sb = b % 1024, swz = sb ^ (((sb >> 9) & 1) << 5); R = (st >> 1) * 16 + swz / 64; C = (st & 1) * 32 + (swz % 64) / 2; }
__host__ __device__ __forceinline__ int perm32(int rho) { const int n = rho >> 4, i = rho & 15; return 8 * (i >> 2) + 4 * n + (i & 3); }

struct Unit { int pm, pn; };
struct Gemm { const bf16_t* A; const bf16_t* Bt; int M, N, K; };

struct StaticOrder {
    int nM, nN, nwg, G, c;
    __host__ __device__ void init(int M, int N, int G_, int c_) { nM = M / BM; nN = N / BM; nwg = nM * nN; G = G_; c = c_; }
    __host__ __device__ bool next(int i, Unit& u) const {
        const long L = (long)i * G + c; if (L >= nwg) return false;
        int wgid = (int)L; { const int q = nwg / NXCD, r = nwg % NXCD, xcd = wgid % NXCD, off = wgid / NXCD; wgid = (xcd < r ? xcd * (q + 1) : r * (q + 1) + (xcd - r) * q) + off; }
        const int nig = WGM * nN, gid = wgid / nig, fm = gid * WGM, gsz = (nM - fm) < WGM ? (nM - fm) : WGM;
        u.pm = fm + ((wgid % nig) % gsz); u.pn = (wgid % nig) / gsz; return true;
    }
    __device__ __forceinline__ void a_ready(const Unit&) const {}
    __device__ __forceinline__ void done(const Unit&) const {}
};

typedef float f32x2 __attribute__((ext_vector_type(2)));
typedef __bf16 bf16x2v __attribute__((ext_vector_type(2)));
typedef unsigned u32x2 __attribute__((ext_vector_type(2)));
__device__ __forceinline__ unsigned cvt_pk_bf16(float lo, float hi) { f32x2 v = {lo, hi}; bf16x2v b = __builtin_convertvector(v, bf16x2v); return __builtin_bit_cast(unsigned, b); }
__device__ __forceinline__ float sigm(float x) { return fmaxf(__builtin_amdgcn_rcpf(1.0f + __expf(-x)), 1e-30f); }

struct EpiIn {
    static constexpr bool PERM = true, AFTER_DRAIN = false, HAS_MID = false; static constexpr int MID_T0 = -1, MID_T1 = -1;
    bf16_t* Z; bf16_t* G; const float* bgate;
    __device__ __forceinline__ void operator()(const f32x4 (&acc)[2][2][4][2], const Unit& u, int wr, int wc, int fr, int fq) const {
        const int row0 = u.pm * BM + wr * 64 + fr; const bool gate = u.pn >= 24;
        const int col0 = (gate ? u.pn - 24 : u.pn) * BM + wc * 32 + 8 * fq; bf16_t* base = gate ? G : Z;
        f32x4 bv[2][2];
#pragma unroll
        for (int bj = 0; bj < 2; ++bj)
#pragma unroll
            for (int n = 0; n < 2; ++n) bv[bj][n] = gate ? *(const f32x4*)(bgate + col0 + bj * HALF + 4 * n) : (f32x4){0.f, 0.f, 0.f, 0.f};
#pragma unroll
        for (int ai = 0; ai < 2; ++ai)
#pragma unroll
            for (int m = 0; m < 4; ++m) { bf16_t* rowp = base + (size_t)(row0 + ai * HALF + m * 16) * 6144 + col0;
#pragma unroll
                for (int bj = 0; bj < 2; ++bj) { f32x4 v0 = acc[ai][bj][m][0] + bv[bj][0], v1 = acc[ai][bj][m][1] + bv[bj][1];
                    if (gate) { v0 = (f32x4){sigm(v0[0]), sigm(v0[1]), sigm(v0[2]), sigm(v0[3])}; v1 = (f32x4){sigm(v1[0]), sigm(v1[1]), sigm(v1[2]), sigm(v1[3])}; }
                    u32x4 w; w.x = cvt_pk_bf16(v0[0], v0[1]); w.y = cvt_pk_bf16(v0[2], v0[3]); w.z = cvt_pk_bf16(v1[0], v1[1]); w.w = cvt_pk_bf16(v1[2], v1[3]);
                    *(u32x4*)(rowp + bj * HALF) = w; } }
    }
};
struct EpiRelu2 {
    static constexpr bool PERM = true, AFTER_DRAIN = false, HAS_MID = false; static constexpr int MID_T0 = -1, MID_T1 = -1;
    bf16_t* O; int ldc;
    __device__ __forceinline__ void operator()(const f32x4 (&acc)[2][2][4][2], const Unit& u, int wr, int wc, int fr, int fq) const {
        const int row0 = u.pm * BM + wr * 64 + fr, col0 = u.pn * BM + wc * 32 + 8 * fq;
#pragma unroll
        for (int ai = 0; ai < 2; ++ai)
#pragma unroll
            for (int m = 0; m < 4; ++m) { bf16_t* rowp = O + (size_t)(row0 + ai * HALF + m * 16) * ldc + col0;
#pragma unroll
                for (int bj = 0; bj < 2; ++bj) { f32x4 v0 = acc[ai][bj][m][0], v1 = acc[ai][bj][m][1];
#pragma unroll
                    for (int e = 0; e < 4; ++e) { const float a0 = v0[e] > 0.f ? v0[e] : 0.f, a1 = v1[e] > 0.f ? v1[e] : 0.f; v0[e] = a0 * a0; v1[e] = a1 * a1; }
                    u32x4 w; w.x = cvt_pk_bf16(v0[0], v0[1]); w.y = cvt_pk_bf16(v0[2], v0[3]); w.z = cvt_pk_bf16(v1[0], v1[1]); w.w = cvt_pk_bf16(v1[2], v1[3]);
                    *(u32x4*)(rowp + bj * HALF) = w; } }
    }
};
struct EpiRes {
    static constexpr bool PERM = false, AFTER_DRAIN = false, HAS_MID = false; static constexpr int MID_T0 = -1, MID_T1 = -1;
    const float* xin; float* xout; const float* gbase; int seq0, tshift;
    __device__ __forceinline__ void operator()(const f32x4 (&acc)[2][2][4][2], const Unit& u, int wr, int wc, int fr, int fq) const {
        const int row0 = u.pm * BM + wr * 64 + fr, col0 = u.pn * BM + wc * 32 + 4 * fq;
        const float* gp = gbase + (size_t)(seq0 + ((u.pm * BM) >> tshift)) * 12288 + col0;
        f32x4 gv[2][2];
#pragma unroll
        for (int bj = 0; bj < 2; ++bj)
#pragma unroll
            for (int n = 0; n < 2; ++n) gv[bj][n] = *(const f32x4*)(gp + bj * HALF + n * 16);
#pragma unroll
        for (int ai = 0; ai < 2; ++ai)
#pragma unroll
            for (int m = 0; m < 4; ++m) { const size_t off = (size_t)(row0 + ai * HALF + m * 16) * 2048 + col0;
#pragma unroll
                for (int bj = 0; bj < 2; ++bj)
#pragma unroll
                    for (int n = 0; n < 2; ++n) { const f32x4 xi = *(const f32x4*)(xin + off + bj * HALF + n * 16);
                        *(f32x4*)(xout + off + bj * HALF + n * 16) = xi + gv[bj][n] * acc[ai][bj][m][n]; } }
    }
};
template <int MODE> struct EpiBr {
    static constexpr bool PERM = false, AFTER_DRAIN = false, HAS_MID = false; static constexpr int MID_T0 = -1, MID_T1 = -1;
    float* T; bf16_t* MRG; const bf16_t* Gt; int gcol0;
    __device__ __forceinline__ void operator()(const f32x4 (&acc)[2][2][4][2], const Unit& u, int wr, int wc, int fr, int fq) const {
        const int row0 = u.pm * BM + wr * 64 + fr, col0 = u.pn * BM + wc * 32 + 4 * fq;
#pragma unroll
        for (int ai = 0; ai < 2; ++ai)
#pragma unroll
            for (int m = 0; m < 4; ++m) { const size_t row = (size_t)(row0 + ai * HALF + m * 16);
#pragma unroll
                for (int bj = 0; bj < 2; ++bj)
#pragma unroll
                    for (int n = 0; n < 2; ++n) { const int col = col0 + bj * HALF + n * 16;
                        const u32x2 gw = *(const u32x2*)(Gt + row * 6144 + gcol0 + col);
                        const f32x4 g = {__uint_as_float(gw.x << 16), __uint_as_float(gw.x & 0xffff0000u), __uint_as_float(gw.y << 16), __uint_as_float(gw.y & 0xffff0000u)};
                        f32x4 v = g * acc[ai][bj][m][n];
                        if (MODE >= 1) v = v + *(const f32x4*)(T + row * 2048 + col);
                        if (MODE <= 1) *(f32x4*)(T + row * 2048 + col) = v;
                        else { u32x2 w; w.x = cvt_pk_bf16(v[0], v[1]); w.y = cvt_pk_bf16(v[2], v[3]); *(u32x2*)(MRG + row * 2048 + col) = w; } } }
    }
};

struct EpiBrM {
    static constexpr bool PERM = false, AFTER_DRAIN = false, HAS_MID = true; static constexpr int MID_T0 = 8, MID_T1 = 12;
    bf16_t* MRG; const bf16_t* Gt;
    __device__ __forceinline__ static f32x4 ld4(const bf16_t* p) { const u32x2 w = *(const u32x2*)p;
        return (f32x4){__uint_as_float(w.x << 16), __uint_as_float(w.x & 0xffff0000u), __uint_as_float(w.y << 16), __uint_as_float(w.y & 0xffff0000u)}; }
    __device__ __forceinline__ void mid(f32x4 (&acc)[2][2][4][2], const Unit& u, int t, int wr, int wc, int fr, int fq) const {
        int row0 = u.pm * BM + wr * 64 + fr, col0 = u.pn * BM + wc * 32 + 4 * fq; const int gprev = t == MID_T0 ? 0 : 2048;
        asm volatile("" : "+v"(row0), "+v"(col0));
#pragma unroll
        for (int ai = 0; ai < 2; ++ai)
#pragma unroll
            for (int m = 0; m < 4; ++m) { const bf16_t* gp = Gt + (unsigned)((row0 + ai * HALF + m * 16) * 6144 + gprev + col0);
#pragma unroll
                for (int bj = 0; bj < 2; ++bj) {
#pragma unroll
                    for (int n = 0; n < 2; ++n) { const f32x4 a = ld4(gp + bj * HALF + n * 16), b = ld4(gp + 2048 + bj * HALF + n * 16);
                        const f32x4 r = {a[0] * __builtin_amdgcn_rcpf(b[0]), a[1] * __builtin_amdgcn_rcpf(b[1]), a[2] * __builtin_amdgcn_rcpf(b[2]), a[3] * __builtin_amdgcn_rcpf(b[3])};
                        acc[ai][bj][m][n] = acc[ai][bj][m][n] * r; }
                    asm volatile("" ::: "memory"); } }
    }
    __device__ __forceinline__ void operator()(const f32x4 (&acc)[2][2][4][2], const Unit& u, int wr, int wc, int fr, int fq) const {
        const int row0 = u.pm * BM + wr * 64 + fr, col0 = u.pn * BM + wc * 32 + 4 * fq;
#pragma unroll
        for (int ai = 0; ai < 2; ++ai)
#pragma unroll
            for (int m = 0; m < 4; ++m) { const size_t row = (size_t)(row0 + ai * HALF + m * 16);
#pragma unroll
                for (int bj = 0; bj < 2; ++bj)
#pragma unroll
                    for (int n = 0; n < 2; ++n) { const int col = col0 + bj * HALF + n * 16;
                        const f32x4 v = ld4(Gt + row * 6144 + 4096 + col) * acc[ai][bj][m][n];
                        u32x2 w; w.x = cvt_pk_bf16(v[0], v[1]); w.y = cvt_pk_bf16(v[2], v[3]); *(u32x2*)(MRG + row * 2048 + col) = w; } }
    }
};

template <class Epi, class Sched, bool ALIGN_EPI = false, bool SP2 = false>
__device__ __forceinline__ void gemm_phase(PG8_LAS unsigned char* lds, const Gemm g, const Sched& S, const Epi& E) {
    int tid_ = threadIdx.x; asm volatile("" : "+v"(tid_));
    const int tid = tid_, wid = __builtin_amdgcn_readfirstlane(tid >> 6), lane = tid & 63, wr = wid >> 2, wc = wid & 3, fr = lane & 15, fq = lane >> 4;
    const int K = g.K, nt = K / BK;
    unsigned voffA[2], voffB[2];
#pragma unroll
    for (int i = 0; i < 2; ++i) { int R, C; stage_rc(tid * 16 + i * 8192, R, C); const int Rb = Epi::PERM ? ((R & ~31) + perm32(R & 31)) : R;
        voffA[i] = (unsigned)(R * K + C) * 2u; voffB[i] = (unsigned)(Rb * K + C) * 2u; }
    const size_t kstep = (size_t)(BK * 2);
    const size_t hstep = (size_t)HALF * K * 2;
    const size_t tstep = 2 * hstep;
    const unsigned ldsw = (unsigned)wid * 1024u;
    const int aoff = lds_byte(wr * 64 + fr, fq * 8), boff = lds_byte(wc * 32 + fr, fq * 8);
#define PG8_SA(b, h) (((b) * 2 + (h)) * HTB)
#define PG8_SB(b, h) ((4 + (b) * 2 + (h)) * HTB)
#define PG8_STAGE(bufoff, gbase, voff) do { _Pragma("unroll") for (int _i = 0; _i < 2; ++_i) \
        __builtin_amdgcn_global_load_lds((const unsigned*)((const char*)(gbase) + (voff)[_i]), (PG8_LAS unsigned*)(lds + (bufoff) + ldsw + _i * 8192), 16, 0, 0); } while (0)
#define PG8_LDA(dst, b, h) do { _Pragma("unroll") for (int m = 0; m < 4; ++m) _Pragma("unroll") for (int k = 0; k < 2; ++k) dst[m][k] = *(const PG8_LAS bf16x8*)(lds + PG8_SA(b, h) + aoff + m * 2048 + k * 1024); } while (0)
#define PG8_LDB(dst, b, h) do { _Pragma("unroll") for (int n = 0; n < 2; ++n) _Pragma("unroll") for (int k = 0; k < 2; ++k) dst[n][k] = *(const PG8_LAS bf16x8*)(lds + PG8_SB(b, h) + boff + n * 2048 + k * 1024); } while (0)
#define PG8_MMA(ai, bj, At, Bt) do { __builtin_amdgcn_s_setprio(1); _Pragma("unroll") for (int m = 0; m < 4; ++m) _Pragma("unroll") for (int n = 0; n < 2; ++n) _Pragma("unroll") for (int k = 0; k < 2; ++k) \
        acc[ai][bj][m][n] = __builtin_amdgcn_mfma_f32_16x16x32_bf16(Bt[n][k], At[m][k], acc[ai][bj][m][n], 0, 0, 0); __builtin_amdgcn_s_setprio(0); } while (0)
#define PG8_WAIT_V(n) asm volatile("s_waitcnt vmcnt(" #n ")" ::: "memory")
#define PG8_WAIT_L(n) asm volatile("s_waitcnt lgkmcnt(" #n ")" ::: "memory")
#define PG8_BAR __builtin_amdgcn_s_barrier()
#define PG8_SCHED __builtin_amdgcn_sched_barrier(0)
    Unit cur, nxt; int ui = 0;
    if (!S.next(0, cur)) return;
    f32x4 acc[2][2][4][2];
#pragma unroll
    for (int a = 0; a < 2; ++a)
#pragma unroll
        for (int b = 0; b < 2; ++b)
#pragma unroll
            for (int m = 0; m < 4; ++m)
#pragma unroll
                for (int n = 0; n < 2; ++n) acc[a][b][m][n] = (f32x4){0.f, 0.f, 0.f, 0.f};
    bf16x8 At[4][2], B0[2][2], B1[2][2];
    const char* cA = (const char*)g.A + (size_t)cur.pm * tstep; const char* cB = (const char*)g.Bt + (size_t)cur.pn * tstep;
    S.a_ready(cur);
    if constexpr (SP2) {
        PG8_STAGE(PG8_SB(0, 0), cB, voffB); PG8_STAGE(PG8_SB(0, 1), cB + hstep, voffB); PG8_STAGE(PG8_SA(0, 0), cA, voffA); PG8_STAGE(PG8_SA(0, 1), cA + hstep, voffA);
        if (wr == 1) PG8_BAR;
        PG8_WAIT_V(2); PG8_BAR;
        PG8_STAGE(PG8_SB(1, 0), cB + kstep, voffB); PG8_STAGE(PG8_SA(1, 0), cA + kstep, voffA); PG8_STAGE(PG8_SB(1, 1), cB + hstep + kstep, voffB);
        PG8_WAIT_V(6); PG8_BAR;
    } else {
        PG8_STAGE(PG8_SB(0, 0), cB, voffB); PG8_STAGE(PG8_SA(0, 0), cA, voffA); PG8_STAGE(PG8_SB(0, 1), cB + hstep, voffB); PG8_STAGE(PG8_SA(0, 1), cA + hstep, voffA);
        if (wr == 1) PG8_BAR;
        PG8_WAIT_V(4); PG8_BAR;
        PG8_STAGE(PG8_SB(1, 0), cB + kstep, voffB); PG8_STAGE(PG8_SA(1, 0), cA + kstep, voffA); PG8_STAGE(PG8_SB(1, 1), cB + hstep + kstep, voffB);
        PG8_WAIT_V(6); PG8_BAR;
    }
    for (;;) {
        const bool has_next = S.next(ui + 1, nxt);
        const char* nA = has_next ? (const char*)g.A + (size_t)nxt.pm * tstep : cA; const char* nB = has_next ? (const char*)g.Bt + (size_t)nxt.pn * tstep : cB;
#pragma unroll 1
        for (int t = 0; t < nt; t += 2) {
            if constexpr (Epi::HAS_MID) { if (t == Epi::MID_T0 || t == Epi::MID_T1) E.mid(acc, cur, t, wr, wc, fr, fq); }
            const bool last = (t == nt - 2);
            const char* a1 = cA + (size_t)(t + 1) * kstep;
            const char* a2 = last ? nA : cA + (size_t)(t + 2) * kstep; const char* b2 = last ? nB : cB + (size_t)(t + 2) * kstep;
            const char* a3 = a2 + kstep; const char* b3 = b2 + kstep;
            if (last && has_next) S.a_ready(nxt);
            if constexpr (SP2) {
            PG8_LDB(B0, 0, 0); PG8_LDB(B1, 0, 1); PG8_SCHED; PG8_LDA(At, 0, 0); PG8_STAGE(PG8_SA(1, 1), a1 + hstep, voffA);
            PG8_WAIT_V(8); PG8_WAIT_L(0); PG8_BAR; PG8_MMA(0, 0, At, B0); PG8_MMA(0, 1, At, B1); PG8_BAR; PG8_SCHED;
            PG8_LDA(At, 0, 1); PG8_STAGE(PG8_SB(0, 0), b2, voffB); PG8_STAGE(PG8_SB(0, 1), b2 + hstep, voffB); PG8_STAGE(PG8_SA(0, 0), a2, voffA);
            PG8_WAIT_V(8); PG8_WAIT_L(0); PG8_BAR; PG8_MMA(1, 0, At, B0); PG8_MMA(1, 1, At, B1); PG8_BAR; PG8_SCHED;
            PG8_LDB(B0, 1, 0); PG8_LDB(B1, 1, 1); PG8_SCHED; PG8_LDA(At, 1, 0); PG8_STAGE(PG8_SA(0, 1), a2 + hstep, voffA);
            PG8_WAIT_V(8); PG8_WAIT_L(0); PG8_BAR; PG8_MMA(0, 0, At, B0); PG8_MMA(0, 1, At, B1); PG8_BAR; PG8_SCHED;
            PG8_LDA(At, 1, 1); PG8_STAGE(PG8_SB(1, 0), b3, voffB); PG8_STAGE(PG8_SB(1, 1), b3 + hstep, voffB); PG8_STAGE(PG8_SA(1, 0), a3, voffA);
            PG8_WAIT_V(8); PG8_WAIT_L(0); PG8_BAR; PG8_MMA(1, 0, At, B0); PG8_MMA(1, 1, At, B1); PG8_BAR; PG8_SCHED;
            } else {
            PG8_LDB(B0, 0, 0); PG8_SCHED; PG8_LDA(At, 0, 0); PG8_STAGE(PG8_SA(1, 1), a1 + hstep, voffA);
            PG8_WAIT_L(8); PG8_BAR; PG8_WAIT_L(0); PG8_MMA(0, 0, At, B0); PG8_BAR; PG8_SCHED;
            PG8_LDB(B1, 0, 1); PG8_STAGE(PG8_SB(0, 0), b2, voffB);
            PG8_BAR; PG8_WAIT_L(0); PG8_MMA(0, 1, At, B1); PG8_BAR;
            PG8_LDA(At, 0, 1); PG8_STAGE(PG8_SA(0, 0), a2, voffA);
            PG8_BAR; PG8_WAIT_L(0); PG8_MMA(1, 0, At, B0); PG8_BAR; PG8_SCHED;
            PG8_STAGE(PG8_SB(0, 1), b2 + hstep, voffB);
            PG8_WAIT_V(6); PG8_BAR; PG8_MMA(1, 1, At, B1); PG8_BAR;
            PG8_LDB(B0, 1, 0); PG8_SCHED; PG8_LDA(At, 1, 0); PG8_STAGE(PG8_SA(0, 1), a2 + hstep, voffA);
            PG8_WAIT_L(8); PG8_BAR; PG8_WAIT_L(0); PG8_MMA(0, 0, At, B0); PG8_BAR; PG8_SCHED;
            PG8_LDB(B1, 1, 1); PG8_STAGE(PG8_SB(1, 0), b3, voffB);
            PG8_BAR; PG8_WAIT_L(0); PG8_MMA(0, 1, At, B1); PG8_BAR;
            PG8_LDA(At, 1, 1); PG8_STAGE(PG8_SA(1, 0), a3, voffA);
            PG8_BAR; PG8_WAIT_L(0); PG8_MMA(1, 0, At, B0); PG8_BAR; PG8_SCHED;
            PG8_STAGE(PG8_SB(1, 1), b3 + hstep, voffB);
            PG8_WAIT_V(6); PG8_BAR; PG8_MMA(1, 1, At, B1); PG8_BAR;
            }
        }
        if constexpr (ALIGN_EPI) { if (wr == 0) PG8_BAR; }
        if constexpr (!Epi::AFTER_DRAIN) { E(acc, cur, wr, wc, fr, fq); S.done(cur); }
        if (!has_next) break;
#pragma unroll
        for (int a = 0; a < 2; ++a)
#pragma unroll
            for (int b = 0; b < 2; ++b)
#pragma unroll
                for (int m = 0; m < 4; ++m)
#pragma unroll
                    for (int n = 0; n < 2; ++n) acc[a][b][m][n] = (f32x4){0.f, 0.f, 0.f, 0.f};
        cur = nxt; cA = nA; cB = nB; ++ui;
        if constexpr (ALIGN_EPI) { if (wr == 1) PG8_BAR; }
    }
    PG8_WAIT_V(0);
    if constexpr (!ALIGN_EPI) { if (wr == 0) PG8_BAR; }
    PG8_BAR;
    if constexpr (Epi::AFTER_DRAIN) { E.fused(acc, cur, wr, wc, fr, fq, lds, wid, lane); S.done(cur); }
#undef PG8_SA
#undef PG8_SB
#undef PG8_STAGE
#undef PG8_LDA
#undef PG8_LDB
#undef PG8_MMA
#undef PG8_WAIT_V
#undef PG8_WAIT_L
#undef PG8_BAR
#undef PG8_SCHED
}
}

constexpr int NWAVES = 8;
constexpr int DM = 2048, NSEQ = 24, MTOT = 65536, DFF = 8192, INC = 6144;
#ifndef MK_CH
#define MK_CH 16384
#endif
constexpr int CH = MK_CH;
constexpr int NCHUNK = MTOT / CH;
constexpr float EPS = 1e-6f, LOG2E = 1.4426950408889634f, LN2 = 0.6931471805599453f;
constexpr float QS128 = 0.08838834764831845f * LOG2E, QS64 = 0.125f * LOG2E;
constexpr float NEGB = -1e30f;

constexpr size_t MiB = 1u << 20;
constexpr size_t WS_CTL = 0, CTL_ZERO_BYTES = 1 * MiB;
constexpr size_t WS_MOD = 1 * MiB;
constexpr size_t WS_ROPEB = 4 * MiB, WS_ROPEC = WS_ROPEB + 512 * 1024;
constexpr size_t WS_LAM = 5 * MiB;
constexpr size_t WS_MODP = 6 * MiB;
constexpr size_t WS_W = 48 * MiB, W_LAYER = 126 * MiB;
constexpr size_t WO_IG = 0, WO_BRA = 48 * MiB, WO_BRB = 50 * MiB, WO_BRC = 51 * MiB, WO_OUT = 54 * MiB, WO_FF1 = 62 * MiB, WO_FF2 = 94 * MiB;
constexpr size_t WS_ACT = 304 * MiB;
constexpr size_t CHS = (size_t)CH;
constexpr size_t A_H = WS_ACT;
constexpr size_t A_Z = A_H + CHS * 2048 * 2;
constexpr size_t A_QK = A_Z + CHS * 6144 * 2;
constexpr size_t A_VT = A_QK + CHS * 4096 * 2;
constexpr size_t A_G = A_VT + CHS * 2048 * 2;
constexpr size_t A_OA = A_G + CHS * 6144 * 2;
constexpr size_t A_OB = A_OA + CHS * 512 * 2;
constexpr size_t A_OC = A_OB + CHS * 256 * 2;
constexpr size_t WS_END = A_OC + CHS * 768 * 2;
constexpr size_t A_BTMP = A_Z;
constexpr size_t A_BLSE = A_BTMP + CHS * 768 * 2;
constexpr size_t A_CTMP = A_BLSE + CHS * 8 * 4;
static_assert(A_CTMP + CHS * 1536 * 4 <= A_QK, "attention temporaries fit in Z");
constexpr size_t A_TMPF = A_QK;
constexpr size_t A_U = A_Z;
static_assert(CHS * 8192 * 2 <= (A_VT - A_Z), "u fits in Z + QK");
constexpr int CW_BAR = 4096;
constexpr int CW_CHK = 65536;

constexpr int RING_OFF = 0, RING_BYTES = 131072;
constexpr int LDSCTL_OFF = RING_BYTES, MISC_OFF = LDSCTL_OFF + 320;
constexpr int LDS_BYTES = 147456;

#define GAS __attribute__((address_space(1)))
#define LAS __attribute__((address_space(3)))
typedef unsigned short bf16;
typedef unsigned v4u __attribute__((ext_vector_type(4)));
typedef unsigned v2u __attribute__((ext_vector_type(2)));
typedef float f32x4 __attribute__((ext_vector_type(4)));
typedef float f32x16 __attribute__((ext_vector_type(16)));
typedef short bf16x8 __attribute__((ext_vector_type(8)));
typedef GAS unsigned gu32;
#define LDS_WAIT() asm volatile("s_waitcnt lgkmcnt(0)" ::: "memory")
#define VM_WAIT() asm volatile("s_waitcnt vmcnt(0)" ::: "memory")
__device__ __forceinline__ unsigned pk2(float lo, float hi) { return pg8::cvt_pk_bf16(lo, hi); }
__device__ __forceinline__ float bflo(unsigned w) { return __uint_as_float(w << 16); }
__device__ __forceinline__ float bfhi(unsigned w) { return __uint_as_float(w & 0xffff0000u); }
__device__ __forceinline__ float bf1(bf16 b) { return __uint_as_float((unsigned)b << 16); }
__device__ __forceinline__ float wave_sum(float v) {
#pragma unroll
    for (int o = 1; o < 64; o <<= 1) v += __shfl_xor(v, o);
    return v;
}
#define XB_TMO      128
#define XB_XCNT(j)  (256  + 64 * (j))
#define XB_XSUB(j)  (1280 + 64 * (j))
#define XB_XGEN(j)  (2304 + 64 * (j))
#define XB_TOP      3328
#define XB_TOPGEN   3392
#define XCD_BAR_WORDS 3456
#define XB_SPIN_CAP (1u << 18)

__device__ __forceinline__ unsigned xb_ld(unsigned* p)              { return __hip_atomic_load(p, __ATOMIC_RELAXED, __HIP_MEMORY_SCOPE_AGENT); }
__device__ __forceinline__ unsigned xb_add(unsigned* p, unsigned v) { return __hip_atomic_fetch_add(p, v, __ATOMIC_RELAXED, __HIP_MEMORY_SCOPE_AGENT); }
__device__ __forceinline__ unsigned xb_xcc_id() { return (unsigned)__builtin_amdgcn_s_getreg((3 << 11) | 20) & 0xFu; }
#define XB_SPIN(cond, bar) do { unsigned _sp = 0; while (cond) { __builtin_amdgcn_s_sleep(1); \
    if ((++_sp & 255u) == 0u) { if (xb_ld(&(bar)[XB_TMO])) break; if (_sp > XB_SPIN_CAP) { atomicAdd(&(bar)[XB_TMO], 1u); break; } } } } while (0)

struct XcdBarrier {
    unsigned* bar; unsigned x;
    volatile LAS unsigned* st;
};

__device__ __forceinline__ XcdBarrier xcd_barrier_post(unsigned* bar, volatile LAS unsigned* st) {
    XcdBarrier b; b.bar = bar; b.x = xb_xcc_id(); b.st = st;
    if (threadIdx.x == 0) (void)xb_add(&bar[XB_XCNT(b.x)], 1u);
    return b;
}
__device__ __forceinline__ void xcd_barrier_complete(unsigned* bar, unsigned x, unsigned& nloc, unsigned& nx) {
    const unsigned G = gridDim.x * gridDim.y * gridDim.z;
    unsigned sum, cnt, mine, sp = 0u;
    for (;;) {
        sum = 0u; cnt = 0u; mine = 0u;
#pragma unroll
        for (unsigned j = 0; j < 16; ++j) { const unsigned c = xb_ld(&bar[XB_XCNT(j)]); sum += c; cnt += (c > 0u) ? 1u : 0u; mine = (j == x) ? c : mine; }
        if (sum == G) break;
        __builtin_amdgcn_s_sleep(1);
        if ((++sp & 255u) == 0u) { if (xb_ld(&bar[XB_TMO])) break; if (sp > XB_SPIN_CAP) { atomicAdd(&bar[XB_TMO], 1u); break; } }
    }
    nloc = mine > 0u ? mine : 1u; nx = cnt > 0u ? cnt : 1u;
}

__device__ __forceinline__ void xcd_barrier(const XcdBarrier& b) {
    asm volatile("s_waitcnt vmcnt(0)" ::: "memory");
    __syncthreads();
    if (threadIdx.x == 0) {
        unsigned* bar = b.bar;
        __builtin_amdgcn_s_waitcnt(0);
        unsigned nloc = b.st[0], nx = b.st[1];
        if (nloc == 0u) { xcd_barrier_complete(bar, b.x, nloc, nx); b.st[0] = nloc; b.st[1] = nx; }
        const unsigned old = xb_add(&bar[XB_XSUB(b.x)], 1u);
        const unsigned gen = old / nloc;
        if (old + 1u == (gen + 1u) * nloc) {
            __builtin_amdgcn_fence(__ATOMIC_RELEASE, "agent");
            asm volatile("s_waitcnt vmcnt(0)" ::: "memory");
            const unsigned og = xb_add(&bar[XB_TOP], 1u);
            const unsigned tg = og / nx;
            if (og + 1u == (tg + 1u) * nx) xb_add(&bar[XB_TOPGEN], 1u);
            else XB_SPIN(xb_ld(&bar[XB_TOPGEN]) == tg, bar);
            __builtin_amdgcn_fence(__ATOMIC_ACQUIRE, "agent");
            xb_add(&bar[XB_XGEN(b.x)], 1u);
            asm volatile("s_waitcnt vmcnt(0)" ::: "memory");
        } else {
            XB_SPIN(xb_ld(&bar[XB_XGEN(b.x)]) == gen, bar);
            __builtin_amdgcn_fence(__ATOMIC_ACQUIRE, "agent");
            asm volatile("s_waitcnt vmcnt(0)" ::: "memory");
        }
    }
    __syncthreads();
}

struct Args { const float* in[29]; float* out; unsigned char* ws; };
typedef const __attribute__((address_space(4))) unsigned long long* kargp_t;
struct AL {
    __device__ __forceinline__ static kargp_t kp() { kargp_t p = (kargp_t)__builtin_amdgcn_kernarg_segment_ptr(); asm volatile("" : "+s"(p)); return p; }
    __device__ __forceinline__ const float* in(int i) const { return (const float*)kp()[i]; }
    __device__ __forceinline__ float* out() const { return (float*)kp()[29]; }
    __device__ __forceinline__ unsigned char* ws() const { return (unsigned char*)kp()[30]; } };
enum { I_XP = 0, I_XS, I_CP, I_CS, I_N1G, I_WADA, I_BADA, I_WIN, I_QNA, I_KNA, I_RPB, I_QNB, I_KNB, I_QNC, I_KNC, I_LQ1, I_LK1, I_LQ2, I_LK2, I_SUBLN,
       I_WBRA, I_WBRB, I_WBRC, I_WGATE, I_BGATE, I_WOUT, I_N2G, I_WFF1, I_WFF2 };

__device__ __forceinline__ void phase_modp(const AL& a, LAS unsigned char* lds, int tid, int lane, int wave) {
    LAS float* sil = (LAS float*)lds;
    const float* wada = a.in(I_WADA); float* modp = (float*)(a.ws() + WS_MODP);
    for (int it = blockIdx.x; it < 256; it += gridDim.x) {
        const int l = it >> 7, ks = (it >> 3) & 15, cg = it & 7, k0 = ks * 128;
        for (int e = tid; e < 24 * 128; e += NWAVES * 64) { const int b = e >> 7, kk = e & 127;
            const float c = b < 8 ? a.in(I_CP)[b * 2048 + k0 + kk] : a.in(I_CS)[(b - 8) * 2048 + k0 + kk];
            sil[e] = c / (1.0f + __expf(-c)); }
        __syncthreads();
        const int n0 = cg * 1536 + wave * 192 + 3 * lane;
        float acc[24][3];
#pragma unroll
        for (int b = 0; b < 24; ++b) { acc[b][0] = 0.f; acc[b][1] = 0.f; acc[b][2] = 0.f; }
        const float* wp = wada + ((size_t)l * 2048 + k0) * 12288 + n0;
#pragma unroll 4
        for (int kk = 0; kk < 128; ++kk) {
            const float w0 = wp[(size_t)kk * 12288], w1 = wp[(size_t)kk * 12288 + 1], w2 = wp[(size_t)kk * 12288 + 2];
#pragma unroll
            for (int b = 0; b < 24; ++b) { const float s = sil[b * 128 + kk]; acc[b][0] += s * w0; acc[b][1] += s * w1; acc[b][2] += s * w2; }
        }
#pragma unroll
        for (int b = 0; b < 24; ++b) { float* o = modp + ((size_t)(ks * 2 + l) * 24 + b) * 12288 + n0; o[0] = acc[b][0]; o[1] = acc[b][1]; o[2] = acc[b][2]; }
        __syncthreads();
    }
}
__device__ __forceinline__ void p0_transpose_item(const float* W, int K, int N, bf16* WT, int row_off, LAS float* scr, int item, int lane, int ldk = 0, int koff = 0) {
    if (ldk == 0) ldk = K;
    const int nblk = N / 32, kb = item / nblk, nb = item % nblk, k0 = 64 * kb, n0 = 32 * nb;
#pragma unroll 8
    for (int i = 0; i < 32; ++i) { const int kk = 2 * i + (lane >> 5); scr[kk * 33 + (lane & 31)] = W[(size_t)(k0 + kk) * N + n0 + (lane & 31)]; }
    LDS_WAIT(); asm volatile("" ::: "memory");
    const int c = lane & 7;
#pragma unroll
    for (int j = 0; j < 4; ++j) { const int n = (lane >> 3) + 8 * j; const LAS float* s = scr + (8 * c) * 33 + n;
        v4u o; o.x = pk2(s[0 * 33], s[1 * 33]); o.y = pk2(s[2 * 33], s[3 * 33]); o.z = pk2(s[4 * 33], s[5 * 33]); o.w = pk2(s[6 * 33], s[7 * 33]);
        *(GAS v4u*)(WT + (size_t)(row_off + n0 + n) * ldk + koff + k0 + 8 * c) = o; }
    LDS_WAIT(); asm volatile("" ::: "memory");
}
__device__ __forceinline__ void phase_pro2(const AL& a, LAS unsigned char* lds, int tid, int lane, int wave, int G) {
    const int gt = blockIdx.x * (NWAVES * 64) + tid, NGT = G * NWAVES * 64;
    { float* mod = (float*)(a.ws() + WS_MOD); const float* modp = (const float*)(a.ws() + WS_MODP); const float* bada = a.in(I_BADA);
      for (int i = gt; i < 2 * 24 * 12288; i += NGT) { const int l = i / (24 * 12288), n = i % 12288; float s = bada[l * 12288 + n];
#pragma unroll
          for (int ks = 0; ks < 16; ++ks) s += modp[(size_t)ks * (2 * 24 * 12288) + i];
          mod[i] = s; } }
    { float2* rb = (float2*)(a.ws() + WS_ROPEB); float2* rc = (float2*)(a.ws() + WS_ROPEC);
      for (int i = gt; i < 4096 * 24; i += NGT) { const int pos = i / 24, j = i % 24; const bool isb = j < 16; const int ii = isb ? j : j - 16; const double half = isb ? 16.0 : 8.0;
          const double inv = exp(-(double)ii / half * 13.122363377404328);
          const double rev = (double)pos * inv * 0.15915494309189535;
          const float fr = (float)(rev - floor(rev));
          const float2 v = make_float2(__builtin_amdgcn_cosf(fr), __builtin_amdgcn_sinf(fr));
          if (isb) rb[pos * 16 + ii] = v; else rc[pos * 8 + ii] = v; } }
    if (gt < 2) { const int l = gt; float s1 = 0.f, s2 = 0.f;
        for (int i = 0; i < 64; ++i) { s1 += a.in(I_LQ1)[l * 64 + i] * a.in(I_LK1)[l * 64 + i]; s2 += a.in(I_LQ2)[l * 64 + i] * a.in(I_LK2)[l * 64 + i]; }
        const float lam_init = 0.8f - 0.6f * expf(-0.3f * (float)l);
        ((float*)(a.ws() + WS_LAM))[l] = expf(s1) - expf(s2) + lam_init;
        float gq = 0.f, gk = 0.f;
        for (int i = 0; i < 64; ++i) { gq = fmaxf(gq, fabsf(a.in(I_QNC)[l * 64 + i])); gk = fmaxf(gk, fabsf(a.in(I_KNC)[l * 64 + i])); }
        ((float*)(a.ws() + WS_LAM))[2 + l] = 8.0f * LOG2E * gq * gk * 1.02f; }
    LAS float* scr = (LAS float*)(lds + RING_OFF + wave * 16384);
    const int gw = blockIdx.x * NWAVES + wave, NGW = G * NWAVES;
    constexpr int I_IN = 32 * 192, I_BA = 8 * 64, I_BB = 4 * 64, I_BC = 12 * 64, I_OU = 32 * 64, I_F1 = 32 * 256, I_F2 = 128 * 64;
    constexpr int PER_L = 2 * I_IN + I_BA + I_BB + I_BC + I_OU + I_F1 + I_F2;
    for (int it = gw; it < 2 * PER_L; it += NGW) {
        const int l = it / PER_L; int r = it % PER_L; unsigned char* wl = a.ws() + WS_W + (size_t)l * W_LAYER;
        if (r < I_IN) { p0_transpose_item(a.in(I_WIN) + (size_t)l * 2048 * 6144, 2048, 6144, (bf16*)(wl + WO_IG), 0, scr, r, lane); continue; } r -= I_IN;
        if (r < I_IN) { p0_transpose_item(a.in(I_WGATE) + (size_t)l * 2048 * 6144, 2048, 6144, (bf16*)(wl + WO_IG), 6144, scr, r, lane); continue; } r -= I_IN;
        if (r < I_BA) { p0_transpose_item(a.in(I_WBRA) + (size_t)l * 512 * 2048, 512, 2048, (bf16*)(wl + WO_BRA), 0, scr, r, lane, 1536, 0); continue; } r -= I_BA;
        if (r < I_BB) { p0_transpose_item(a.in(I_WBRB) + (size_t)l * 256 * 2048, 256, 2048, (bf16*)(wl + WO_BRA), 0, scr, r, lane, 1536, 512); continue; } r -= I_BB;
        if (r < I_BC) { p0_transpose_item(a.in(I_WBRC) + (size_t)l * 768 * 2048, 768, 2048, (bf16*)(wl + WO_BRA), 0, scr, r, lane, 1536, 768); continue; } r -= I_BC;
        if (r < I_OU) { p0_transpose_item(a.in(I_WOUT) + (size_t)l * 2048 * 2048, 2048, 2048, (bf16*)(wl + WO_OUT), 0, scr, r, lane); continue; } r -= I_OU;
        if (r < I_F1) { p0_transpose_item(a.in(I_WFF1) + (size_t)l * 2048 * 8192, 2048, 8192, (bf16*)(wl + WO_FF1), 0, scr, r, lane); continue; } r -= I_F1;
        p0_transpose_item(a.in(I_WFF2) + (size_t)l * 8192 * 2048, 8192, 2048, (bf16*)(wl + WO_FF2), 0, scr, r, lane);
    }
}

__device__ __forceinline__ void phase_norm(const float* xsrc, const float* gn, const float* modl, int sh_off, int sc_off, int seq0, int tshift, bf16* H, int gw, int NGW, int lane) {
    for (int blk = gw; blk < CH / 8; blk += NGW) {
        const int r0 = blk * 8; const float* mo = modl + (size_t)(seq0 + (r0 >> tshift)) * 12288;
        f32x4 A[8], B[8];
#pragma unroll
        for (int j = 0; j < 8; ++j) { const int c = 4 * lane + 256 * j; const f32x4 g = *(const f32x4*)(gn + c), sc = *(const f32x4*)(mo + sc_off + c); A[j] = g * (1.0f + sc); B[j] = *(const f32x4*)(mo + sh_off + c); }
        for (int r = 0; r < 8; r += 2) {
            const f32x4* xr0 = (const f32x4*)(xsrc + (size_t)(r0 + r) * 2048) + lane; const f32x4* xr1 = xr0 + 512; f32x4 v0[8], v1[8]; float s0 = 0.f, s1 = 0.f;
#pragma unroll
            for (int j = 0; j < 8; ++j) { v0[j] = xr0[64 * j]; v1[j] = xr1[64 * j]; }
#pragma unroll
            for (int j = 0; j < 8; ++j) { s0 += (v0[j].x * v0[j].x + v0[j].y * v0[j].y) + (v0[j].z * v0[j].z + v0[j].w * v0[j].w); s1 += (v1[j].x * v1[j].x + v1[j].y * v1[j].y) + (v1[j].z * v1[j].z + v1[j].w * v1[j].w); }
            const float rstd0 = rsqrtf(wave_sum(s0) * (1.0f / 2048.0f) + EPS), rstd1 = rsqrtf(wave_sum(s1) * (1.0f / 2048.0f) + EPS);
            v2u* o8 = (v2u*)(H + (size_t)(r0 + r) * 2048) + lane;
#pragma unroll
            for (int j = 0; j < 8; ++j) { const f32x4 o = v0[j] * rstd0 * A[j] + B[j]; v2u w; w.x = pk2(o.x, o.y); w.y = pk2(o.z, o.w); o8[64 * j] = w; }
#pragma unroll
            for (int j = 0; j < 8; ++j) { const f32x4 o = v1[j] * rstd1 * A[j] + B[j]; v2u w; w.x = pk2(o.x, o.y); w.y = pk2(o.z, o.w); o8[512 + 64 * j] = w; }
        }
    }
}
__device__ __forceinline__ int perm_tok(int p, int dsh, int Lsh) { return dsh == 0 ? p : (((p & ((1 << Lsh) - 1)) << dsh) + (p >> Lsh)); }
__device__ __forceinline__ void prep_qk_item(const bf16* Z, bf16* QK, const AL& a, int l, int item, int S, int tshift, int lane) {
    const int slot = item & 31, rb = item >> 5;
    int srccol, dstcol, dsh = 0, kind = 0; const float* gain; float scale = 1.f;
    if (slot < 4) { srccol = 128 * slot; dstcol = 128 * slot; gain = a.in(I_QNA) + l * 128; scale = QS128; }
    else if (slot < 8) { const int j = slot - 4; srccol = 512 + 128 * j; dstcol = 512 + 128 * j; gain = a.in(I_KNA) + l * 128; }
    else if (slot < 14) { const int j = slot - 8; srccol = 1536 + 128 * j; dstcol = 1024 + 128 * j; kind = 1; gain = a.in(I_QNB) + l * 128; scale = QS128; dsh = 2 * (j >> 1); }
    else if (slot < 20) { const int j = slot - 14; srccol = 2304 + 128 * j; dstcol = 1792 + 128 * j; kind = 1; gain = a.in(I_KNB) + l * 128; dsh = 2 * (j >> 1); }
    else if (slot < 26) { const int j = slot - 20; srccol = 3840 + 128 * j; dstcol = 2560 + 128 * j; kind = 2; gain = a.in(I_QNC) + l * 64; scale = QS64; }
    else { const int j = slot - 26; srccol = 4608 + 128 * j; dstcol = 3328 + 128 * j; kind = 2; gain = a.in(I_KNC) + l * 64; }
    const int sub = lane & 15, Lsh = tshift - dsh;
    float g[8];
#pragma unroll
    for (int e = 0; e < 8; ++e) g[e] = gain[((8 * sub) & (kind == 2 ? 63 : 127)) + e];
    const float2* ropeB = (const float2*)(a.ws() + WS_ROPEB); const float2* ropeC = (const float2*)(a.ws() + WS_ROPEC);
    const int RS = kind == 1 ? 2 : 1, subg = kind == 1 ? sub : (sub & 7);
    const bool roper = kind != 0 && subg < 2 * RS, first = subg < RS; const int ib = 8 * (subg & (RS - 1));
    for (int p4 = 0; p4 < 16; p4 += 4) {
        v4u w[4]; int tt[4]; float2 cs[4][8];
#pragma unroll
        for (int q = 0; q < 4; ++q) { const int orow = rb * 64 + (p4 + q) * 4 + (lane >> 4), sl = orow >> tshift, p = orow & (S - 1);
            tt[q] = perm_tok(p, dsh, Lsh);
            w[q] = *(const v4u*)(Z + (size_t)((sl << tshift) + tt[q]) * 6144 + srccol + 8 * sub); }
        if (roper) {
#pragma unroll
            for (int q = 0; q < 4; ++q) { const float2* tab = kind == 1 ? ropeB + tt[q] * 16 + ib : ropeC + tt[q] * 8 + ib;
#pragma unroll
                for (int e = 0; e < 8; ++e) cs[q][e] = tab[e]; } }
#pragma unroll
        for (int q = 0; q < 4; ++q) { const int orow = rb * 64 + (p4 + q) * 4 + (lane >> 4);
            float y[8] = {bflo(w[q].x), bfhi(w[q].x), bflo(w[q].y), bfhi(w[q].y), bflo(w[q].z), bfhi(w[q].z), bflo(w[q].w), bfhi(w[q].w)};
            float ss = 0.f;
#pragma unroll
            for (int e = 0; e < 8; ++e) ss += y[e] * y[e];
            ss += __shfl_xor(ss, 1); ss += __shfl_xor(ss, 2); ss += __shfl_xor(ss, 4);
            if (kind != 2) ss += __shfl_xor(ss, 8);
            const float rstd = rsqrtf(ss * (kind == 2 ? (1.0f / 64.0f) : (1.0f / 128.0f)) + EPS);
#pragma unroll
            for (int e = 0; e < 8; ++e) y[e] = y[e] * rstd * g[e];
            if (kind != 0) {
                float pr[8];
#pragma unroll
                for (int e = 0; e < 8; ++e) pr[e] = __shfl_xor(y[e], RS);
                if (roper) {
#pragma unroll
                    for (int e = 0; e < 8; ++e) y[e] = first ? y[e] * cs[q][e].x - pr[e] * cs[q][e].y : y[e] * cs[q][e].x + pr[e] * cs[q][e].y; }
            }
            v4u o; o.x = pk2(y[0] * scale, y[1] * scale); o.y = pk2(y[2] * scale, y[3] * scale); o.z = pk2(y[4] * scale, y[5] * scale); o.w = pk2(y[6] * scale, y[7] * scale);
            *(v4u*)(QK + (size_t)orow * 4096 + dstcol + 8 * sub) = o; }
    }
}
struct VtItem { int srccol, dsh, sl, p0, vrow; };
__device__ __forceinline__ VtItem vt_decode(int item, int S, int tshift) {
    const int dh = item & 1, vh = (item >> 1) & 15, pb = item >> 5; VtItem v; v.dsh = 0;
    if (vh < 4) v.srccol = 1024 + 128 * vh; else if (vh < 10) { const int j = vh - 4; v.srccol = 3072 + 128 * j; v.dsh = 2 * (j >> 1); } else v.srccol = 5376 + 128 * (vh - 10);
    v.srccol += 64 * dh; const int o0 = pb * 64; v.sl = o0 >> tshift; v.p0 = o0 & (S - 1); v.vrow = (v.sl * 16 + vh) * 128 + 64 * dh; return v;
}
__device__ __forceinline__ void vt_load(const bf16* Z, const VtItem& v, int tshift, v4u (&w)[8], int lane) {
    const int Lsh = tshift - v.dsh;
#pragma unroll
    for (int pass = 0; pass < 8; ++pass) { const int i = pass * 8 + (lane >> 3), c8 = lane & 7, t = perm_tok(v.p0 + i, v.dsh, Lsh);
        w[pass] = *(const v4u*)(Z + (size_t)((v.sl << tshift) + t) * 6144 + v.srccol + 8 * c8); }
}
__device__ __forceinline__ void vt_store(bf16* VT, const VtItem& v, int S, const v4u (&w)[8], LAS unsigned short* T, int lane) {
#pragma unroll
    for (int pass = 0; pass < 8; ++pass) { const int i = pass * 8 + (lane >> 3), c8 = lane & 7;
        LAS unsigned short* tp = T + (8 * c8) * 68 + i;
        tp[0 * 68] = (unsigned short)(w[pass].x & 0xffffu); tp[1 * 68] = (unsigned short)(w[pass].x >> 16); tp[2 * 68] = (unsigned short)(w[pass].y & 0xffffu); tp[3 * 68] = (unsigned short)(w[pass].y >> 16);
        tp[4 * 68] = (unsigned short)(w[pass].z & 0xffffu); tp[5 * 68] = (unsigned short)(w[pass].z >> 16); tp[6 * 68] = (unsigned short)(w[pass].w & 0xffffu); tp[7 * 68] = (unsigned short)(w[pass].w >> 16); }
    LDS_WAIT(); asm volatile("" ::: "memory");
#pragma unroll
    for (int pass = 0; pass < 16; ++pass) { const int d = pass * 4 + (lane >> 4), c4 = lane & 15;
        const v2u x = *(const LAS v2u*)(T + d * 68 + 4 * c4);
        *(v2u*)(VT + (size_t)(v.vrow + d) * S + v.p0 + 4 * c4) = x; }
    LDS_WAIT(); asm volatile("" ::: "memory");
}
__device__ __forceinline__ void phase_prep(const AL& a, int l, LAS unsigned char* lds, int S, int tshift, int gw, int NGW, int wave, int lane) {
    const bf16* Z = (const bf16*)(a.ws() + A_Z); bf16* QK = (bf16*)(a.ws() + A_QK); bf16* VT = (bf16*)(a.ws() + A_VT);
    for (int it = gw; it < (CH / 64) * 32; it += NGW) prep_qk_item(Z, QK, a, l, it, S, tshift, lane);
    LAS unsigned short* T = (LAS unsigned short*)(lds + RING_OFF + wave * 16384);
    { int it = gw; const int NIT = (CH / 64) * 32;
      if (it < NIT) { VtItem cur = vt_decode(it, S, tshift); v4u w[8]; vt_load(Z, cur, tshift, w, lane);
          for (;;) { const int nx = it + NGW; const bool more = nx < NIT; VtItem nv = cur; v4u wn[8];
              if (more) { nv = vt_decode(nx, S, tshift); vt_load(Z, nv, tshift, wn, lane); }
              vt_store(VT, cur, S, w, T, lane);
              if (!more) break;
              cur = nv; it = nx;
#pragma unroll
              for (int i = 0; i < 8; ++i) w[i] = wn[i]; } } }
}

namespace att {
#define MFMA32(a, b, c) __builtin_amdgcn_mfma_f32_32x32x16_bf16((a), (b), (c), 0, 0, 0)
__device__ __forceinline__ float ex2(float x) { return __builtin_amdgcn_exp2f(x); }
struct MaskNone { static constexpr bool MASKED = false; __device__ __forceinline__ float operator()(float v, int) const { return v; } };
struct MaskB { static constexpr bool MASKED = true; int dq;
    __device__ __forceinline__ float operator()(float v, int koff) const { const int d = dq + koff; return (d >= -64 && d <= 64) ? v : NEGB; } };
struct MaskA { static constexpr bool MASKED = true; const LAS float* brow; int kc0, qc, cs;
    __device__ __forceinline__ float operator()(float v, int koff) const { const int kc = kc0 + koff; int di = kc - qc + 15; di = di < 0 ? 0 : (di > 30 ? 30 : di);
        const float b = brow[di]; return (kc >= cs && kc < cs + 16) ? v + b : NEGB; } };

template <int NK, class MaskFn>
__device__ __forceinline__ void tile_step(const bf16* Kt, const bf16* VTt, int S, const bf16x8 (&qf)[NK], f32x16 (&o)[4], float& m, float& l, int lane, const MaskFn& mf) {
    const int r32 = lane & 31, hi = lane >> 5;
    const int pim = (r32 & 19) | ((r32 & 4) << 1) | ((r32 & 8) >> 1);
    const bf16* kp = Kt + (size_t)pim * 4096 + 8 * hi;
    bf16x8 kf[NK];
#pragma unroll
    for (int d0 = 0; d0 < NK; ++d0) kf[d0] = *(const bf16x8*)(kp + 16 * d0);
    bf16x8 vf[4][2];
    const bf16* vp = VTt + (size_t)r32 * S + 8 * hi;
#pragma unroll
    for (int db = 0; db < 4; ++db)
#pragma unroll
        for (int s2 = 0; s2 < 2; ++s2) vf[db][s2] = *(const bf16x8*)(vp + (size_t)(32 * db) * S + 16 * s2);
    f32x16 s;
#pragma unroll
    for (int r = 0; r < 16; ++r) s[r] = 0.f;
#pragma unroll
    for (int d0 = 0; d0 < NK; ++d0) s = MFMA32(kf[d0], qf[d0], s);
    float mx = NEGB;
#pragma unroll
    for (int r = 0; r < 16; ++r) { s[r] = mf(s[r], 16 * (r >> 3) + 8 * hi + (r & 7)); mx = fmaxf(mx, s[r]); }
    mx = fmaxf(mx, __shfl_xor(mx, 32));
    const float mn = fmaxf(m, mx), alpha = ex2(m - mn);
    float ps = 0.f;
#pragma unroll
    for (int r = 0; r < 16; ++r) { float p = ex2(s[r] - mn); if (MaskFn::MASKED) p = s[r] <= -1e29f ? 0.f : p; s[r] = p; ps += p; }
    l = l * alpha + ps; m = mn;
    if (!__all(alpha == 1.0f)) {
#pragma unroll
        for (int db = 0; db < 4; ++db)
#pragma unroll
            for (int r = 0; r < 16; ++r) o[db][r] *= alpha;
    }
    bf16x8 pf[2];
#pragma unroll
    for (int s2 = 0; s2 < 2; ++s2) { v4u w; w.x = pk2(s[8 * s2 + 0], s[8 * s2 + 1]); w.y = pk2(s[8 * s2 + 2], s[8 * s2 + 3]); w.z = pk2(s[8 * s2 + 4], s[8 * s2 + 5]); w.w = pk2(s[8 * s2 + 6], s[8 * s2 + 7]); pf[s2] = __builtin_bit_cast(bf16x8, w); }
#pragma unroll
    for (int db = 0; db < 4; ++db)
#pragma unroll
        for (int s2 = 0; s2 < 2; ++s2) o[db] = MFMA32(vf[db][s2], pf[s2], o[db]);
}
template <int NK> __device__ __forceinline__ void load_q(const bf16* Qp, bf16x8 (&qf)[NK], int lane) {
    const bf16* q = Qp + (size_t)(lane & 31) * 4096 + 8 * (lane >> 5);
#pragma unroll
    for (int d0 = 0; d0 < NK; ++d0) qf[d0] = *(const bf16x8*)(q + 16 * d0);
}
__device__ __forceinline__ void zero_o(f32x16 (&o)[4]) {
#pragma unroll
    for (int db = 0; db < 4; ++db)
#pragma unroll
        for (int r = 0; r < 16; ++r) o[db][r] = 0.f;
}
__device__ __forceinline__ void store_o_bf16(bf16* dst, const f32x16 (&o)[4], float inv, int hi) {
#pragma unroll
    for (int db = 0; db < 4; ++db)
#pragma unroll
        for (int g = 0; g < 4; ++g) { v2u w; w.x = pk2(o[db][4 * g] * inv, o[db][4 * g + 1] * inv); w.y = pk2(o[db][4 * g + 2] * inv, o[db][4 * g + 3] * inv);
            *(v2u*)(dst + 32 * db + 8 * g + 4 * hi) = w; }
}
__device__ __forceinline__ void store_o_f32(float* dst, const f32x16 (&o)[4], float inv, int hi) {
#pragma unroll
    for (int db = 0; db < 4; ++db)
#pragma unroll
        for (int g = 0; g < 4; ++g) { const f32x4 v = {o[db][4 * g] * inv, o[db][4 * g + 1] * inv, o[db][4 * g + 2] * inv, o[db][4 * g + 3] * inv};
            *(f32x4*)(dst + 32 * db + 8 * g + 4 * hi) = v; }
}
__device__ __forceinline__ void wave_c(const bf16* QK, const bf16* VT, float* CTMP, int sl, int map, int q0, int S, int tshift, int lane) {
    const size_t row0 = (size_t)sl << tshift; const int hi = lane >> 5;
    const bf16* Kp = QK + row0 * 4096 + 3328 + 64 * map;
    const bf16* Vp = VT + (size_t)((sl * 16 + 10 + (map >> 1)) * 128) * S;
    bf16x8 qf[4]; load_q<4>(QK + (row0 + q0) * 4096 + 2560 + 64 * map, qf, lane);
    f32x16 o[4]; zero_o(o); float m = NEGB, l = 0.f; const MaskNone mf;
    for (int kb = 0; kb < S; kb += 32) tile_step<4, MaskNone>(Kp + (size_t)kb * 4096, Vp + kb, S, qf, o, m, l, lane, mf);
    l += __shfl_xor(l, 32);
    store_o_f32(CTMP + (row0 + q0 + (lane & 31)) * 1536 + map * 128, o, 1.0f / l, hi);
}
__device__ __forceinline__ void wave_b(const bf16* QK, const bf16* VT, bf16* BTMP, float* BLSE, int sl, int slot, int p0, int S, int tshift, int lane) {
    const size_t row0 = (size_t)sl << tshift; const int hi = lane >> 5, dsh = 2 * (slot >> 1), Lsh = tshift - dsh;
    const bf16* Kp = QK + row0 * 4096 + 1792 + 128 * slot;
    const bf16* Vp = VT + (size_t)((sl * 16 + 4 + slot) * 128) * S;
    bf16x8 qf[8]; load_q<8>(QK + (row0 + p0) * 4096 + 1024 + 128 * slot, qf, lane);
    f32x16 o[4]; zero_o(o); float m = NEGB, l = 0.f;
    const int qp = p0 + (lane & 31);
#pragma unroll 1
    for (int ti = 0; ti < 5; ++ti) { const int kb = p0 - 64 + 32 * ti;
        if (kb < 0 || kb >= S || (kb >> Lsh) != (p0 >> Lsh)) continue;
        const MaskB mf{kb - qp};
        tile_step<8, MaskB>(Kp + (size_t)kb * 4096, Vp + kb, S, qf, o, m, l, lane, mf); }
    l += __shfl_xor(l, 32);
    const int t = perm_tok(qp, dsh, Lsh);
    store_o_bf16(BTMP + (row0 + t) * 768 + slot * 128, o, 1.0f / l, hi);
    if (hi == 0) BLSE[(row0 + t) * 8 + slot] = (__log2f(l) + m) * LN2;
}
__device__ __forceinline__ void wave_a(const bf16* QK, const bf16* VT, bf16* OA, const LAS float* btab, int sl, int h, int r, int qh, int S, int tshift, int lane) {
    const size_t row0 = (size_t)sl << tshift; const int hi = lane >> 5, rows = S >> 6;
    int rs = r - 4; rs = rs < 0 ? 0 : (rs > rows - 8 ? rows - 8 : rs);
    const bf16* Kp = QK + row0 * 4096 + 512 + 128 * h;
    const bf16* Vp = VT + (size_t)((sl * 16 + h) * 128) * S;
    const int q0 = r * 64 + 32 * qh, qc = 32 * qh + (lane & 31);
    int cs = qc - 8; cs = cs < 0 ? 0 : (cs > 48 ? 48 : cs);
    bf16x8 qf[8]; load_q<8>(QK + (row0 + q0) * 4096 + 128 * h, qf, lane);
    f32x16 o[4]; zero_o(o); float m = NEGB, l = 0.f;
#pragma unroll 1
    for (int ti = 0; ti < 16; ++ti) { const int j = ti >> 1, chh = ti & 1, kb = (rs + j) * 64 + 32 * chh;
        const MaskA mf{btab + (rs + j - r + 7) * 31, 32 * chh, qc, cs};
        tile_step<8, MaskA>(Kp + (size_t)kb * 4096, Vp + kb, S, qf, o, m, l, lane, mf); }
    l += __shfl_xor(l, 32);
    store_o_bf16(OA + (row0 + q0 + (lane & 31)) * 1536 + h * 128, o, 1.0f / l, hi);
}

constexpr int CST = 24576;
__device__ __forceinline__ void glds16(const void* gsrc, unsigned lds_dst) { unsigned keep;
    asm volatile("s_mov_b32 %0, m0\n\ts_mov_b32 m0, %2\n\ts_nop 0\n\tglobal_load_lds_dwordx4 %1, off\n\ts_mov_b32 m0, %0" : "=&s"(keep) : "v"(gsrc), "s"(lds_dst) : "memory"); }
__device__ __forceinline__ void c_dma(const bf16* Kp, const bf16* Vp, int S, int kb, unsigned sb, int wave, int lane) {
    { const int row = 8 * wave + (lane >> 3), c = (lane & 7) ^ ((row >> 1) & 7);
      glds16(Kp + (size_t)(kb + row) * 4096 + 8 * c, (unsigned)__builtin_amdgcn_readfirstlane(sb + wave * 1024)); }
#pragma unroll
    for (int jj = 0; jj < 2; ++jj) { const int j = wave + 8 * jj, row = 8 * j + (lane >> 3), c = (lane & 7) ^ ((row >> 1) & 7);
      glds16(Vp + (size_t)row * S + kb + 8 * c, (unsigned)__builtin_amdgcn_readfirstlane(sb + 8192 + j * 1024)); }
}
#define C_WAIT_BAR(N) asm volatile("s_waitcnt vmcnt(" #N ")\n\ts_barrier" ::: "memory")
__device__ __forceinline__ void unit_c_fast(const bf16* QK, const bf16* VT, float* CTMP, LAS unsigned char* ring, int sl, int map, int qb, int S, int tshift, int wave, int lane) {
    const size_t row0 = (size_t)sl << tshift; const int r32 = lane & 31, hi = lane >> 5, q0 = qb * 256 + 32 * wave;
    const bf16* Kp = QK + row0 * 4096 + 3328 + 64 * map;
    const bf16* Vp = VT + (size_t)((sl * 16 + 10 + (map >> 1)) * 128) * S;
    bf16x8 qf[4]; load_q<4>(QK + (row0 + q0) * 4096 + 2560 + 64 * map, qf, lane);
    const int pim = (r32 & 19) | ((r32 & 4) << 1) | ((r32 & 8) >> 1);
    int ka[4], va[4];
#pragma unroll
    for (int d0 = 0; d0 < 4; ++d0) ka[d0] = pim * 128 + (((2 * d0 + hi) ^ ((pim >> 1) & 7)) << 4);
#pragma unroll
    for (int x = 0; x < 4; ++x) va[x] = 8192 + r32 * 128 + (((2 * x + hi) ^ ((r32 >> 1) & 7)) << 4);
    f32x16 o[4]; zero_o(o); float l = 0.f;
    const int NT = S >> 6;
#pragma unroll
    for (int d0 = 0; d0 < 4; ++d0) asm volatile("" : "+v"(qf[d0]));
    asm volatile("s_waitcnt vmcnt(0)\n\ts_barrier" ::: "memory");
    const unsigned ring_a = (unsigned)(size_t)ring;
    c_dma(Kp, Vp, S, 0, ring_a, wave, lane); c_dma(Kp, Vp, S, 64, ring_a + CST, wave, lane);
    int st_cur = 0, st_nxt2 = 2 * CST;
#pragma unroll 1
    for (int t = 0; t < NT; ++t) {
        if (t + 1 < NT) C_WAIT_BAR(3); else C_WAIT_BAR(0);
        if (t + 2 < NT) c_dma(Kp, Vp, S, (t + 2) * 64, ring_a + st_nxt2, wave, lane);
        const LAS unsigned char* sb = ring + st_cur;
#pragma unroll
        for (int st = 0; st < 2; ++st) {
            bf16x8 kf[4];
#pragma unroll
            for (int d0 = 0; d0 < 4; ++d0) kf[d0] = *(const LAS bf16x8*)(sb + st * 4096 + ka[d0]);
            f32x16 s;
#pragma unroll
            for (int r = 0; r < 16; ++r) s[r] = 0.f;
#pragma unroll
            for (int d0 = 0; d0 < 4; ++d0) s = MFMA32(kf[d0], qf[d0], s);
            bf16x8 vf[4][2];
#pragma unroll
            for (int db = 0; db < 4; ++db)
#pragma unroll
                for (int s2 = 0; s2 < 2; ++s2) vf[db][s2] = *(const LAS bf16x8*)(sb + db * 4096 + va[2 * st + s2]);
#pragma unroll
            for (int r = 0; r < 16; ++r) { s[r] = ex2(s[r]); l += s[r]; }
            bf16x8 pf[2];
#pragma unroll
            for (int s2 = 0; s2 < 2; ++s2) { v4u w; w.x = pk2(s[8 * s2 + 0], s[8 * s2 + 1]); w.y = pk2(s[8 * s2 + 2], s[8 * s2 + 3]); w.z = pk2(s[8 * s2 + 4], s[8 * s2 + 5]); w.w = pk2(s[8 * s2 + 6], s[8 * s2 + 7]); pf[s2] = __builtin_bit_cast(bf16x8, w); }
#pragma unroll
            for (int db = 0; db < 4; ++db)
#pragma unroll
                for (int s2 = 0; s2 < 2; ++s2) o[db] = MFMA32(vf[db][s2], pf[s2], o[db]);
        }
        st_cur = st_cur == 2 * CST ? 0 : st_cur + CST; st_nxt2 = st_nxt2 == 2 * CST ? 0 : st_nxt2 + CST;
    }
    l += __shfl_xor(l, 32);
    store_o_f32(CTMP + (row0 + q0 + r32) * 1536 + map * 128, o, 1.0f / l, hi);
}
}

__device__ __forceinline__ void phase_attn(const AL& a, int l, LAS unsigned char* lds, int S, int tshift, int tid, int wave, int lane, int types = 7) {
    const bf16* QK = (const bf16*)(a.ws() + A_QK); const bf16* VT = (const bf16*)(a.ws() + A_VT);
    const int nqb = S >> 8, nseq = CH >> tshift;
    if (types & 1) { float* CTMP = (float*)(a.ws() + A_CTMP); const float cbound = ((const float*)(a.ws() + WS_LAM))[2 + l];
      const int G = gridDim.x, vid = (G % 8 == 0) ? (blockIdx.x % 8) * (G / 8) + blockIdx.x / 8 : blockIdx.x;
      if (cbound <= 64.0f) {
          for (int u = vid; u < nseq * 12 * nqb; u += G) { const int qb = u % nqb, map = (u / nqb) % 12, sl = u / (nqb * 12);
              att::unit_c_fast(QK, VT, CTMP, lds + RING_OFF, sl, map, qb, S, tshift, wave, lane); }
      } else {
          for (int u = vid; u < nseq * 12 * nqb; u += G) { const int qb = u % nqb, map = (u / nqb) % 12, sl = u / (nqb * 12);
              att::wave_c(QK, VT, CTMP, sl, map, qb * 256 + 32 * wave, S, tshift, lane); } } }
    if (types & 2) { bf16* OA = (bf16*)(a.ws() + A_OA); LAS float* btab = (LAS float*)(lds + RING_OFF);
      for (int u = blockIdx.x; u < nseq * 4 * nqb; u += gridDim.x) { const int qb = u % nqb, h = (u / nqb) % 4, sl = u / (nqb * 4);
          __syncthreads();
          for (int e = tid; e < 15 * 31; e += NWAVES * 64) btab[e] = a.in(I_RPB)[((size_t)(l * 4 + h) * 15) * 31 + e] * LOG2E;
          __syncthreads();
          att::wave_a(QK, VT, OA, btab, sl, h, 4 * qb + (wave >> 1), wave & 1, S, tshift, lane); } }
    if (types & 4) { bf16* BTMP = (bf16*)(a.ws() + A_BTMP); float* BLSE = (float*)(a.ws() + A_BLSE);
      for (int u = blockIdx.x; u < nseq * 6 * nqb; u += gridDim.x) { const int pb = u % nqb, slot = (u / nqb) % 6, sl = u / (nqb * 6);
          att::wave_b(QK, VT, BTMP, BLSE, sl, slot, pb * 256 + 32 * wave, S, tshift, lane); } }
}
__device__ __forceinline__ void phase_combine(const AL& a, int l, int gw, int NGW, int lane) {
    const bf16* BTMP = (const bf16*)(a.ws() + A_BTMP); const float* BLSE = (const float*)(a.ws() + A_BLSE); const float* CTMP = (const float*)(a.ws() + A_CTMP);
    bf16* OB = (bf16*)(a.ws() + A_OA) + 512; bf16* OC = (bf16*)(a.ws() + A_OA) + 768;
    const float lam = ((const float*)(a.ws() + WS_LAM))[l], lam_init = 0.8f - 0.6f * expf(-0.3f * (float)l);
    const float* subln = a.in(I_SUBLN) + l * 128;
    const int sub = lane & 15, d0 = 8 * sub;
    const int NIT = (CH / 4) * 8;
    if ((NGW & 7) == 0) {
        const int slot = gw & 7;
        if (slot < 2) { const int hg = slot;
            for (int it = gw; it < NIT; it += 2 * NGW) { const bool two = it + NGW < NIT;
                const size_t rowa = (size_t)(it >> 3) * 4 + (lane >> 4), rowb = two ? (size_t)((it + NGW) >> 3) * 4 + (lane >> 4) : rowa;
                float la[3], lb[3]; v4u xa[3], xb[3];
#pragma unroll
                for (int g = 0; g < 3; ++g) { la[g] = BLSE[rowa * 8 + 2 * g + hg]; lb[g] = BLSE[rowb * 8 + 2 * g + hg];
                    xa[g] = *(const v4u*)(BTMP + rowa * 768 + (2 * g + hg) * 128 + d0); xb[g] = *(const v4u*)(BTMP + rowb * 768 + (2 * g + hg) * 128 + d0); }
#pragma unroll
                for (int q = 0; q < 2; ++q) { if (q == 1 && !two) break;
                    const float l0 = q ? lb[0] : la[0], l1 = q ? lb[1] : la[1], l2 = q ? lb[2] : la[2]; const v4u a0 = q ? xb[0] : xa[0], a1 = q ? xb[1] : xa[1], a2 = q ? xb[2] : xa[2];
                    const float mx = fmaxf(l0, fmaxf(l1, l2)); float w0 = __expf(l0 - mx), w1 = __expf(l1 - mx), w2 = __expf(l2 - mx);
                    const float inv = 1.0f / (w0 + w1 + w2); w0 *= inv; w1 *= inv; w2 *= inv;
                    v4u o;
                    o.x = pk2(w0 * bflo(a0.x) + w1 * bflo(a1.x) + w2 * bflo(a2.x), w0 * bfhi(a0.x) + w1 * bfhi(a1.x) + w2 * bfhi(a2.x));
                    o.y = pk2(w0 * bflo(a0.y) + w1 * bflo(a1.y) + w2 * bflo(a2.y), w0 * bfhi(a0.y) + w1 * bfhi(a1.y) + w2 * bfhi(a2.y));
                    o.z = pk2(w0 * bflo(a0.z) + w1 * bflo(a1.z) + w2 * bflo(a2.z), w0 * bfhi(a0.z) + w1 * bfhi(a1.z) + w2 * bfhi(a2.z));
                    o.w = pk2(w0 * bflo(a0.w) + w1 * bflo(a1.w) + w2 * bflo(a2.w), w0 * bfhi(a0.w) + w1 * bfhi(a1.w) + w2 * bfhi(a2.w));
                    *(v4u*)(OB + (q ? rowb : rowa) * 1536 + hg * 128 + d0) = o; } }
        } else { const int h = slot - 2;
            const f32x4 g0 = *(const f32x4*)(subln + d0), g1 = *(const f32x4*)(subln + d0 + 4);
            for (int it = gw; it < NIT; it += 2 * NGW) { const bool two = it + NGW < NIT;
                const size_t rowa = (size_t)(it >> 3) * 4 + (lane >> 4), rowb = two ? (size_t)((it + NGW) >> 3) * 4 + (lane >> 4) : rowa;
                const float* pa = CTMP + rowa * 1536 + (2 * h) * 128 + d0; const float* pb = CTMP + rowb * 1536 + (2 * h) * 128 + d0;
                const f32x4 a10 = *(const f32x4*)pa, a11 = *(const f32x4*)(pa + 4), a20 = *(const f32x4*)(pa + 128), a21 = *(const f32x4*)(pa + 132);
                const f32x4 b10 = *(const f32x4*)pb, b11 = *(const f32x4*)(pb + 4), b20 = *(const f32x4*)(pb + 128), b21 = *(const f32x4*)(pb + 132);
#pragma unroll
                for (int q = 0; q < 2; ++q) { if (q == 1 && !two) break;
                    const f32x4 x0 = q ? b10 - lam * b20 : a10 - lam * a20, x1 = q ? b11 - lam * b21 : a11 - lam * a21;
                    float ss = (x0.x * x0.x + x0.y * x0.y) + (x0.z * x0.z + x0.w * x0.w) + (x1.x * x1.x + x1.y * x1.y) + (x1.z * x1.z + x1.w * x1.w);
                    ss += __shfl_xor(ss, 1); ss += __shfl_xor(ss, 2); ss += __shfl_xor(ss, 4); ss += __shfl_xor(ss, 8);
                    const float rstd = rsqrtf(ss * (1.0f / 128.0f) + EPS) * (1.0f - lam_init);
                    v4u o; o.x = pk2(x0.x * rstd * g0.x, x0.y * rstd * g0.y); o.y = pk2(x0.z * rstd * g0.z, x0.w * rstd * g0.w);
                    o.z = pk2(x1.x * rstd * g1.x, x1.y * rstd * g1.y); o.w = pk2(x1.z * rstd * g1.z, x1.w * rstd * g1.w);
                    *(v4u*)(OC + (q ? rowb : rowa) * 1536 + h * 128 + d0) = o; } }
        }
        return;
    }
    for (int it = gw; it < (CH / 4) * 8; it += NGW) { const int slot = it & 7; const size_t row = (size_t)(it >> 3) * 4 + (lane >> 4);
        if (slot < 2) { const int hg = slot;
            const float l0 = BLSE[row * 8 + hg], l1 = BLSE[row * 8 + 2 + hg], l2 = BLSE[row * 8 + 4 + hg];
            const float mx = fmaxf(l0, fmaxf(l1, l2)); float w0 = __expf(l0 - mx), w1 = __expf(l1 - mx), w2 = __expf(l2 - mx);
            const float inv = 1.0f / (w0 + w1 + w2); w0 *= inv; w1 *= inv; w2 *= inv;
            const v4u a0 = *(const v4u*)(BTMP + row * 768 + (0 + hg) * 128 + d0), a1 = *(const v4u*)(BTMP + row * 768 + (2 + hg) * 128 + d0), a2 = *(const v4u*)(BTMP + row * 768 + (4 + hg) * 128 + d0);
            v4u o;
            o.x = pk2(w0 * bflo(a0.x) + w1 * bflo(a1.x) + w2 * bflo(a2.x), w0 * bfhi(a0.x) + w1 * bfhi(a1.x) + w2 * bfhi(a2.x));
            o.y = pk2(w0 * bflo(a0.y) + w1 * bflo(a1.y) + w2 * bflo(a2.y), w0 * bfhi(a0.y) + w1 * bfhi(a1.y) + w2 * bfhi(a2.y));
            o.z = pk2(w0 * bflo(a0.z) + w1 * bflo(a1.z) + w2 * bflo(a2.z), w0 * bfhi(a0.z) + w1 * bfhi(a1.z) + w2 * bfhi(a2.z));
            o.w = pk2(w0 * bflo(a0.w) + w1 * bflo(a1.w) + w2 * bflo(a2.w), w0 * bfhi(a0.w) + w1 * bfhi(a1.w) + w2 * bfhi(a2.w));
            *(v4u*)(OB + row * 1536 + hg * 128 + d0) = o;
        } else { const int h = slot - 2;
            const float* p1 = CTMP + row * 1536 + (2 * h) * 128 + d0; const float* p2 = p1 + 128;
            const f32x4 x0 = *(const f32x4*)p1 - lam * *(const f32x4*)p2, x1 = *(const f32x4*)(p1 + 4) - lam * *(const f32x4*)(p2 + 4);
            float ss = (x0.x * x0.x + x0.y * x0.y) + (x0.z * x0.z + x0.w * x0.w) + (x1.x * x1.x + x1.y * x1.y) + (x1.z * x1.z + x1.w * x1.w);
            ss += __shfl_xor(ss, 1); ss += __shfl_xor(ss, 2); ss += __shfl_xor(ss, 4); ss += __shfl_xor(ss, 8);
            const float rstd = rsqrtf(ss * (1.0f / 128.0f) + EPS) * (1.0f - lam_init);
            const f32x4 g0 = *(const f32x4*)(subln + d0), g1 = *(const f32x4*)(subln + d0 + 4);
            v4u o; o.x = pk2(x0.x * rstd * g0.x, x0.y * rstd * g0.y); o.y = pk2(x0.z * rstd * g0.z, x0.w * rstd * g0.w);
            o.z = pk2(x1.x * rstd * g1.x, x1.y * rstd * g1.y); o.w = pk2(x1.z * rstd * g1.z, x1.w * rstd * g1.w);
            *(v4u*)(OC + row * 1536 + h * 128 + d0) = o;
        }
    }
}
#define CHECK_HOOK(stage, c, l) do {} while (0)
#define CHECK_FINAL() do {} while (0)

#ifndef PHMASK
#define PHMASK 0xFFFF
#endif
#define PH(k) ((PHMASK >> (k)) & 1)
#ifndef DUPMASK
#define DUPMASK 0
#endif
#define DUP(k) ((DUPMASK >> (k)) & 1)
#ifndef BARX
#define BARX 1
#endif
__global__ void __launch_bounds__(NWAVES * 64, 2) fwd(Args kargs) {
    extern __shared__ __attribute__((aligned(16))) unsigned char lds_raw[];
    LAS unsigned char* lds = (LAS unsigned char*)lds_raw;
    volatile LAS unsigned* MISC = (volatile LAS unsigned*)(lds + MISC_OFF);
    int tid = threadIdx.x, lane = tid & 63, wave = __builtin_amdgcn_readfirstlane(tid >> 6);
    for (int u = tid; u < (LDS_BYTES - LDSCTL_OFF) / 4; u += NWAVES * 64) ((LAS unsigned*)(lds + LDSCTL_OFF))[u] = 0u;
    __syncthreads();
    const AL a{};
    XcdBarrier bar = xcd_barrier_post((unsigned*)(a.ws() + WS_CTL) + CW_BAR, MISC + 8);
#define GRID_BAR() do { for (int b_ = 0; b_ < BARX; ++b_) xcd_barrier(bar); } while (0)
    int G = gridDim.x, bid = (int)blockIdx.x;
#define LAUNDER() do { asm volatile("" : "+s"(G), "+s"(bid)); tid = threadIdx.x; asm volatile("" : "+v"(tid)); lane = tid & 63; wave = __builtin_amdgcn_readfirstlane(tid >> 6); } while (0)
#define GW (bid * NWAVES + wave)
#define NGW_ (G * NWAVES)

    if (PH(0)) phase_modp(a, lds, tid, lane, wave);
    if (DUP(0)) { __syncthreads(); phase_modp(a, lds, tid, lane, wave); }
    GRID_BAR();
    if (PH(1)) phase_pro2(a, lds, tid, lane, wave, G);
    if (DUP(1)) { __syncthreads(); phase_pro2(a, lds, tid, lane, wave, G); }
    GRID_BAR();
    CHECK_HOOK(0, 0, 0);

#pragma unroll 1
    for (int cl = 0; cl < NCHUNK * 2; ++cl) {
        int c = cl >> 1, l = cl & 1;
        asm volatile("" : "+s"(c), "+s"(l));
#define R0 (c * CH)
#define PROMPT (R0 < 32768)
#define S_ (PROMPT ? 4096 : 2048)
#define TSH (PROMPT ? 12 : 11)
#define SEQ0 (PROMPT ? (R0 >> 12) : 8 + ((R0 - 32768) >> 11))
#define XIN0 (PROMPT ? a.in(I_XP) + (size_t)R0 * DM : a.in(I_XS) + (size_t)(R0 - 32768) * DM)
#define XO (a.out() + (size_t)R0 * DM)
#define XCUR (l == 0 ? XIN0 : (const float*)XO)
#define MODL ((const float*)(a.ws() + WS_MOD) + (size_t)l * 24 * 12288)
#define WL (a.ws() + WS_W + (size_t)l * W_LAYER)
        if (PH(2)) { LAUNDER(); phase_norm(XCUR, a.in(I_N1G) + l * DM, MODL, 0, 2048, SEQ0, TSH, (bf16*)(a.ws() + A_H), GW, NGW_, lane); }
        if (DUP(2)) { LAUNDER(); __syncthreads(); phase_norm(XCUR, a.in(I_N1G) + l * DM, MODL, 0, 2048, SEQ0, TSH, (bf16*)(a.ws() + A_H), GW, NGW_, lane); }
        GRID_BAR(); CHECK_HOOK(1, c, l);
        for (int rep_ = 0; rep_ < (PH(3) ? 1 + DUP(3) : 0); ++rep_) { LAUNDER(); unsigned char* ws = a.ws(); pg8::Gemm g{(const pg8::bf16_t*)(ws + A_H), (const pg8::bf16_t*)(WL + WO_IG), CH, 2 * INC, DM}; pg8::StaticOrder So; So.init(CH, 2 * INC, G, bid);
          pg8::EpiIn E{(pg8::bf16_t*)(ws + A_Z), (pg8::bf16_t*)(ws + A_G), a.in(I_BGATE) + l * INC};
          pg8::gemm_phase<pg8::EpiIn, pg8::StaticOrder, true, true>(lds + RING_OFF, g, So, E); }
        GRID_BAR(); CHECK_HOOK(2, c, l);
        if (PH(4)) { LAUNDER(); phase_prep(a, l, lds, S_, TSH, GW, NGW_, wave, lane); }
        if (DUP(4)) { LAUNDER(); __syncthreads(); phase_prep(a, l, lds, S_, TSH, GW, NGW_, wave, lane); }
        GRID_BAR(); CHECK_HOOK(3, c, l);
        if (PH(5)) { LAUNDER(); phase_attn(a, l, lds, S_, TSH, tid, wave, lane); }
        if (DUP(5)) { LAUNDER(); __syncthreads(); phase_attn(a, l, lds, S_, TSH, tid, wave, lane); }
        if (DUP(12) || DUP(13) || DUP(14)) { LAUNDER(); __syncthreads(); phase_attn(a, l, lds, S_, TSH, tid, wave, lane, DUP(12) | (DUP(13) << 1) | (DUP(14) << 2)); }
        GRID_BAR(); CHECK_HOOK(4, c, l);
        if (PH(6)) { LAUNDER(); phase_combine(a, l, GW, NGW_, lane); }
        if (DUP(6)) { LAUNDER(); __syncthreads(); phase_combine(a, l, GW, NGW_, lane); }
        GRID_BAR(); CHECK_HOOK(5, c, l);
        for (int rep_ = 0; rep_ < (PH(7) ? 1 + DUP(7) : 0); ++rep_) { LAUNDER(); unsigned char* ws = a.ws(); pg8::StaticOrder So; So.init(CH, DM, G, bid);
          pg8::Gemm g{(const pg8::bf16_t*)(ws + A_OA), (const pg8::bf16_t*)(WL + WO_BRA), CH, DM, 1536}; pg8::EpiBrM E{(pg8::bf16_t*)(ws + A_H), (const pg8::bf16_t*)(ws + A_G)};
          pg8::gemm_phase<pg8::EpiBrM, pg8::StaticOrder, true, true>(lds + RING_OFF, g, So, E); }
        GRID_BAR(); CHECK_HOOK(6, c, l);
        if (PH(8)) { LAUNDER(); unsigned char* ws = a.ws(); pg8::Gemm g{(const pg8::bf16_t*)(ws + A_H), (const pg8::bf16_t*)(WL + WO_OUT), CH, DM, DM}; pg8::StaticOrder So; So.init(CH, DM, G, bid);
          if (DUP(8)) { pg8::EpiRes E0{XCUR, (float*)(ws + A_G), MODL + 2 * 2048, SEQ0, TSH}; pg8::gemm_phase<pg8::EpiRes, pg8::StaticOrder, true, true>(lds + RING_OFF, g, So, E0); }
          pg8::EpiRes E{XCUR, XO, MODL + 2 * 2048, SEQ0, TSH};
          pg8::gemm_phase<pg8::EpiRes, pg8::StaticOrder, true, true>(lds + RING_OFF, g, So, E); }
        GRID_BAR(); CHECK_HOOK(7, c, l);
        if (PH(9)) { LAUNDER(); phase_norm(XO, a.in(I_N2G) + l * DM, MODL, 3 * 2048, 4 * 2048, SEQ0, TSH, (bf16*)(a.ws() + A_H), GW, NGW_, lane); }
        if (DUP(9)) { LAUNDER(); __syncthreads(); phase_norm(XO, a.in(I_N2G) + l * DM, MODL, 3 * 2048, 4 * 2048, SEQ0, TSH, (bf16*)(a.ws() + A_H), GW, NGW_, lane); }
        GRID_BAR(); CHECK_HOOK(8, c, l);
        for (int rep_ = 0; rep_ < (PH(10) ? 1 + DUP(10) : 0); ++rep_) { LAUNDER(); unsigned char* ws = a.ws(); pg8::Gemm g{(const pg8::bf16_t*)(ws + A_H), (const pg8::bf16_t*)(WL + WO_FF1), CH, DFF, DM}; pg8::StaticOrder So; So.init(CH, DFF, G, bid);
          pg8::EpiRelu2 E{(pg8::bf16_t*)(ws + A_U), DFF};
          pg8::gemm_phase<pg8::EpiRelu2, pg8::StaticOrder, true, true>(lds + RING_OFF, g, So, E); }
        GRID_BAR(); CHECK_HOOK(9, c, l);
        if (PH(11)) { LAUNDER(); unsigned char* ws = a.ws(); pg8::Gemm g{(const pg8::bf16_t*)(ws + A_U), (const pg8::bf16_t*)(WL + WO_FF2), CH, DM, DFF}; pg8::StaticOrder So; So.init(CH, DM, G, bid);
          if (DUP(11)) { pg8::EpiRes E0{XO, (float*)(ws + A_G), MODL + 5 * 2048, SEQ0, TSH}; pg8::gemm_phase<pg8::EpiRes, pg8::StaticOrder, true, true>(lds + RING_OFF, g, So, E0); }
          pg8::EpiRes E{XO, XO, MODL + 5 * 2048, SEQ0, TSH};
          pg8::gemm_phase<pg8::EpiRes, pg8::StaticOrder, true, true>(lds + RING_OFF, g, So, E); }
        GRID_BAR(); CHECK_HOOK(10, c, l);
    }
    CHECK_FINAL();
}

extern "C" void kernel_launch(void* const* d_in, const int* in_sizes, int n_in, void* d_out, int out_size, void* d_ws, size_t ws_size, hipStream_t stream) {
    static int grid = 0;
    if (grid == 0) {
        if (n_in != 29 || out_size != MTOT * DM || ws_size < WS_END) { fprintf(stderr, "kernel_launch: unexpected shapes (n_in %d out %d ws %zu need %zu)\n", n_in, out_size, ws_size, (size_t)WS_END); grid = -1; return; }
        int dev = 0, cus = 0, per_cu = 0;
        if (hipGetDevice(&dev) != hipSuccess || hipDeviceGetAttribute(&cus, hipDeviceAttributeMultiprocessorCount, dev) != hipSuccess) { grid = -1; return; }
        if (hipFuncSetAttribute((const void*)fwd, hipFuncAttributeMaxDynamicSharedMemorySize, LDS_BYTES) != hipSuccess) { grid = -1; return; }
        if (hipOccupancyMaxActiveBlocksPerMultiprocessor(&per_cu, (const void*)fwd, NWAVES * 64, LDS_BYTES) != hipSuccess || per_cu < 1) { fprintf(stderr, "kernel_launch: occupancy query says %d\n", per_cu); }
        (void)hipGetLastError();
        grid = cus;
    }
    if (grid < 0) return;
    if (hipMemsetAsync((char*)d_ws + WS_CTL, 0, CTL_ZERO_BYTES, stream) != hipSuccess) return;
    Args a{};
    for (int i = 0; i < 29; ++i) a.in[i] = (const float*)d_in[i];
    a.out = (float*)d_out; a.ws = (unsigned char*)d_ws;
    hipLaunchKernelGGL(fwd, dim3(grid), dim3(NWAVES * 64), LDS_BYTES, stream, a);
}
```

```cpp
#include <hip/hip_runtime.h>
#include <hip/hip_bf16.h>
#include <cstdio>
#include <cstdint>
#include <cmath>
namespace pg8 {
#define PG8_LAS __attribute__((address_space(3)))
typedef unsigned short bf16_t;
typedef short bf16x8 __attribute__((ext_vector_type(8)));
typedef float f32x4 __attribute__((ext_vector_type(4)));
typedef unsigned u32x4 __attribute__((ext_vector_type(4)));
constexpr int BM = 256, BK = 64, HALF = 128, HTB = HALF * BK * 2  , STAGE_BYTES = 8 * HTB, NXCD = 8, WGM = 8;

__host__ __device__ __forceinline__ int lds_byte(int r, int c) { const int st = (r >> 4) * 2 + (c >> 5), rr = r & 15, cc = c & 31, ob = rr * 64 + cc * 2; return st * 1024 + (ob ^ (((ob >> 9) & 1) << 5)); }
__host__ __device__ __forceinline__ void stage_rc(int b, int& R, int& C) { const int st = b / 1024, sb = b % 1024, swz = sb ^ (((sb >> 9) & 1) << 5); R = (st >> 1) * 16 + swz / 64; C = (st & 1) * 32 + (swz % 64) / 2; }
__host__ __device__ __forceinline__ int perm32(int rho) { const int n = rho >> 4, i = rho & 15; return 8 * (i >> 2) + 4 * n + (i & 3); }

struct Unit { int pm, pn; };
struct Gemm { const bf16_t* A; const bf16_t* Bt; int M, N, K; };

struct StaticOrder {
    int nM, nN, nwg, G, c;
    __host__ __device__ void init(int M, int N, int G_, int c_) { nM = M / BM; nN = N / BM; nwg = nM * nN; G = G_; c = c_; }
    __host__ __device__ bool next(int i, Unit& u) const {
        const long L = (long)i * G + c; if (L >= nwg) return false;
        int wgid = (int)L; { const int q = nwg / NXCD, r = nwg % NXCD, xcd = wgid % NXCD, off = wgid / NXCD; wgid = (xcd < r ? xcd * (q + 1) : r * (q + 1) + (xcd - r) * q) + off; }
        const int nig = WGM * nN, gid = wgid / nig, fm = gid * WGM, gsz = (nM - fm) < WGM ? (nM - fm) : WGM;
        u.pm = fm + ((wgid % nig) % gsz); u.pn = (wgid % nig) / gsz; return true;
    }
    __device__ __forceinline__ void a_ready(const Unit&) const {}
    __device__ __forceinline__ void done(const Unit&) const {}
};

typedef float f32x2 __attribute__((ext_vector_type(2)));
typedef __bf16 bf16x2v __attribute__((ext_vector_type(2)));
typedef unsigned u32x2 __attribute__((ext_vector_type(2)));
__device__ __forceinline__ unsigned cvt_pk_bf16(float lo, float hi) { f32x2 v = {lo, hi}; bf16x2v b = __builtin_convertvector(v, bf16x2v); return __builtin_bit_cast(unsigned, b); }
__device__ __forceinline__ float sigm(float x) { return fmaxf(__builtin_amdgcn_rcpf(1.0f + __expf(-x)), 1e-30f); }

struct EpiIn {
    static constexpr bool PERM = true, AFTER_DRAIN = false, HAS_MID = false; static constexpr int MID_T0 = -1, MID_T1 = -1;
    bf16_t* Z; bf16_t* G; const float* bgate;
    __device__ __forceinline__ void operator()(const f32x4 (&acc)[2][2][4][2], const Unit& u, int wr, int wc, int fr, int fq) const {
        const int row0 = u.pm * BM + wr * 64 + fr; const bool gate = u.pn >= 24;
        if (!gate) { const int col0 = u.pn * BM + wc * 32 + 8 * fq;
#pragma unroll
            for (int ai = 0; ai < 2; ++ai)
#pragma unroll
                for (int m = 0; m < 4; ++m) { bf16_t* rowp = Z + (size_t)(row0 + ai * HALF + m * 16) * 6144 + col0;
#pragma unroll
                    for (int bj = 0; bj < 2; ++bj) { const f32x4 v0 = acc[ai][bj][m][0], v1 = acc[ai][bj][m][1];
                        u32x4 w; w.x = cvt_pk_bf16(v0[0], v0[1]); w.y = cvt_pk_bf16(v0[2], v0[3]); w.z = cvt_pk_bf16(v1[0], v1[1]); w.w = cvt_pk_bf16(v1[2], v1[3]);
                        *(u32x4*)(rowp + bj * HALF) = w; } }
        } else { const int gt = u.pn - 24, col0 = gt * BM + wc * 32 + 8 * fq, lane = fq * 16 + fr, wave = wr * 4 + wc;
            f32x4 bv[2][2];
#pragma unroll
            for (int bj = 0; bj < 2; ++bj)
#pragma unroll
                for (int n = 0; n < 2; ++n) bv[bj][n] = *(const f32x4*)(bgate + col0 + bj * HALF + 4 * n);
            bf16_t* tp = G + (size_t)(u.pm * 24 + gt) * 65536 + (size_t)wave * 8192 + lane * 8;
#pragma unroll
            for (int ai = 0; ai < 2; ++ai)
#pragma unroll
                for (int m = 0; m < 4; ++m)
#pragma unroll
                    for (int bj = 0; bj < 2; ++bj) { const f32x4 v0 = acc[ai][bj][m][0] + bv[bj][0], v1 = acc[ai][bj][m][1] + bv[bj][1];
                        u32x4 w; w.x = cvt_pk_bf16(sigm(v0[0]), sigm(v0[1])); w.y = cvt_pk_bf16(sigm(v0[2]), sigm(v0[3])); w.z = cvt_pk_bf16(sigm(v1[0]), sigm(v1[1])); w.w = cvt_pk_bf16(sigm(v1[2]), sigm(v1[3]));
                        *(u32x4*)(tp + ((ai * 4 + m) * 2 + bj) * 512) = w; }
        }
    }
};
struct EpiRelu2 {
    static constexpr bool PERM = true, AFTER_DRAIN = false, HAS_MID = false; static constexpr int MID_T0 = -1, MID_T1 = -1;
    bf16_t* O; int ldc;
    __device__ __forceinline__ void operator()(const f32x4 (&acc)[2][2][4][2], const Unit& u, int wr, int wc, int fr, int fq) const {
        const int row0 = u.pm * BM + wr * 64 + fr, col0 = u.pn * BM + wc * 32 + 8 * fq;
#pragma unroll
        for (int ai = 0; ai < 2; ++ai)
#pragma unroll
            for (int m = 0; m < 4; ++m) { bf16_t* rowp = O + (size_t)(row0 + ai * HALF + m * 16) * ldc + col0;
#pragma unroll
                for (int bj = 0; bj < 2; ++bj) { f32x4 v0 = acc[ai][bj][m][0], v1 = acc[ai][bj][m][1];
#pragma unroll
                    for (int e = 0; e < 4; ++e) { const float a0 = v0[e] > 0.f ? v0[e] : 0.f, a1 = v1[e] > 0.f ? v1[e] : 0.f; v0[e] = a0 * a0; v1[e] = a1 * a1; }
                    u32x4 w; w.x = cvt_pk_bf16(v0[0], v0[1]); w.y = cvt_pk_bf16(v0[2], v0[3]); w.z = cvt_pk_bf16(v1[0], v1[1]); w.w = cvt_pk_bf16(v1[2], v1[3]);
                    *(u32x4*)(rowp + bj * HALF) = w; } }
    }
};
struct EpiRes {
    static constexpr bool PERM = false, AFTER_DRAIN = false, HAS_MID = false; static constexpr int MID_T0 = -1, MID_T1 = -1;
    const float* xin; float* xout; const float* gbase; int seq0, tshift;
    __device__ __forceinline__ void operator()(const f32x4 (&acc)[2][2][4][2], const Unit& u, int wr, int wc, int fr, int fq) const {
        const int row0 = u.pm * BM + wr * 64 + fr, col0 = u.pn * BM + wc * 32 + 4 * fq;
        const float* gp = gbase + (size_t)(seq0 + ((u.pm * BM) >> tshift)) * 12288 + col0;
        f32x4 gv[2][2];
#pragma unroll
        for (int bj = 0; bj < 2; ++bj)
#pragma unroll
            for (int n = 0; n < 2; ++n) gv[bj][n] = *(const f32x4*)(gp + bj * HALF + n * 16);
#pragma unroll
        for (int ai = 0; ai < 2; ++ai)
#pragma unroll
            for (int m = 0; m < 4; ++m) { const size_t off = (size_t)(row0 + ai * HALF + m * 16) * 2048 + col0;
#pragma unroll
                for (int bj = 0; bj < 2; ++bj)
#pragma unroll
                    for (int n = 0; n < 2; ++n) { const f32x4 xi = *(const f32x4*)(xin + off + bj * HALF + n * 16);
                        *(f32x4*)(xout + off + bj * HALF + n * 16) = xi + gv[bj][n] * acc[ai][bj][m][n]; } }
    }
};
template <int MODE> struct EpiBr {
    static constexpr bool PERM = false, AFTER_DRAIN = false, HAS_MID = false; static constexpr int MID_T0 = -1, MID_T1 = -1;
    float* T; bf16_t* MRG; const bf16_t* Gt; int gcol0;
    __device__ __forceinline__ void operator()(const f32x4 (&acc)[2][2][4][2], const Unit& u, int wr, int wc, int fr, int fq) const {
        const int row0 = u.pm * BM + wr * 64 + fr, col0 = u.pn * BM + wc * 32 + 4 * fq;
#pragma unroll
        for (int ai = 0; ai < 2; ++ai)
#pragma unroll
            for (int m = 0; m < 4; ++m) { const size_t row = (size_t)(row0 + ai * HALF + m * 16);
#pragma unroll
                for (int bj = 0; bj < 2; ++bj)
#pragma unroll
                    for (int n = 0; n < 2; ++n) { const int col = col0 + bj * HALF + n * 16;
                        const u32x2 gw = *(const u32x2*)(Gt + row * 6144 + gcol0 + col);
                        const f32x4 g = {__uint_as_float(gw.x << 16), __uint_as_float(gw.x & 0xffff0000u), __uint_as_float(gw.y << 16), __uint_as_float(gw.y & 0xffff0000u)};
                        f32x4 v = g * acc[ai][bj][m][n];
                        if (MODE >= 1) v = v + *(const f32x4*)(T + row * 2048 + col);
                        if (MODE <= 1) *(f32x4*)(T + row * 2048 + col) = v;
                        else { u32x2 w; w.x = cvt_pk_bf16(v[0], v[1]); w.y = cvt_pk_bf16(v[2], v[3]); *(u32x2*)(MRG + row * 2048 + col) = w; } } }
    }
};

struct EpiBrM {
    static constexpr bool PERM = true, AFTER_DRAIN = false, HAS_MID = true; static constexpr int MID_T0 = 8, MID_T1 = 12;
    bf16_t* MRG; const bf16_t* Gt;
    __device__ __forceinline__ static void up8(const u32x4 w, f32x4& lo, f32x4& hi) {
        lo = (f32x4){__uint_as_float(w.x << 16), __uint_as_float(w.x & 0xffff0000u), __uint_as_float(w.y << 16), __uint_as_float(w.y & 0xffff0000u)};
        hi = (f32x4){__uint_as_float(w.z << 16), __uint_as_float(w.z & 0xffff0000u), __uint_as_float(w.w << 16), __uint_as_float(w.w & 0xffff0000u)}; }
    __device__ __forceinline__ static f32x4 rdiv(const f32x4 a, const f32x4 b) { return (f32x4){a[0] * __builtin_amdgcn_rcpf(b[0]), a[1] * __builtin_amdgcn_rcpf(b[1]), a[2] * __builtin_amdgcn_rcpf(b[2]), a[3] * __builtin_amdgcn_rcpf(b[3])}; }
    __device__ __forceinline__ void mid(f32x4 (&acc)[2][2][4][2], const Unit& u, int t, int wr, int wc, int fr, int fq) const {
        int off = (u.pm * 24 + u.pn + (t == MID_T0 ? 0 : 8)) * 65536 + (wr * 4 + wc) * 8192 + (fq * 16 + fr) * 8;
        asm volatile("" : "+v"(off));
        const bf16_t* gp = Gt + (unsigned)off;
#pragma unroll
        for (int ai = 0; ai < 2; ++ai)
#pragma unroll
            for (int m = 0; m < 4; ++m) {
#pragma unroll
                for (int bj = 0; bj < 2; ++bj) { const int s = ((ai * 4 + m) * 2 + bj) * 512;
                    const u32x4 wa = *(const u32x4*)(gp + s), wb = *(const u32x4*)(gp + 8 * 65536 + s);
                    f32x4 a0, a1, b0, b1; up8(wa, a0, a1); up8(wb, b0, b1);
                    acc[ai][bj][m][0] = acc[ai][bj][m][0] * rdiv(a0, b0); acc[ai][bj][m][1] = acc[ai][bj][m][1] * rdiv(a1, b1); }
                asm volatile("" ::: "memory"); }
    }
    __device__ __forceinline__ void operator()(const f32x4 (&acc)[2][2][4][2], const Unit& u, int wr, int wc, int fr, int fq) const {
        const int row0 = u.pm * BM + wr * 64 + fr, col0 = u.pn * BM + wc * 32 + 8 * fq;
        const bf16_t* gp = Gt + (size_t)(u.pm * 24 + u.pn + 16) * 65536 + (wr * 4 + wc) * 8192 + (fq * 16 + fr) * 8;
#pragma unroll
        for (int ai = 0; ai < 2; ++ai)
#pragma unroll
            for (int m = 0; m < 4; ++m) { bf16_t* rowp = MRG + (size_t)(row0 + ai * HALF + m * 16) * 2048 + col0;
#pragma unroll
                for (int bj = 0; bj < 2; ++bj) { const u32x4 wg = *(const u32x4*)(gp + ((ai * 4 + m) * 2 + bj) * 512); f32x4 g0, g1; up8(wg, g0, g1);
                    const f32x4 v0 = acc[ai][bj][m][0] * g0, v1 = acc[ai][bj][m][1] * g1;
                    u32x4 w; w.x = cvt_pk_bf16(v0[0], v0[1]); w.y = cvt_pk_bf16(v0[2], v0[3]); w.z = cvt_pk_bf16(v1[0], v1[1]); w.w = cvt_pk_bf16(v1[2], v1[3]);
                    *(u32x4*)(rowp + bj * HALF) = w; } }
    }
};
struct EpiDelta {
    static constexpr bool PERM = true, AFTER_DRAIN = false, HAS_MID = false; static constexpr int MID_T0 = -1, MID_T1 = -1;
    bf16_t* Dl; const float* gbase; int seq0, tshift;
    __device__ __forceinline__ void operator()(const f32x4 (&acc)[2][2][4][2], const Unit& u, int wr, int wc, int fr, int fq) const {
        const int row0 = u.pm * BM + wr * 64 + fr, col0 = u.pn * BM + wc * 32 + 8 * fq;
        const float* gp = gbase + (size_t)(seq0 + ((u.pm * BM) >> tshift)) * 12288 + col0;
        f32x4 gv[2][2];
#pragma unroll
        for (int bj = 0; bj < 2; ++bj)
#pragma unroll
            for (int n = 0; n < 2; ++n) gv[bj][n] = *(const f32x4*)(gp + bj * HALF + 4 * n);
#pragma unroll
        for (int ai = 0; ai < 2; ++ai)
#pragma unroll
            for (int m = 0; m < 4; ++m) { bf16_t* rowp = Dl + (size_t)(row0 + ai * HALF + m * 16) * 2048 + col0;
#pragma unroll
                for (int bj = 0; bj < 2; ++bj) { const f32x4 v0 = acc[ai][bj][m][0] * gv[bj][0], v1 = acc[ai][bj][m][1] * gv[bj][1];
                    u32x4 w; w.x = cvt_pk_bf16(v0[0], v0[1]); w.y = cvt_pk_bf16(v0[2], v0[3]); w.z = cvt_pk_bf16(v1[0], v1[1]); w.w = cvt_pk_bf16(v1[2], v1[3]);
                    *(u32x4*)(rowp + bj * HALF) = w; } }
    }
};
template <class Epi, class Sched, bool ALIGN_EPI = false, bool SP2 = false>
__device__ __forceinline__ void gemm_phase(PG8_LAS unsigned char* lds, const Gemm g, const Sched& S, const Epi& E) {
    int tid_ = threadIdx.x; asm volatile("" : "+v"(tid_));
    const int tid = tid_, wid = __builtin_amdgcn_readfirstlane(tid >> 6), lane = tid & 63, wr = wid >> 2, wc = wid & 3, fr = lane & 15, fq = lane >> 4;
    const int K = g.K, nt = K / BK;
    unsigned voffA[2], voffB[2];
#pragma unroll
    for (int i = 0; i < 2; ++i) { int R, C; stage_rc(tid * 16 + i * 8192, R, C); const int Rb = Epi::PERM ? ((R & ~31) + perm32(R & 31)) : R;
        voffA[i] = (unsigned)(R * K + C) * 2u; voffB[i] = (unsigned)(Rb * K + C) * 2u; }
    const size_t kstep = (size_t)(BK * 2);
    const size_t hstep = (size_t)HALF * K * 2;
    const size_t tstep = 2 * hstep;
    const unsigned ldsw = (unsigned)wid * 1024u;
    const int aoff = lds_byte(wr * 64 + fr, fq * 8), boff = lds_byte(wc * 32 + fr, fq * 8);
#define PG8_SA(b, h) (((b) * 2 + (h)) * HTB)
#define PG8_SB(b, h) ((4 + (b) * 2 + (h)) * HTB)
#define PG8_STAGE(bufoff, gbase, voff) do { _Pragma("unroll") for (int _i = 0; _i < 2; ++_i) \
        __builtin_amdgcn_global_load_lds((const unsigned*)((const char*)(gbase) + (voff)[_i]), (PG8_LAS unsigned*)(lds + (bufoff) + ldsw + _i * 8192), 16, 0, 0); } while (0)
#define PG8_LDA(dst, b, h) do { _Pragma("unroll") for (int m = 0; m < 4; ++m) _Pragma("unroll") for (int k = 0; k < 2; ++k) dst[m][k] = *(const PG8_LAS bf16x8*)(lds + PG8_SA(b, h) + aoff + m * 2048 + k * 1024); } while (0)
#define PG8_LDB(dst, b, h) do { _Pragma("unroll") for (int n = 0; n < 2; ++n) _Pragma("unroll") for (int k = 0; k < 2; ++k) dst[n][k] = *(const PG8_LAS bf16x8*)(lds + PG8_SB(b, h) + boff + n * 2048 + k * 1024); } while (0)
#define PG8_MMA(ai, bj, At, Bt) do { __builtin_amdgcn_s_setprio(1); _Pragma("unroll") for (int m = 0; m < 4; ++m) _Pragma("unroll") for (int n = 0; n < 2; ++n) _Pragma("unroll") for (int k = 0; k < 2; ++k) \
        acc[ai][bj][m][n] = __builtin_amdgcn_mfma_f32_16x16x32_bf16(Bt[n][k], At[m][k], acc[ai][bj][m][n], 0, 0, 0); __builtin_amdgcn_s_setprio(0); } while (0)
#define PG8_WAIT_V(n) asm volatile("s_waitcnt vmcnt(" #n ")" ::: "memory")
#define PG8_WAIT_L(n) asm volatile("s_waitcnt lgkmcnt(" #n ")" ::: "memory")
#define PG8_BAR __builtin_amdgcn_s_barrier()
#define PG8_SCHED __builtin_amdgcn_sched_barrier(0)
    Unit cur, nxt; int ui = 0;
    if (!S.next(0, cur)) return;
    f32x4 acc[2][2][4][2];
#pragma unroll
    for (int a = 0; a < 2; ++a)
#pragma unroll
        for (int b = 0; b < 2; ++b)
#pragma unroll
            for (int m = 0; m < 4; ++m)
#pragma unroll
                for (int n = 0; n < 2; ++n) acc[a][b][m][n] = (f32x4){0.f, 0.f, 0.f, 0.f};
    bf16x8 At[4][2], B0[2][2], B1[2][2];
    const char* cA = (const char*)g.A + (size_t)cur.pm * tstep; const char* cB = (const char*)g.Bt + (size_t)cur.pn * tstep;
    S.a_ready(cur);
    if constexpr (SP2) {
        PG8_STAGE(PG8_SB(0, 0), cB, voffB); PG8_STAGE(PG8_SB(0, 1), cB + hstep, voffB); PG8_STAGE(PG8_SA(0, 0), cA, voffA); PG8_STAGE(PG8_SA(0, 1), cA + hstep, voffA);
        if (wr == 1) PG8_BAR;
        PG8_WAIT_V(2); PG8_BAR;
        PG8_STAGE(PG8_SB(1, 0), cB + kstep, voffB); PG8_STAGE(PG8_SA(1, 0), cA + kstep, voffA); PG8_STAGE(PG8_SB(1, 1), cB + hstep + kstep, voffB);
        PG8_WAIT_V(6); PG8_BAR;
    } else {
        PG8_STAGE(PG8_SB(0, 0), cB, voffB); PG8_STAGE(PG8_SA(0, 0), cA, voffA); PG8_STAGE(PG8_SB(0, 1), cB + hstep, voffB); PG8_STAGE(PG8_SA(0, 1), cA + hstep, voffA);
        if (wr == 1) PG8_BAR;
        PG8_WAIT_V(4); PG8_BAR;
        PG8_STAGE(PG8_SB(1, 0), cB + kstep, voffB); PG8_STAGE(PG8_SA(1, 0), cA + kstep, voffA); PG8_STAGE(PG8_SB(1, 1), cB + hstep + kstep, voffB);
        PG8_WAIT_V(6); PG8_BAR;
    }
    for (;;) {
        const bool has_next = S.next(ui + 1, nxt);
        const char* nA = has_next ? (const char*)g.A + (size_t)nxt.pm * tstep : cA; const char* nB = has_next ? (const char*)g.Bt + (size_t)nxt.pn * tstep : cB;
#pragma unroll 1
        for (int t = 0; t < nt; t += 2) {
            if constexpr (Epi::HAS_MID) { if (t == Epi::MID_T0 || t == Epi::MID_T1) E.mid(acc, cur, t, wr, wc, fr, fq); }
            const bool last = (t == nt - 2);
            const char* a1 = cA + (size_t)(t + 1) * kstep;
            const char* a2 = last ? nA : cA + (size_t)(t + 2) * kstep; const char* b2 = last ? nB : cB + (size_t)(t + 2) * kstep;
            const char* a3 = a2 + kstep; const char* b3 = b2 + kstep;
            if (last && has_next) S.a_ready(nxt);
            if constexpr (SP2) {
            PG8_LDB(B0, 0, 0); PG8_LDB(B1, 0, 1); PG8_SCHED; PG8_LDA(At, 0, 0); PG8_STAGE(PG8_SA(1, 1), a1 + hstep, voffA);
            PG8_WAIT_V(8); PG8_WAIT_L(0); PG8_BAR; PG8_MMA(0, 0, At, B0); PG8_MMA(0, 1, At, B1); PG8_BAR; PG8_SCHED;
            PG8_LDA(At, 0, 1); PG8_STAGE(PG8_SB(0, 0), b2, voffB); PG8_STAGE(PG8_SB(0, 1), b2 + hstep, voffB); PG8_STAGE(PG8_SA(0, 0), a2, voffA);
            PG8_WAIT_V(8); PG8_WAIT_L(0); PG8_BAR; PG8_MMA(1, 0, At, B0); PG8_MMA(1, 1, At, B1); PG8_BAR; PG8_SCHED;
            PG8_LDB(B0, 1, 0); PG8_LDB(B1, 1, 1); PG8_SCHED; PG8_LDA(At, 1, 0); PG8_STAGE(PG8_SA(0, 1), a2 + hstep, voffA);
            PG8_WAIT_V(8); PG8_WAIT_L(0); PG8_BAR; PG8_MMA(0, 0, At, B0); PG8_MMA(0, 1, At, B1); PG8_BAR; PG8_SCHED;
            PG8_LDA(At, 1, 1); PG8_STAGE(PG8_SB(1, 0), b3, voffB); PG8_STAGE(PG8_SB(1, 1), b3 + hstep, voffB); PG8_STAGE(PG8_SA(1, 0), a3, voffA);
            PG8_WAIT_V(8); PG8_WAIT_L(0); PG8_BAR; PG8_MMA(1, 0, At, B0); PG8_MMA(1, 1, At, B1); PG8_BAR; PG8_SCHED;
            } else {
            PG8_LDB(B0, 0, 0); PG8_SCHED; PG8_LDA(At, 0, 0); PG8_STAGE(PG8_SA(1, 1), a1 + hstep, voffA);
            PG8_WAIT_L(8); PG8_BAR; PG8_WAIT_L(0); PG8_MMA(0, 0, At, B0); PG8_BAR; PG8_SCHED;
            PG8_LDB(B1, 0, 1); PG8_STAGE(PG8_SB(0, 0), b2, voffB);
            PG8_BAR; PG8_WAIT_L(0); PG8_MMA(0, 1, At, B1); PG8_BAR;
            PG8_LDA(At, 0, 1); PG8_STAGE(PG8_SA(0, 0), a2, voffA);
            PG8_BAR; PG8_WAIT_L(0); PG8_MMA(1, 0, At, B0); PG8_BAR; PG8_SCHED;
            PG8_STAGE(PG8_SB(0, 1), b2 + hstep, voffB);
            PG8_WAIT_V(6); PG8_BAR; PG8_MMA(1, 1, At, B1); PG8_BAR;
            PG8_LDB(B0, 1, 0); PG8_SCHED; PG8_LDA(At, 1, 0); PG8_STAGE(PG8_SA(0, 1), a2 + hstep, voffA);
            PG8_WAIT_L(8); PG8_BAR; PG8_WAIT_L(0); PG8_MMA(0, 0, At, B0); PG8_BAR; PG8_SCHED;
            PG8_LDB(B1, 1, 1); PG8_STAGE(PG8_SB(1, 0), b3, voffB);
            PG8_BAR; PG8_WAIT_L(0); PG8_MMA(0, 1, At, B1); PG8_BAR;
            PG8_LDA(At, 1, 1); PG8_STAGE(PG8_SA(1, 0), a3, voffA);
            PG8_BAR; PG8_WAIT_L(0); PG8_MMA(1, 0, At, B0); PG8_BAR; PG8_SCHED;
            PG8_STAGE(PG8_SB(1, 1), b3 + hstep, voffB);
            PG8_WAIT_V(6); PG8_BAR; PG8_MMA(1, 1, At, B1); PG8_BAR;
            }
        }
        if constexpr (ALIGN_EPI) { if (wr == 0) PG8_BAR; }
        if constexpr (!Epi::AFTER_DRAIN) { E(acc, cur, wr, wc, fr, fq); S.done(cur); }
        if (!has_next) break;
#pragma unroll
        for (int a = 0; a < 2; ++a)
#pragma unroll
            for (int b = 0; b < 2; ++b)
#pragma unroll
                for (int m = 0; m < 4; ++m)
#pragma unroll
                    for (int n = 0; n < 2; ++n) acc[a][b][m][n] = (f32x4){0.f, 0.f, 0.f, 0.f};
        cur = nxt; cA = nA; cB = nB; ++ui;
        if constexpr (ALIGN_EPI) { if (wr == 1) PG8_BAR; }
    }
    PG8_WAIT_V(0);
    if constexpr (!ALIGN_EPI) { if (wr == 0) PG8_BAR; }
    PG8_BAR;
    if constexpr (Epi::AFTER_DRAIN) { E.fused(acc, cur, wr, wc, fr, fq, lds, wid, lane); S.done(cur); }
#undef PG8_SA
#undef PG8_SB
#undef PG8_STAGE
#undef PG8_LDA
#undef PG8_LDB
#undef PG8_MMA
#undef PG8_WAIT_V
#undef PG8_WAIT_L
#undef PG8_BAR
#undef PG8_SCHED
}
}

constexpr int NWAVES = 8;
constexpr int DM = 2048, NSEQ = 24, MTOT = 65536, DFF = 8192, INC = 6144;
#ifndef MK_CH
#define MK_CH 16384
#endif
constexpr int CH = MK_CH;
constexpr int NCHUNK = MTOT / CH;
constexpr float EPS = 1e-6f, LOG2E = 1.4426950408889634f, LN2 = 0.6931471805599453f;
constexpr float QS128 = 0.08838834764831845f * LOG2E, QS64 = 0.125f * LOG2E;
constexpr float NEGB = -1e30f;

constexpr size_t MiB = 1u << 20;
constexpr size_t WS_CTL = 0, CTL_ZERO_BYTES = 1 * MiB;
constexpr size_t WS_MOD = 1 * MiB;
constexpr size_t WS_ROPEB = 4 * MiB, WS_ROPEC = WS_ROPEB + 512 * 1024;
constexpr size_t WS_LAM = 5 * MiB;
constexpr size_t WS_MODP = 6 * MiB;
constexpr size_t WS_W = 48 * MiB, W_LAYER = 126 * MiB;
constexpr size_t WO_IG = 0, WO_BRA = 48 * MiB, WO_BRB = 50 * MiB, WO_BRC = 51 * MiB, WO_OUT = 54 * MiB, WO_FF1 = 62 * MiB, WO_FF2 = 94 * MiB;
constexpr size_t WS_ACT = 304 * MiB;
constexpr size_t CHS = (size_t)CH;
constexpr size_t A_H = WS_ACT;
constexpr size_t A_Z = A_H + CHS * 2048 * 2;
constexpr size_t A_QK = A_Z + CHS * 6144 * 2;
constexpr size_t A_VT = A_QK + CHS * 4096 * 2;
constexpr size_t A_G = A_VT + CHS * 2048 * 2;
constexpr size_t A_OA = A_G + CHS * 6144 * 2;
constexpr size_t A_OB = A_OA + CHS * 512 * 2;
constexpr size_t A_OC = A_OB + CHS * 256 * 2;
constexpr size_t WS_END = A_OC + CHS * 768 * 2;
constexpr size_t A_BTMP = A_Z;
constexpr size_t A_BLSE = A_BTMP + CHS * 768 * 2;
constexpr size_t A_CTMP = A_BLSE + CHS * 8 * 4;
static_assert(A_CTMP + CHS * 1536 * 4 <= A_QK, "attention temporaries fit in Z");
constexpr size_t A_TMPF = A_QK;
constexpr size_t A_U = A_Z;
static_assert(CHS * 8192 * 2 <= (A_VT - A_Z), "u fits in Z + QK");
constexpr int CW_BAR = 4096;
constexpr int CW_CHK = 65536;

constexpr int RING_OFF = 0, RING_BYTES = 131072;
constexpr int LDSCTL_OFF = RING_BYTES, MISC_OFF = LDSCTL_OFF + 320;
constexpr int LDS_BYTES = 147456;

#define GAS __attribute__((address_space(1)))
#define LAS __attribute__((address_space(3)))
typedef unsigned short bf16;
typedef unsigned v4u __attribute__((ext_vector_type(4)));
typedef unsigned v2u __attribute__((ext_vector_type(2)));
typedef float f32x4 __attribute__((ext_vector_type(4)));
typedef float f32x16 __attribute__((ext_vector_type(16)));
typedef short bf16x8 __attribute__((ext_vector_type(8)));
typedef GAS unsigned gu32;
#define LDS_WAIT() asm volatile("s_waitcnt lgkmcnt(0)" ::: "memory")
#define VM_WAIT() asm volatile("s_waitcnt vmcnt(0)" ::: "memory")
__device__ __forceinline__ unsigned pk2(float lo, float hi) { return pg8::cvt_pk_bf16(lo, hi); }
__device__ __forceinline__ float bflo(unsigned w) { return __uint_as_float(w << 16); }
__device__ __forceinline__ float bfhi(unsigned w) { return __uint_as_float(w & 0xffff0000u); }
__device__ __forceinline__ float bf1(bf16 b) { return __uint_as_float((unsigned)b << 16); }
__device__ __forceinline__ float wave_sum(float v) {
#pragma unroll
    for (int o = 1; o < 64; o <<= 1) v += __shfl_xor(v, o);
    return v;
}
#define XB_TMO      128
#define XB_XCNT(j)  (256  + 64 * (j))
#define XB_XSUB(j)  (1280 + 64 * (j))
#define XB_XGEN(j)  (2304 + 64 * (j))
#define XB_TOP      3328
#define XB_TOPGEN   3392
#define XCD_BAR_WORDS 3456
#define XB_SPIN_CAP (1u << 18)

__device__ __forceinline__ unsigned xb_ld(unsigned* p)              { return __hip_atomic_load(p, __ATOMIC_RELAXED, __HIP_MEMORY_SCOPE_AGENT); }
__device__ __forceinline__ unsigned xb_add(unsigned* p, unsigned v) { return __hip_atomic_fetch_add(p, v, __ATOMIC_RELAXED, __HIP_MEMORY_SCOPE_AGENT); }
__device__ __forceinline__ unsigned xb_xcc_id() { return (unsigned)__builtin_amdgcn_s_getreg((3 << 11) | 20) & 0xFu; }
#define XB_SPIN(cond, bar) do { unsigned _sp = 0; while (cond) { __builtin_amdgcn_s_sleep(1); \
    if ((++_sp & 255u) == 0u) { if (xb_ld(&(bar)[XB_TMO])) break; if (_sp > XB_SPIN_CAP) { atomicAdd(&(bar)[XB_TMO], 1u); break; } } } } while (0)

struct XcdBarrier {
    unsigned* bar; unsigned x;
    volatile LAS unsigned* st;
};

__device__ __forceinline__ XcdBarrier xcd_barrier_post(unsigned* bar, volatile LAS unsigned* st) {
    XcdBarrier b; b.bar = bar; b.x = xb_xcc_id(); b.st = st;
    if (threadIdx.x == 0) (void)xb_add(&bar[XB_XCNT(b.x)], 1u);
    return b;
}
__device__ __forceinline__ void xcd_barrier_complete(unsigned* bar, unsigned x, unsigned& nloc, unsigned& nx) {
    const unsigned G = gridDim.x * gridDim.y * gridDim.z;
    unsigned sum, cnt, mine, sp = 0u;
    for (;;) {
        sum = 0u; cnt = 0u; mine = 0u;
#pragma unroll
        for (unsigned j = 0; j < 16; ++j) { const unsigned c = xb_ld(&bar[XB_XCNT(j)]); sum += c; cnt += (c > 0u) ? 1u : 0u; mine = (j == x) ? c : mine; }
        if (sum == G) break;
        __builtin_amdgcn_s_sleep(1);
        if ((++sp & 255u) == 0u) { if (xb_ld(&bar[XB_TMO])) break; if (sp > XB_SPIN_CAP) { atomicAdd(&bar[XB_TMO], 1u); break; } }
    }
    nloc = mine > 0u ? mine : 1u; nx = cnt > 0u ? cnt : 1u;
}

__device__ __forceinline__ void xcd_barrier(const XcdBarrier& b) {
    asm volatile("s_waitcnt vmcnt(0)" ::: "memory");
    __syncthreads();
    if (threadIdx.x == 0) {
        unsigned* bar = b.bar;
        __builtin_amdgcn_s_waitcnt(0);
        unsigned nloc = b.st[0], nx = b.st[1];
        if (nloc == 0u) { xcd_barrier_complete(bar, b.x, nloc, nx); b.st[0] = nloc; b.st[1] = nx; }
        const unsigned old = xb_add(&bar[XB_XSUB(b.x)], 1u);
        const unsigned gen = old / nloc;
        if (old + 1u == (gen + 1u) * nloc) {
            __builtin_amdgcn_fence(__ATOMIC_RELEASE, "agent");
            asm volatile("s_waitcnt vmcnt(0)" ::: "memory");
            const unsigned og = xb_add(&bar[XB_TOP], 1u);
            const unsigned tg = og / nx;
            if (og + 1u == (tg + 1u) * nx) xb_add(&bar[XB_TOPGEN], 1u);
            else XB_SPIN(xb_ld(&bar[XB_TOPGEN]) == tg, bar);
            __builtin_amdgcn_fence(__ATOMIC_ACQUIRE, "agent");
            xb_add(&bar[XB_XGEN(b.x)], 1u);
            asm volatile("s_waitcnt vmcnt(0)" ::: "memory");
        } else {
            XB_SPIN(xb_ld(&bar[XB_XGEN(b.x)]) == gen, bar);
            __builtin_amdgcn_fence(__ATOMIC_ACQUIRE, "agent");
            asm volatile("s_waitcnt vmcnt(0)" ::: "memory");
        }
    }
    __syncthreads();
}

struct Args { const float* in[29]; float* out; unsigned char* ws; };
typedef const __attribute__((address_space(4))) unsigned long long* kargp_t;
struct AL {
    __device__ __forceinline__ static kargp_t kp() { kargp_t p = (kargp_t)__builtin_amdgcn_kernarg_segment_ptr(); asm volatile("" : "+s"(p)); return p; }
    __device__ __forceinline__ const float* in(int i) const { return (const float*)kp()[i]; }
    __device__ __forceinline__ float* out() const { return (float*)kp()[29]; }
    __device__ __forceinline__ unsigned char* ws() const { return (unsigned char*)kp()[30]; } };
enum { I_XP = 0, I_XS, I_CP, I_CS, I_N1G, I_WADA, I_BADA, I_WIN, I_QNA, I_KNA, I_RPB, I_QNB, I_KNB, I_QNC, I_KNC, I_LQ1, I_LK1, I_LQ2, I_LK2, I_SUBLN,
       I_WBRA, I_WBRB, I_WBRC, I_WGATE, I_BGATE, I_WOUT, I_N2G, I_WFF1, I_WFF2 };

__device__ __forceinline__ void phase_modp(const AL& a, LAS unsigned char* lds, int tid, int lane, int wave) {
    LAS float* sil = (LAS float*)lds;
    const float* wada = a.in(I_WADA); float* modp = (float*)(a.ws() + WS_MODP);
    for (int it = blockIdx.x; it < 256; it += gridDim.x) {
        const int l = it >> 7, ks = (it >> 3) & 15, cg = it & 7, k0 = ks * 128;
        for (int e = tid; e < 24 * 128; e += NWAVES * 64) { const int b = e >> 7, kk = e & 127;
            const float c = b < 8 ? a.in(I_CP)[b * 2048 + k0 + kk] : a.in(I_CS)[(b - 8) * 2048 + k0 + kk];
            sil[e] = c / (1.0f + __expf(-c)); }
        __syncthreads();
        const int n0 = cg * 1536 + wave * 192 + 3 * lane;
        float acc[24][3];
#pragma unroll
        for (int b = 0; b < 24; ++b) { acc[b][0] = 0.f; acc[b][1] = 0.f; acc[b][2] = 0.f; }
        const float* wp = wada + ((size_t)l * 2048 + k0) * 12288 + n0;
#pragma unroll 8
        for (int kk = 0; kk < 128; ++kk) {
            const float w0 = wp[(size_t)kk * 12288], w1 = wp[(size_t)kk * 12288 + 1], w2 = wp[(size_t)kk * 12288 + 2];
#pragma unroll
            for (int b = 0; b < 24; ++b) { const float s = sil[b * 128 + kk]; acc[b][0] += s * w0; acc[b][1] += s * w1; acc[b][2] += s * w2; }
        }
#pragma unroll
        for (int b = 0; b < 24; ++b) { float* o = modp + ((size_t)(ks * 2 + l) * 24 + b) * 12288 + n0; o[0] = acc[b][0]; o[1] = acc[b][1]; o[2] = acc[b][2]; }
        __syncthreads();
    }
}
struct TrItem { const float* src; bf16* dst; int N, ldk; };
__device__ __forceinline__ void tr_load(const TrItem& t, float (&v)[32], int lane) {
    const float* s = t.src + (size_t)(lane >> 5) * t.N + (lane & 31);
#pragma unroll
    for (int i = 0; i < 32; ++i) v[i] = s[(size_t)(2 * i) * t.N];
}
__device__ __forceinline__ void tr_store(const TrItem& t, const float (&v)[32], LAS float* scr, int lane) {
#pragma unroll
    for (int i = 0; i < 32; ++i) scr[(2 * i + (lane >> 5)) * 33 + (lane & 31)] = v[i];
    LDS_WAIT(); asm volatile("" ::: "memory");
    const int c = lane & 7;
#pragma unroll
    for (int j = 0; j < 4; ++j) { const int n = (lane >> 3) + 8 * j; const LAS float* s = scr + (8 * c) * 33 + n;
        v4u o; o.x = pk2(s[0 * 33], s[1 * 33]); o.y = pk2(s[2 * 33], s[3 * 33]); o.z = pk2(s[4 * 33], s[5 * 33]); o.w = pk2(s[6 * 33], s[7 * 33]);
        *(GAS v4u*)(t.dst + (size_t)n * t.ldk + 8 * c) = o; }
    LDS_WAIT(); asm volatile("" ::: "memory");
}
__device__ __forceinline__ void phase_pro2(const AL& a, LAS unsigned char* lds, int tid, int lane, int wave, int G) {
    const int gt = blockIdx.x * (NWAVES * 64) + tid, NGT = G * NWAVES * 64;
    { float* mod = (float*)(a.ws() + WS_MOD); const float* modp = (const float*)(a.ws() + WS_MODP); const float* bada = a.in(I_BADA);
      for (int i = gt; i < 2 * 24 * 12288; i += NGT) { const int l = i / (24 * 12288), n = i % 12288; float s = bada[l * 12288 + n];
#pragma unroll
          for (int ks = 0; ks < 16; ++ks) s += modp[(size_t)ks * (2 * 24 * 12288) + i];
          mod[i] = s; } }
    { float2* rb = (float2*)(a.ws() + WS_ROPEB); float2* rc = (float2*)(a.ws() + WS_ROPEC);
      for (int i = gt; i < 4096 * 24; i += NGT) { const int pos = i / 24, j = i % 24; const bool isb = j < 16; const int ii = isb ? j : j - 16; const double half = isb ? 16.0 : 8.0;
          const double inv = exp(-(double)ii / half * 13.122363377404328);
          const double rev = (double)pos * inv * 0.15915494309189535;
          const float fr = (float)(rev - floor(rev));
          const float2 v = make_float2(__builtin_amdgcn_cosf(fr), __builtin_amdgcn_sinf(fr));
          if (isb) rb[pos * 16 + ii] = v; else rc[pos * 8 + ii] = v; } }
    if (gt < 2) { const int l = gt; float s1 = 0.f, s2 = 0.f;
        for (int i = 0; i < 64; ++i) { s1 += a.in(I_LQ1)[l * 64 + i] * a.in(I_LK1)[l * 64 + i]; s2 += a.in(I_LQ2)[l * 64 + i] * a.in(I_LK2)[l * 64 + i]; }
        const float lam_init = 0.8f - 0.6f * expf(-0.3f * (float)l);
        ((float*)(a.ws() + WS_LAM))[l] = expf(s1) - expf(s2) + lam_init;
        float gq = 0.f, gk = 0.f;
        for (int i = 0; i < 64; ++i) { gq = fmaxf(gq, fabsf(a.in(I_QNC)[l * 64 + i])); gk = fmaxf(gk, fabsf(a.in(I_KNC)[l * 64 + i])); }
        ((float*)(a.ws() + WS_LAM))[2 + l] = 8.0f * LOG2E * gq * gk * 1.02f; }
    LAS float* scr = (LAS float*)(lds + RING_OFF + wave * 16384);
    const int gw = blockIdx.x * NWAVES + wave, NGW = G * NWAVES;
    constexpr int I_IN = 32 * 192, I_BA = 8 * 64, I_BB = 4 * 64, I_BC = 12 * 64, I_OU = 32 * 64, I_F1 = 32 * 256, I_F2 = 128 * 64;
    constexpr int PER_L = 2 * I_IN + I_BA + I_BB + I_BC + I_OU + I_F1 + I_F2;
    auto decode = [&](int it) -> TrItem {
        const int l = it / PER_L; int r = it % PER_L; unsigned char* wl = a.ws() + WS_W + (size_t)l * W_LAYER;
        const float* W; bf16* WT; int K, N, row_off = 0, ldk, koff = 0;
        if (r < I_IN) { W = a.in(I_WIN) + (size_t)l * 2048 * 6144; K = 2048; N = 6144; WT = (bf16*)(wl + WO_IG); ldk = 2048; }
        else if ((r -= I_IN) < I_IN) { W = a.in(I_WGATE) + (size_t)l * 2048 * 6144; K = 2048; N = 6144; WT = (bf16*)(wl + WO_IG); row_off = 6144; ldk = 2048; }
        else if ((r -= I_IN) < I_BA) { W = a.in(I_WBRA) + (size_t)l * 512 * 2048; K = 512; N = 2048; WT = (bf16*)(wl + WO_BRA); ldk = 1536; }
        else if ((r -= I_BA) < I_BB) { W = a.in(I_WBRB) + (size_t)l * 256 * 2048; K = 256; N = 2048; WT = (bf16*)(wl + WO_BRA); ldk = 1536; koff = 512; }
        else if ((r -= I_BB) < I_BC) { W = a.in(I_WBRC) + (size_t)l * 768 * 2048; K = 768; N = 2048; WT = (bf16*)(wl + WO_BRA); ldk = 1536; koff = 768; }
        else if ((r -= I_BC) < I_OU) { W = a.in(I_WOUT) + (size_t)l * 2048 * 2048; K = 2048; N = 2048; WT = (bf16*)(wl + WO_OUT); ldk = 2048; }
        else if ((r -= I_OU) < I_F1) { W = a.in(I_WFF1) + (size_t)l * 2048 * 8192; K = 2048; N = 8192; WT = (bf16*)(wl + WO_FF1); ldk = 2048; }
        else { r -= I_F1; W = a.in(I_WFF2) + (size_t)l * 8192 * 2048; K = 8192; N = 2048; WT = (bf16*)(wl + WO_FF2); ldk = 8192; }
        (void)K; const int nblk = N / 32, kb = r / nblk, nb = r % nblk, k0 = 64 * kb, n0 = 32 * nb;
        TrItem t; t.src = W + (size_t)k0 * N + n0; t.dst = WT + (size_t)(row_off + n0) * ldk + koff + k0; t.N = N; t.ldk = ldk; return t; };
    { int it = gw; const int NIT = 2 * PER_L;
      if (it < NIT) { TrItem cur = decode(it); float v[32]; tr_load(cur, v, lane);
          for (;;) { const int nx = it + NGW; const bool more = nx < NIT; TrItem nt = cur; float vn[32];
              if (more) { nt = decode(nx); tr_load(nt, vn, lane); }
              tr_store(cur, v, scr, lane);
              if (!more) break;
              cur = nt; it = nx;
#pragma unroll
              for (int i = 0; i < 32; ++i) v[i] = vn[i]; } } }
}

template <bool HASD>
__device__ __forceinline__ void phase_norm(const float* xsrc, const bf16* D, float* xout, const float* gn, const float* modl, int sh_off, int sc_off, int seq0, int tshift, bf16* H, int gw, int NGW, int lane) {
    for (int blk = gw; blk < CH / 8; blk += NGW) {
        const int r0 = blk * 8; const float* mo = modl + (size_t)(seq0 + (r0 >> tshift)) * 12288;
        f32x4 A[8], B[8];
#pragma unroll
        for (int j = 0; j < 8; ++j) { const int c = 4 * lane + 256 * j; const f32x4 g = *(const f32x4*)(gn + c), sc = *(const f32x4*)(mo + sc_off + c); A[j] = g * (1.0f + sc); B[j] = *(const f32x4*)(mo + sh_off + c); }
        for (int r = 0; r < 8; r += 2) {
            const f32x4* xr0 = (const f32x4*)(xsrc + (size_t)(r0 + r) * 2048) + lane; const f32x4* xr1 = xr0 + 512; f32x4 v0[8], v1[8]; float s0 = 0.f, s1 = 0.f;
#pragma unroll
            for (int j = 0; j < 8; ++j) { v0[j] = xr0[64 * j]; v1[j] = xr1[64 * j]; }
            if (HASD) { const v2u* d0 = (const v2u*)(D + (size_t)(r0 + r) * 2048) + lane; const v2u* d1 = d0 + 512; v2u e0[8], e1[8];
#pragma unroll
                for (int j = 0; j < 8; ++j) { e0[j] = d0[64 * j]; e1[j] = d1[64 * j]; }
                f32x4* xo0 = (f32x4*)(xout + (size_t)(r0 + r) * 2048) + lane; f32x4* xo1 = xo0 + 512;
#pragma unroll
                for (int j = 0; j < 8; ++j) { v0[j] = v0[j] + (f32x4){bflo(e0[j].x), bfhi(e0[j].x), bflo(e0[j].y), bfhi(e0[j].y)}; v1[j] = v1[j] + (f32x4){bflo(e1[j].x), bfhi(e1[j].x), bflo(e1[j].y), bfhi(e1[j].y)};
                    xo0[64 * j] = v0[j]; xo1[64 * j] = v1[j]; } }
#pragma unroll
            for (int j = 0; j < 8; ++j) { s0 += (v0[j].x * v0[j].x + v0[j].y * v0[j].y) + (v0[j].z * v0[j].z + v0[j].w * v0[j].w); s1 += (v1[j].x * v1[j].x + v1[j].y * v1[j].y) + (v1[j].z * v1[j].z + v1[j].w * v1[j].w); }
            const float rstd0 = rsqrtf(wave_sum(s0) * (1.0f / 2048.0f) + EPS), rstd1 = rsqrtf(wave_sum(s1) * (1.0f / 2048.0f) + EPS);
            v2u* o8 = (v2u*)(H + (size_t)(r0 + r) * 2048) + lane;
#pragma unroll
            for (int j = 0; j < 8; ++j) { const f32x4 o = v0[j] * rstd0 * A[j] + B[j]; v2u w; w.x = pk2(o.x, o.y); w.y = pk2(o.z, o.w); o8[64 * j] = w; }
#pragma unroll
            for (int j = 0; j < 8; ++j) { const f32x4 o = v1[j] * rstd1 * A[j] + B[j]; v2u w; w.x = pk2(o.x, o.y); w.y = pk2(o.z, o.w); o8[512 + 64 * j] = w; }
        }
    }
}
__device__ __forceinline__ void phase_final(const float* xsrc, const bf16* D, float* xout, int gw, int NGW, int lane) {
    for (int r = 2 * gw; r < CH; r += 2 * NGW) {
        const f32x4* xr0 = (const f32x4*)(xsrc + (size_t)r * 2048) + lane; const f32x4* xr1 = xr0 + 512; const v2u* d0 = (const v2u*)(D + (size_t)r * 2048) + lane; const v2u* d1 = d0 + 512;
        f32x4 v0[8], v1[8]; v2u e0[8], e1[8];
#pragma unroll
        for (int j = 0; j < 8; ++j) { v0[j] = xr0[64 * j]; v1[j] = xr1[64 * j]; e0[j] = d0[64 * j]; e1[j] = d1[64 * j]; }
        f32x4* xo0 = (f32x4*)(xout + (size_t)r * 2048) + lane; f32x4* xo1 = xo0 + 512;
#pragma unroll
        for (int j = 0; j < 8; ++j) { xo0[64 * j] = v0[j] + (f32x4){bflo(e0[j].x), bfhi(e0[j].x), bflo(e0[j].y), bfhi(e0[j].y)}; xo1[64 * j] = v1[j] + (f32x4){bflo(e1[j].x), bfhi(e1[j].x), bflo(e1[j].y), bfhi(e1[j].y)}; }
    }
}
__device__ __forceinline__ int perm_tok(int p, int dsh, int Lsh) { return dsh == 0 ? p : (((p & ((1 << Lsh) - 1)) << dsh) + (p >> Lsh)); }
__device__ __forceinline__ void prep_qk_item(const bf16* Z, bf16* QK, const AL& a, int l, int item, int S, int tshift, int lane) {
    const int slot = item & 31, rb = item >> 5;
    int srccol, dstcol, dsh = 0, kind = 0; const float* gain; float scale = 1.f;
    if (slot < 4) { srccol = 128 * slot; dstcol = 128 * slot; gain = a.in(I_QNA) + l * 128; scale = QS128; }
    else if (slot < 8) { const int j = slot - 4; srccol = 512 + 128 * j; dstcol = 512 + 128 * j; gain = a.in(I_KNA) + l * 128; }
    else if (slot < 14) { const int j = slot - 8; srccol = 1536 + 128 * j; dstcol = 1024 + 128 * j; kind = 1; gain = a.in(I_QNB) + l * 128; scale = QS128; dsh = 2 * (j >> 1); }
    else if (slot < 20) { const int j = slot - 14; srccol = 2304 + 128 * j; dstcol = 1792 + 128 * j; kind = 1; gain = a.in(I_KNB) + l * 128; dsh = 2 * (j >> 1); }
    else if (slot < 26) { const int j = slot - 20; srccol = 3840 + 128 * j; dstcol = 2560 + 128 * j; kind = 2; gain = a.in(I_QNC) + l * 64; scale = QS64; }
    else { const int j = slot - 26; srccol = 4608 + 128 * j; dstcol = 3328 + 128 * j; kind = 2; gain = a.in(I_KNC) + l * 64; }
    const int sub = lane & 15, Lsh = tshift - dsh;
    float g[8];
#pragma unroll
    for (int e = 0; e < 8; ++e) g[e] = gain[((8 * sub) & (kind == 2 ? 63 : 127)) + e];
    const float2* ropeB = (const float2*)(a.ws() + WS_ROPEB); const float2* ropeC = (const float2*)(a.ws() + WS_ROPEC);
    const int RS = kind == 1 ? 2 : 1, subg = kind == 1 ? sub : (sub & 7);
    const bool roper = kind != 0 && subg < 2 * RS, first = subg < RS; const int ib = 8 * (subg & (RS - 1));
    for (int p4 = 0; p4 < 16; p4 += 4) {
        v4u w[4]; int tt[4]; float2 cs[4][8];
#pragma unroll
        for (int q = 0; q < 4; ++q) { const int orow = rb * 64 + (p4 + q) * 4 + (lane >> 4), sl = orow >> tshift, p = orow & (S - 1);
            tt[q] = perm_tok(p, dsh, Lsh);
            w[q] = *(const v4u*)(Z + (size_t)((sl << tshift) + tt[q]) * 6144 + srccol + 8 * sub); }
        if (roper) {
#pragma unroll
            for (int q = 0; q < 4; ++q) { const float2* tab = kind == 1 ? ropeB + tt[q] * 16 + ib : ropeC + tt[q] * 8 + ib;
#pragma unroll
                for (int e = 0; e < 8; ++e) cs[q][e] = tab[e]; } }
#pragma unroll
        for (int q = 0; q < 4; ++q) { const int orow = rb * 64 + (p4 + q) * 4 + (lane >> 4);
            float y[8] = {bflo(w[q].x), bfhi(w[q].x), bflo(w[q].y), bfhi(w[q].y), bflo(w[q].z), bfhi(w[q].z), bflo(w[q].w), bfhi(w[q].w)};
            float ss = 0.f;
#pragma unroll
            for (int e = 0; e < 8; ++e) ss += y[e] * y[e];
            ss += __shfl_xor(ss, 1); ss += __shfl_xor(ss, 2); ss += __shfl_xor(ss, 4);
            if (kind != 2) ss += __shfl_xor(ss, 8);
            const float rstd = rsqrtf(ss * (kind == 2 ? (1.0f / 64.0f) : (1.0f / 128.0f)) + EPS);
#pragma unroll
            for (int e = 0; e < 8; ++e) y[e] = y[e] * rstd * g[e];
            if (kind != 0) {
                float pr[8];
#pragma unroll
                for (int e = 0; e < 8; ++e) pr[e] = __shfl_xor(y[e], RS);
                if (roper) {
#pragma unroll
                    for (int e = 0; e < 8; ++e) y[e] = first ? y[e] * cs[q][e].x - pr[e] * cs[q][e].y : y[e] * cs[q][e].x + pr[e] * cs[q][e].y; }
            }
            v4u o; o.x = pk2(y[0] * scale, y[1] * scale); o.y = pk2(y[2] * scale, y[3] * scale); o.z = pk2(y[4] * scale, y[5] * scale); o.w = pk2(y[6] * scale, y[7] * scale);
            *(v4u*)(QK + (size_t)orow * 4096 + dstcol + 8 * sub) = o; }
    }
}
struct VtItem { int srccol, dsh, sl, p0, vrow; };
__device__ __forceinline__ VtItem vt_decode(int item, int S, int tshift) {
    const int dh = item & 1, vh = (item >> 1) & 15, pb = item >> 5; VtItem v; v.dsh = 0;
    if (vh < 4) v.srccol = 1024 + 128 * vh; else if (vh < 10) { const int j = vh - 4; v.srccol = 3072 + 128 * j; v.dsh = 2 * (j >> 1); } else v.srccol = 5376 + 128 * (vh - 10);
    v.srccol += 64 * dh; const int o0 = pb * 64; v.sl = o0 >> tshift; v.p0 = o0 & (S - 1); v.vrow = (v.sl * 16 + vh) * 128 + 64 * dh; return v;
}
__device__ __forceinline__ void vt_load(const bf16* Z, const VtItem& v, int tshift, v4u (&w)[8], int lane) {
    const int Lsh = tshift - v.dsh;
#pragma unroll
    for (int pass = 0; pass < 8; ++pass) { const int i = pass * 8 + (lane >> 3), c8 = lane & 7, t = perm_tok(v.p0 + i, v.dsh, Lsh);
        w[pass] = *(const v4u*)(Z + (size_t)((v.sl << tshift) + t) * 6144 + v.srccol + 8 * c8); }
}
__device__ __forceinline__ void vt_store(bf16* VT, const VtItem& v, int S, const v4u (&w)[8], LAS unsigned short* T, int lane) {
#pragma unroll
    for (int pass = 0; pass < 8; ++pass) { const int i = pass * 8 + (lane >> 3), c8 = lane & 7;
        LAS unsigned short* tp = T + (8 * c8) * 68 + i;
        tp[0 * 68] = (unsigned short)(w[pass].x & 0xffffu); tp[1 * 68] = (unsigned short)(w[pass].x >> 16); tp[2 * 68] = (unsigned short)(w[pass].y & 0xffffu); tp[3 * 68] = (unsigned short)(w[pass].y >> 16);
        tp[4 * 68] = (unsigned short)(w[pass].z & 0xffffu); tp[5 * 68] = (unsigned short)(w[pass].z >> 16); tp[6 * 68] = (unsigned short)(w[pass].w & 0xffffu); tp[7 * 68] = (unsigned short)(w[pass].w >> 16); }
    LDS_WAIT(); asm volatile("" ::: "memory");
#pragma unroll
    for (int pass = 0; pass < 16; ++pass) { const int d = pass * 4 + (lane >> 4), c4 = lane & 15;
        const v2u x = *(const LAS v2u*)(T + d * 68 + 4 * c4);
        *(v2u*)(VT + (size_t)(v.vrow + d) * S + v.p0 + 4 * c4) = x; }
    LDS_WAIT(); asm volatile("" ::: "memory");
}
__device__ __forceinline__ void phase_prep(const AL& a, int l, LAS unsigned char* lds, int S, int tshift, int gw, int NGW, int wave, int lane) {
    const bf16* Z = (const bf16*)(a.ws() + A_Z); bf16* QK = (bf16*)(a.ws() + A_QK); bf16* VT = (bf16*)(a.ws() + A_VT);
    for (int it = gw; it < (CH / 64) * 32; it += NGW) prep_qk_item(Z, QK, a, l, it, S, tshift, lane);
    LAS unsigned short* T = (LAS unsigned short*)(lds + RING_OFF + wave * 16384);
    { int it = gw; const int NIT = (CH / 64) * 32;
      if (it < NIT) { VtItem cur = vt_decode(it, S, tshift); v4u w[8]; vt_load(Z, cur, tshift, w, lane);
          for (;;) { const int nx = it + NGW; const bool more = nx < NIT; VtItem nv = cur; v4u wn[8];
              if (more) { nv = vt_decode(nx, S, tshift); vt_load(Z, nv, tshift, wn, lane); }
              vt_store(VT, cur, S, w, T, lane);
              if (!more) break;
              cur = nv; it = nx;
#pragma unroll
              for (int i = 0; i < 8; ++i) w[i] = wn[i]; } } }
}

namespace att {
#define MFMA32(a, b, c) __builtin_amdgcn_mfma_f32_32x32x16_bf16((a), (b), (c), 0, 0, 0)
__device__ __forceinline__ float ex2(float x) { return __builtin_amdgcn_exp2f(x); }
struct MaskNone { static constexpr bool MASKED = false; __device__ __forceinline__ float operator()(float v, int) const { return v; } };
struct MaskB { static constexpr bool MASKED = true; int dq;
    __device__ __forceinline__ float operator()(float v, int koff) const { const int d = dq + koff; return (d >= -64 && d <= 64) ? v : NEGB; } };
struct MaskA { static constexpr bool MASKED = true; const LAS float* brow; int kc0, qc, cs;
    __device__ __forceinline__ float operator()(float v, int koff) const { const int kc = kc0 + koff; int di = kc - qc + 15; di = di < 0 ? 0 : (di > 30 ? 30 : di);
        const float b = brow[di]; return (kc >= cs && kc < cs + 16) ? v + b : NEGB; } };

template <int NK, class MaskFn>
__device__ __forceinline__ void tile_step(const bf16* Kt, const bf16* VTt, int S, const bf16x8 (&qf)[NK], f32x16 (&o)[4], float& m, float& l, int lane, const MaskFn& mf) {
    const int r32 = lane & 31, hi = lane >> 5;
    const int pim = (r32 & 19) | ((r32 & 4) << 1) | ((r32 & 8) >> 1);
    const bf16* kp = Kt + (size_t)pim * 4096 + 8 * hi;
    bf16x8 kf[NK];
#pragma unroll
    for (int d0 = 0; d0 < NK; ++d0) kf[d0] = *(const bf16x8*)(kp + 16 * d0);
    bf16x8 vf[4][2];
    const bf16* vp = VTt + (size_t)r32 * S + 8 * hi;
#pragma unroll
    for (int db = 0; db < 4; ++db)
#pragma unroll
        for (int s2 = 0; s2 < 2; ++s2) vf[db][s2] = *(const bf16x8*)(vp + (size_t)(32 * db) * S + 16 * s2);
    f32x16 s;
#pragma unroll
    for (int r = 0; r < 16; ++r) s[r] = 0.f;
#pragma unroll
    for (int d0 = 0; d0 < NK; ++d0) s = MFMA32(kf[d0], qf[d0], s);
    float mx = NEGB;
#pragma unroll
    for (int r = 0; r < 16; ++r) { s[r] = mf(s[r], 16 * (r >> 3) + 8 * hi + (r & 7)); mx = fmaxf(mx, s[r]); }
    mx = fmaxf(mx, __shfl_xor(mx, 32));
    const float mn = fmaxf(m, mx), alpha = ex2(m - mn);
    float ps = 0.f;
#pragma unroll
    for (int r = 0; r < 16; ++r) { float p = ex2(s[r] - mn); if (MaskFn::MASKED) p = s[r] <= -1e29f ? 0.f : p; s[r] = p; ps += p; }
    l = l * alpha + ps; m = mn;
    if (!__all(alpha == 1.0f)) {
#pragma unroll
        for (int db = 0; db < 4; ++db)
#pragma unroll
            for (int r = 0; r < 16; ++r) o[db][r] *= alpha;
    }
    bf16x8 pf[2];
#pragma unroll
    for (int s2 = 0; s2 < 2; ++s2) { v4u w; w.x = pk2(s[8 * s2 + 0], s[8 * s2 + 1]); w.y = pk2(s[8 * s2 + 2], s[8 * s2 + 3]); w.z = pk2(s[8 * s2 + 4], s[8 * s2 + 5]); w.w = pk2(s[8 * s2 + 6], s[8 * s2 + 7]); pf[s2] = __builtin_bit_cast(bf16x8, w); }
#pragma unroll
    for (int db = 0; db < 4; ++db)
#pragma unroll
        for (int s2 = 0; s2 < 2; ++s2) o[db] = MFMA32(vf[db][s2], pf[s2], o[db]);
}
template <int NK> __device__ __forceinline__ void load_q(const bf16* Qp, bf16x8 (&qf)[NK], int lane) {
    const bf16* q = Qp + (size_t)(lane & 31) * 4096 + 8 * (lane >> 5);
#pragma unroll
    for (int d0 = 0; d0 < NK; ++d0) qf[d0] = *(const bf16x8*)(q + 16 * d0);
}
__device__ __forceinline__ void zero_o(f32x16 (&o)[4]) {
#pragma unroll
    for (int db = 0; db < 4; ++db)
#pragma unroll
        for (int r = 0; r < 16; ++r) o[db][r] = 0.f;
}
__device__ __forceinline__ void store_o_bf16(bf16* dst, const f32x16 (&o)[4], float inv, int hi) {
#pragma unroll
    for (int db = 0; db < 4; ++db)
#pragma unroll
        for (int g = 0; g < 4; ++g) { v2u w; w.x = pk2(o[db][4 * g] * inv, o[db][4 * g + 1] * inv); w.y = pk2(o[db][4 * g + 2] * inv, o[db][4 * g + 3] * inv);
            *(v2u*)(dst + 32 * db + 8 * g + 4 * hi) = w; }
}
__device__ __forceinline__ void store_o_f32(float* dst, const f32x16 (&o)[4], float inv, int hi) {
#pragma unroll
    for (int db = 0; db < 4; ++db)
#pragma unroll
        for (int g = 0; g < 4; ++g) { const f32x4 v = {o[db][4 * g] * inv, o[db][4 * g + 1] * inv, o[db][4 * g + 2] * inv, o[db][4 * g + 3] * inv};
            *(f32x4*)(dst + 32 * db + 8 * g + 4 * hi) = v; }
}
__device__ __forceinline__ void wave_c(const bf16* QK, const bf16* VT, float* CTMP, int sl, int map, int q0, int S, int tshift, int lane) {
    const size_t row0 = (size_t)sl << tshift; const int hi = lane >> 5;
    const bf16* Kp = QK + row0 * 4096 + 3328 + 64 * map;
    const bf16* Vp = VT + (size_t)((sl * 16 + 10 + (map >> 1)) * 128) * S;
    bf16x8 qf[4]; load_q<4>(QK + (row0 + q0) * 4096 + 2560 + 64 * map, qf, lane);
    f32x16 o[4]; zero_o(o); float m = NEGB, l = 0.f; const MaskNone mf;
    for (int kb = 0; kb < S; kb += 32) tile_step<4, MaskNone>(Kp + (size_t)kb * 4096, Vp + kb, S, qf, o, m, l, lane, mf);
    l += __shfl_xor(l, 32);
    store_o_f32(CTMP + (row0 + q0 + (lane & 31)) * 1536 + map * 128, o, 1.0f / l, hi);
}
__device__ __forceinline__ void wave_b(const bf16* QK, const bf16* VT, bf16* BTMP, float* BLSE, int sl, int slot, int p0, int S, int tshift, int lane) {
    const size_t row0 = (size_t)sl << tshift; const int hi = lane >> 5, dsh = 2 * (slot >> 1), Lsh = tshift - dsh;
    const bf16* Kp = QK + row0 * 4096 + 1792 + 128 * slot;
    const bf16* Vp = VT + (size_t)((sl * 16 + 4 + slot) * 128) * S;
    bf16x8 qf[8]; load_q<8>(QK + (row0 + p0) * 4096 + 1024 + 128 * slot, qf, lane);
    f32x16 o[4]; zero_o(o); float m = NEGB, l = 0.f;
    const int qp = p0 + (lane & 31);
#pragma unroll 1
    for (int ti = 0; ti < 5; ++ti) { const int kb = p0 - 64 + 32 * ti;
        if (kb < 0 || kb >= S || (kb >> Lsh) != (p0 >> Lsh)) continue;
        const MaskB mf{kb - qp};
        tile_step<8, MaskB>(Kp + (size_t)kb * 4096, Vp + kb, S, qf, o, m, l, lane, mf); }
    l += __shfl_xor(l, 32);
    const int t = perm_tok(qp, dsh, Lsh);
    store_o_bf16(BTMP + (row0 + t) * 768 + slot * 128, o, 1.0f / l, hi);
    if (hi == 0) BLSE[(row0 + t) * 8 + slot] = (__log2f(l) + m) * LN2;
}
__device__ __forceinline__ void wave_a(const bf16* QK, const bf16* VT, bf16* OA, const LAS float* btab, int sl, int h, int r, int qh, int S, int tshift, int lane) {
    const size_t row0 = (size_t)sl << tshift; const int hi = lane >> 5, rows = S >> 6;
    int rs = r - 4; rs = rs < 0 ? 0 : (rs > rows - 8 ? rows - 8 : rs);
    const bf16* Kp = QK + row0 * 4096 + 512 + 128 * h;
    const bf16* Vp = VT + (size_t)((sl * 16 + h) * 128) * S;
    const int q0 = r * 64 + 32 * qh, qc = 32 * qh + (lane & 31);
    int cs = qc - 8; cs = cs < 0 ? 0 : (cs > 48 ? 48 : cs);
    bf16x8 qf[8]; load_q<8>(QK + (row0 + q0) * 4096 + 128 * h, qf, lane);
    f32x16 o[4]; zero_o(o); float m = NEGB, l = 0.f;
#pragma unroll 1
    for (int ti = 0; ti < 16; ++ti) { const int j = ti >> 1, chh = ti & 1, kb = (rs + j) * 64 + 32 * chh;
        const MaskA mf{btab + (rs + j - r + 7) * 31, 32 * chh, qc, cs};
        tile_step<8, MaskA>(Kp + (size_t)kb * 4096, Vp + kb, S, qf, o, m, l, lane, mf); }
    l += __shfl_xor(l, 32);
    store_o_bf16(OA + (row0 + q0 + (lane & 31)) * 1536 + h * 128, o, 1.0f / l, hi);
}

constexpr int CST = 24576;
__device__ __forceinline__ void glds16(const void* gsrc, unsigned lds_dst) { unsigned keep;
    asm volatile("s_mov_b32 %0, m0\n\ts_mov_b32 m0, %2\n\ts_nop 0\n\tglobal_load_lds_dwordx4 %1, off\n\ts_mov_b32 m0, %0" : "=&s"(keep) : "v"(gsrc), "s"(lds_dst) : "memory"); }
__device__ __forceinline__ void c_dma(const bf16* Kp, const bf16* Vp, int S, int kb, unsigned sb, int wave, int lane) {
    { const int row = 8 * wave + (lane >> 3), c = (lane & 7) ^ ((row >> 1) & 7);
      glds16(Kp + (size_t)(kb + row) * 4096 + 8 * c, (unsigned)__builtin_amdgcn_readfirstlane(sb + wave * 1024)); }
#pragma unroll
    for (int jj = 0; jj < 2; ++jj) { const int j = wave + 8 * jj, row = 8 * j + (lane >> 3), c = (lane & 7) ^ ((row >> 1) & 7);
      glds16(Vp + (size_t)row * S + kb + 8 * c, (unsigned)__builtin_amdgcn_readfirstlane(sb + 8192 + j * 1024)); }
}
#define C_WAIT_BAR(N) asm volatile("s_waitcnt vmcnt(" #N ")\n\ts_barrier" ::: "memory")
__device__ __forceinline__ void unit_c_fast(const bf16* QK, const bf16* VT, float* CTMP, LAS unsigned char* ring, int sl, int map, int qb, int S, int tshift, int wave, int lane) {
    const size_t row0 = (size_t)sl << tshift; const int r32 = lane & 31, hi = lane >> 5, q0 = qb * 256 + 32 * wave;
    const bf16* Kp = QK + row0 * 4096 + 3328 + 64 * map;
    const bf16* Vp = VT + (size_t)((sl * 16 + 10 + (map >> 1)) * 128) * S;
    bf16x8 qf[4]; load_q<4>(QK + (row0 + q0) * 4096 + 2560 + 64 * map, qf, lane);
    const int pim = (r32 & 19) | ((r32 & 4) << 1) | ((r32 & 8) >> 1);
    int ka[4], va[4];
#pragma unroll
    for (int d0 = 0; d0 < 4; ++d0) ka[d0] = pim * 128 + (((2 * d0 + hi) ^ ((pim >> 1) & 7)) << 4);
#pragma unroll
    for (int x = 0; x < 4; ++x) va[x] = 8192 + r32 * 128 + (((2 * x + hi) ^ ((r32 >> 1) & 7)) << 4);
    f32x16 o[4]; zero_o(o); float l = 0.f;
    const int NT = S >> 6;
#pragma unroll
    for (int d0 = 0; d0 < 4; ++d0) asm volatile("" : "+v"(qf[d0]));
    asm volatile("s_waitcnt vmcnt(0)\n\ts_barrier" ::: "memory");
    const unsigned ring_a = (unsigned)(size_t)ring;
    c_dma(Kp, Vp, S, 0, ring_a, wave, lane); c_dma(Kp, Vp, S, 64, ring_a + CST, wave, lane);
    int st_cur = 0, st_nxt2 = 2 * CST;
#pragma unroll 1
    for (int t = 0; t < NT; ++t) {
        if (t + 1 < NT) C_WAIT_BAR(3); else C_WAIT_BAR(0);
        if (t + 2 < NT) c_dma(Kp, Vp, S, (t + 2) * 64, ring_a + st_nxt2, wave, lane);
        const LAS unsigned char* sb = ring + st_cur;
#pragma unroll
        for (int st = 0; st < 2; ++st) {
            bf16x8 kf[4];
#pragma unroll
            for (int d0 = 0; d0 < 4; ++d0) kf[d0] = *(const LAS bf16x8*)(sb + st * 4096 + ka[d0]);
            f32x16 s;
#pragma unroll
            for (int r = 0; r < 16; ++r) s[r] = 0.f;
#pragma unroll
            for (int d0 = 0; d0 < 4; ++d0) s = MFMA32(kf[d0], qf[d0], s);
            bf16x8 vf[4][2];
#pragma unroll
            for (int db = 0; db < 4; ++db)
#pragma unroll
                for (int s2 = 0; s2 < 2; ++s2) vf[db][s2] = *(const LAS bf16x8*)(sb + db * 4096 + va[2 * st + s2]);
#pragma unroll
            for (int r = 0; r < 16; ++r) { s[r] = ex2(s[r]); l += s[r]; }
            bf16x8 pf[2];
#pragma unroll
            for (int s2 = 0; s2 < 2; ++s2) { v4u w; w.x = pk2(s[8 * s2 + 0], s[8 * s2 + 1]); w.y = pk2(s[8 * s2 + 2], s[8 * s2 + 3]); w.z = pk2(s[8 * s2 + 4], s[8 * s2 + 5]); w.w = pk2(s[8 * s2 + 6], s[8 * s2 + 7]); pf[s2] = __builtin_bit_cast(bf16x8, w); }
#pragma unroll
            for (int db = 0; db < 4; ++db)
#pragma unroll
                for (int s2 = 0; s2 < 2; ++s2) o[db] = MFMA32(vf[db][s2], pf[s2], o[db]);
        }
        st_cur = st_cur == 2 * CST ? 0 : st_cur + CST; st_nxt2 = st_nxt2 == 2 * CST ? 0 : st_nxt2 + CST;
    }
    l += __shfl_xor(l, 32);
    store_o_f32(CTMP + (row0 + q0 + r32) * 1536 + map * 128, o, 1.0f / l, hi);
}
}

__device__ __forceinline__ void phase_attn(const AL& a, int l, LAS unsigned char* lds, int S, int tshift, int tid, int wave, int lane, int types = 7) {
    const bf16* QK = (const bf16*)(a.ws() + A_QK); const bf16* VT = (const bf16*)(a.ws() + A_VT);
    const int nqb = S >> 8, nseq = CH >> tshift;
    if (types & 1) { float* CTMP = (float*)(a.ws() + A_CTMP); const float cbound = ((const float*)(a.ws() + WS_LAM))[2 + l];
      const int G = gridDim.x, vid = (G % 8 == 0) ? (blockIdx.x % 8) * (G / 8) + blockIdx.x / 8 : blockIdx.x;
      if (cbound <= 64.0f) {
          for (int u = vid; u < nseq * 12 * nqb; u += G) { const int qb = u % nqb, map = (u / nqb) % 12, sl = u / (nqb * 12);
              att::unit_c_fast(QK, VT, CTMP, lds + RING_OFF, sl, map, qb, S, tshift, wave, lane); }
      } else {
          for (int u = vid; u < nseq * 12 * nqb; u += G) { const int qb = u % nqb, map = (u / nqb) % 12, sl = u / (nqb * 12);
              att::wave_c(QK, VT, CTMP, sl, map, qb * 256 + 32 * wave, S, tshift, lane); } } }
    if (types & 2) { bf16* OA = (bf16*)(a.ws() + A_OA); LAS float* btab = (LAS float*)(lds + RING_OFF);
      for (int u = blockIdx.x; u < nseq * 4 * nqb; u += gridDim.x) { const int qb = u % nqb, h = (u / nqb) % 4, sl = u / (nqb * 4);
          __syncthreads();
          for (int e = tid; e < 15 * 31; e += NWAVES * 64) btab[e] = a.in(I_RPB)[((size_t)(l * 4 + h) * 15) * 31 + e] * LOG2E;
          __syncthreads();
          att::wave_a(QK, VT, OA, btab, sl, h, 4 * qb + (wave >> 1), wave & 1, S, tshift, lane); } }
    if (types & 4) { bf16* BTMP = (bf16*)(a.ws() + A_BTMP); float* BLSE = (float*)(a.ws() + A_BLSE);
      for (int u = blockIdx.x; u < nseq * 6 * nqb; u += gridDim.x) { const int pb = u % nqb, slot = (u / nqb) % 6, sl = u / (nqb * 6);
          att::wave_b(QK, VT, BTMP, BLSE, sl, slot, pb * 256 + 32 * wave, S, tshift, lane); } }
}
__device__ __forceinline__ void phase_combine(const AL& a, int l, int gw, int NGW, int lane) {
    const bf16* BTMP = (const bf16*)(a.ws() + A_BTMP); const float* BLSE = (const float*)(a.ws() + A_BLSE); const float* CTMP = (const float*)(a.ws() + A_CTMP);
    bf16* OB = (bf16*)(a.ws() + A_OA) + 512; bf16* OC = (bf16*)(a.ws() + A_OA) + 768;
    const float lam = ((const float*)(a.ws() + WS_LAM))[l], lam_init = 0.8f - 0.6f * expf(-0.3f * (float)l);
    const float* subln = a.in(I_SUBLN) + l * 128;
    const int sub = lane & 15, d0 = 8 * sub;
    const int NIT = (CH / 4) * 8;
    if ((NGW & 7) == 0) {
        const int slot = gw & 7;
        if (slot < 2) { const int hg = slot;
            for (int it = gw; it < NIT; it += 2 * NGW) { const bool two = it + NGW < NIT;
                const size_t rowa = (size_t)(it >> 3) * 4 + (lane >> 4), rowb = two ? (size_t)((it + NGW) >> 3) * 4 + (lane >> 4) : rowa;
                float la[3], lb[3]; v4u xa[3], xb[3];
#pragma unroll
                for (int g = 0; g < 3; ++g) { la[g] = BLSE[rowa * 8 + 2 * g + hg]; lb[g] = BLSE[rowb * 8 + 2 * g + hg];
                    xa[g] = *(const v4u*)(BTMP + rowa * 768 + (2 * g + hg) * 128 + d0); xb[g] = *(const v4u*)(BTMP + rowb * 768 + (2 * g + hg) * 128 + d0); }
#pragma unroll
                for (int q = 0; q < 2; ++q) { if (q == 1 && !two) break;
                    const float l0 = q ? lb[0] : la[0], l1 = q ? lb[1] : la[1], l2 = q ? lb[2] : la[2]; const v4u a0 = q ? xb[0] : xa[0], a1 = q ? xb[1] : xa[1], a2 = q ? xb[2] : xa[2];
                    const float mx = fmaxf(l0, fmaxf(l1, l2)); float w0 = __expf(l0 - mx), w1 = __expf(l1 - mx), w2 = __expf(l2 - mx);
                    const float inv = 1.0f / (w0 + w1 + w2); w0 *= inv; w1 *= inv; w2 *= inv;
                    v4u o;
                    o.x = pk2(w0 * bflo(a0.x) + w1 * bflo(a1.x) + w2 * bflo(a2.x), w0 * bfhi(a0.x) + w1 * bfhi(a1.x) + w2 * bfhi(a2.x));
                    o.y = pk2(w0 * bflo(a0.y) + w1 * bflo(a1.y) + w2 * bflo(a2.y), w0 * bfhi(a0.y) + w1 * bfhi(a1.y) + w2 * bfhi(a2.y));
                    o.z = pk2(w0 * bflo(a0.z) + w1 * bflo(a1.z) + w2 * bflo(a2.z), w0 * bfhi(a0.z) + w1 * bfhi(a1.z) + w2 * bfhi(a2.z));
                    o.w = pk2(w0 * bflo(a0.w) + w1 * bflo(a1.w) + w2 * bflo(a2.w), w0 * bfhi(a0.w) + w1 * bfhi(a1.w) + w2 * bfhi(a2.w));
                    *(v4u*)(OB + (q ? rowb : rowa) * 1536 + hg * 128 + d0) = o; } }
        } else { const int h = slot - 2;
            const f32x4 g0 = *(const f32x4*)(subln + d0), g1 = *(const f32x4*)(subln + d0 + 4);
            for (int it = gw; it < NIT; it += 2 * NGW) { const bool two = it + NGW < NIT;
                const size_t rowa = (size_t)(it >> 3) * 4 + (lane >> 4), rowb = two ? (size_t)((it + NGW) >> 3) * 4 + (lane >> 4) : rowa;
                const float* pa = CTMP + rowa * 1536 + (2 * h) * 128 + d0; const float* pb = CTMP + rowb * 1536 + (2 * h) * 128 + d0;
                const f32x4 a10 = *(const f32x4*)pa, a11 = *(const f32x4*)(pa + 4), a20 = *(const f32x4*)(pa + 128), a21 = *(const f32x4*)(pa + 132);
                const f32x4 b10 = *(const f32x4*)pb, b11 = *(const f32x4*)(pb + 4), b20 = *(const f32x4*)(pb + 128), b21 = *(const f32x4*)(pb + 132);
#pragma unroll
                for (int q = 0; q < 2; ++q) { if (q == 1 && !two) break;
                    const f32x4 x0 = q ? b10 - lam * b20 : a10 - lam * a20, x1 = q ? b11 - lam * b21 : a11 - lam * a21;
                    float ss = (x0.x * x0.x + x0.y * x0.y) + (x0.z * x0.z + x0.w * x0.w) + (x1.x * x1.x + x1.y * x1.y) + (x1.z * x1.z + x1.w * x1.w);
                    ss += __shfl_xor(ss, 1); ss += __shfl_xor(ss, 2); ss += __shfl_xor(ss, 4); ss += __shfl_xor(ss, 8);
                    const float rstd = rsqrtf(ss * (1.0f / 128.0f) + EPS) * (1.0f - lam_init);
                    v4u o; o.x = pk2(x0.x * rstd * g0.x, x0.y * rstd * g0.y); o.y = pk2(x0.z * rstd * g0.z, x0.w * rstd * g0.w);
                    o.z = pk2(x1.x * rstd * g1.x, x1.y * rstd * g1.y); o.w = pk2(x1.z * rstd * g1.z, x1.w * rstd * g1.w);
                    *(v4u*)(OC + (q ? rowb : rowa) * 1536 + h * 128 + d0) = o; } }
        }
        return;
    }
    for (int it = gw; it < (CH / 4) * 8; it += NGW) { const int slot = it & 7; const size_t row = (size_t)(it >> 3) * 4 + (lane >> 4);
        if (slot < 2) { const int hg = slot;
            const float l0 = BLSE[row * 8 + hg], l1 = BLSE[row * 8 + 2 + hg], l2 = BLSE[row * 8 + 4 + hg];
            const float mx = fmaxf(l0, fmaxf(l1, l2)); float w0 = __expf(l0 - mx), w1 = __expf(l1 - mx), w2 = __expf(l2 - mx);
            const float inv = 1.0f / (w0 + w1 + w2); w0 *= inv; w1 *= inv; w2 *= inv;
            const v4u a0 = *(const v4u*)(BTMP + row * 768 + (0 + hg) * 128 + d0), a1 = *(const v4u*)(BTMP + row * 768 + (2 + hg) * 128 + d0), a2 = *(const v4u*)(BTMP + row * 768 + (4 + hg) * 128 + d0);
            v4u o;
            o.x = pk2(w0 * bflo(a0.x) + w1 * bflo(a1.x) + w2 * bflo(a2.x), w0 * bfhi(a0.x) + w1 * bfhi(a1.x) + w2 * bfhi(a2.x));
            o.y = pk2(w0 * bflo(a0.y) + w1 * bflo(a1.y) + w2 * bflo(a2.y), w0 * bfhi(a0.y) + w1 * bfhi(a1.y) + w2 * bfhi(a2.y));
            o.z = pk2(w0 * bflo(a0.z) + w1 * bflo(a1.z) + w2 * bflo(a2.z), w0 * bfhi(a0.z) + w1 * bfhi(a1.z) + w2 * bfhi(a2.z));
            o.w = pk2(w0 * bflo(a0.w) + w1 * bflo(a1.w) + w2 * bflo(a2.w), w0 * bfhi(a0.w) + w1 * bfhi(a1.w) + w2 * bfhi(a2.w));
            *(v4u*)(OB + row * 1536 + hg * 128 + d0) = o;
        } else { const int h = slot - 2;
            const float* p1 = CTMP + row * 1536 + (2 * h) * 128 + d0; const float* p2 = p1 + 128;
            const f32x4 x0 = *(const f32x4*)p1 - lam * *(const f32x4*)p2, x1 = *(const f32x4*)(p1 + 4) - lam * *(const f32x4*)(p2 + 4);
            float ss = (x0.x * x0.x + x0.y * x0.y) + (x0.z * x0.z + x0.w * x0.w) + (x1.x * x1.x + x1.y * x1.y) + (x1.z * x1.z + x1.w * x1.w);
            ss += __shfl_xor(ss, 1); ss += __shfl_xor(ss, 2); ss += __shfl_xor(ss, 4); ss += __shfl_xor(ss, 8);
            const float rstd = rsqrtf(ss * (1.0f / 128.0f) + EPS) * (1.0f - lam_init);
            const f32x4 g0 = *(const f32x4*)(subln + d0), g1 = *(const f32x4*)(subln + d0 + 4);
            v4u o; o.x = pk2(x0.x * rstd * g0.x, x0.y * rstd * g0.y); o.y = pk2(x0.z * rstd * g0.z, x0.w * rstd * g0.w);
            o.z = pk2(x1.x * rstd * g1.x, x1.y * rstd * g1.y); o.w = pk2(x1.z * rstd * g1.z, x1.w * rstd * g1.w);
            *(v4u*)(OC + row * 1536 + h * 128 + d0) = o;
        }
    }
}
#define CHECK_HOOK(stage, c, l) do {} while (0)
#define CHECK_FINAL() do {} while (0)

#ifndef PHMASK
#define PHMASK 0xFFFF
#endif
#define PH(k) ((PHMASK >> (k)) & 1)
#ifndef DUPMASK
#define DUPMASK 0
#endif
#define DUP(k) ((DUPMASK >> (k)) & 1)
#ifndef BARX
#define BARX 1
#endif
__global__ void __launch_bounds__(NWAVES * 64, 2) fwd(Args kargs) {
    extern __shared__ __attribute__((aligned(16))) unsigned char lds_raw[];
    LAS unsigned char* lds = (LAS unsigned char*)lds_raw;
    volatile LAS unsigned* MISC = (volatile LAS unsigned*)(lds + MISC_OFF);
    int tid = threadIdx.x, lane = tid & 63, wave = __builtin_amdgcn_readfirstlane(tid >> 6);
    for (int u = tid; u < (LDS_BYTES - LDSCTL_OFF) / 4; u += NWAVES * 64) ((LAS unsigned*)(lds + LDSCTL_OFF))[u] = 0u;
    __syncthreads();
    const AL a{};
    XcdBarrier bar = xcd_barrier_post((unsigned*)(a.ws() + WS_CTL) + CW_BAR, MISC + 8);
#define GRID_BAR() do { for (int b_ = 0; b_ < BARX; ++b_) xcd_barrier(bar); } while (0)
    int G = gridDim.x, bid = (int)blockIdx.x;
#define LAUNDER() do { asm volatile("" : "+s"(G), "+s"(bid)); tid = threadIdx.x; asm volatile("" : "+v"(tid)); lane = tid & 63; wave = __builtin_amdgcn_readfirstlane(tid >> 6); } while (0)
#define GW (bid * NWAVES + wave)
#define NGW_ (G * NWAVES)

    if (PH(0)) phase_modp(a, lds, tid, lane, wave);
    if (DUP(0)) { __syncthreads(); phase_modp(a, lds, tid, lane, wave); }
    GRID_BAR();
    if (PH(1)) phase_pro2(a, lds, tid, lane, wave, G);
    if (DUP(1)) { __syncthreads(); phase_pro2(a, lds, tid, lane, wave, G); }
    GRID_BAR();
    CHECK_HOOK(0, 0, 0);

#pragma unroll 1
    for (int cl = 0; cl < NCHUNK * 2; ++cl) {
        int c = cl >> 1, l = cl & 1;
        asm volatile("" : "+s"(c), "+s"(l));
#define R0 (c * CH)
#define PROMPT (R0 < 32768)
#define S_ (PROMPT ? 4096 : 2048)
#define TSH (PROMPT ? 12 : 11)
#define SEQ0 (PROMPT ? (R0 >> 12) : 8 + ((R0 - 32768) >> 11))
#define XIN0 (PROMPT ? a.in(I_XP) + (size_t)R0 * DM : a.in(I_XS) + (size_t)(R0 - 32768) * DM)
#define XO (a.out() + (size_t)R0 * DM)
#define XCUR (l == 0 ? XIN0 : (const float*)XO)
#define MODL ((const float*)(a.ws() + WS_MOD) + (size_t)l * 24 * 12288)
#define WL (a.ws() + WS_W + (size_t)l * W_LAYER)
        if (PH(2)) { LAUNDER();
            if (l == 0) { if (c > 0) phase_final(a.out() + (size_t)(R0 - CH) * DM, (const bf16*)(a.ws() + A_VT), a.out() + (size_t)(R0 - CH) * DM, GW, NGW_, lane);
                          phase_norm<false>(XIN0, nullptr, nullptr, a.in(I_N1G) + l * DM, MODL, 0, 2048, SEQ0, TSH, (bf16*)(a.ws() + A_H), GW, NGW_, lane); }
            else phase_norm<true>(XO, (const bf16*)(a.ws() + A_VT), XO, a.in(I_N1G) + l * DM, MODL, 0, 2048, SEQ0, TSH, (bf16*)(a.ws() + A_H), GW, NGW_, lane); }
        GRID_BAR(); CHECK_HOOK(1, c, l);
        for (int rep_ = 0; rep_ < (PH(3) ? 1 + DUP(3) : 0); ++rep_) { LAUNDER(); unsigned char* ws = a.ws(); pg8::Gemm g{(const pg8::bf16_t*)(ws + A_H), (const pg8::bf16_t*)(WL + WO_IG), CH, 2 * INC, DM}; pg8::StaticOrder So; So.init(CH, 2 * INC, G, bid);
          pg8::EpiIn E{(pg8::bf16_t*)(ws + A_Z), (pg8::bf16_t*)(ws + A_G), a.in(I_BGATE) + l * INC};
          pg8::gemm_phase<pg8::EpiIn, pg8::StaticOrder, true, true>(lds + RING_OFF, g, So, E); }
        GRID_BAR(); CHECK_HOOK(2, c, l);
        if (PH(4)) { LAUNDER(); phase_prep(a, l, lds, S_, TSH, GW, NGW_, wave, lane); }
        if (DUP(4)) { LAUNDER(); __syncthreads(); phase_prep(a, l, lds, S_, TSH, GW, NGW_, wave, lane); }
        GRID_BAR(); CHECK_HOOK(3, c, l);
        if (PH(5)) { LAUNDER(); phase_attn(a, l, lds, S_, TSH, tid, wave, lane); }
        if (DUP(5)) { LAUNDER(); __syncthreads(); phase_attn(a, l, lds, S_, TSH, tid, wave, lane); }
        if (DUP(12) || DUP(13) || DUP(14)) { LAUNDER(); __syncthreads(); phase_attn(a, l, lds, S_, TSH, tid, wave, lane, DUP(12) | (DUP(13) << 1) | (DUP(14) << 2)); }
        GRID_BAR(); CHECK_HOOK(4, c, l);
        if (PH(6)) { LAUNDER(); phase_combine(a, l, GW, NGW_, lane); }
        if (DUP(6)) { LAUNDER(); __syncthreads(); phase_combine(a, l, GW, NGW_, lane); }
        GRID_BAR(); CHECK_HOOK(5, c, l);
        for (int rep_ = 0; rep_ < (PH(7) ? 1 + DUP(7) : 0); ++rep_) { LAUNDER(); unsigned char* ws = a.ws(); pg8::StaticOrder So; So.init(CH, DM, G, bid);
          pg8::Gemm g{(const pg8::bf16_t*)(ws + A_OA), (const pg8::bf16_t*)(WL + WO_BRA), CH, DM, 1536}; pg8::EpiBrM E{(pg8::bf16_t*)(ws + A_H), (const pg8::bf16_t*)(ws + A_G)};
          pg8::gemm_phase<pg8::EpiBrM, pg8::StaticOrder, true, true>(lds + RING_OFF, g, So, E); }
        GRID_BAR(); CHECK_HOOK(6, c, l);
        if (PH(8)) { LAUNDER(); unsigned char* ws = a.ws(); pg8::Gemm g{(const pg8::bf16_t*)(ws + A_H), (const pg8::bf16_t*)(WL + WO_OUT), CH, DM, DM}; pg8::StaticOrder So; So.init(CH, DM, G, bid);
          pg8::EpiDelta E{(pg8::bf16_t*)(ws + A_VT), MODL + 2 * 2048, SEQ0, TSH};
          for (int rep_ = 0; rep_ < 1 + DUP(8); ++rep_) pg8::gemm_phase<pg8::EpiDelta, pg8::StaticOrder, true, true>(lds + RING_OFF, g, So, E); }
        GRID_BAR(); CHECK_HOOK(7, c, l);
        if (PH(9)) { LAUNDER(); phase_norm<true>(XCUR, (const bf16*)(a.ws() + A_VT), XO, a.in(I_N2G) + l * DM, MODL, 3 * 2048, 4 * 2048, SEQ0, TSH, (bf16*)(a.ws() + A_H), GW, NGW_, lane); }
        GRID_BAR(); CHECK_HOOK(8, c, l);
        for (int rep_ = 0; rep_ < (PH(10) ? 1 + DUP(10) : 0); ++rep_) { LAUNDER(); unsigned char* ws = a.ws(); pg8::Gemm g{(const pg8::bf16_t*)(ws + A_H), (const pg8::bf16_t*)(WL + WO_FF1), CH, DFF, DM}; pg8::StaticOrder So; So.init(CH, DFF, G, bid);
          pg8::EpiRelu2 E{(pg8::bf16_t*)(ws + A_U), DFF};
          pg8::gemm_phase<pg8::EpiRelu2, pg8::StaticOrder, true, true>(lds + RING_OFF, g, So, E); }
        GRID_BAR(); CHECK_HOOK(9, c, l);
        if (PH(11)) { LAUNDER(); unsigned char* ws = a.ws(); pg8::Gemm g{(const pg8::bf16_t*)(ws + A_U), (const pg8::bf16_t*)(WL + WO_FF2), CH, DM, DFF}; pg8::StaticOrder So; So.init(CH, DM, G, bid);
          pg8::EpiDelta E{(pg8::bf16_t*)(ws + A_VT), MODL + 5 * 2048, SEQ0, TSH};
          for (int rep_ = 0; rep_ < 1 + DUP(11); ++rep_) pg8::gemm_phase<pg8::EpiDelta, pg8::StaticOrder, true, true>(lds + RING_OFF, g, So, E); }
        GRID_BAR(); CHECK_HOOK(10, c, l);
    }
    { LAUNDER(); phase_final(a.out() + (size_t)(MTOT - CH) * DM, (const bf16*)(a.ws() + A_VT), a.out() + (size_t)(MTOT - CH) * DM, GW, NGW_, lane); }
    CHECK_FINAL();
}

extern "C" void kernel_launch(void* const* d_in, const int* in_sizes, int n_in, void* d_out, int out_size, void* d_ws, size_t ws_size, hipStream_t stream) {
    static int grid = 0;
    if (grid == 0) {
        if (n_in != 29 || out_size != MTOT * DM || ws_size < WS_END) { fprintf(stderr, "kernel_launch: unexpected shapes (n_in %d out %d ws %zu need %zu)\n", n_in, out_size, ws_size, (size_t)WS_END); grid = -1; return; }
        int dev = 0, cus = 0, per_cu = 0;
        if (hipGetDevice(&dev) != hipSuccess || hipDeviceGetAttribute(&cus, hipDeviceAttributeMultiprocessorCount, dev) != hipSuccess) { grid = -1; return; }
        if (hipFuncSetAttribute((const void*)fwd, hipFuncAttributeMaxDynamicSharedMemorySize, LDS_BYTES) != hipSuccess) { grid = -1; return; }
        if (hipOccupancyMaxActiveBlocksPerMultiprocessor(&per_cu, (const void*)fwd, NWAVES * 64, LDS_BYTES) != hipSuccess || per_cu < 1) { fprintf(stderr, "kernel_launch: occupancy query says %d\n", per_cu); }
        (void)hipGetLastError();
        grid = cus;
    }
    if (grid < 0) return;
    if (hipMemsetAsync((char*)d_ws + WS_CTL, 0, CTL_ZERO_BYTES, stream) != hipSuccess) return;
    Args a{};
    for (int i = 0; i < 29; ++i) a.in[i] = (const float*)d_in[i];
    a.out = (float*)d_out; a.ws = (unsigned char*)d_ws;
    hipLaunchKernelGGL(fwd, dim3(grid), dim3(NWAVES * 64), LDS_BYTES, stream, a);
}
```

```cpp
#include <hip/hip_runtime.h>
#include <hip/hip_bf16.h>
#include <cstdio>
#include <cstdint>
#include <cmath>

constexpr int NWAVES = 8;
constexpr int DM = 2048, NSEQ = 24, MTOT = 65536, DFF = 8192, INC = 6144;
#ifndef MK_CH
#define MK_CH 32768
#endif
constexpr int CH = MK_CH;
constexpr int NCHUNK = MTOT / CH;
constexpr float EPS = 1e-6f, LOG2E = 1.4426950408889634f, LN2 = 0.6931471805599453f;
constexpr float QS128 = 0.08838834764831845f * LOG2E, QS64 = 0.125f * LOG2E;
constexpr float NEGB = -1e30f;

constexpr size_t MiB = 1u << 20;
constexpr size_t WS_CTL = 0, CTL_ZERO_BYTES = 1 * MiB;
constexpr size_t WS_MOD = 1 * MiB;
constexpr size_t WS_ROPEB = 4 * MiB, WS_ROPEC = WS_ROPEB + 512 * 1024;
constexpr size_t WS_LAM = 5 * MiB;
constexpr size_t WS_MODP = 6 * MiB;
constexpr size_t WS_W = 48 * MiB, W_LAYER = 126 * MiB;
constexpr size_t WO_IG = 0, WO_BRA = 48 * MiB, WO_BRB = 50 * MiB, WO_BRC = 51 * MiB, WO_OUT = 54 * MiB, WO_FF1 = 62 * MiB, WO_FF2 = 94 * MiB;
constexpr size_t WS_ACT = 304 * MiB;
constexpr size_t CHS = (size_t)CH;
constexpr size_t A_H = WS_ACT;
constexpr size_t A_Z = A_H + (MK_CH > 16384 ? 0 : CHS * 2048 * 2);
constexpr size_t A_QK = A_Z + CHS * 6144 * 2;
constexpr size_t A_VT = A_QK + CHS * 4096 * 2;
constexpr size_t A_G = A_VT + CHS * 2048 * 2;
constexpr size_t A_OA = A_G + CHS * 6144 * 2;
constexpr size_t A_OB = A_OA + CHS * 512 * 2;
constexpr size_t A_OC = A_OB + CHS * 256 * 2;
constexpr size_t A_X = A_OC + CHS * 768 * 2;
constexpr size_t A_HI8 = A_X + CHS * 2048 * 2;
constexpr size_t A_HS = A_HI8 + CHS * 2048;
constexpr size_t WS_END = A_HS + (1u << 20);
constexpr size_t A_BTMP = A_Z + CHS * 2048 * 2;
constexpr size_t A_BLSE = A_BTMP + CHS * 768 * 2;
constexpr size_t A_CTMP = A_BLSE + CHS * 8 * 4;
static_assert(A_CTMP + CHS * 1536 * 4 <= A_QK, "attention temporaries fit in Z");
constexpr size_t A_TMPF = A_QK;
constexpr size_t A_U = A_Z;
static_assert(CHS * 8192 * 2 <= (A_VT - A_Z), "u fits in Z + QK");
constexpr int CW_BAR = 4096;
constexpr int CW_WMAX = 131072;
#ifndef I8FF1
#define I8FF1 1
#endif
constexpr int WMAX_L = 20480;
constexpr int CW_CHK = 65536;

constexpr int RING_OFF = 0, RING_BYTES = 131072;
constexpr int LDSCTL_OFF = RING_BYTES, MISC_OFF = LDSCTL_OFF + 320;
constexpr int LDS_BYTES = 147456;

#define LAS __attribute__((address_space(3)))
#define GAS __attribute__((address_space(1)))
struct Args { const float* in[29]; float* out; unsigned char* ws; };
typedef const __attribute__((address_space(4))) unsigned long long* kargp_t;
struct AL {
    __device__ __forceinline__ static kargp_t kp() { kargp_t p = (kargp_t)__builtin_amdgcn_kernarg_segment_ptr(); asm volatile("" : "+s"(p)); return p; }
    __device__ __forceinline__ const float* in(int i) const { return (const float*)kp()[i]; }
    __device__ __forceinline__ float* out() const { return (float*)kp()[29]; }
    __device__ __forceinline__ unsigned char* ws() const { return (unsigned char*)kp()[30]; } };
enum { I_XP = 0, I_XS, I_CP, I_CS, I_N1G, I_WADA, I_BADA, I_WIN, I_QNA, I_KNA, I_RPB, I_QNB, I_KNB, I_QNC, I_KNC, I_LQ1, I_LK1, I_LQ2, I_LK2, I_SUBLN,
       I_WBRA, I_WBRB, I_WBRC, I_WGATE, I_BGATE, I_WOUT, I_N2G, I_WFF1, I_WFF2 };


template <int N> __device__ __forceinline__ float shx(float v) { return __shfl_xor(v, N); }
__device__ __forceinline__ void shx32_pair(float v, float& a, float& b) { const float o = __shfl_xor(v, 32); const bool hi = (__lane_id() >> 5) != 0; a = hi ? o : v; b = hi ? v : o; }
__device__ __forceinline__ float sum32(float v) { return v + __shfl_xor(v, 32); }
__device__ __forceinline__ float max32(float v) { return fmaxf(v, __shfl_xor(v, 32)); }
#ifndef WGM_SMALL
#define WGM_SMALL 4
#endif
namespace pg8 {
#define PG8_LAS __attribute__((address_space(3)))
typedef unsigned short bf16_t;
typedef short bf16x8 __attribute__((ext_vector_type(8)));
typedef float f32x4 __attribute__((ext_vector_type(4)));
typedef unsigned u32x4 __attribute__((ext_vector_type(4)));
constexpr int BM = 256, BK = 64, HALF = 128, HTB = HALF * BK * 2  , STAGE_BYTES = 8 * HTB, NXCD = 8, WGM = WGM_SMALL;

__host__ __device__ __forceinline__ int lds_byte(int r, int c) { const int st = (r >> 4) * 2 + (c >> 5), rr = r & 15, cc = c & 31, ob = rr * 64 + cc * 2; return st * 1024 + (ob ^ (((ob >> 9) & 1) << 5)); }
__host__ __device__ __forceinline__ void stage_rc(int b, int& R, int& C) { const int st = b / 1024, sb = b % 1024, swz = sb ^ (((sb >> 9) & 1) << 5); R = (st >> 1) * 16 + swz / 64; C = (st & 1) * 32 + (swz % 64) / 2; }
__host__ __device__ __forceinline__ int perm32(int rho) { const int n = rho >> 4, i = rho & 15; return 8 * (i >> 2) + 4 * n + (i & 3); }

struct Unit { int pm, pn; };
struct Gemm { const bf16_t* A; const bf16_t* Bt; int M, N, K; };

struct StaticOrder {
    int nM, nN, nwg, G, c, wgm;
    __host__ __device__ void init(int M, int N, int G_, int c_, int wgm_ = WGM) { nM = M / BM; nN = N / BM; nwg = nM * nN; G = G_; c = c_; wgm = wgm_; }
    __host__ __device__ bool next(int i, Unit& u) const {
        const long L = (long)i * G + c; if (L >= nwg) return false;
        int wgid = (int)L; { const int q = nwg / NXCD, r = nwg % NXCD, xcd = wgid % NXCD, off = wgid / NXCD; wgid = (xcd < r ? xcd * (q + 1) : r * (q + 1) + (xcd - r) * q) + off; }
        const int nig = wgm * nN, gid = wgid / nig, fm = gid * wgm, gsz = (nM - fm) < wgm ? (nM - fm) : wgm;
        u.pm = fm + ((wgid % nig) % gsz); u.pn = (wgid % nig) / gsz; return true;
    }
    __device__ __forceinline__ void a_ready(const Unit&) const {}
    __device__ __forceinline__ void done(const Unit&) const {}
};

struct GateOrder {
    StaticOrder br; int n;
    __host__ __device__ void init(int M, int N, int G_, int c_) { br.init(M, N, G_, c_); n = (br.nwg + G_ - 1 - c_) / G_; if (n < 0) n = 0; }
    __host__ __device__ bool next(int i, Unit& u) const { if (i >= 3 * n) return false; Unit b; br.next(i / 3, b); u.pm = b.pm; u.pn = b.pn + 8 * (i % 3); return true; }
    __device__ __forceinline__ void a_ready(const Unit&) const {}
    __device__ __forceinline__ void done(const Unit&) const {}
};

typedef float f32x2 __attribute__((ext_vector_type(2)));
typedef __bf16 bf16x2v __attribute__((ext_vector_type(2)));
typedef unsigned u32x2 __attribute__((ext_vector_type(2)));
__device__ __forceinline__ unsigned cvt_pk_bf16(float lo, float hi) { f32x2 v = {lo, hi}; bf16x2v b = __builtin_convertvector(v, bf16x2v); return __builtin_bit_cast(unsigned, b); }
#ifndef INGRP
#define INGRP 1
#endif
#ifndef HOOKGRP
#define HOOKGRP 4
#endif
#ifndef I8IN
#define I8IN 1
#endif
__device__ __forceinline__ f32x4 cvti(const f32x4 a) { const float a0 = a[0], a1 = a[1], a2 = a[2], a3 = a[3];
    return (f32x4){(float)__float_as_int(a0), (float)__float_as_int(a1), (float)__float_as_int(a2), (float)__float_as_int(a3)}; }
__device__ __forceinline__ float sigm(float x) { return fmaxf(__builtin_amdgcn_rcpf(1.0f + __expf(-x)), 1e-30f); }

#if I8IN
#define CVTIN(x) cvti(x)
#else
#define CVTIN(x) (x)
#endif
struct EpiIn {
    static constexpr bool PERM = true, AFTER_DRAIN = false, HAS_MID = false; static constexpr int MID_T0 = -1, MID_T1 = -1;
    int l, S, tshift; PG8_LAS float* xch;
    __device__ __forceinline__ void operator()(const f32x4 (&acc)[2][2][4][2], const Unit& u, int wr, int wc, int fr, int fq) const {
        const int row0 = u.pm * BM + wr * 64 + fr; const AL a{}; unsigned char* ws = a.ws();
        const unsigned* wmx = (const unsigned*)(ws + WS_CTL) + CW_WMAX + l * WMAX_L + u.pn * BM + wc * 32 + 8 * fq; const float* HSp = (const float*)(ws + A_HS);
        f32x4 wsc[2][2];
#pragma unroll
        for (int bj = 0; bj < 2; ++bj)
#pragma unroll
            for (int n = 0; n < 2; ++n) { const u32x4 w = *(const GAS u32x4*)(wmx + bj * HALF + 4 * n);
                wsc[bj][n] = I8IN ? (f32x4){__uint_as_float(w.x), __uint_as_float(w.y), __uint_as_float(w.z), __uint_as_float(w.w)} * (1.0f / 127.0f) : (f32x4){1.f, 1.f, 1.f, 1.f}; }
        if (u.pn < 16) { const int tn = u.pn; bf16_t* QKb = (bf16_t*)(ws + A_QK); const float* ropeB = (const float*)(ws + WS_ROPEB); const float* ropeC = (const float*)(ws + WS_ROPEC);
            int gi, dsh = 0, kind; float scale = 1.f;
            if (tn < 2) { gi = 0; kind = 0; scale = 0.08838834764831845f * 1.4426950408889634f; } else if (tn < 4) { gi = 1; kind = 0; }
            else if (tn < 7) { gi = 2; kind = 1; scale = 0.08838834764831845f * 1.4426950408889634f; dsh = 2 * (tn - 4); } else if (tn < 10) { gi = 3; kind = 1; dsh = 2 * (tn - 7); }
            else if (tn < 13) { gi = 4; kind = 2; scale = 0.125f * 1.4426950408889634f; } else { gi = 5; kind = 2; }
#pragma unroll
            for (int ai = 0; ai < 2; ++ai)
#pragma unroll
                for (int m = 0; m < 4; ++m)
#pragma unroll
                    for (int bj = 0; bj < 2; ++bj) { const f32x4 a4 = CVTIN(acc[ai][bj][m][0]) * wsc[bj][0], b4 = CVTIN(acc[ai][bj][m][1]) * wsc[bj][1];
                        float p = (a4[0] * a4[0] + a4[1] * a4[1]) + (a4[2] * a4[2] + a4[3] * a4[3]) + (b4[0] * b4[0] + b4[1] * b4[1]) + (b4[2] * b4[2] + b4[3] * b4[3]);
                        p += shx<16>(p); p = sum32(p);
                        if (fq == 0) xch[((ai * HALF + wr * 64 + m * 16 + fr) * 2 + bj) * 4 + wc] = p; }
            asm volatile("s_waitcnt lgkmcnt(0)\n\ts_barrier" ::: "memory");
            const float* gp = a.in(I_QNA + gi + (gi >= 2 ? 1 : 0)) + l * (kind == 2 ? 64 : 128) + ((32 * wc + 8 * fq) & (kind == 2 ? 63 : 127));
            const f32x4 g0 = *(const GAS f32x4*)gp, g1 = *(const GAS f32x4*)(gp + 4);
            const bool ropew = kind == 1 ? (wc == 0) : (kind == 2 ? ((wc & 1) == 0) : false);
            const bool ropel = kind == 1 ? true : (fq < 2), first = kind == 1 ? (fq < 2) : (fq == 0);
            const int Lsh = tshift - dsh;
#pragma unroll
            for (int ai = 0; ai < 2; ++ai)
#pragma unroll
                for (int m = 0; m < 4; ++m) { const int rl = ai * HALF + wr * 64 + m * 16 + fr, row = u.pm * BM + rl, t = row & (S - 1);
                    const float* tb = kind == 1 ? ropeB + (size_t)(t * 16 + 8 * (fq & 1)) * 2 : ropeC + (size_t)(t * 8) * 2;
                    const int drow = dsh == 0 ? row : ((row & ~(S - 1)) + ((t & ((1 << dsh) - 1)) << Lsh) + (t >> dsh));
                    const float hs = I8IN ? HSp[row] : 1.0f, epsr = 1e-6f * __builtin_amdgcn_rcpf(hs * hs + 1e-30f);
                    f32x4 cs[2][2];
                    if (ropew && ropel) {
#pragma unroll
                        for (int hf = 0; hf < 2; ++hf) { cs[hf][0] = *(const GAS f32x4*)(tb + 8 * hf); cs[hf][1] = *(const GAS f32x4*)(tb + 8 * hf + 4); } }
#pragma unroll
                    for (int bj = 0; bj < 2; ++bj) { const f32x4 P4 = *(const PG8_LAS f32x4*)(xch + (rl * 2 + bj) * 4);
                        const float tot = kind == 2 ? (wc < 2 ? P4[0] + P4[1] : P4[2] + P4[3]) : (P4[0] + P4[1]) + (P4[2] + P4[3]);
                        const float rstd = __builtin_amdgcn_rsqf(tot * (kind == 2 ? (1.0f / 64.0f) : (1.0f / 128.0f)) + epsr);
                        u32x4 w;
#pragma unroll
                        for (int hf = 0; hf < 2; ++hf) {
                            const f32x4 gg = (hf ? g1 : g0) * wsc[bj][hf], av = CVTIN(acc[ai][bj][m][hf]); float y[4];
#pragma unroll
                            for (int e2 = 0; e2 < 4; ++e2) y[e2] = av[e2] * rstd * gg[e2];
                            if (ropew) { float pr[4];
#pragma unroll
                                for (int e2 = 0; e2 < 4; ++e2) { if (kind == 1) { float r0, r1; shx32_pair(y[e2], r0, r1); pr[e2] = fq >= 2 ? r0 : r1; } else pr[e2] = shx<16>(y[e2]); }
                                if (ropel) { const f32x4 c0 = cs[hf][0], c1 = cs[hf][1];
                                    y[0] = first ? y[0] * c0[0] - pr[0] * c0[1] : y[0] * c0[0] + pr[0] * c0[1]; y[1] = first ? y[1] * c0[2] - pr[1] * c0[3] : y[1] * c0[2] + pr[1] * c0[3];
                                    y[2] = first ? y[2] * c1[0] - pr[2] * c1[1] : y[2] * c1[0] + pr[2] * c1[1]; y[3] = first ? y[3] * c1[2] - pr[3] * c1[3] : y[3] * c1[2] + pr[3] * c1[3]; } }
                            if (hf == 0) { w.x = cvt_pk_bf16(y[0] * scale, y[1] * scale); w.y = cvt_pk_bf16(y[2] * scale, y[3] * scale); }
                            else { w.z = cvt_pk_bf16(y[0] * scale, y[1] * scale); w.w = cvt_pk_bf16(y[2] * scale, y[3] * scale); } }
                        *(GAS u32x4*)(QKb + (size_t)drow * 4096 + tn * BM + bj * HALF + wc * 32 + 8 * fq) = w; }
                    if (INGRP == 1 || (m % INGRP) == INGRP - 1) asm volatile("" ::: "memory"); }
        } else { const int col0 = (u.pn - 16) * BM + wc * 32 + 8 * fq; bf16_t* Zv = (bf16_t*)(ws + A_Z);
#pragma unroll
            for (int ai = 0; ai < 2; ++ai)
#pragma unroll
                for (int m = 0; m < 4; ++m) { const int row = row0 + ai * HALF + m * 16; const float hs = I8IN ? HSp[row] : 1.0f; bf16_t* rowp = Zv + (size_t)row * 2048 + col0;
#pragma unroll
                    for (int bj = 0; bj < 2; ++bj) { const f32x4 v0 = CVTIN(acc[ai][bj][m][0]) * wsc[bj][0] * hs, v1 = CVTIN(acc[ai][bj][m][1]) * wsc[bj][1] * hs;
                        u32x4 w; w.x = cvt_pk_bf16(v0[0], v0[1]); w.y = cvt_pk_bf16(v0[2], v0[3]); w.z = cvt_pk_bf16(v1[0], v1[1]); w.w = cvt_pk_bf16(v1[2], v1[3]);
                        *(GAS u32x4*)(rowp + bj * HALF) = w; } }
        }
    }
};
struct EpiGate {
    static constexpr bool PERM = true, AFTER_DRAIN = false, HAS_MID = false; static constexpr int MID_T0 = -1, MID_T1 = -1, NSTORE = 0;
    int l;
    __device__ __forceinline__ static unsigned pk4(const f32x4 s) { unsigned w = 0;
        w = __builtin_amdgcn_cvt_pk_u8_f32(__builtin_floorf(fmaxf(s[0] * 255.0f + 0.5f, 1.0f)), 0, w); w = __builtin_amdgcn_cvt_pk_u8_f32(__builtin_floorf(fmaxf(s[1] * 255.0f + 0.5f, 1.0f)), 1, w);
        w = __builtin_amdgcn_cvt_pk_u8_f32(__builtin_floorf(fmaxf(s[2] * 255.0f + 0.5f, 1.0f)), 2, w); w = __builtin_amdgcn_cvt_pk_u8_f32(__builtin_floorf(fmaxf(s[3] * 255.0f + 0.5f, 1.0f)), 3, w); return w; }
    __device__ __forceinline__ void operator()(const f32x4 (&acc)[2][2][4][2], const Unit& u, int wr, int wc, int fr, int fq) const {
        const AL a{}; unsigned char* ws = a.ws();
        const int gt = u.pn, col0 = gt * BM + wc * 32 + 8 * fq, lane = fq * 16 + fr, wave = wr * 4 + wc; const float* bgate = a.in(I_BGATE) + l * 6144;
        f32x4 bv[2][2];
#pragma unroll
        for (int bj = 0; bj < 2; ++bj)
#pragma unroll
            for (int n = 0; n < 2; ++n) bv[bj][n] = *(const GAS f32x4*)(bgate + col0 + bj * HALF + 4 * n);
        unsigned char* tp = ws + A_G + (size_t)(u.pm * 24 + gt) * 65536 + (size_t)wave * 8192 + lane * 16;
        const unsigned* wmx = (const unsigned*)(ws + WS_CTL) + CW_WMAX + l * WMAX_L + 6144 + col0; const float* HSp = (const float*)(ws + A_HS);
        f32x4 wsc[2][2];
#pragma unroll
        for (int bj = 0; bj < 2; ++bj)
#pragma unroll
            for (int n = 0; n < 2; ++n) { const u32x4 w = *(const GAS u32x4*)(wmx + bj * HALF + 4 * n);
                wsc[bj][n] = (f32x4){__uint_as_float(w.x), __uint_as_float(w.y), __uint_as_float(w.z), __uint_as_float(w.w)} * (1.0f / 127.0f); }
#pragma unroll
        for (int ai = 0; ai < 2; ++ai)
#pragma unroll
            for (int m = 0; m < 4; ++m) { const float hs = HSp[u.pm * BM + ai * HALF + wr * 64 + m * 16 + fr]; u32x4 w;
#pragma unroll
                for (int bj = 0; bj < 2; ++bj) { const f32x4 v0 = cvti(acc[ai][bj][m][0]) * wsc[bj][0] * hs + bv[bj][0], v1 = cvti(acc[ai][bj][m][1]) * wsc[bj][1] * hs + bv[bj][1];
                    const f32x4 s0 = {sigm(v0[0]), sigm(v0[1]), sigm(v0[2]), sigm(v0[3])}, s1 = {sigm(v1[0]), sigm(v1[1]), sigm(v1[2]), sigm(v1[3])};
                    if (bj == 0) { w.x = pk4(s0); w.y = pk4(s1); } else { w.z = pk4(s0); w.w = pk4(s1); } }
                *(GAS u32x4*)(tp + (ai * 4 + m) * 1024) = w;
                if (m & 1) asm volatile("" ::: "memory"); }
    }
};
struct EpiRelu2 {
    static constexpr bool PERM = true, AFTER_DRAIN = false, HAS_MID = false; static constexpr int MID_T0 = -1, MID_T1 = -1;
    bf16_t* O; int ldc; int l;
    __device__ __forceinline__ void operator()(const f32x4 (&acc)[2][2][4][2], const Unit& u, int wr, int wc, int fr, int fq) const {
        const int row0 = u.pm * BM + wr * 64 + fr, col0 = u.pn * BM + wc * 32 + 8 * fq;
#pragma unroll
        for (int ai = 0; ai < 2; ++ai)
#pragma unroll
            for (int m = 0; m < 4; ++m) { bf16_t* rowp = O + (size_t)(row0 + ai * HALF + m * 16) * ldc + col0;
#pragma unroll
                for (int bj = 0; bj < 2; ++bj) {
#if I8FF1
                    f32x4 v0 = cvti(acc[ai][bj][m][0]), v1 = cvti(acc[ai][bj][m][1]);
#else
                    f32x4 v0 = acc[ai][bj][m][0], v1 = acc[ai][bj][m][1];
#endif
#pragma unroll
                    for (int e = 0; e < 4; ++e) { const float a0 = v0[e] > 0.f ? v0[e] : 0.f, a1 = v1[e] > 0.f ? v1[e] : 0.f; v0[e] = a0 * a0; v1[e] = a1 * a1; }
                    u32x4 w; w.x = cvt_pk_bf16(v0[0], v0[1]); w.y = cvt_pk_bf16(v0[2], v0[3]); w.z = cvt_pk_bf16(v1[0], v1[1]); w.w = cvt_pk_bf16(v1[2], v1[3]);
                    *(GAS u32x4*)(rowp + bj * HALF) = w; } }
    }
};
struct EpiRes {
    static constexpr bool PERM = false, AFTER_DRAIN = false, HAS_MID = false; static constexpr int MID_T0 = -1, MID_T1 = -1;
    const float* xin; float* xout; const float* gbase; int seq0, tshift;
    __device__ __forceinline__ void operator()(const f32x4 (&acc)[2][2][4][2], const Unit& u, int wr, int wc, int fr, int fq) const {
        const int row0 = u.pm * BM + wr * 64 + fr, col0 = u.pn * BM + wc * 32 + 4 * fq;
        const float* gp = gbase + (size_t)(seq0 + ((u.pm * BM) >> tshift)) * 12288 + col0;
        f32x4 gv[2][2];
#pragma unroll
        for (int bj = 0; bj < 2; ++bj)
#pragma unroll
            for (int n = 0; n < 2; ++n) gv[bj][n] = *(const GAS f32x4*)(gp + bj * HALF + n * 16);
#pragma unroll
        for (int ai = 0; ai < 2; ++ai)
#pragma unroll
            for (int m = 0; m < 4; ++m) { const size_t off = (size_t)(row0 + ai * HALF + m * 16) * 2048 + col0;
#pragma unroll
                for (int bj = 0; bj < 2; ++bj)
#pragma unroll
                    for (int n = 0; n < 2; ++n) { const f32x4 xi = *(const GAS f32x4*)(xin + off + bj * HALF + n * 16);
                        *(GAS f32x4*)(xout + off + bj * HALF + n * 16) = xi + gv[bj][n] * acc[ai][bj][m][n]; } }
    }
};
template <int MODE> struct EpiBr {
    static constexpr bool PERM = false, AFTER_DRAIN = false, HAS_MID = false; static constexpr int MID_T0 = -1, MID_T1 = -1;
    float* T; bf16_t* MRG; const bf16_t* Gt; int gcol0;
    __device__ __forceinline__ void operator()(const f32x4 (&acc)[2][2][4][2], const Unit& u, int wr, int wc, int fr, int fq) const {
        const int row0 = u.pm * BM + wr * 64 + fr, col0 = u.pn * BM + wc * 32 + 4 * fq;
#pragma unroll
        for (int ai = 0; ai < 2; ++ai)
#pragma unroll
            for (int m = 0; m < 4; ++m) { const size_t row = (size_t)(row0 + ai * HALF + m * 16);
#pragma unroll
                for (int bj = 0; bj < 2; ++bj)
#pragma unroll
                    for (int n = 0; n < 2; ++n) { const int col = col0 + bj * HALF + n * 16;
                        const u32x2 gw = *(const GAS u32x2*)(Gt + row * 6144 + gcol0 + col);
                        const f32x4 g = {__uint_as_float(gw.x << 16), __uint_as_float(gw.x & 0xffff0000u), __uint_as_float(gw.y << 16), __uint_as_float(gw.y & 0xffff0000u)};
                        f32x4 v = g * acc[ai][bj][m][n];
                        if (MODE >= 1) v = v + *(const GAS f32x4*)(T + row * 2048 + col);
                        if (MODE <= 1) *(GAS f32x4*)(T + row * 2048 + col) = v;
                        else { u32x2 w; w.x = cvt_pk_bf16(v[0], v[1]); w.y = cvt_pk_bf16(v[2], v[3]); *(GAS u32x2*)(MRG + row * 2048 + col) = w; } } }
    }
};

struct EpiBrM {
    static constexpr bool PERM = true, AFTER_DRAIN = false, HAS_MID = true; static constexpr int MID_T0 = 8, MID_T1 = 12, NSTORE = 0;
    bf16_t* MRG; const unsigned char* Gt;
    __device__ __forceinline__ static f32x4 ub4(const unsigned d) { return (f32x4){(float)(d & 0xffu), (float)((d >> 8) & 0xffu), (float)((d >> 16) & 0xffu), (float)(d >> 24)}; }
    __device__ __forceinline__ static f32x4 rdiv(const f32x4 a, const f32x4 b) { return (f32x4){a[0] * __builtin_amdgcn_rcpf(b[0]), a[1] * __builtin_amdgcn_rcpf(b[1]), a[2] * __builtin_amdgcn_rcpf(b[2]), a[3] * __builtin_amdgcn_rcpf(b[3])}; }
    __device__ __forceinline__ void mid(f32x4 (&acc)[2][2][4][2], const Unit& u, int t, int wr, int wc, int fr, int fq) const {
        int off = (u.pm * 24 + u.pn + (t == MID_T0 ? 0 : 8)) * 65536 + (wr * 4 + wc) * 8192 + (fq * 16 + fr) * 16;
        asm volatile("" : "+v"(off));
        const unsigned char* gp = Gt + (unsigned)off;
#pragma unroll
        for (int ai = 0; ai < 2; ++ai)
#pragma unroll
            for (int m = 0; m < 4; ++m) { const int s = (ai * 4 + m) * 1024;
                const u32x4 wa = *(const GAS u32x4*)(gp + s), wb = *(const GAS u32x4*)(gp + 8 * 65536 + s);
                acc[ai][0][m][0] = acc[ai][0][m][0] * rdiv(ub4(wa.x), ub4(wb.x)); acc[ai][0][m][1] = acc[ai][0][m][1] * rdiv(ub4(wa.y), ub4(wb.y));
                acc[ai][1][m][0] = acc[ai][1][m][0] * rdiv(ub4(wa.z), ub4(wb.z)); acc[ai][1][m][1] = acc[ai][1][m][1] * rdiv(ub4(wa.w), ub4(wb.w));
                if (HOOKGRP == 1 || (m % HOOKGRP) == HOOKGRP - 1) asm volatile("" ::: "memory"); }
    }
    __device__ __forceinline__ void operator()(const f32x4 (&acc)[2][2][4][2], const Unit& u, int wr, int wc, int fr, int fq) const {
        const int row0 = u.pm * BM + wr * 64 + fr, col0 = u.pn * BM + wc * 32 + 8 * fq;
        const unsigned char* gp = Gt + (size_t)(u.pm * 24 + u.pn + 16) * 65536 + (wr * 4 + wc) * 8192 + (fq * 16 + fr) * 16;
#pragma unroll
        for (int ai = 0; ai < 2; ++ai)
#pragma unroll
            for (int m = 0; m < 4; ++m) { bf16_t* rowp = MRG + (size_t)(row0 + ai * HALF + m * 16) * 2048 + col0;
                const u32x4 wg = *(const GAS u32x4*)(gp + (ai * 4 + m) * 1024);
#pragma unroll
                for (int bj = 0; bj < 2; ++bj) { const f32x4 g0 = ub4(bj ? wg.z : wg.x) * (1.0f / 255.0f), g1 = ub4(bj ? wg.w : wg.y) * (1.0f / 255.0f);
                    const f32x4 v0 = acc[ai][bj][m][0] * g0, v1 = acc[ai][bj][m][1] * g1;
                    u32x4 w; w.x = cvt_pk_bf16(v0[0], v0[1]); w.y = cvt_pk_bf16(v0[2], v0[3]); w.z = cvt_pk_bf16(v1[0], v1[1]); w.w = cvt_pk_bf16(v1[2], v1[3]);
                    *(GAS u32x4*)(rowp + bj * HALF) = w; } }
    }
};
struct EpiDelta {
    static constexpr bool PERM = true, AFTER_DRAIN = false, HAS_MID = false; static constexpr int MID_T0 = -1, MID_T1 = -1;
    bf16_t* Dl; const float* gbase; int seq0, tshift; const float* HS2 = nullptr;
    __device__ __forceinline__ void operator()(const f32x4 (&acc)[2][2][4][2], const Unit& u, int wr, int wc, int fr, int fq) const {
        const int row0 = u.pm * BM + wr * 64 + fr, col0 = u.pn * BM + wc * 32 + 8 * fq;
        const float* gp = gbase + (size_t)(seq0 + ((u.pm * BM) >> tshift)) * 12288 + col0;
        f32x4 gv[2][2];
#pragma unroll
        for (int bj = 0; bj < 2; ++bj)
#pragma unroll
            for (int n = 0; n < 2; ++n) gv[bj][n] = *(const GAS f32x4*)(gp + bj * HALF + 4 * n);
#pragma unroll
        for (int ai = 0; ai < 2; ++ai)
#pragma unroll
            for (int m = 0; m < 4; ++m) { bf16_t* rowp = Dl + (size_t)(row0 + ai * HALF + m * 16) * 2048 + col0;
                float rs = 1.0f; if (HS2) { rs = HS2[row0 + ai * HALF + m * 16]; rs *= rs; }
#pragma unroll
                for (int bj = 0; bj < 2; ++bj) { const f32x4 v0 = acc[ai][bj][m][0] * gv[bj][0] * rs, v1 = acc[ai][bj][m][1] * gv[bj][1] * rs;
                    u32x4 w; w.x = cvt_pk_bf16(v0[0], v0[1]); w.y = cvt_pk_bf16(v0[2], v0[3]); w.z = cvt_pk_bf16(v1[0], v1[1]); w.w = cvt_pk_bf16(v1[2], v1[3]);
                    *(GAS u32x4*)(rowp + bj * HALF) = w; } }
    }
};

struct EpiFinal {
    static constexpr bool PERM = true, AFTER_DRAIN = false, HAS_MID = false; static constexpr int MID_T0 = -1, MID_T1 = -1;
    const bf16_t* XS; float* out; const float* gbase; int seq0, tshift; const float* HS2 = nullptr;
    __device__ __forceinline__ void operator()(const f32x4 (&acc)[2][2][4][2], const Unit& u, int wr, int wc, int fr, int fq) const {
        const int row0 = u.pm * BM + wr * 64 + fr, col0 = u.pn * BM + wc * 32 + 8 * fq;
        const float* gp = gbase + (size_t)(seq0 + ((u.pm * BM) >> tshift)) * 12288 + col0;
        f32x4 gv[2][2];
#pragma unroll
        for (int bj = 0; bj < 2; ++bj)
#pragma unroll
            for (int n = 0; n < 2; ++n) gv[bj][n] = *(const GAS f32x4*)(gp + bj * HALF + 4 * n);
#pragma unroll
        for (int ai = 0; ai < 2; ++ai)
#pragma unroll
            for (int m = 0; m < 4; ++m) { const size_t off = (size_t)(row0 + ai * HALF + m * 16) * 2048 + col0;
                float rs = 1.0f; if (HS2) { rs = HS2[row0 + ai * HALF + m * 16]; rs *= rs; }
#pragma unroll
                for (int bj = 0; bj < 2; ++bj) { const u32x4 xw = *(const GAS u32x4*)(XS + off + bj * HALF);
                    const f32x4 x0 = {__uint_as_float(xw.x << 16), __uint_as_float(xw.x & 0xffff0000u), __uint_as_float(xw.y << 16), __uint_as_float(xw.y & 0xffff0000u)};
                    const f32x4 x1 = {__uint_as_float(xw.z << 16), __uint_as_float(xw.z & 0xffff0000u), __uint_as_float(xw.w << 16), __uint_as_float(xw.w & 0xffff0000u)};
                    *(GAS f32x4*)(out + off + bj * HALF) = x0 + acc[ai][bj][m][0] * gv[bj][0] * rs;
                    *(GAS f32x4*)(out + off + bj * HALF + 4) = x1 + acc[ai][bj][m][1] * gv[bj][1] * rs; }
                if (m & 1) asm volatile("" ::: "memory"); }
    }
};
template <class Epi, class Sched, bool ALIGN_EPI = false, bool SP2 = false, bool I8 = false>
__device__ __forceinline__ void gemm_phase(PG8_LAS unsigned char* lds, const Gemm g, const Sched& S, const Epi& E, int tid_in) {
    int tid_ = tid_in; asm volatile("" : "+v"(tid_));
    const int tid = tid_, wid = __builtin_amdgcn_readfirstlane(tid >> 6), lane = tid & 63, wr = wid >> 2, wc = wid & 3, fr = lane & 15, fq = lane >> 4;
    const int K = g.K, nt = K / BK;
    unsigned voffA[2], voffB[2];
#pragma unroll
    for (int i = 0; i < 2; ++i) { int R, C; stage_rc(tid * 16 + i * 8192, R, C); const int Rb = Epi::PERM ? ((R & ~31) + perm32(R & 31)) : R;
        voffA[i] = (unsigned)(R * K + C) * 2u; voffB[i] = (unsigned)(Rb * K + C) * 2u; }
    const size_t kstep = (size_t)(BK * 2);
    const size_t hstep = (size_t)HALF * K * 2;
    const size_t tstep = 2 * hstep;
    const unsigned ldsw = (unsigned)wid * 1024u;
    const int aoff = lds_byte(wr * 64 + fr, fq * 8), boff = lds_byte(wc * 32 + fr, fq * 8);
#define PG8_SA(b, h) (((b) * 2 + (h)) * HTB)
#define PG8_SB(b, h) ((4 + (b) * 2 + (h)) * HTB)
#define PG8_STAGE(bufoff, gbase, voff) do { _Pragma("unroll") for (int _i = 0; _i < 2; ++_i) \
        __builtin_amdgcn_global_load_lds((const unsigned*)((const char*)(gbase) + (voff)[_i]), (PG8_LAS unsigned*)(lds + (bufoff) + ldsw + _i * 8192), 16, 0, 0); } while (0)
#define PG8_LDA(dst, b, h) do { _Pragma("unroll") for (int m = 0; m < 4; ++m) _Pragma("unroll") for (int k = 0; k < 2; ++k) dst[m][k] = *(const PG8_LAS bf16x8*)(lds + PG8_SA(b, h) + aoff + m * 2048 + k * 1024); } while (0)
#define PG8_LDB(dst, b, h) do { _Pragma("unroll") for (int n = 0; n < 2; ++n) _Pragma("unroll") for (int k = 0; k < 2; ++k) dst[n][k] = *(const PG8_LAS bf16x8*)(lds + PG8_SB(b, h) + boff + n * 2048 + k * 1024); } while (0)
#define PG8_MMA(ai, bj, At, Bt) do { __builtin_amdgcn_s_setprio(1); _Pragma("unroll") for (int m = 0; m < 4; ++m) _Pragma("unroll") for (int n = 0; n < 2; ++n) _Pragma("unroll") for (int k = 0; k < 2; ++k) { \
        if constexpr (I8) acc[ai][bj][m][n] = __builtin_bit_cast(f32x4, __builtin_amdgcn_mfma_i32_16x16x64_i8(__builtin_bit_cast(v4i_t, Bt[n][k]), __builtin_bit_cast(v4i_t, At[m][k]), __builtin_bit_cast(v4i_t, acc[ai][bj][m][n]), 0, 0, 0)); \
        else acc[ai][bj][m][n] = __builtin_amdgcn_mfma_f32_16x16x32_bf16(Bt[n][k], At[m][k], acc[ai][bj][m][n], 0, 0, 0); } \
        __builtin_amdgcn_s_setprio(0); } while (0)
#define PG8_WAIT_V(n) asm volatile("s_waitcnt vmcnt(" #n ")" ::: "memory")
#define PG8_WAIT_L(n) asm volatile("s_waitcnt lgkmcnt(" #n ")" ::: "memory")
#define PG8_BAR __builtin_amdgcn_s_barrier()
#define PG8_SCHED __builtin_amdgcn_sched_barrier(0)
    Unit cur, nxt; int ui = 0;
    if (!S.next(0, cur)) return;
    f32x4 acc[2][2][4][2];
#pragma unroll
    for (int a = 0; a < 2; ++a)
#pragma unroll
        for (int b = 0; b < 2; ++b)
#pragma unroll
            for (int m = 0; m < 4; ++m)
#pragma unroll
                for (int n = 0; n < 2; ++n) acc[a][b][m][n] = (f32x4){0.f, 0.f, 0.f, 0.f};
    typedef int v4i_t __attribute__((ext_vector_type(4)));
    bf16x8 At[4][2], B0[2][2], B1[2][2];
    const char* cA = (const char*)g.A + (size_t)cur.pm * tstep; const char* cB = (const char*)g.Bt + (size_t)cur.pn * tstep;
    S.a_ready(cur);
    if constexpr (SP2) {
        PG8_STAGE(PG8_SB(0, 0), cB, voffB); PG8_STAGE(PG8_SB(0, 1), cB + hstep, voffB); PG8_STAGE(PG8_SA(0, 0), cA, voffA); PG8_STAGE(PG8_SA(0, 1), cA + hstep, voffA);
        if (wr == 1) PG8_BAR;
        PG8_WAIT_V(2); PG8_BAR;
        PG8_STAGE(PG8_SB(1, 0), cB + kstep, voffB); PG8_STAGE(PG8_SA(1, 0), cA + kstep, voffA); PG8_STAGE(PG8_SB(1, 1), cB + hstep + kstep, voffB);
        PG8_WAIT_V(6); PG8_BAR;
    } else {
        PG8_STAGE(PG8_SB(0, 0), cB, voffB); PG8_STAGE(PG8_SA(0, 0), cA, voffA); PG8_STAGE(PG8_SB(0, 1), cB + hstep, voffB); PG8_STAGE(PG8_SA(0, 1), cA + hstep, voffA);
        if (wr == 1) PG8_BAR;
        PG8_WAIT_V(4); PG8_BAR;
        PG8_STAGE(PG8_SB(1, 0), cB + kstep, voffB); PG8_STAGE(PG8_SA(1, 0), cA + kstep, voffA); PG8_STAGE(PG8_SB(1, 1), cB + hstep + kstep, voffB);
        PG8_WAIT_V(6); PG8_BAR;
    }
    for (;;) {
        const bool has_next = S.next(ui + 1, nxt);
        const char* nA = has_next ? (const char*)g.A + (size_t)nxt.pm * tstep : cA; const char* nB = has_next ? (const char*)g.Bt + (size_t)nxt.pn * tstep : cB;
#pragma unroll 1
        for (int t = 0; t < nt; t += 2) {
            if constexpr (Epi::HAS_MID) { if (t == Epi::MID_T0 || t == Epi::MID_T1) E.mid(acc, cur, t, wr, wc, fr, fq); }
            const bool last = (t == nt - 2);
            const char* a1 = cA + (size_t)(t + 1) * kstep;
            const char* a2 = last ? nA : cA + (size_t)(t + 2) * kstep; const char* b2 = last ? nB : cB + (size_t)(t + 2) * kstep;
            const char* a3 = a2 + kstep; const char* b3 = b2 + kstep;
            if (last && has_next) S.a_ready(nxt);
            if constexpr (SP2) {
            PG8_LDB(B0, 0, 0); PG8_LDB(B1, 0, 1); PG8_SCHED; PG8_LDA(At, 0, 0); PG8_STAGE(PG8_SA(1, 1), a1 + hstep, voffA);
            PG8_WAIT_V(8); PG8_WAIT_L(0); PG8_BAR; PG8_MMA(0, 0, At, B0); PG8_MMA(0, 1, At, B1); PG8_BAR; PG8_SCHED;
            PG8_LDA(At, 0, 1); PG8_STAGE(PG8_SB(0, 0), b2, voffB); PG8_STAGE(PG8_SB(0, 1), b2 + hstep, voffB); PG8_STAGE(PG8_SA(0, 0), a2, voffA);
            PG8_WAIT_V(8); PG8_WAIT_L(0); PG8_BAR; PG8_MMA(1, 0, At, B0); PG8_MMA(1, 1, At, B1); PG8_BAR; PG8_SCHED;
            PG8_LDB(B0, 1, 0); PG8_LDB(B1, 1, 1); PG8_SCHED; PG8_LDA(At, 1, 0); PG8_STAGE(PG8_SA(0, 1), a2 + hstep, voffA);
            PG8_WAIT_V(8); PG8_WAIT_L(0); PG8_BAR; PG8_MMA(0, 0, At, B0); PG8_MMA(0, 1, At, B1); PG8_BAR; PG8_SCHED;
            PG8_LDA(At, 1, 1); PG8_STAGE(PG8_SB(1, 0), b3, voffB); PG8_STAGE(PG8_SB(1, 1), b3 + hstep, voffB); PG8_STAGE(PG8_SA(1, 0), a3, voffA);
            PG8_WAIT_V(8); PG8_WAIT_L(0); PG8_BAR; PG8_MMA(1, 0, At, B0); PG8_MMA(1, 1, At, B1); PG8_BAR; PG8_SCHED;
            } else {
            PG8_LDB(B0, 0, 0); PG8_SCHED; PG8_LDA(At, 0, 0); PG8_STAGE(PG8_SA(1, 1), a1 + hstep, voffA);
            PG8_WAIT_L(8); PG8_BAR; PG8_WAIT_L(0); PG8_MMA(0, 0, At, B0); PG8_BAR; PG8_SCHED;
            PG8_LDB(B1, 0, 1); PG8_STAGE(PG8_SB(0, 0), b2, voffB);
            PG8_BAR; PG8_WAIT_L(0); PG8_MMA(0, 1, At, B1); PG8_BAR;
            PG8_LDA(At, 0, 1); PG8_STAGE(PG8_SA(0, 0), a2, voffA);
            PG8_BAR; PG8_WAIT_L(0); PG8_MMA(1, 0, At, B0); PG8_BAR; PG8_SCHED;
            PG8_STAGE(PG8_SB(0, 1), b2 + hstep, voffB);
            PG8_WAIT_V(6); PG8_BAR; PG8_MMA(1, 1, At, B1); PG8_BAR;
            PG8_LDB(B0, 1, 0); PG8_SCHED; PG8_LDA(At, 1, 0); PG8_STAGE(PG8_SA(0, 1), a2 + hstep, voffA);
            PG8_WAIT_L(8); PG8_BAR; PG8_WAIT_L(0); PG8_MMA(0, 0, At, B0); PG8_BAR; PG8_SCHED;
            PG8_LDB(B1, 1, 1); PG8_STAGE(PG8_SB(1, 0), b3, voffB);
            PG8_BAR; PG8_WAIT_L(0); PG8_MMA(0, 1, At, B1); PG8_BAR;
            PG8_LDA(At, 1, 1); PG8_STAGE(PG8_SA(1, 0), a3, voffA);
            PG8_BAR; PG8_WAIT_L(0); PG8_MMA(1, 0, At, B0); PG8_BAR; PG8_SCHED;
            PG8_STAGE(PG8_SB(1, 1), b3 + hstep, voffB);
            PG8_WAIT_V(6); PG8_BAR; PG8_MMA(1, 1, At, B1); PG8_BAR;
            }
        }
        if constexpr (ALIGN_EPI) { if (wr == 0) PG8_BAR; }
        if constexpr (!Epi::AFTER_DRAIN) { E(acc, cur, wr, wc, fr, fq); S.done(cur); }
        if (!has_next) break;
#pragma unroll
        for (int a = 0; a < 2; ++a)
#pragma unroll
            for (int b = 0; b < 2; ++b)
#pragma unroll
                for (int m = 0; m < 4; ++m)
#pragma unroll
                    for (int n = 0; n < 2; ++n) acc[a][b][m][n] = (f32x4){0.f, 0.f, 0.f, 0.f};
        cur = nxt; cA = nA; cB = nB; ++ui;
        if constexpr (ALIGN_EPI) { if (wr == 1) PG8_BAR; }
    }
    PG8_WAIT_V(0);
    if constexpr (!ALIGN_EPI) { if (wr == 0) PG8_BAR; }
    PG8_BAR;
    if constexpr (Epi::AFTER_DRAIN) { E.fused(acc, cur, wr, wc, fr, fq, lds, wid, lane); S.done(cur); }
#undef PG8_SA
#undef PG8_SB
#undef PG8_STAGE
#undef PG8_LDA
#undef PG8_LDB
#undef PG8_MMA
#undef PG8_WAIT_V
#undef PG8_WAIT_L
#undef PG8_BAR
#undef PG8_SCHED
}
}
typedef unsigned short bf16;
typedef unsigned v4u __attribute__((ext_vector_type(4)));
typedef unsigned v2u __attribute__((ext_vector_type(2)));
typedef float f32x4 __attribute__((ext_vector_type(4)));
typedef float f32x16 __attribute__((ext_vector_type(16)));
typedef short bf16x8 __attribute__((ext_vector_type(8)));
typedef GAS unsigned gu32;
#define LDS_WAIT() asm volatile("s_waitcnt lgkmcnt(0)" ::: "memory")
#define VM_WAIT() asm volatile("s_waitcnt vmcnt(0)" ::: "memory")
__device__ __forceinline__ unsigned pk2(float lo, float hi) { return pg8::cvt_pk_bf16(lo, hi); }
__device__ __forceinline__ float bflo(unsigned w) { return __uint_as_float(w << 16); }
__device__ __forceinline__ float bfhi(unsigned w) { return __uint_as_float(w & 0xffff0000u); }
__device__ __forceinline__ float bf1(bf16 b) { return __uint_as_float((unsigned)b << 16); }
__device__ __forceinline__ float wave_sum(float v) {
    v += shx<1>(v); v += shx<2>(v); v += shx<4>(v); v += shx<8>(v); v += shx<16>(v); return sum32(v);
}
#define XB_TMO      128
#define XB_XCNT(j)  (256  + 64 * (j))
#define XB_XSUB(j)  (1280 + 64 * (j))
#define XB_XGEN(j)  (2304 + 64 * (j))
#define XB_TOP      3328
#define XB_TOPGEN   3392
#define XCD_BAR_WORDS 3456
#define XB_SPIN_CAP (1u << 18)

__device__ __forceinline__ unsigned xb_ld(unsigned* p)              { return __hip_atomic_load(p, __ATOMIC_RELAXED, __HIP_MEMORY_SCOPE_AGENT); }
__device__ __forceinline__ unsigned xb_add(unsigned* p, unsigned v) { return __hip_atomic_fetch_add(p, v, __ATOMIC_RELAXED, __HIP_MEMORY_SCOPE_AGENT); }
__device__ __forceinline__ unsigned xb_xcc_id() { return (unsigned)__builtin_amdgcn_s_getreg((3 << 11) | 20) & 0xFu; }
#define XB_SPIN(cond, bar) do { unsigned _sp = 0; while (cond) { __builtin_amdgcn_s_sleep(1); \
    if ((++_sp & 255u) == 0u) { if (xb_ld(&(bar)[XB_TMO])) break; if (_sp > XB_SPIN_CAP) { atomicAdd(&(bar)[XB_TMO], 1u); break; } } } } while (0)

struct XcdBarrier {
    unsigned* bar; unsigned x;
    volatile LAS unsigned* st;
};

__device__ __forceinline__ XcdBarrier xcd_barrier_post(unsigned* bar, volatile LAS unsigned* st, int tid) {
    XcdBarrier b; b.bar = bar; b.x = xb_xcc_id(); b.st = st;
    if (tid == 0) (void)xb_add(&bar[XB_XCNT(b.x)], 1u);
    return b;
}
__device__ __forceinline__ void xcd_barrier_complete(unsigned* bar, unsigned x, unsigned& nloc, unsigned& nx) {
    const unsigned G = gridDim.x * gridDim.y * gridDim.z;
    unsigned sum, cnt, mine, sp = 0u;
    for (;;) {
        sum = 0u; cnt = 0u; mine = 0u;
#pragma unroll
        for (unsigned j = 0; j < 16; ++j) { const unsigned c = xb_ld(&bar[XB_XCNT(j)]); sum += c; cnt += (c > 0u) ? 1u : 0u; mine = (j == x) ? c : mine; }
        if (sum == G) break;
        __builtin_amdgcn_s_sleep(1);
        if ((++sp & 255u) == 0u) { if (xb_ld(&bar[XB_TMO])) break; if (sp > XB_SPIN_CAP) { atomicAdd(&bar[XB_TMO], 1u); break; } }
    }
    nloc = mine > 0u ? mine : 1u; nx = cnt > 0u ? cnt : 1u;
}

__device__ __forceinline__ void xcd_barrier(const XcdBarrier& b, int tid) {
    asm volatile("s_waitcnt vmcnt(0)" ::: "memory");
    __syncthreads();
    if (tid == 0) {
        unsigned* bar = b.bar;
        __builtin_amdgcn_s_waitcnt(0);
        unsigned nloc = b.st[0], nx = b.st[1];
        if (nloc == 0u) { xcd_barrier_complete(bar, b.x, nloc, nx); b.st[0] = nloc; b.st[1] = nx; }
        const unsigned old = xb_add(&bar[XB_XSUB(b.x)], 1u);
        const unsigned gen = old / nloc;
        if (old + 1u == (gen + 1u) * nloc) {
            __builtin_amdgcn_fence(__ATOMIC_RELEASE, "agent");
            asm volatile("s_waitcnt vmcnt(0)" ::: "memory");
            const unsigned og = xb_add(&bar[XB_TOP], 1u);
            const unsigned tg = og / nx;
            if (og + 1u == (tg + 1u) * nx) xb_add(&bar[XB_TOPGEN], 1u);
            else XB_SPIN(xb_ld(&bar[XB_TOPGEN]) == tg, bar);
            __builtin_amdgcn_fence(__ATOMIC_ACQUIRE, "agent");
            xb_add(&bar[XB_XGEN(b.x)], 1u);
            asm volatile("s_waitcnt vmcnt(0)" ::: "memory");
        } else {
            XB_SPIN(xb_ld(&bar[XB_XGEN(b.x)]) == gen, bar);
            __builtin_amdgcn_fence(__ATOMIC_ACQUIRE, "agent");
            asm volatile("s_waitcnt vmcnt(0)" ::: "memory");
        }
    }
    __syncthreads();
}

__device__ __forceinline__ void phase_modp(const AL& a, LAS unsigned char* lds, int tid, int lane, int wave) {
    LAS float* sil = (LAS float*)lds;
    const float* wada = a.in(I_WADA); float* modp = (float*)(a.ws() + WS_MODP);
    for (int it = blockIdx.x; it < 256; it += gridDim.x) {
        const int l = it >> 7, ks = (it >> 3) & 15, cg = it & 7, k0 = ks * 128;
        for (int e = tid; e < 24 * 128; e += NWAVES * 64) { const int b = e >> 7, kk = e & 127;
            const float c = b < 8 ? a.in(I_CP)[b * 2048 + k0 + kk] : a.in(I_CS)[(b - 8) * 2048 + k0 + kk];
            sil[e] = c / (1.0f + __expf(-c)); }
        __syncthreads();
        const int n0 = cg * 1536 + wave * 192 + 3 * lane;
        float acc[24][3];
#pragma unroll
        for (int b = 0; b < 24; ++b) { acc[b][0] = 0.f; acc[b][1] = 0.f; acc[b][2] = 0.f; }
        const GAS float* wp = (const GAS float*)wada + ((size_t)l * 2048 + k0) * 12288 + n0;
#pragma unroll 8
        for (int kk = 0; kk < 128; ++kk) {
            const float w0 = wp[(size_t)kk * 12288], w1 = wp[(size_t)kk * 12288 + 1], w2 = wp[(size_t)kk * 12288 + 2];
#pragma unroll
            for (int b = 0; b < 24; ++b) { const float s = sil[b * 128 + kk]; acc[b][0] += s * w0; acc[b][1] += s * w1; acc[b][2] += s * w2; }
        }
#pragma unroll
        for (int b = 0; b < 24; ++b) { GAS float* o = (GAS float*)modp + ((size_t)(ks * 2 + l) * 24 + b) * 12288 + n0; o[0] = acc[b][0]; o[1] = acc[b][1]; o[2] = acc[b][2]; }
        __syncthreads();
    }
}
__device__ __forceinline__ int win_row(int n0) { return n0 < 1024 ? n0 : n0 < 1536 ? n0 + 3072 : n0 < 3072 ? n0 - 512 : n0 < 3840 ? n0 + 1536 : n0 < 5376 ? n0 - 1280 : n0; }
__device__ __forceinline__ void phase_colmax(const AL& a, int gw, int NGW, int lane) {
    unsigned* wmax = (unsigned*)(a.ws() + WS_CTL) + CW_WMAX;
    for (int it = gw; it < 2 * 2 * 96 * 8; it += NGW) { const int ks = it & 7, cb = (it >> 3) % 96, mat = (it / 768) & 1, l = it / 1536, n0 = 64 * cb;
        const GAS float* w = (const GAS float*)(mat ? a.in(I_WGATE) : a.in(I_WIN)) + ((size_t)l * 2048 + ks * 256) * 6144 + n0 + lane;
        float mx = 0.f;
#pragma unroll 16
        for (int k = 0; k < 256; ++k) mx = fmaxf(mx, fabsf(w[(size_t)k * 6144]));
        const int d = mat ? 6144 + n0 + lane : win_row(n0) + lane;
        atomicMax(wmax + l * WMAX_L + d, __float_as_uint(mx)); }
#if I8FF1
    for (int it = gw; it < 2 * 128 * 8; it += NGW) { const int ks = it & 7, cb = (it >> 3) & 127, l = it >> 10, n0 = 64 * cb;
        const GAS float* w = (const GAS float*)a.in(I_WFF1) + ((size_t)l * 2048 + ks * 256) * 8192 + n0 + lane;
        float mx = 0.f;
#pragma unroll 16
        for (int k = 0; k < 256; ++k) mx = fmaxf(mx, fabsf(w[(size_t)k * 8192]));
        atomicMax(wmax + l * WMAX_L + 12288 + n0 + lane, __float_as_uint(mx)); }
#endif
}
__device__ __forceinline__ unsigned pk_i8x4(f32x4 v) {
    const int a = (int)__builtin_rintf(v.x), b = (int)__builtin_rintf(v.y), c = (int)__builtin_rintf(v.z), d = (int)__builtin_rintf(v.w);
    return (unsigned)(a & 255) | ((unsigned)(b & 255) << 8) | ((unsigned)(c & 255) << 16) | ((unsigned)d << 24); }
struct TrItem { const float* src; bf16* dst; int N, ldk; const unsigned* cmax; const unsigned* ksc; };
__device__ __forceinline__ void tr_load(const TrItem& t, float (&v)[32], int lane) {
    const GAS float* s = (const GAS float*)t.src + (size_t)(lane >> 5) * t.N + (lane & 31);
#pragma unroll
    for (int i = 0; i < 32; ++i) v[i] = s[(size_t)(2 * i) * t.N];
}
__device__ __forceinline__ void tr_store(const TrItem& t, const float (&v)[32], LAS float* scr, int lane) {
#pragma unroll
    for (int i = 0; i < 32; ++i) scr[(2 * i + (lane >> 5)) * 33 + (lane & 31)] = v[i];
    LDS_WAIT(); asm volatile("" ::: "memory");
    const int c = lane & 7;
#pragma unroll
    for (int j = 0; j < 4; ++j) { const int n = (lane >> 3) + 8 * j; const LAS float* s = scr + (8 * c) * 33 + n;
        if (t.cmax) { const float cm = __uint_as_float(t.cmax[n]), inv = cm > 0.f ? 127.0f / cm : 0.f;
            v2u o; o.x = pk_i8x4((f32x4){s[0 * 33], s[1 * 33], s[2 * 33], s[3 * 33]} * inv); o.y = pk_i8x4((f32x4){s[4 * 33], s[5 * 33], s[6 * 33], s[7 * 33]} * inv);
            *(GAS v2u*)((unsigned char*)t.dst + (size_t)n * t.ldk + 8 * c) = o; }
        else { float f[8];
#pragma unroll
            for (int e = 0; e < 8; ++e) f[e] = s[e * 33];
            if (t.ksc) { const v4u k0 = *(const GAS v4u*)(t.ksc + 8 * c), k1 = *(const GAS v4u*)(t.ksc + 8 * c + 4); const unsigned kk[8] = {k0.x, k0.y, k0.z, k0.w, k1.x, k1.y, k1.z, k1.w};
#pragma unroll
                for (int e = 0; e < 8; ++e) { const float q = __uint_as_float(kk[e]) * (1.0f / 127.0f); f[e] *= q * q; } }
            v4u o; o.x = pk2(f[0], f[1]); o.y = pk2(f[2], f[3]); o.z = pk2(f[4], f[5]); o.w = pk2(f[6], f[7]);
            *(GAS v4u*)(t.dst + (size_t)n * t.ldk + 8 * c) = o; } }
    LDS_WAIT(); asm volatile("" ::: "memory");
}
__device__ __forceinline__ void phase_pro2(const AL& a, LAS unsigned char* lds, int tid, int lane, int wave, int G) {
    const int gt = blockIdx.x * (NWAVES * 64) + tid, NGT = G * NWAVES * 64;
    { float* mod = (float*)(a.ws() + WS_MOD); const float* modp = (const float*)(a.ws() + WS_MODP); const float* bada = a.in(I_BADA);
      for (int i = gt; i < 2 * 24 * 12288; i += NGT) { const int l = i / (24 * 12288), n = i % 12288; float s = bada[l * 12288 + n];
#pragma unroll
          for (int ks = 0; ks < 16; ++ks) s += modp[(size_t)ks * (2 * 24 * 12288) + i];
          mod[i] = s; } }
    { float2* rb = (float2*)(a.ws() + WS_ROPEB); float2* rc = (float2*)(a.ws() + WS_ROPEC);
      for (int i = gt; i < 4096 * 24; i += NGT) { const int pos = i / 24, j = i % 24; const bool isb = j < 16; const int ii = isb ? j : j - 16; const double half = isb ? 16.0 : 8.0;
          const double inv = exp(-(double)ii / half * 13.122363377404328);
          const double rev = (double)pos * inv * 0.15915494309189535;
          const float fr = (float)(rev - floor(rev));
          const float2 v = make_float2(__builtin_amdgcn_cosf(fr), __builtin_amdgcn_sinf(fr));
          if (isb) rb[pos * 16 + ii] = v; else rc[pos * 8 + ii] = v; } }
    if (gt < 2) { const int l = gt; float s1 = 0.f, s2 = 0.f;
        for (int i = 0; i < 64; ++i) { s1 += a.in(I_LQ1)[l * 64 + i] * a.in(I_LK1)[l * 64 + i]; s2 += a.in(I_LQ2)[l * 64 + i] * a.in(I_LK2)[l * 64 + i]; }
        const float lam_init = 0.8f - 0.6f * expf(-0.3f * (float)l);
        ((float*)(a.ws() + WS_LAM))[l] = expf(s1) - expf(s2) + lam_init;
        float gq = 0.f, gk = 0.f;
        for (int i = 0; i < 64; ++i) { gq = fmaxf(gq, fabsf(a.in(I_QNC)[l * 64 + i])); gk = fmaxf(gk, fabsf(a.in(I_KNC)[l * 64 + i])); }
        ((float*)(a.ws() + WS_LAM))[2 + l] = 8.0f * LOG2E * gq * gk * 1.02f; }
    LAS float* scr = (LAS float*)(lds + RING_OFF + wave * 16384);
    const int gw = blockIdx.x * NWAVES + wave, NGW = G * NWAVES;
    constexpr int I_IN = 32 * 192, I_BA = 8 * 64, I_BB = 4 * 64, I_BC = 12 * 64, I_OU = 32 * 64, I_F1 = 32 * 256, I_F2 = 128 * 64;
    constexpr int PER_L = 2 * I_IN + I_BA + I_BB + I_BC + I_OU + I_F1 + I_F2;
    auto decode = [&](int it) -> TrItem {
        const int l = it / PER_L; int r = it % PER_L; unsigned char* wl = a.ws() + WS_W + (size_t)l * W_LAYER;
        const float* W; bf16* WT; int K, N, row_off = 0, ldk, koff = 0, i8 = 0; bool win = false, ff2 = false;
        if (r < I_IN) { win = true; i8 = I8IN ? 1 : 0; W = a.in(I_WIN) + (size_t)l * 2048 * 6144; K = 2048; N = 6144; WT = (bf16*)(wl + WO_IG); ldk = 2048; }
        else if ((r -= I_IN) < I_IN) { i8 = 2; W = a.in(I_WGATE) + (size_t)l * 2048 * 6144; K = 2048; N = 6144; WT = (bf16*)(wl + WO_IG + (size_t)6144 * 2048 * (I8IN ? 1 : 2)); ldk = 2048; }
        else if ((r -= I_IN) < I_BA) { W = a.in(I_WBRA) + (size_t)l * 512 * 2048; K = 512; N = 2048; WT = (bf16*)(wl + WO_BRA); ldk = 1536; }
        else if ((r -= I_BA) < I_BB) { W = a.in(I_WBRB) + (size_t)l * 256 * 2048; K = 256; N = 2048; WT = (bf16*)(wl + WO_BRA); ldk = 1536; koff = 512; }
        else if ((r -= I_BB) < I_BC) { W = a.in(I_WBRC) + (size_t)l * 768 * 2048; K = 768; N = 2048; WT = (bf16*)(wl + WO_BRA); ldk = 1536; koff = 768; }
        else if ((r -= I_BC) < I_OU) { W = a.in(I_WOUT) + (size_t)l * 2048 * 2048; K = 2048; N = 2048; WT = (bf16*)(wl + WO_OUT); ldk = 2048; }
        else if ((r -= I_OU) < I_F1) { W = a.in(I_WFF1) + (size_t)l * 2048 * 8192; K = 2048; N = 8192; WT = (bf16*)(wl + WO_FF1); ldk = 2048; i8 = I8FF1 ? 3 : 0; }
        else { r -= I_F1; W = a.in(I_WFF2) + (size_t)l * 8192 * 2048; K = 8192; N = 2048; WT = (bf16*)(wl + WO_FF2); ldk = 8192; ff2 = I8FF1 != 0; }
        (void)K; const int nblk = N / 32, kb = r / nblk, nb = r % nblk, k0 = 64 * kb, n0 = 32 * nb; const int nd = win ? win_row(n0) : n0;
        TrItem t; t.src = W + (size_t)k0 * N + n0; t.N = N; t.ldk = ldk; t.cmax = nullptr; t.ksc = ff2 ? (const unsigned*)(a.ws() + WS_CTL) + CW_WMAX + l * WMAX_L + 12288 + k0 : nullptr;
        if (i8) { t.dst = (bf16*)((unsigned char*)WT + (size_t)nd * ldk + k0); t.cmax = (const unsigned*)(a.ws() + WS_CTL) + CW_WMAX + l * WMAX_L + (i8 == 3 ? 12288 : i8 == 2 ? 6144 : 0) + nd; }
        else t.dst = WT + (size_t)(row_off + nd) * ldk + koff + k0;
        return t; };
    { int it = gw; const int NIT = 2 * PER_L;
      if (it < NIT) { TrItem cur = decode(it); float v[32]; tr_load(cur, v, lane);
          for (;;) { const int nx = it + NGW; const bool more = nx < NIT; TrItem nt = cur; float vn[32];
              if (more) { nt = decode(nx); tr_load(nt, vn, lane); }
              tr_store(cur, v, scr, lane);
              if (!more) break;
              cur = nt; it = nx;
#pragma unroll
              for (int i = 0; i < 32; ++i) v[i] = vn[i]; } } }
}

__device__ __forceinline__ f32x4 up4(v2u w) { return (f32x4){bflo(w.x), bfhi(w.x), bflo(w.y), bfhi(w.y)}; }
template <bool XF32, bool HASD, bool QI8 = false>
__device__ __forceinline__ void phase_norm(const float* xf, const bf16* XS, const bf16* D, bf16* XB, const float* gn, const float* modl, int sh_off, int sc_off, int seq0, int tshift, bf16* H, int gw, int NGW, int lane, unsigned char* HI8 = nullptr, float* HS = nullptr) {
    for (int blk = gw; blk < CH / 8; blk += NGW) {
        const int r0 = blk * 8; const float* mo = modl + (size_t)(seq0 + (r0 >> tshift)) * 12288;
        f32x4 A[8], B[8];
#pragma unroll
        for (int j = 0; j < 8; ++j) { const int c = 4 * lane + 256 * j; const f32x4 g = *(const GAS f32x4*)(gn + c), sc = *(const GAS f32x4*)(mo + sc_off + c); A[j] = g * (1.0f + sc); B[j] = *(const GAS f32x4*)(mo + sh_off + c); }
        for (int r = 0; r < 8; r += 2) {
            f32x4 v0[8], v1[8]; float s0 = 0.f, s1 = 0.f;
            if (XF32) { const GAS f32x4* xr0 = (const GAS f32x4*)(xf + (size_t)(r0 + r) * 2048) + lane; const GAS f32x4* xr1 = xr0 + 512;
#pragma unroll
                for (int j = 0; j < 8; ++j) { v0[j] = xr0[64 * j]; v1[j] = xr1[64 * j]; } }
            else { const GAS v2u* xr0 = (const GAS v2u*)(XS + (size_t)(r0 + r) * 2048) + lane; const GAS v2u* xr1 = xr0 + 512; v2u e0[8], e1[8];
#pragma unroll
                for (int j = 0; j < 8; ++j) { e0[j] = xr0[64 * j]; e1[j] = xr1[64 * j]; }
#pragma unroll
                for (int j = 0; j < 8; ++j) { v0[j] = up4(e0[j]); v1[j] = up4(e1[j]); } }
            if (HASD) { const GAS v2u* d0 = (const GAS v2u*)(D + (size_t)(r0 + r) * 2048) + lane; const GAS v2u* d1 = d0 + 512; v2u e0[8], e1[8];
#pragma unroll
                for (int j = 0; j < 8; ++j) { e0[j] = d0[64 * j]; e1[j] = d1[64 * j]; }
                GAS v2u* xo0 = (GAS v2u*)(XB + (size_t)(r0 + r) * 2048) + lane; GAS v2u* xo1 = xo0 + 512;
#pragma unroll
                for (int j = 0; j < 8; ++j) { v0[j] = v0[j] + up4(e0[j]); v1[j] = v1[j] + up4(e1[j]);
                    v2u w0, w1; w0.x = pk2(v0[j].x, v0[j].y); w0.y = pk2(v0[j].z, v0[j].w); w1.x = pk2(v1[j].x, v1[j].y); w1.y = pk2(v1[j].z, v1[j].w); xo0[64 * j] = w0; xo1[64 * j] = w1; } }
#pragma unroll
            for (int j = 0; j < 8; ++j) { s0 += (v0[j].x * v0[j].x + v0[j].y * v0[j].y) + (v0[j].z * v0[j].z + v0[j].w * v0[j].w); s1 += (v1[j].x * v1[j].x + v1[j].y * v1[j].y) + (v1[j].z * v1[j].z + v1[j].w * v1[j].w); }
            const float rstd0 = rsqrtf(wave_sum(s0) * (1.0f / 2048.0f) + EPS), rstd1 = rsqrtf(wave_sum(s1) * (1.0f / 2048.0f) + EPS);
            if constexpr (QI8) {
                float m0 = 0.f, m1 = 0.f;
#pragma unroll
                for (int j = 0; j < 8; ++j) { const f32x4 p = v0[j] * rstd0 * A[j] + B[j], q = v1[j] * rstd1 * A[j] + B[j];
                    m0 = fmaxf(fmaxf(m0, fmaxf(fabsf(p.x), fabsf(p.y))), fmaxf(fabsf(p.z), fabsf(p.w))); m1 = fmaxf(fmaxf(m1, fmaxf(fabsf(q.x), fabsf(q.y))), fmaxf(fabsf(q.z), fabsf(q.w))); }
#pragma unroll
                for (int o_ = 1; o_ < 64; o_ <<= 1) { m0 = fmaxf(m0, __shfl_xor(m0, o_)); m1 = fmaxf(m1, __shfl_xor(m1, o_)); }
                const float i0 = m0 > 0.f ? 127.0f / m0 : 0.f, i1 = m1 > 0.f ? 127.0f / m1 : 0.f;
                GAS unsigned* q0 = (GAS unsigned*)(HI8 + (size_t)(r0 + r) * 2048) + lane; GAS unsigned* q1 = q0 + 512;
#pragma unroll
                for (int j = 0; j < 8; ++j) { q0[64 * j] = pk_i8x4((v0[j] * rstd0 * A[j] + B[j]) * i0); q1[64 * j] = pk_i8x4((v1[j] * rstd1 * A[j] + B[j]) * i1); }
                if (lane == 0) { HS[r0 + r] = m0 * (1.0f / 127.0f); HS[r0 + r + 1] = m1 * (1.0f / 127.0f); }
                if (H) { GAS v2u* o8 = (GAS v2u*)(H + (size_t)(r0 + r) * 2048) + lane;
#pragma unroll
                    for (int j = 0; j < 8; ++j) { const f32x4 o = v0[j] * rstd0 * A[j] + B[j], p = v1[j] * rstd1 * A[j] + B[j]; v2u w; w.x = pk2(o.x, o.y); w.y = pk2(o.z, o.w); o8[64 * j] = w; w.x = pk2(p.x, p.y); w.y = pk2(p.z, p.w); o8[512 + 64 * j] = w; } }
            } else {
            GAS v2u* o8 = (GAS v2u*)(H + (size_t)(r0 + r) * 2048) + lane;
#pragma unroll
            for (int j = 0; j < 8; ++j) { const f32x4 o = v0[j] * rstd0 * A[j] + B[j]; v2u w; w.x = pk2(o.x, o.y); w.y = pk2(o.z, o.w); o8[64 * j] = w; }
#pragma unroll
            for (int j = 0; j < 8; ++j) { const f32x4 o = v1[j] * rstd1 * A[j] + B[j]; v2u w; w.x = pk2(o.x, o.y); w.y = pk2(o.z, o.w); o8[512 + 64 * j] = w; }
            }
        }
    }
}
__device__ __forceinline__ void phase_final(const bf16* XS, const bf16* D, float* xout, int gw, int NGW, int lane) {
    for (int r = 2 * gw; r < CH; r += 2 * NGW) {
        const GAS v2u* xr0 = (const GAS v2u*)(XS + (size_t)r * 2048) + lane; const GAS v2u* xr1 = xr0 + 512; const GAS v2u* d0 = (const GAS v2u*)(D + (size_t)r * 2048) + lane; const GAS v2u* d1 = d0 + 512;
        v2u x0[8], x1[8], e0[8], e1[8];
#pragma unroll
        for (int j = 0; j < 8; ++j) { x0[j] = xr0[64 * j]; x1[j] = xr1[64 * j]; e0[j] = d0[64 * j]; e1[j] = d1[64 * j]; }
        GAS f32x4* xo0 = (GAS f32x4*)(xout + (size_t)r * 2048) + lane; GAS f32x4* xo1 = xo0 + 512;
#pragma unroll
        for (int j = 0; j < 8; ++j) { xo0[64 * j] = up4(x0[j]) + up4(e0[j]); xo1[64 * j] = up4(x1[j]) + up4(e1[j]); }
    }
}
__device__ __forceinline__ int perm_tok(int p, int dsh, int Lsh) { return dsh == 0 ? p : (((p & ((1 << Lsh) - 1)) << dsh) + (p >> Lsh)); }
__device__ __forceinline__ void prep_qk_item(const bf16* Z, bf16* QK, const AL& a, int l, int item, int S, int tshift, int lane) {
    const int slot = item & 31, rb = item >> 5;
    int srccol, dstcol, dsh = 0, kind = 0; const float* gain; float scale = 1.f;
    if (slot < 4) { srccol = 128 * slot; dstcol = 128 * slot; gain = a.in(I_QNA) + l * 128; scale = QS128; }
    else if (slot < 8) { const int j = slot - 4; srccol = 512 + 128 * j; dstcol = 512 + 128 * j; gain = a.in(I_KNA) + l * 128; }
    else if (slot < 14) { const int j = slot - 8; srccol = 1536 + 128 * j; dstcol = 1024 + 128 * j; kind = 1; gain = a.in(I_QNB) + l * 128; scale = QS128; dsh = 2 * (j >> 1); }
    else if (slot < 20) { const int j = slot - 14; srccol = 2304 + 128 * j; dstcol = 1792 + 128 * j; kind = 1; gain = a.in(I_KNB) + l * 128; dsh = 2 * (j >> 1); }
    else if (slot < 26) { const int j = slot - 20; srccol = 3840 + 128 * j; dstcol = 2560 + 128 * j; kind = 2; gain = a.in(I_QNC) + l * 64; scale = QS64; }
    else { const int j = slot - 26; srccol = 4608 + 128 * j; dstcol = 3328 + 128 * j; kind = 2; gain = a.in(I_KNC) + l * 64; }
    const int sub = lane & 15, Lsh = tshift - dsh;
    float g[8];
#pragma unroll
    for (int e = 0; e < 8; ++e) g[e] = gain[((8 * sub) & (kind == 2 ? 63 : 127)) + e];
    const float2* ropeB = (const float2*)(a.ws() + WS_ROPEB); const float2* ropeC = (const float2*)(a.ws() + WS_ROPEC);
    const int RS = kind == 1 ? 2 : 1, subg = kind == 1 ? sub : (sub & 7);
    const bool roper = kind != 0 && subg < 2 * RS, first = subg < RS; const int ib = 8 * (subg & (RS - 1));
    for (int p4 = 0; p4 < 16; p4 += 4) {
        v4u w[4]; int tt[4]; float2 cs[4][8];
#pragma unroll
        for (int q = 0; q < 4; ++q) { const int orow = rb * 64 + (p4 + q) * 4 + (lane >> 4), sl = orow >> tshift, p = orow & (S - 1);
            tt[q] = perm_tok(p, dsh, Lsh);
            w[q] = *(const GAS v4u*)(Z + (size_t)((sl << tshift) + tt[q]) * 6144 + srccol + 8 * sub); }
        if (roper) {
#pragma unroll
            for (int q = 0; q < 4; ++q) { const float2* tab = kind == 1 ? ropeB + tt[q] * 16 + ib : ropeC + tt[q] * 8 + ib;
#pragma unroll
                for (int e = 0; e < 8; ++e) cs[q][e] = tab[e]; } }
#pragma unroll
        for (int q = 0; q < 4; ++q) { const int orow = rb * 64 + (p4 + q) * 4 + (lane >> 4);
            float y[8] = {bflo(w[q].x), bfhi(w[q].x), bflo(w[q].y), bfhi(w[q].y), bflo(w[q].z), bfhi(w[q].z), bflo(w[q].w), bfhi(w[q].w)};
            float ss = 0.f;
#pragma unroll
            for (int e = 0; e < 8; ++e) ss += y[e] * y[e];
            ss += __shfl_xor(ss, 1); ss += __shfl_xor(ss, 2); ss += __shfl_xor(ss, 4);
            if (kind != 2) ss += __shfl_xor(ss, 8);
            const float rstd = rsqrtf(ss * (kind == 2 ? (1.0f / 64.0f) : (1.0f / 128.0f)) + EPS);
#pragma unroll
            for (int e = 0; e < 8; ++e) y[e] = y[e] * rstd * g[e];
            if (kind != 0) {
                float pr[8];
#pragma unroll
                for (int e = 0; e < 8; ++e) pr[e] = __shfl_xor(y[e], RS);
                if (roper) {
#pragma unroll
                    for (int e = 0; e < 8; ++e) y[e] = first ? y[e] * cs[q][e].x - pr[e] * cs[q][e].y : y[e] * cs[q][e].x + pr[e] * cs[q][e].y; }
            }
            v4u o; o.x = pk2(y[0] * scale, y[1] * scale); o.y = pk2(y[2] * scale, y[3] * scale); o.z = pk2(y[4] * scale, y[5] * scale); o.w = pk2(y[6] * scale, y[7] * scale);
            *(GAS v4u*)(QK + (size_t)orow * 4096 + dstcol + 8 * sub) = o; }
    }
}
struct VtItem { int srccol, dsh, sl, p0, vrow; };
__device__ __forceinline__ VtItem vt_decode(int item, int S, int tshift, int nvh) {
    const int dh = item & 1, vh = 10 + (item >> 1) % nvh, pb = item / (2 * nvh); VtItem v; v.dsh = 0;
    v.srccol = 128 * vh; if (vh >= 4 && vh < 10) v.dsh = 2 * ((vh - 4) >> 1);
    v.srccol += 64 * dh; const int o0 = pb * 64; v.sl = o0 >> tshift; v.p0 = o0 & (S - 1); v.vrow = (v.sl * 16 + vh) * 128 + 64 * dh; return v;
}
__device__ __forceinline__ void vt_load(const bf16* Z, const VtItem& v, int tshift, v4u (&w)[8], int lane) {
    const int Lsh = tshift - v.dsh;
#pragma unroll
    for (int pass = 0; pass < 8; ++pass) { const int i = pass * 8 + (lane >> 3), c8 = lane & 7, t = perm_tok(v.p0 + i, v.dsh, Lsh);
        w[pass] = *(const GAS v4u*)(Z + (size_t)((v.sl << tshift) + t) * 2048 + v.srccol + 8 * c8); }
}
__device__ __forceinline__ void vt_store(bf16* VT, const VtItem& v, int S, const v4u (&w)[8], LAS unsigned short* T, int lane) {
#pragma unroll
    for (int pass = 0; pass < 8; ++pass) { const int i = pass * 8 + (lane >> 3), c8 = lane & 7;
        LAS unsigned short* tp = T + (8 * c8) * 68 + i;
        tp[0 * 68] = (unsigned short)(w[pass].x & 0xffffu); tp[1 * 68] = (unsigned short)(w[pass].x >> 16); tp[2 * 68] = (unsigned short)(w[pass].y & 0xffffu); tp[3 * 68] = (unsigned short)(w[pass].y >> 16);
        tp[4 * 68] = (unsigned short)(w[pass].z & 0xffffu); tp[5 * 68] = (unsigned short)(w[pass].z >> 16); tp[6 * 68] = (unsigned short)(w[pass].w & 0xffffu); tp[7 * 68] = (unsigned short)(w[pass].w >> 16); }
    LDS_WAIT(); asm volatile("" ::: "memory");
#pragma unroll
    for (int pass = 0; pass < 16; ++pass) { const int d = pass * 4 + (lane >> 4), c4 = lane & 15;
        const v2u x = *(const LAS v2u*)(T + d * 68 + 4 * c4);
        *(GAS v2u*)(VT + (size_t)(v.vrow + d) * S + v.p0 + 4 * c4) = x; }
    LDS_WAIT(); asm volatile("" ::: "memory");
}
__device__ __forceinline__ void phase_prep(const AL& a, int l, LAS unsigned char* lds, int S, int tshift, int gw, int NGW, int wave, int lane) {
    const bf16* Z = (const bf16*)(a.ws() + A_Z); bf16* VT = (bf16*)(a.ws() + A_VT);
    LAS unsigned short* T = (LAS unsigned short*)(lds + RING_OFF + wave * 16384);
    const int nvh = 6;
    { int it = gw; const int NIT = (CH / 64) * 2 * nvh;
      if (it < NIT) { VtItem cur = vt_decode(it, S, tshift, nvh); v4u w[8]; vt_load(Z, cur, tshift, w, lane);
          for (;;) { const int nx = it + NGW; const bool more = nx < NIT; VtItem nv = cur; v4u wn[8];
              if (more) { nv = vt_decode(nx, S, tshift, nvh); vt_load(Z, nv, tshift, wn, lane); }
              vt_store(VT, cur, S, w, T, lane);
              if (!more) break;
              cur = nv; it = nx;
#pragma unroll
              for (int i = 0; i < 8; ++i) w[i] = wn[i]; } } }
}

namespace att {
#define MFMA32(a, b, c) __builtin_amdgcn_mfma_f32_32x32x16_bf16((a), (b), (c), 0, 0, 0)
__device__ __forceinline__ float ex2(float x) { return __builtin_amdgcn_exp2f(x); }
struct MaskNone { static constexpr bool MASKED = false; __device__ __forceinline__ float operator()(float v, int) const { return v; } };
struct MaskB { static constexpr bool MASKED = true; int dq;
    __device__ __forceinline__ float operator()(float v, int koff) const { const int d = dq + koff; return (d >= -64 && d <= 64) ? v : NEGB; } };
struct MaskA { static constexpr bool MASKED = true; const LAS float* brow; int kc0, qc, cs;
    __device__ __forceinline__ float operator()(float v, int koff) const { const int kc = kc0 + koff; int di = kc - qc + 15; di = di < 0 ? 0 : (di > 30 ? 30 : di);
        const float b = brow[di]; return (kc >= cs && kc < cs + 16) ? v + b : NEGB; } };

template <int NK, class MaskFn>
__device__ __forceinline__ void tile_core(const bf16x8 (&kf)[NK], const bf16x8 (&vf)[4][2], const bf16x8 (&qf)[NK], f32x16 (&o)[4], float& m, float& l, int lane, const MaskFn& mf) {
    const int hi = lane >> 5;
    f32x16 s;
#pragma unroll
    for (int r = 0; r < 16; ++r) s[r] = 0.f;
#pragma unroll
    for (int d0 = 0; d0 < NK; ++d0) s = MFMA32(kf[d0], qf[d0], s);
    float mx = NEGB;
#pragma unroll
    for (int r = 0; r < 16; ++r) { s[r] = mf(s[r], 16 * (r >> 3) + 8 * hi + (r & 7)); mx = fmaxf(mx, s[r]); }
    mx = max32(mx);
    const float mn = fmaxf(m, mx), alpha = ex2(m - mn);
    float ps = 0.f;
#pragma unroll
    for (int r = 0; r < 16; ++r) { float p = ex2(s[r] - mn); if (MaskFn::MASKED) p = s[r] <= -1e29f ? 0.f : p; s[r] = p; ps += p; }
    l = l * alpha + ps; m = mn;
    if (!__all(alpha == 1.0f)) {
#pragma unroll
        for (int db = 0; db < 4; ++db)
#pragma unroll
            for (int r = 0; r < 16; ++r) o[db][r] *= alpha;
    }
    bf16x8 pf[2];
#pragma unroll
    for (int s2 = 0; s2 < 2; ++s2) { v4u w; w.x = pk2(s[8 * s2 + 0], s[8 * s2 + 1]); w.y = pk2(s[8 * s2 + 2], s[8 * s2 + 3]); w.z = pk2(s[8 * s2 + 4], s[8 * s2 + 5]); w.w = pk2(s[8 * s2 + 6], s[8 * s2 + 7]); pf[s2] = __builtin_bit_cast(bf16x8, w); }
#pragma unroll
    for (int db = 0; db < 4; ++db)
#pragma unroll
        for (int s2 = 0; s2 < 2; ++s2) o[db] = MFMA32(vf[db][s2], pf[s2], o[db]);
}
template <int NK, class MaskFn>
__device__ __forceinline__ void tile_step(const bf16* Kt, const bf16* VTt, int S, const bf16x8 (&qf)[NK], f32x16 (&o)[4], float& m, float& l, int lane, const MaskFn& mf) {
    const int r32 = lane & 31, hi = lane >> 5;
    const int pim = (r32 & 19) | ((r32 & 4) << 1) | ((r32 & 8) >> 1);
    const bf16* kp = Kt + (size_t)pim * 4096 + 8 * hi;
    bf16x8 kf[NK];
#pragma unroll
    for (int d0 = 0; d0 < NK; ++d0) kf[d0] = *(const GAS bf16x8*)(kp + 16 * d0);
    bf16x8 vf[4][2];
    const bf16* vp = VTt + (size_t)r32 * S + 8 * hi;
#pragma unroll
    for (int db = 0; db < 4; ++db)
#pragma unroll
        for (int s2 = 0; s2 < 2; ++s2) vf[db][s2] = *(const GAS bf16x8*)(vp + (size_t)(32 * db) * S + 16 * s2);
    tile_core<NK, MaskFn>(kf, vf, qf, o, m, l, lane, mf);
}
template <int NK> __device__ __forceinline__ void load_q(const bf16* Qp, bf16x8 (&qf)[NK], int lane) {
    const bf16* q = Qp + (size_t)(lane & 31) * 4096 + 8 * (lane >> 5);
#pragma unroll
    for (int d0 = 0; d0 < NK; ++d0) qf[d0] = *(const GAS bf16x8*)(q + 16 * d0);
}
__device__ __forceinline__ void zero_o(f32x16 (&o)[4]) {
#pragma unroll
    for (int db = 0; db < 4; ++db)
#pragma unroll
        for (int r = 0; r < 16; ++r) o[db][r] = 0.f;
}
__device__ __forceinline__ void store_o_bf16(bf16* dst, const f32x16 (&o)[4], float inv, int hi) {
#pragma unroll
    for (int db = 0; db < 4; ++db)
#pragma unroll
        for (int g = 0; g < 4; ++g) { v2u w; w.x = pk2(o[db][4 * g] * inv, o[db][4 * g + 1] * inv); w.y = pk2(o[db][4 * g + 2] * inv, o[db][4 * g + 3] * inv);
            *(GAS v2u*)(dst + 32 * db + 8 * g + 4 * hi) = w; }
}
__device__ __forceinline__ void store_o_f32(float* dst, const f32x16 (&o)[4], float inv, int hi) {
#pragma unroll
    for (int db = 0; db < 4; ++db)
#pragma unroll
        for (int g = 0; g < 4; ++g) { const f32x4 v = {o[db][4 * g] * inv, o[db][4 * g + 1] * inv, o[db][4 * g + 2] * inv, o[db][4 * g + 3] * inv};
            *(GAS f32x4*)(dst + 32 * db + 8 * g + 4 * hi) = v; }
}
__device__ __forceinline__ void wave_c(const bf16* QK, const bf16* VT, float* CTMP, int sl, int map, int q0, int S, int tshift, int lane) {
    const size_t row0 = (size_t)sl << tshift; const int hi = lane >> 5;
    const bf16* Kp = QK + row0 * 4096 + 3328 + 64 * map;
    const bf16* Vp = VT + (size_t)((sl * 16 + 10 + (map >> 1)) * 128) * S;
    bf16x8 qf[4]; load_q<4>(QK + (row0 + q0) * 4096 + 2560 + 64 * map, qf, lane);
    f32x16 o[4]; zero_o(o); float m = NEGB, l = 0.f; const MaskNone mf;
    for (int kb = 0; kb < S; kb += 32) tile_step<4, MaskNone>(Kp + (size_t)kb * 4096, Vp + kb, S, qf, o, m, l, lane, mf);
    l = sum32(l);
    store_o_f32(CTMP + (row0 + q0 + (lane & 31)) * 1536 + map * 128, o, 1.0f / l, hi);
}
__device__ __forceinline__ void wave_b(const bf16* QK, const bf16* VT, bf16* BTMP, float* BLSE, int sl, int slot, int p0, int S, int tshift, int lane) {
    const size_t row0 = (size_t)sl << tshift; const int hi = lane >> 5, dsh = 2 * (slot >> 1), Lsh = tshift - dsh;
    const bf16* Kp = QK + row0 * 4096 + 1792 + 128 * slot;
    const bf16* Vp = VT + (size_t)((sl * 16 + 4 + slot) * 128) * S;
    bf16x8 qf[8]; load_q<8>(QK + (row0 + p0) * 4096 + 1024 + 128 * slot, qf, lane);
    f32x16 o[4]; zero_o(o); float m = NEGB, l = 0.f;
    const int qp = p0 + (lane & 31);
#pragma unroll 1
    for (int ti = 0; ti < 5; ++ti) { const int kb = p0 - 64 + 32 * ti;
        if (kb < 0 || kb >= S || (kb >> Lsh) != (p0 >> Lsh)) continue;
        const MaskB mf{kb - qp};
        tile_step<8, MaskB>(Kp + (size_t)kb * 4096, Vp + kb, S, qf, o, m, l, lane, mf); }
    l = sum32(l);
    const int t = perm_tok(qp, dsh, Lsh);
    store_o_bf16(BTMP + (row0 + t) * 768 + slot * 128, o, 1.0f / l, hi);
    if (hi == 0) ((GAS float*)BLSE)[(row0 + t) * 8 + slot] = (__log2f(l) + m) * LN2;
}
__device__ __forceinline__ void wave_a(const bf16* QK, const bf16* VT, bf16* OA, const LAS float* btab, int sl, int h, int r, int qh, int S, int tshift, int lane) {
    const size_t row0 = (size_t)sl << tshift; const int hi = lane >> 5, rows = S >> 6;
    int rs = r - 4; rs = rs < 0 ? 0 : (rs > rows - 8 ? rows - 8 : rs);
    const bf16* Kp = QK + row0 * 4096 + 512 + 128 * h;
    const bf16* Vp = VT + (size_t)((sl * 16 + h) * 128) * S;
    const int q0 = r * 64 + 32 * qh, qc = 32 * qh + (lane & 31);
    int cs = qc - 8; cs = cs < 0 ? 0 : (cs > 48 ? 48 : cs);
    bf16x8 qf[8]; load_q<8>(QK + (row0 + q0) * 4096 + 128 * h, qf, lane);
    f32x16 o[4]; zero_o(o); float m = NEGB, l = 0.f;
#pragma unroll 1
    for (int ti = 0; ti < 16; ++ti) { const int j = ti >> 1, chh = ti & 1, kb = (rs + j) * 64 + 32 * chh;
        const MaskA mf{btab + (rs + j - r + 7) * 31, 32 * chh, qc, cs};
        tile_step<8, MaskA>(Kp + (size_t)kb * 4096, Vp + kb, S, qf, o, m, l, lane, mf); }
    l = sum32(l);
    store_o_bf16(OA + (row0 + q0 + (lane & 31)) * 1536 + h * 128, o, 1.0f / l, hi);
}

constexpr int CST = 24576;
__device__ __forceinline__ void glds16(const void* gsrc, unsigned lds_dst) { unsigned keep;
    asm volatile("s_mov_b32 %0, m0\n\ts_mov_b32 m0, %2\n\ts_nop 0\n\tglobal_load_lds_dwordx4 %1, off\n\ts_mov_b32 m0, %0" : "=&s"(keep) : "v"(gsrc), "s"(lds_dst) : "memory"); }
__device__ __forceinline__ void c_dma(const bf16* Kp, const bf16* Vp, int S, int kb, unsigned sb, int wave, int lane) {
    { const int row = 8 * wave + (lane >> 3), c = (lane & 7) ^ ((row >> 1) & 7);
      glds16(Kp + (size_t)(kb + row) * 4096 + 8 * c, (unsigned)__builtin_amdgcn_readfirstlane(sb + wave * 1024)); }
#pragma unroll
    for (int jj = 0; jj < 2; ++jj) { const int j = wave + 8 * jj, row = 8 * j + (lane >> 3), c = (lane & 7) ^ ((row >> 1) & 7);
      glds16(Vp + (size_t)row * S + kb + 8 * c, (unsigned)__builtin_amdgcn_readfirstlane(sb + 8192 + j * 1024)); }
}
#define C_WAIT_BAR(N) asm volatile("s_waitcnt vmcnt(" #N ")\n\ts_barrier" ::: "memory")
__device__ __forceinline__ void unit_c_fast(const bf16* QK, const bf16* VT, float* CTMP, LAS unsigned char* ring, int sl, int map, int qb, int S, int tshift, int wave, int lane) {
    constexpr int CV = 0;
    const size_t row0 = (size_t)sl << tshift; const int r32 = lane & 31, hi = lane >> 5, q0 = qb * 256 + 32 * wave;
    const bf16* Kp = QK + row0 * 4096 + 3328 + 64 * map;
    const bf16* Vp = VT + (size_t)((sl * 16 + 10 + (map >> 1)) * 128) * S;
    bf16x8 qf[4]; load_q<4>(QK + (row0 + q0) * 4096 + 2560 + 64 * map, qf, lane);
    const int pim = (r32 & 19) | ((r32 & 4) << 1) | ((r32 & 8) >> 1);
    int ka[4], va[4];
#pragma unroll
    for (int d0 = 0; d0 < 4; ++d0) ka[d0] = pim * 128 + (((2 * d0 + hi) ^ ((pim >> 1) & 7)) << 4);
#pragma unroll
    for (int x = 0; x < 4; ++x) va[x] = 8192 + r32 * 128 + (((2 * x + hi) ^ ((r32 >> 1) & 7)) << 4);
    f32x16 o[4]; zero_o(o); float l = 0.f;
    const int NT = S >> 6;
#pragma unroll
    for (int d0 = 0; d0 < 4; ++d0) asm volatile("" : "+v"(qf[d0]));
    asm volatile("s_waitcnt vmcnt(0)\n\ts_barrier" ::: "memory");
    const unsigned ring_a = (unsigned)(size_t)ring;
    c_dma(Kp, Vp, S, 0, ring_a, wave, lane); c_dma(Kp, Vp, S, 64, ring_a + CST, wave, lane);
    int st_cur = 0, st_nxt2 = 2 * CST;
#pragma unroll 1
    for (int t = 0; t < NT; ++t) {
        if (t + 1 < NT) C_WAIT_BAR(3); else C_WAIT_BAR(0);
        if (t + 2 < NT) c_dma(Kp, Vp, S, (t + 2) * 64, ring_a + st_nxt2, wave, lane);
        const LAS unsigned char* sb = ring + st_cur;
        bf16x8 kf[2][4];
#pragma unroll
        for (int st = 0; st < 2; ++st)
#pragma unroll
            for (int d0 = 0; d0 < 4; ++d0) { if (CV & 2) kf[st][d0] = qf[(d0 + st) & 3]; else kf[st][d0] = *(const LAS bf16x8*)(sb + st * 4096 + ka[d0]); }
        f32x16 s[2];
#pragma unroll
        for (int st = 0; st < 2; ++st) {
#pragma unroll
            for (int r = 0; r < 16; ++r) s[st][r] = 0.f;
#pragma unroll
            for (int d0 = 0; d0 < 4; ++d0) s[st] = MFMA32(kf[st][d0], qf[d0], s[st]); }
#pragma unroll
        for (int st = 0; st < 2; ++st) {
            bf16x8 vf[4][2];
#pragma unroll
            for (int db = 0; db < 4; ++db)
#pragma unroll
                for (int s2 = 0; s2 < 2; ++s2) vf[db][s2] = *(const LAS bf16x8*)(sb + db * 4096 + va[2 * st + s2]);
#pragma unroll
            for (int r = 0; r < 16; ++r) { s[st][r] = ex2(s[st][r]); l += s[st][r]; }
            bf16x8 pf[2];
#pragma unroll
            for (int s2 = 0; s2 < 2; ++s2) { v4u w; w.x = pk2(s[st][8 * s2 + 0], s[st][8 * s2 + 1]); w.y = pk2(s[st][8 * s2 + 2], s[st][8 * s2 + 3]); w.z = pk2(s[st][8 * s2 + 4], s[st][8 * s2 + 5]); w.w = pk2(s[st][8 * s2 + 6], s[st][8 * s2 + 7]); pf[s2] = __builtin_bit_cast(bf16x8, w); }
#pragma unroll
            for (int db = 0; db < 4; ++db)
#pragma unroll
                for (int s2 = 0; s2 < 2; ++s2) o[db] = MFMA32(vf[db][s2], pf[s2], o[db]);
        }
        st_cur = st_cur == 2 * CST ? 0 : st_cur + CST; st_nxt2 = st_nxt2 == 2 * CST ? 0 : st_nxt2 + CST;
    }
    l = sum32(l);
    store_o_f32(CTMP + (row0 + q0 + r32) * 1536 + map * 128, o, 1.0f / l, hi);
}

constexpr int CST2 = 32768, CEXP = 132;
typedef short v4i16_t __attribute__((ext_vector_type(4)));
__device__ __forceinline__ v4i16_t vtr(const LAS unsigned char* p) { return __builtin_amdgcn_ds_read_tr16_b64_v4i16((LAS v4i16_t*)p); }
__device__ __forceinline__ void c2_dma(const bf16* Kp0, const bf16* Vrow, int kb, unsigned sb, int wave, int lane) {
    { const int row = 8 * wave + (lane >> 3), c = (lane & 7) ^ ((row >> 1) & 7);
      const bf16* src = Kp0 + (size_t)(kb + row) * 4096 + 8 * c;
      glds16(src, (unsigned)__builtin_amdgcn_readfirstlane(sb + wave * 1024));
      glds16(src + 64, (unsigned)__builtin_amdgcn_readfirstlane(sb + 8192 + wave * 1024)); }
#pragma unroll
    for (int jj = 0; jj < 2; ++jj) { const int j = wave + 8 * jj, st = j >> 3, row = 4 * (j & 7) + (lane >> 4), ch = (lane & 15) ^ (((row & 3) << 2) | ((row >> 2) & 3));
      glds16(Vrow + (size_t)(kb + 32 * st + row) * 2048 + 8 * ch, (unsigned)__builtin_amdgcn_readfirstlane(sb + 16384 + j * 1024)); }
}
template <int CV = 0>
__device__ __forceinline__ void unit_c_fused(const bf16* QK, const bf16* Zv, bf16* OC, const float* subln, float lam, float onemli, LAS unsigned char* ring, int sl, int h, int qb, int S, int tshift, int wave, int lane) {
    const size_t row0 = (size_t)sl << tshift; const int r32 = lane & 31, hi = lane >> 5, mp = wave >> 2, q0 = qb * 128 + 32 * (wave & 3);
    const bf16* Kp0 = QK + row0 * 4096 + 3328 + 128 * h;
    const bf16* Vrow = Zv + row0 * 2048 + 1280 + 128 * h;
    bf16x8 qf[4]; load_q<4>(QK + (row0 + q0) * 4096 + 2560 + 128 * h + 64 * mp, qf, lane);
    const int pim = (r32 & 19) | ((r32 & 4) << 1) | ((r32 & 8) >> 1);
    int ka[4];
#pragma unroll
    for (int d0 = 0; d0 < 4; ++d0) ka[d0] = mp * 8192 + pim * 128 + (((2 * d0 + hi) ^ ((pim >> 1) & 7)) << 4);
    const int tq = (lane & 15) >> 2, tp = lane & 3, tblk = (lane >> 4) & 1;
    const int vlane = 16384 + 256 * (8 * hi + tq) + 8 * (tp & 1);
    int vo[4][2];
#pragma unroll
    for (int db = 0; db < 4; ++db)
#pragma unroll
        for (int t = 0; t < 2; ++t) vo[db][t] = vlane + 1024 * t + 16 * ((((db ^ tq) & 3) << 2) | ((2 * tblk + (tp >> 1)) ^ ((2 * hi + t) & 3)));
    f32x16 o[4]; zero_o(o); float l = 0.f;
    const int NT = S >> 6;
#pragma unroll
    for (int d0 = 0; d0 < 4; ++d0) asm volatile("" : "+v"(qf[d0]));
    asm volatile("s_waitcnt vmcnt(0)\n\ts_barrier" ::: "memory");
    const unsigned ring_a = (unsigned)(size_t)ring;
    c2_dma(Kp0, Vrow, 0, ring_a, wave, lane); c2_dma(Kp0, Vrow, 64, ring_a + CST2, wave, lane);
    int st_cur = 0, st_nxt2 = 2 * CST2;
    if (CV & 16) C_WAIT_BAR(0);
#pragma unroll 1
    for (int t = 0; t < NT; ++t) {
        if (!(CV & 16)) { if (t + 1 < NT) C_WAIT_BAR(4); else C_WAIT_BAR(0); }
        const LAS unsigned char* sb = ring + st_cur;
        bf16x8 kf[2][4];
#pragma unroll
        for (int st = 0; st < 2; ++st)
#pragma unroll
            for (int d0 = 0; d0 < 4; ++d0) { if (CV & 2) kf[st][d0] = qf[(d0 + st) & 3]; else kf[st][d0] = *(const LAS bf16x8*)(sb + st * 4096 + ka[d0]); }
        f32x16 s[2];
#pragma unroll
        for (int st = 0; st < 2; ++st) {
#pragma unroll
            for (int r = 0; r < 16; ++r) s[st][r] = 0.f;
#pragma unroll
            for (int d0 = 0; d0 < 4; ++d0) s[st] = MFMA32(kf[st][d0], qf[d0], s[st]); }
        if (!(CV & 8)) if (t + 2 < NT) c2_dma(Kp0, Vrow, (t + 2) * 64, ring_a + st_nxt2, wave, lane);
#pragma unroll
        for (int st = 0; st < 2; ++st) {
            bf16x8 vf[4][2];
#pragma unroll
            for (int db = 0; db < 4; ++db)
#pragma unroll
                for (int s2 = 0; s2 < 2; ++s2) { if (CV & 4) { vf[db][s2] = qf[(db + s2) & 3]; } else { const v4i16_t lo = vtr(sb + st * 8192 + s2 * 4096 + vo[db][0]), hi4 = vtr(sb + st * 8192 + s2 * 4096 + vo[db][1]);
                    vf[db][s2] = (bf16x8){lo[0], lo[1], lo[2], lo[3], hi4[0], hi4[1], hi4[2], hi4[3]}; } }
#pragma unroll
            for (int r = 0; r < 16; ++r) { if (!(CV & 1)) s[st][r] = ex2(s[st][r]); l += s[st][r]; }
            bf16x8 pf[2];
#pragma unroll
            for (int s2 = 0; s2 < 2; ++s2) { v4u w; w.x = pk2(s[st][8 * s2 + 0], s[st][8 * s2 + 1]); w.y = pk2(s[st][8 * s2 + 2], s[st][8 * s2 + 3]); w.z = pk2(s[st][8 * s2 + 4], s[st][8 * s2 + 5]); w.w = pk2(s[st][8 * s2 + 6], s[st][8 * s2 + 7]); pf[s2] = __builtin_bit_cast(bf16x8, w); }
#pragma unroll
            for (int db = 0; db < 4; ++db)
#pragma unroll
                for (int s2 = 0; s2 < 2; ++s2) o[db] = MFMA32(vf[db][s2], pf[s2], o[db]);
        }
        st_cur = st_cur == 2 * CST2 ? 0 : st_cur + CST2; st_nxt2 = st_nxt2 == 2 * CST2 ? 0 : st_nxt2 + CST2;
    }
    l = sum32(l);
    const float inv = 1.0f / l;
    LAS float* ex = (LAS float*)ring + (32 * (wave & 3) + r32) * CEXP + 4 * hi;
    asm volatile("s_waitcnt lgkmcnt(0)\n\ts_barrier" ::: "memory");
    if (mp == 1) {
#pragma unroll
        for (int db = 0; db < 4; ++db)
#pragma unroll
            for (int g = 0; g < 4; ++g) *(LAS f32x4*)(ex + 32 * db + 8 * g) = (f32x4){o[db][4 * g] * inv, o[db][4 * g + 1] * inv, o[db][4 * g + 2] * inv, o[db][4 * g + 3] * inv};
    }
    asm volatile("s_waitcnt lgkmcnt(0)\n\ts_barrier" ::: "memory");
    if (mp == 0) {
        float ss = 0.f;
#pragma unroll
        for (int db = 0; db < 4; ++db)
#pragma unroll
            for (int g = 0; g < 4; ++g) { const f32x4 o2 = *(const LAS f32x4*)(ex + 32 * db + 8 * g);
#pragma unroll
                for (int e = 0; e < 4; ++e) { const float x = o[db][4 * g + e] * inv - lam * o2[e]; o[db][4 * g + e] = x; ss += x * x; } }
        ss = sum32(ss);
        const float rstd = rsqrtf(ss * (1.0f / 128.0f) + EPS) * onemli;
        bf16* dst = OC + (row0 + q0 + r32) * 1536 + h * 128;
#pragma unroll
        for (int db = 0; db < 4; ++db)
#pragma unroll
            for (int g = 0; g < 4; ++g) { const f32x4 gn = *(const GAS f32x4*)(subln + 32 * db + 8 * g + 4 * hi);
                v2u w; w.x = pk2(o[db][4 * g] * rstd * gn[0], o[db][4 * g + 1] * rstd * gn[1]); w.y = pk2(o[db][4 * g + 2] * rstd * gn[2], o[db][4 * g + 3] * rstd * gn[3]);
                *(GAS v2u*)(dst + 32 * db + 8 * g + 4 * hi) = w; }
    }
}

constexpr int CSTA = 32768;
typedef short a_v4i16_t __attribute__((ext_vector_type(4)));
__device__ __forceinline__ a_v4i16_t a_vtr(const LAS unsigned char* p) { return __builtin_amdgcn_ds_read_tr16_b64_v4i16((LAS a_v4i16_t*)p); }
__device__ __forceinline__ void a_dma(const bf16* Kp, const bf16* Vrow, int kb, unsigned sb, int wave, int lane) {
#pragma unroll
    for (int jj = 0; jj < 2; ++jj) { const int j = wave + 8 * jj, row = 4 * j + (lane >> 4), c = (lane & 15) ^ (row & 15);
      glds16(Kp + (size_t)(kb + row) * 4096 + 8 * c, (unsigned)__builtin_amdgcn_readfirstlane(sb + j * 1024)); }
#pragma unroll
    for (int jj = 0; jj < 2; ++jj) { const int j = wave + 8 * jj, st = j >> 3, row = 4 * (j & 7) + (lane >> 4), ch = (lane & 15) ^ (((row & 3) << 2) | ((row >> 2) & 3));
      glds16(Vrow + (size_t)(kb + 32 * st + row) * 2048 + 8 * ch, (unsigned)__builtin_amdgcn_readfirstlane(sb + 16384 + j * 1024)); }
}
__device__ __forceinline__ void unit_a_lds(const bf16* QK, const bf16* Zv, bf16* OA, const float* rpb, LAS float* btab, LAS unsigned char* ring, int sl, int h, int qb, int S, int tshift, int wave, int lane, int tid) {
    const size_t row0 = (size_t)sl << tshift; const int r32 = lane & 31, hi = lane >> 5, rows = S >> 6;
    const int r = 4 * qb + (wave >> 1), qh = wave & 1;
    int rs = r - 4; rs = rs < 0 ? 0 : (rs > rows - 8 ? rows - 8 : rs);
    int kr_lo = 4 * qb - 4; kr_lo = kr_lo < 0 ? 0 : (kr_lo > rows - 8 ? rows - 8 : kr_lo);
    int kr_hi = 4 * qb - 1; kr_hi = (kr_hi < 0 ? 0 : (kr_hi > rows - 8 ? rows - 8 : kr_hi)) + 8;
    const int NT = kr_hi - kr_lo;
    const bf16* Kp = QK + row0 * 4096 + 512 + 128 * h;
    const bf16* Vrow = Zv + row0 * 2048 + 128 * h;
    const int q0 = r * 64 + 32 * qh, qc = 32 * qh + r32;
    int cs = qc - 8; cs = cs < 0 ? 0 : (cs > 48 ? 48 : cs);
    bf16x8 qf[8]; load_q<8>(QK + (row0 + q0) * 4096 + 128 * h, qf, lane);
    const int pim = (r32 & 19) | ((r32 & 4) << 1) | ((r32 & 8) >> 1);
    const int kbase = pim * 256, kx = pim & 15;
    const int tq = (lane & 15) >> 2, tp = lane & 3, tblk = (lane >> 4) & 1, vlane = 16384 + 256 * (8 * hi + tq) + 8 * (tp & 1);
    int vo[4][2];
#pragma unroll
    for (int db = 0; db < 4; ++db)
#pragma unroll
        for (int t = 0; t < 2; ++t) vo[db][t] = vlane + 1024 * t + 16 * ((((db ^ tq) & 3) << 2) | ((2 * tblk + (tp >> 1)) ^ ((2 * hi + t) & 3)));
    f32x16 o[4]; zero_o(o); float m = NEGB, l = 0.f;
#pragma unroll
    for (int d0 = 0; d0 < 8; ++d0) asm volatile("" : "+v"(qf[d0]));
    asm volatile("s_waitcnt vmcnt(0)\n\ts_barrier" ::: "memory");
    for (int e = tid; e < 15 * 31; e += NWAVES * 64) btab[e] = rpb[e] * LOG2E;
    asm volatile("s_waitcnt vmcnt(0) lgkmcnt(0)" ::: "memory");
    const unsigned ring_a = (unsigned)(size_t)ring;
    a_dma(Kp, Vrow, kr_lo * 64, ring_a, wave, lane); a_dma(Kp, Vrow, (kr_lo + 1) * 64, ring_a + CSTA, wave, lane);
    int st_cur = 0, st_nxt2 = 2 * CSTA;
#pragma unroll 1
    for (int t = 0; t < NT; ++t) { const int kr = kr_lo + t;
        if (t + 1 < NT) C_WAIT_BAR(4); else C_WAIT_BAR(0);
        if (t + 2 < NT) a_dma(Kp, Vrow, (kr + 2) * 64, ring_a + st_nxt2, wave, lane);
        if (kr >= rs && kr < rs + 8) { const LAS unsigned char* sb = ring + st_cur;
#pragma unroll 1
            for (int chh = 0; chh < 2; ++chh) {
                bf16x8 kf[8];
#pragma unroll
                for (int d0 = 0; d0 < 8; ++d0) kf[d0] = *(const LAS bf16x8*)(sb + chh * 8192 + kbase + (((2 * d0 + hi) ^ kx) << 4));
                bf16x8 vf[4][2];
#pragma unroll
                for (int db = 0; db < 4; ++db)
#pragma unroll
                    for (int s2 = 0; s2 < 2; ++s2) { const a_v4i16_t lo = a_vtr(sb + chh * 8192 + s2 * 4096 + vo[db][0]), hi4 = a_vtr(sb + chh * 8192 + s2 * 4096 + vo[db][1]);
                        vf[db][s2] = (bf16x8){lo[0], lo[1], lo[2], lo[3], hi4[0], hi4[1], hi4[2], hi4[3]}; }
                const MaskA mf{btab + (kr - r + 7) * 31, 32 * chh, qc, cs};
                tile_core<8, MaskA>(kf, vf, qf, o, m, l, lane, mf); } }
        st_cur = st_cur == 2 * CSTA ? 0 : st_cur + CSTA; st_nxt2 = st_nxt2 == 2 * CSTA ? 0 : st_nxt2 + CSTA;
    }
    l = sum32(l);
    store_o_bf16(OA + (row0 + q0 + r32) * 1536 + h * 128, o, 1.0f / l, hi);
}

struct MaskB2 { static constexpr bool MASKED = true; int qp, kp0, Lsh, qcls;
    __device__ __forceinline__ float operator()(float v, int koff) const { const int kp = kp0 + koff, d = kp - qp; return (d >= -64 && d <= 64 && (kp >> Lsh) == qcls) ? v : NEGB; } };
__device__ __forceinline__ void b_dma(const bf16* Kp, const bf16* Vrow, int S, int dsh, int Lsh, int kp0, unsigned sb, int wave, int lane) {
#pragma unroll
    for (int jj = 0; jj < 2; ++jj) { const int j = wave + 8 * jj, row = 4 * j + (lane >> 4), c = (lane & 15) ^ (row & 15);
      int kp = kp0 + row; kp = kp < 0 ? 0 : (kp > S - 1 ? S - 1 : kp);
      glds16(Kp + (size_t)kp * 4096 + 8 * c, (unsigned)__builtin_amdgcn_readfirstlane(sb + j * 1024)); }
#pragma unroll
    for (int jj = 0; jj < 2; ++jj) { const int j = wave + 8 * jj, st = j >> 3, row = 4 * (j & 7) + (lane >> 4), ch = (lane & 15) ^ (((row & 3) << 2) | ((row >> 2) & 3));
      int kp = kp0 + 32 * st + row; kp = kp < 0 ? 0 : (kp > S - 1 ? S - 1 : kp);
      glds16(Vrow + (size_t)perm_tok(kp, dsh, Lsh) * 2048 + 8 * ch, (unsigned)__builtin_amdgcn_readfirstlane(sb + 16384 + j * 1024)); }
}
__device__ __forceinline__ void unit_b_lds(const bf16* QK, const bf16* Zv, bf16* BTMP, float* BLSE, LAS unsigned char* ring, int sl, int slot, int pb, int S, int tshift, int wave, int lane) {
    const size_t row0 = (size_t)sl << tshift; const int r32 = lane & 31, hi = lane >> 5, dsh = 2 * (slot >> 1), Lsh = tshift - dsh;
    const int p0 = pb * 256, qp = p0 + 32 * wave + r32;
    const bf16* Kp = QK + row0 * 4096 + 1792 + 128 * slot;
    const bf16* Vrow = Zv + row0 * 2048 + 512 + 128 * slot;
    bf16x8 qf[8]; load_q<8>(QK + (row0 + p0 + 32 * wave) * 4096 + 1024 + 128 * slot, qf, lane);
    const int pim = (r32 & 19) | ((r32 & 4) << 1) | ((r32 & 8) >> 1);
    const int kbase = pim * 256, kx = pim & 15;
    const int tq = (lane & 15) >> 2, tp = lane & 3, tblk = (lane >> 4) & 1, vlane = 16384 + 256 * (8 * hi + tq) + 8 * (tp & 1);
    int vo[4][2];
#pragma unroll
    for (int db = 0; db < 4; ++db)
#pragma unroll
        for (int t = 0; t < 2; ++t) vo[db][t] = vlane + 1024 * t + 16 * ((((db ^ tq) & 3) << 2) | ((2 * tblk + (tp >> 1)) ^ ((2 * hi + t) & 3)));
    f32x16 o[4]; zero_o(o); float m = NEGB, l = 0.f;
#pragma unroll
    for (int d0 = 0; d0 < 8; ++d0) asm volatile("" : "+v"(qf[d0]));
    asm volatile("s_waitcnt vmcnt(0)\n\ts_barrier" ::: "memory");
    const unsigned ring_a = (unsigned)(size_t)ring;
    const int kpo = p0 - 64;
    b_dma(Kp, Vrow, S, dsh, Lsh, kpo, ring_a, wave, lane); b_dma(Kp, Vrow, S, dsh, Lsh, kpo + 64, ring_a + CSTA, wave, lane);
    int st_cur = 0, st_nxt2 = 2 * CSTA;
    const int jlo = wave >> 1, qcls = qp >> Lsh;
#pragma unroll 1
    for (int t = 0; t < 6; ++t) {
        if (t + 1 < 6) C_WAIT_BAR(4); else C_WAIT_BAR(0);
        if (t + 2 < 6) b_dma(Kp, Vrow, S, dsh, Lsh, kpo + 64 * (t + 2), ring_a + st_nxt2, wave, lane);
        if (t >= jlo && t <= jlo + 2) { const LAS unsigned char* sb = ring + st_cur;
#pragma unroll 1
            for (int chh = 0; chh < 2; ++chh) { const int ks = 64 * t + 32 * chh;
                if (ks + 32 <= 32 * wave || ks >= 32 * wave + 160) continue;
                bf16x8 kf[8];
#pragma unroll
                for (int d0 = 0; d0 < 8; ++d0) kf[d0] = *(const LAS bf16x8*)(sb + chh * 8192 + kbase + (((2 * d0 + hi) ^ kx) << 4));
                bf16x8 vf[4][2];
#pragma unroll
                for (int db = 0; db < 4; ++db)
#pragma unroll
                    for (int s2 = 0; s2 < 2; ++s2) { const a_v4i16_t lo = a_vtr(sb + chh * 8192 + s2 * 4096 + vo[db][0]), hi4 = a_vtr(sb + chh * 8192 + s2 * 4096 + vo[db][1]);
                        vf[db][s2] = (bf16x8){lo[0], lo[1], lo[2], lo[3], hi4[0], hi4[1], hi4[2], hi4[3]}; }
                const MaskB2 mf{qp, kpo + ks, Lsh, qcls};
                tile_core<8, MaskB2>(kf, vf, qf, o, m, l, lane, mf); } }
        st_cur = st_cur == 2 * CSTA ? 0 : st_cur + CSTA; st_nxt2 = st_nxt2 == 2 * CSTA ? 0 : st_nxt2 + CSTA;
    }
    l = sum32(l);
    const int tok = perm_tok(qp, dsh, Lsh);
    store_o_bf16(BTMP + (row0 + tok) * 768 + slot * 128, o, 1.0f / l, hi);
    if (hi == 0) ((GAS float*)BLSE)[(row0 + tok) * 8 + slot] = (__log2f(l) + m) * LN2;
}
}

template <int CV = 0>
__device__ __forceinline__ void phase_attn(const AL& a, int l, LAS unsigned char* lds, int S, int tshift, int tid, int wave, int lane, int types = 7) {
    const bf16* QK = (const bf16*)(a.ws() + A_QK); const bf16* VT = (const bf16*)(a.ws() + A_VT);
    const int nqb = S >> 8, nseq = CH >> tshift;
    const int G = gridDim.x, vid = (G % 8 == 0) ? (blockIdx.x % 8) * (G / 8) + blockIdx.x / 8 : blockIdx.x;
    if (types & 1) { float* CTMP = (float*)(a.ws() + A_CTMP); const float cbound = ((const float*)(a.ws() + WS_LAM))[2 + l];
      if (cbound <= 64.0f) { const int nq2 = S >> 7;
          const float lam = ((const float*)(a.ws() + WS_LAM))[l], onemli = 1.0f - (0.8f - 0.6f * expf(-0.3f * (float)l));
          bf16* OC = (bf16*)(a.ws() + A_OA) + 768; const float* subln = a.in(I_SUBLN) + l * 128;
          for (int u = vid; u < nseq * 6 * nq2; u += G) { const int qb = u % nq2, h = (u / nq2) % 6, sl = u / (nq2 * 6);
              att::unit_c_fused<CV>(QK, (const bf16*)(a.ws() + A_Z), OC, subln, lam, onemli, lds + RING_OFF, sl, h, qb, S, tshift, wave, lane); }
      } else {
          for (int u = vid; u < nseq * 12 * nqb; u += G) { const int qb = u % nqb, map = (u / nqb) % 12, sl = u / (nqb * 12);
              att::wave_c(QK, VT, CTMP, sl, map, qb * 256 + 32 * wave, S, tshift, lane); } } }
    if (types & 2) { bf16* OA = (bf16*)(a.ws() + A_OA); LAS float* btab = (LAS float*)(lds + LDSCTL_OFF + 1024);
      for (int u = vid; u < nseq * 4 * nqb; u += G) { const int qb = u % nqb, h = (u / nqb) % 4, sl = u / (nqb * 4);
          att::unit_a_lds(QK, (const bf16*)(a.ws() + A_Z), OA, a.in(I_RPB) + (size_t)(l * 4 + h) * 465, btab, lds + RING_OFF, sl, h, qb, S, tshift, wave, lane, tid); }
      __syncthreads(); }
    if (types & 4) { bf16* BTMP = (bf16*)(a.ws() + A_BTMP); float* BLSE = (float*)(a.ws() + A_BLSE);
      for (int u = vid; u < nseq * 6 * nqb; u += G) { const int pb = u % nqb, slot = (u / nqb) % 6, sl = u / (nqb * 6);
          att::unit_b_lds(QK, (const bf16*)(a.ws() + A_Z), BTMP, BLSE, lds + RING_OFF, sl, slot, pb, S, tshift, wave, lane); }
      __syncthreads(); }
}
__device__ __forceinline__ void phase_combine(const AL& a, int l, int gw, int NGW, int lane) {
    const bool do_c = ((const float*)(a.ws() + WS_LAM))[2 + l] > 64.0f;
    const int nsh = do_c ? 3 : 1, nsm = (1 << nsh) - 1;
    const bf16* BTMP = (const bf16*)(a.ws() + A_BTMP); const float* BLSE = (const float*)(a.ws() + A_BLSE); const float* CTMP = (const float*)(a.ws() + A_CTMP);
    bf16* OB = (bf16*)(a.ws() + A_OA) + 512; bf16* OC = (bf16*)(a.ws() + A_OA) + 768;
    const float lam = ((const float*)(a.ws() + WS_LAM))[l], lam_init = 0.8f - 0.6f * expf(-0.3f * (float)l);
    const float* subln = a.in(I_SUBLN) + l * 128;
    const int sub = lane & 15, d0 = 8 * sub;
    const int NIT = (CH / 4) << nsh;
    if ((NGW & 7) == 0) {
        const int slot = gw & nsm;
        if (slot < 2) { const int hg = slot;
            for (int it = gw; it < NIT; it += 2 * NGW) { const bool two = it + NGW < NIT;
                const size_t rowa = (size_t)(it >> nsh) * 4 + (lane >> 4), rowb = two ? (size_t)((it + NGW) >> nsh) * 4 + (lane >> 4) : rowa;
                float la[3], lb[3]; v4u xa[3], xb[3];
#pragma unroll
                for (int g = 0; g < 3; ++g) { la[g] = ((const GAS float*)BLSE)[rowa * 8 + 2 * g + hg]; lb[g] = ((const GAS float*)BLSE)[rowb * 8 + 2 * g + hg];
                    xa[g] = *(const GAS v4u*)(BTMP + rowa * 768 + (2 * g + hg) * 128 + d0); xb[g] = *(const GAS v4u*)(BTMP + rowb * 768 + (2 * g + hg) * 128 + d0); }
#pragma unroll
                for (int q = 0; q < 2; ++q) { if (q == 1 && !two) break;
                    const float l0 = q ? lb[0] : la[0], l1 = q ? lb[1] : la[1], l2 = q ? lb[2] : la[2]; const v4u a0 = q ? xb[0] : xa[0], a1 = q ? xb[1] : xa[1], a2 = q ? xb[2] : xa[2];
                    const float mx = fmaxf(l0, fmaxf(l1, l2)); float w0 = __expf(l0 - mx), w1 = __expf(l1 - mx), w2 = __expf(l2 - mx);
                    const float inv = 1.0f / (w0 + w1 + w2); w0 *= inv; w1 *= inv; w2 *= inv;
                    v4u o;
                    o.x = pk2(w0 * bflo(a0.x) + w1 * bflo(a1.x) + w2 * bflo(a2.x), w0 * bfhi(a0.x) + w1 * bfhi(a1.x) + w2 * bfhi(a2.x));
                    o.y = pk2(w0 * bflo(a0.y) + w1 * bflo(a1.y) + w2 * bflo(a2.y), w0 * bfhi(a0.y) + w1 * bfhi(a1.y) + w2 * bfhi(a2.y));
                    o.z = pk2(w0 * bflo(a0.z) + w1 * bflo(a1.z) + w2 * bflo(a2.z), w0 * bfhi(a0.z) + w1 * bfhi(a1.z) + w2 * bfhi(a2.z));
                    o.w = pk2(w0 * bflo(a0.w) + w1 * bflo(a1.w) + w2 * bflo(a2.w), w0 * bfhi(a0.w) + w1 * bfhi(a1.w) + w2 * bfhi(a2.w));
                    *(GAS v4u*)(OB + (q ? rowb : rowa) * 1536 + hg * 128 + d0) = o; } }
        } else { const int h = slot - 2;
            const f32x4 g0 = *(const GAS f32x4*)(subln + d0), g1 = *(const GAS f32x4*)(subln + d0 + 4);
            for (int it = gw; it < NIT; it += 2 * NGW) { const bool two = it + NGW < NIT;
                const size_t rowa = (size_t)(it >> nsh) * 4 + (lane >> 4), rowb = two ? (size_t)((it + NGW) >> nsh) * 4 + (lane >> 4) : rowa;
                const float* pa = CTMP + rowa * 1536 + (2 * h) * 128 + d0; const float* pb = CTMP + rowb * 1536 + (2 * h) * 128 + d0;
                const f32x4 a10 = *(const f32x4*)pa, a11 = *(const GAS f32x4*)(pa + 4), a20 = *(const GAS f32x4*)(pa + 128), a21 = *(const GAS f32x4*)(pa + 132);
                const f32x4 b10 = *(const f32x4*)pb, b11 = *(const GAS f32x4*)(pb + 4), b20 = *(const GAS f32x4*)(pb + 128), b21 = *(const GAS f32x4*)(pb + 132);
#pragma unroll
                for (int q = 0; q < 2; ++q) { if (q == 1 && !two) break;
                    const f32x4 x0 = q ? b10 - lam * b20 : a10 - lam * a20, x1 = q ? b11 - lam * b21 : a11 - lam * a21;
                    float ss = (x0.x * x0.x + x0.y * x0.y) + (x0.z * x0.z + x0.w * x0.w) + (x1.x * x1.x + x1.y * x1.y) + (x1.z * x1.z + x1.w * x1.w);
                    ss += shx<1>(ss); ss += shx<2>(ss); ss += shx<4>(ss); ss += shx<8>(ss);
                    const float rstd = rsqrtf(ss * (1.0f / 128.0f) + EPS) * (1.0f - lam_init);
                    v4u o; o.x = pk2(x0.x * rstd * g0.x, x0.y * rstd * g0.y); o.y = pk2(x0.z * rstd * g0.z, x0.w * rstd * g0.w);
                    o.z = pk2(x1.x * rstd * g1.x, x1.y * rstd * g1.y); o.w = pk2(x1.z * rstd * g1.z, x1.w * rstd * g1.w);
                    *(GAS v4u*)(OC + (q ? rowb : rowa) * 1536 + h * 128 + d0) = o; } }
        }
        return;
    }
    for (int it = gw; it < NIT; it += NGW) { const int slot = it & nsm; const size_t row = (size_t)(it >> nsh) * 4 + (lane >> 4);
        if (slot < 2) { const int hg = slot;
            const float l0 = BLSE[row * 8 + hg], l1 = BLSE[row * 8 + 2 + hg], l2 = BLSE[row * 8 + 4 + hg];
            const float mx = fmaxf(l0, fmaxf(l1, l2)); float w0 = __expf(l0 - mx), w1 = __expf(l1 - mx), w2 = __expf(l2 - mx);
            const float inv = 1.0f / (w0 + w1 + w2); w0 *= inv; w1 *= inv; w2 *= inv;
            const v4u a0 = *(const GAS v4u*)(BTMP + row * 768 + (0 + hg) * 128 + d0), a1 = *(const GAS v4u*)(BTMP + row * 768 + (2 + hg) * 128 + d0), a2 = *(const GAS v4u*)(BTMP + row * 768 + (4 + hg) * 128 + d0);
            v4u o;
            o.x = pk2(w0 * bflo(a0.x) + w1 * bflo(a1.x) + w2 * bflo(a2.x), w0 * bfhi(a0.x) + w1 * bfhi(a1.x) + w2 * bfhi(a2.x));
            o.y = pk2(w0 * bflo(a0.y) + w1 * bflo(a1.y) + w2 * bflo(a2.y), w0 * bfhi(a0.y) + w1 * bfhi(a1.y) + w2 * bfhi(a2.y));
            o.z = pk2(w0 * bflo(a0.z) + w1 * bflo(a1.z) + w2 * bflo(a2.z), w0 * bfhi(a0.z) + w1 * bfhi(a1.z) + w2 * bfhi(a2.z));
            o.w = pk2(w0 * bflo(a0.w) + w1 * bflo(a1.w) + w2 * bflo(a2.w), w0 * bfhi(a0.w) + w1 * bfhi(a1.w) + w2 * bfhi(a2.w));
            *(GAS v4u*)(OB + row * 1536 + hg * 128 + d0) = o;
        } else { const int h = slot - 2;
            const float* p1 = CTMP + row * 1536 + (2 * h) * 128 + d0; const float* p2 = p1 + 128;
            const f32x4 x0 = *(const f32x4*)p1 - lam * *(const f32x4*)p2, x1 = *(const GAS f32x4*)(p1 + 4) - lam * *(const GAS f32x4*)(p2 + 4);
            float ss = (x0.x * x0.x + x0.y * x0.y) + (x0.z * x0.z + x0.w * x0.w) + (x1.x * x1.x + x1.y * x1.y) + (x1.z * x1.z + x1.w * x1.w);
            ss += shx<1>(ss); ss += shx<2>(ss); ss += shx<4>(ss); ss += shx<8>(ss);
            const float rstd = rsqrtf(ss * (1.0f / 128.0f) + EPS) * (1.0f - lam_init);
            const f32x4 g0 = *(const GAS f32x4*)(subln + d0), g1 = *(const GAS f32x4*)(subln + d0 + 4);
            v4u o; o.x = pk2(x0.x * rstd * g0.x, x0.y * rstd * g0.y); o.y = pk2(x0.z * rstd * g0.z, x0.w * rstd * g0.w);
            o.z = pk2(x1.x * rstd * g1.x, x1.y * rstd * g1.y); o.w = pk2(x1.z * rstd * g1.z, x1.w * rstd * g1.w);
            *(GAS v4u*)(OC + row * 1536 + h * 128 + d0) = o;
        }
    }
}
#define CHECK_HOOK(stage, c, l) do {} while (0)
#define CHECK_FINAL() do {} while (0)

#ifndef PHMASK
#define PHMASK 0xFFFF
#endif
#define PH(k) ((PHMASK >> (k)) & 1)
#ifndef DUPMASK
#define DUPMASK 0
#endif
#define DUP(k) ((DUPMASK >> (k)) & 1)
#ifndef BARX
#define BARX 1
#endif
__device__ __forceinline__ int lane_id_now() { unsigned z = 0u; asm volatile("" : "+v"(z)); return (int)__builtin_amdgcn_mbcnt_hi(~0u, __builtin_amdgcn_mbcnt_lo(~0u, z)); }
__global__ void __launch_bounds__(NWAVES * 64, 2) fwd(Args kargs) {
    extern __shared__ __attribute__((aligned(16))) unsigned char lds_raw[];
    LAS unsigned char* lds = (LAS unsigned char*)lds_raw;
    volatile LAS unsigned* MISC = (volatile LAS unsigned*)(lds + MISC_OFF);
    int wave = __builtin_amdgcn_readfirstlane((int)threadIdx.x >> 6);
#define LANE_ID() lane_id_now()
    int lane = LANE_ID(), tid = wave * 64 + lane;
    for (int u = tid; u < (LDS_BYTES - LDSCTL_OFF) / 4; u += NWAVES * 64) ((LAS unsigned*)(lds + LDSCTL_OFF))[u] = 0u;
    __syncthreads();
    const AL a{};
    XcdBarrier bar = xcd_barrier_post((unsigned*)(a.ws() + WS_CTL) + CW_BAR, MISC + 8, tid);
#define GRID_BAR() do { for (int b_ = 0; b_ < BARX; ++b_) xcd_barrier(bar, wave * 64 + LANE_ID()); } while (0)
    int G = gridDim.x, bid = (int)blockIdx.x;
#define LAUNDER() do { asm volatile("" : "+s"(G), "+s"(bid)); asm volatile("" : "+s"(wave)); lane = LANE_ID(); asm volatile("" : "+v"(lane)); tid = wave * 64 + lane; } while (0)
#ifndef WGM_BIG
#define WGM_BIG 8
#endif
#ifndef STAG_TICKS
#define STAG_TICKS 0
#endif
#define STAGGER() do { if (STAG_TICKS > 0) { const unsigned long long t0_ = __builtin_amdgcn_s_memrealtime(); const unsigned long long w_ = (unsigned long long)(((bid >> 3) & 3) * STAG_TICKS); \
    while (__builtin_amdgcn_s_memrealtime() - t0_ < w_) __builtin_amdgcn_s_sleep(8); } } while (0)
#define GW (bid * NWAVES + wave)
#define NGW_ (G * NWAVES)

    if (PH(0)) { phase_modp(a, lds, tid, lane, wave); phase_colmax(a, (int)blockIdx.x * NWAVES + wave, (int)gridDim.x * NWAVES, lane); }
    if (DUP(0)) { __syncthreads(); phase_modp(a, lds, tid, lane, wave); }
    GRID_BAR();
    if (PH(1)) phase_pro2(a, lds, tid, lane, wave, G);
    if (DUP(1)) { __syncthreads(); phase_pro2(a, lds, tid, lane, wave, G); }
    GRID_BAR();
    CHECK_HOOK(0, 0, 0);

#pragma unroll 1
    for (int cl = 0; cl < NCHUNK * 2; ++cl) {
        int c = cl >> 1, l = cl & 1;
        asm volatile("" : "+s"(c), "+s"(l));
#define R0 (c * CH)
#define PROMPT (R0 < 32768)
#define S_ (PROMPT ? 4096 : 2048)
#define TSH (PROMPT ? 12 : 11)
#define SEQ0 (PROMPT ? (R0 >> 12) : 8 + ((R0 - 32768) >> 11))
#define XIN0 (PROMPT ? a.in(I_XP) + (size_t)R0 * DM : a.in(I_XS) + (size_t)(R0 - 32768) * DM)
#define XO (a.out() + (size_t)R0 * DM)
#define XCUR (l == 0 ? XIN0 : (const float*)XO)
#define MODL ((const float*)(a.ws() + WS_MOD) + (size_t)l * 24 * 12288)
#define WL (a.ws() + WS_W + (size_t)l * W_LAYER)
        if (PH(2)) { LAUNDER();
            if (l == 0) { phase_norm<true, false, true>(XIN0, nullptr, nullptr, nullptr, a.in(I_N1G) + l * DM, MODL, 0, 2048, SEQ0, TSH, I8IN ? nullptr : (bf16*)(a.ws() + A_H), GW, NGW_, lane, a.ws() + A_HI8, (float*)(a.ws() + A_HS)); }
            else phase_norm<false, true, true>(nullptr, (const bf16*)(a.ws() + A_X), (const bf16*)(a.ws() + A_VT), (bf16*)(a.ws() + A_X), a.in(I_N1G) + l * DM, MODL, 0, 2048, SEQ0, TSH, I8IN ? nullptr : (bf16*)(a.ws() + A_H), GW, NGW_, lane, a.ws() + A_HI8, (float*)(a.ws() + A_HS)); }
        GRID_BAR(); CHECK_HOOK(1, c, l);
        for (int rep_ = 0; rep_ < (PH(3) ? 1 + DUP(3) : 0); ++rep_) { LAUNDER(); unsigned char* ws = a.ws(); pg8::StaticOrder So; So.init(CH, INC, G, bid, WGM_BIG);
          pg8::EpiIn E{l, S_, TSH, (LAS float*)(lds + LDSCTL_OFF + 1024)}; STAGGER();
#if I8IN
          pg8::Gemm g{(const pg8::bf16_t*)(ws + A_HI8), (const pg8::bf16_t*)(WL + WO_IG), CH, INC, DM / 2};
          pg8::gemm_phase<pg8::EpiIn, pg8::StaticOrder, true, true, true>(lds + RING_OFF, g, So, E, tid); }
#else
          pg8::Gemm g{(const pg8::bf16_t*)(ws + A_H), (const pg8::bf16_t*)(WL + WO_IG), CH, INC, DM};
          pg8::gemm_phase<pg8::EpiIn, pg8::StaticOrder, true, true, false>(lds + RING_OFF, g, So, E, tid); }
#endif
        GRID_BAR(); CHECK_HOOK(2, c, l);
        if (__builtin_amdgcn_readfirstlane(__float_as_int(((const float*)(a.ws() + WS_LAM))[2 + l])) > 0x42800000) {
            if (PH(4)) { LAUNDER(); phase_prep(a, l, lds, S_, TSH, GW, NGW_, wave, lane); }
            GRID_BAR(); }
#ifdef CVARX
        { LAUNDER(); phase_attn<CVARX>(a, l, lds, S_, TSH, tid, wave, lane, 1); __syncthreads(); }
#endif
        if (PH(5)) { LAUNDER(); phase_attn(a, l, lds, S_, TSH, tid, wave, lane); }
        if (DUP(5)) { LAUNDER(); __syncthreads(); phase_attn(a, l, lds, S_, TSH, tid, wave, lane); }
        if (DUP(12) || DUP(13) || DUP(14)) { LAUNDER(); __syncthreads(); phase_attn(a, l, lds, S_, TSH, tid, wave, lane, DUP(12) | (DUP(13) << 1) | (DUP(14) << 2)); }
        GRID_BAR(); CHECK_HOOK(4, c, l);
        if (PH(6)) { LAUNDER(); phase_combine(a, l, GW, NGW_, lane); }
        if (DUP(6)) { LAUNDER(); __syncthreads(); phase_combine(a, l, GW, NGW_, lane); }
        GRID_BAR(); CHECK_HOOK(5, c, l);
        if (PH(7)) {
          { LAUNDER(); unsigned char* ws = a.ws(); pg8::GateOrder So; So.init(CH, DM, G, bid);
            pg8::Gemm g{(const pg8::bf16_t*)(ws + A_HI8), (const pg8::bf16_t*)(WL + WO_IG + (size_t)INC * DM * (I8IN ? 1 : 2)), CH, INC, DM / 2}; pg8::EpiGate E{l};
            pg8::gemm_phase<pg8::EpiGate, pg8::GateOrder, true, true, true>(lds + RING_OFF, g, So, E, tid); }
          { LAUNDER(); unsigned char* ws = a.ws(); pg8::StaticOrder So; So.init(CH, DM, G, bid);
            pg8::Gemm g{(const pg8::bf16_t*)(ws + A_OA), (const pg8::bf16_t*)(WL + WO_BRA), CH, DM, 1536}; pg8::EpiBrM E{(pg8::bf16_t*)(ws + A_QK), (const unsigned char*)(ws + A_G)};
            pg8::gemm_phase<pg8::EpiBrM, pg8::StaticOrder, true, true>(lds + RING_OFF, g, So, E, tid); } }
        GRID_BAR(); CHECK_HOOK(6, c, l);
        if (PH(8)) { LAUNDER(); unsigned char* ws = a.ws(); pg8::Gemm g{(const pg8::bf16_t*)(ws + A_QK), (const pg8::bf16_t*)(WL + WO_OUT), CH, DM, DM}; pg8::StaticOrder So; So.init(CH, DM, G, bid);
          pg8::EpiDelta E{(pg8::bf16_t*)(ws + A_VT), MODL + 2 * 2048, SEQ0, TSH};
          for (int rep_ = 0; rep_ < 1 + DUP(8); ++rep_) pg8::gemm_phase<pg8::EpiDelta, pg8::StaticOrder, true, true>(lds + RING_OFF, g, So, E, tid); }
        GRID_BAR(); CHECK_HOOK(7, c, l);
        if (PH(9)) { LAUNDER();
            if (l == 0) phase_norm<true, true, I8FF1 != 0>(XIN0, nullptr, (const bf16*)(a.ws() + A_VT), (bf16*)(a.ws() + A_X), a.in(I_N2G) + l * DM, MODL, 3 * 2048, 4 * 2048, SEQ0, TSH, I8FF1 ? nullptr : (bf16*)(a.ws() + A_H), GW, NGW_, lane, a.ws() + A_HI8, (float*)(a.ws() + A_HS));
            else phase_norm<false, true, I8FF1 != 0>(nullptr, (const bf16*)(a.ws() + A_X), (const bf16*)(a.ws() + A_VT), (bf16*)(a.ws() + A_X), a.in(I_N2G) + l * DM, MODL, 3 * 2048, 4 * 2048, SEQ0, TSH, I8FF1 ? nullptr : (bf16*)(a.ws() + A_H), GW, NGW_, lane, a.ws() + A_HI8, (float*)(a.ws() + A_HS)); }
        GRID_BAR(); CHECK_HOOK(8, c, l);
        for (int rep_ = 0; rep_ < (PH(10) ? 1 + DUP(10) : 0); ++rep_) { LAUNDER(); unsigned char* ws = a.ws(); pg8::StaticOrder So; So.init(CH, DFF, G, bid, WGM_BIG);
          pg8::EpiRelu2 E{(pg8::bf16_t*)(ws + A_U), DFF, l}; STAGGER();
#if I8FF1
          pg8::Gemm g{(const pg8::bf16_t*)(ws + A_HI8), (const pg8::bf16_t*)(WL + WO_FF1), CH, DFF, DM / 2};
          pg8::gemm_phase<pg8::EpiRelu2, pg8::StaticOrder, true, true, true>(lds + RING_OFF, g, So, E, tid); }
#else
          pg8::Gemm g{(const pg8::bf16_t*)(ws + A_H), (const pg8::bf16_t*)(WL + WO_FF1), CH, DFF, DM};
          pg8::gemm_phase<pg8::EpiRelu2, pg8::StaticOrder, true, true>(lds + RING_OFF, g, So, E, tid); }
#endif
        GRID_BAR(); CHECK_HOOK(9, c, l);
        if (PH(11)) { LAUNDER(); unsigned char* ws = a.ws(); pg8::Gemm g{(const pg8::bf16_t*)(ws + A_U), (const pg8::bf16_t*)(WL + WO_FF2), CH, DM, DFF}; pg8::StaticOrder So; So.init(CH, DM, G, bid);
          if (l == 0) { pg8::EpiDelta E{(pg8::bf16_t*)(ws + A_VT), MODL + 5 * 2048, SEQ0, TSH, I8FF1 ? (const float*)(ws + A_HS) : nullptr};
              for (int rep_ = 0; rep_ < 1 + DUP(11); ++rep_) pg8::gemm_phase<pg8::EpiDelta, pg8::StaticOrder, true, true>(lds + RING_OFF, g, So, E, tid); }
          else { pg8::EpiFinal E{(const pg8::bf16_t*)(ws + A_X), XO, MODL + 5 * 2048, SEQ0, TSH, I8FF1 ? (const float*)(ws + A_HS) : nullptr};
              for (int rep_ = 0; rep_ < 1 + DUP(11); ++rep_) pg8::gemm_phase<pg8::EpiFinal, pg8::StaticOrder, true, true>(lds + RING_OFF, g, So, E, tid); } }
        GRID_BAR(); CHECK_HOOK(10, c, l);
    }
    CHECK_FINAL();
}

extern "C" void kernel_launch(void* const* d_in, const int* in_sizes, int n_in, void* d_out, int out_size, void* d_ws, size_t ws_size, hipStream_t stream) {
    static int grid = 0;
    if (grid == 0) {
        if (n_in != 29 || out_size != MTOT * DM || ws_size < WS_END) { fprintf(stderr, "kernel_launch: unexpected shapes (n_in %d out %d ws %zu need %zu)\n", n_in, out_size, ws_size, (size_t)WS_END); grid = -1; return; }
        int dev = 0, cus = 0, per_cu = 0;
        if (hipGetDevice(&dev) != hipSuccess || hipDeviceGetAttribute(&cus, hipDeviceAttributeMultiprocessorCount, dev) != hipSuccess) { grid = -1; return; }
        if (hipFuncSetAttribute((const void*)fwd, hipFuncAttributeMaxDynamicSharedMemorySize, LDS_BYTES) != hipSuccess) { grid = -1; return; }
        if (hipOccupancyMaxActiveBlocksPerMultiprocessor(&per_cu, (const void*)fwd, NWAVES * 64, LDS_BYTES) != hipSuccess || per_cu < 1) { fprintf(stderr, "kernel_launch: occupancy query says %d\n", per_cu); }
        (void)hipGetLastError();
        grid = cus;
    }
    if (grid < 0) return;
    if (hipMemsetAsync((char*)d_ws + WS_CTL, 0, CTL_ZERO_BYTES, stream) != hipSuccess) return;
    Args a{};
    for (int i = 0; i < 29; ++i) a.in[i] = (const float*)d_in[i];
    a.out = (float*)d_out; a.ws = (unsigned char*)d_ws;
    hipLaunchKernelGGL(fwd, dim3(grid), dim3(NWAVES * 64), LDS_BYTES, stream, a);
}
```

```cpp
#include <hip/hip_runtime.h>
#include <hip/hip_bf16.h>
#include <cstdio>
#include <cstdint>
#include <cmath>

constexpr int NWAVES = 8;
constexpr int DM = 2048, NSEQ = 24, MTOT = 65536, DFF = 8192, INC = 6144;
#ifndef MK_CH
#define MK_CH 32768
#endif
constexpr int CH = MK_CH;
constexpr int NCHUNK = MTOT / CH;
constexpr float EPS = 1e-6f, LOG2E = 1.4426950408889634f, LN2 = 0.6931471805599453f;
constexpr float QS128 = 0.08838834764831845f * LOG2E, QS64 = 0.125f * LOG2E;
constexpr float NEGB = -1e30f;

constexpr size_t MiB = 1u << 20;
constexpr size_t WS_CTL = 0, CTL_ZERO_BYTES = 1 * MiB;
constexpr size_t WS_MOD = 1 * MiB;
constexpr size_t WS_ROPEB = 4 * MiB, WS_ROPEC = WS_ROPEB + 512 * 1024;
constexpr size_t WS_LAM = 5 * MiB;
constexpr size_t WS_MODP = 6 * MiB;
constexpr size_t WS_W = 48 * MiB, W_LAYER = 126 * MiB;
constexpr size_t WO_IG = 0, WO_BRA = 48 * MiB, WO_BRB = 50 * MiB, WO_BRC = 51 * MiB, WO_OUT = 54 * MiB, WO_FF1 = 62 * MiB, WO_FF2 = 94 * MiB;
constexpr size_t WS_ACT = 304 * MiB;
constexpr size_t CHS = (size_t)CH;
constexpr size_t A_H = WS_ACT;
constexpr size_t A_Z = A_H + (MK_CH > 16384 ? 0 : CHS * 2048 * 2);
constexpr size_t A_QK = A_Z + CHS * 6144 * 2;
constexpr size_t A_VT = A_QK + CHS * 4096 * 2;
constexpr size_t A_G = A_VT + CHS * 2048 * 2;
constexpr size_t A_OA = A_G + CHS * 6144 * 2;
constexpr size_t A_OB = A_OA + CHS * 512 * 2;
constexpr size_t A_OC = A_OB + CHS * 256 * 2;
constexpr size_t A_X = A_OC + CHS * 768 * 2;
constexpr size_t A_HI8 = A_X + CHS * 2048 * 2;
constexpr size_t A_HS = A_HI8 + CHS * 2048;
constexpr size_t WS_END = A_HS + (1u << 20);
constexpr size_t A_BTMP = A_Z + CHS * 2048 * 2;
constexpr size_t A_BLSE = A_BTMP + CHS * 768 * 2;
constexpr size_t A_CTMP = A_BLSE + CHS * 8 * 4;
static_assert(A_CTMP + CHS * 1536 * 4 <= A_QK, "attention temporaries fit in Z");
constexpr size_t A_TMPF = A_QK;
constexpr size_t A_U = A_Z;
static_assert(CHS * 8192 * 2 <= (A_VT - A_Z), "u fits in Z + QK");
constexpr int CW_BAR = 4096;
constexpr int CW_WMAX = 131072;
#ifndef I8FF1
#define I8FF1 1
#endif
constexpr int WMAX_L = 20480;
constexpr int CW_CHK = 65536;

constexpr int RING_OFF = 0, RING_BYTES = 131072;
constexpr int LDSCTL_OFF = RING_BYTES, MISC_OFF = LDSCTL_OFF + 320;
constexpr int LDS_BYTES = 147456;

#define LAS __attribute__((address_space(3)))
#define GAS __attribute__((address_space(1)))
struct Args { const float* in[29]; float* out; unsigned char* ws; };
typedef const __attribute__((address_space(4))) unsigned long long* kargp_t;
struct AL {
    __device__ __forceinline__ static kargp_t kp() { kargp_t p = (kargp_t)__builtin_amdgcn_kernarg_segment_ptr(); asm volatile("" : "+s"(p)); return p; }
    __device__ __forceinline__ const float* in(int i) const { return (const float*)kp()[i]; }
    __device__ __forceinline__ float* out() const { return (float*)kp()[29]; }
    __device__ __forceinline__ unsigned char* ws() const { return (unsigned char*)kp()[30]; } };
enum { I_XP = 0, I_XS, I_CP, I_CS, I_N1G, I_WADA, I_BADA, I_WIN, I_QNA, I_KNA, I_RPB, I_QNB, I_KNB, I_QNC, I_KNC, I_LQ1, I_LK1, I_LQ2, I_LK2, I_SUBLN,
       I_WBRA, I_WBRB, I_WBRC, I_WGATE, I_BGATE, I_WOUT, I_N2G, I_WFF1, I_WFF2 };


template <int N> __device__ __forceinline__ float shx(float v) { return __shfl_xor(v, N); }
__device__ __forceinline__ void shx32_pair(float v, float& a, float& b) { const float o = __shfl_xor(v, 32); const bool hi = (__lane_id() >> 5) != 0; a = hi ? o : v; b = hi ? v : o; }
__device__ __forceinline__ float sum32(float v) { return v + __shfl_xor(v, 32); }
__device__ __forceinline__ float max32(float v) { return fmaxf(v, __shfl_xor(v, 32)); }
#ifndef WGM_SMALL
#define WGM_SMALL 4
#endif
namespace pg8 {
#define PG8_LAS __attribute__((address_space(3)))
typedef unsigned short bf16_t;
typedef short bf16x8 __attribute__((ext_vector_type(8)));
typedef float f32x4 __attribute__((ext_vector_type(4)));
typedef unsigned u32x4 __attribute__((ext_vector_type(4)));
constexpr int BM = 256, BK = 64, HALF = 128, HTB = HALF * BK * 2  , STAGE_BYTES = 8 * HTB, NXCD = 8, WGM = WGM_SMALL;

__host__ __device__ __forceinline__ int lds_byte(int r, int c) { const int st = (r >> 4) * 2 + (c >> 5), rr = r & 15, cc = c & 31, ob = rr * 64 + cc * 2; return st * 1024 + (ob ^ (((ob >> 9) & 1) << 5)); }
__host__ __device__ __forceinline__ void stage_rc(int b, int& R, int& C) { const int st = b / 1024, sb = b % 1024, swz = sb ^ (((sb >> 9) & 1) << 5); R = (st >> 1) * 16 + swz / 64; C = (st & 1) * 32 + (swz % 64) / 2; }
__host__ __device__ __forceinline__ int perm32(int rho) { const int n = rho >> 4, i = rho & 15; return 8 * (i >> 2) + 4 * n + (i & 3); }

struct Unit { int pm, pn; };
struct Gemm { const bf16_t* A; const bf16_t* Bt; int M, N, K; };

struct StaticOrder {
    int nM, nN, nwg, G, c, wgm;
    __host__ __device__ void init(int M, int N, int G_, int c_, int wgm_ = WGM) { nM = M / BM; nN = N / BM; nwg = nM * nN; G = G_; c = c_; wgm = wgm_; }
    __host__ __device__ bool next(int i, Unit& u) const {
        const long L = (long)i * G + c; if (L >= nwg) return false;
        int wgid = (int)L; { const int q = nwg / NXCD, r = nwg % NXCD, xcd = wgid % NXCD, off = wgid / NXCD; wgid = (xcd < r ? xcd * (q + 1) : r * (q + 1) + (xcd - r) * q) + off; }
        const int nig = wgm * nN, gid = wgid / nig, fm = gid * wgm, gsz = (nM - fm) < wgm ? (nM - fm) : wgm;
        u.pm = fm + ((wgid % nig) % gsz); u.pn = (wgid % nig) / gsz; return true;
    }
    __device__ __forceinline__ void a_ready(const Unit&) const {}
    __device__ __forceinline__ void done(const Unit&) const {}
};

struct GateOrder {
    StaticOrder br; int n;
    __host__ __device__ void init(int M, int N, int G_, int c_) { br.init(M, N, G_, c_); n = (br.nwg + G_ - 1 - c_) / G_; if (n < 0) n = 0; }
    __host__ __device__ bool next(int i, Unit& u) const { if (i >= 3 * n) return false; Unit b; br.next(i / 3, b); u.pm = b.pm; u.pn = b.pn + 8 * (i % 3); return true; }
    __device__ __forceinline__ void a_ready(const Unit&) const {}
    __device__ __forceinline__ void done(const Unit&) const {}
};

typedef float f32x2 __attribute__((ext_vector_type(2)));
typedef __bf16 bf16x2v __attribute__((ext_vector_type(2)));
typedef unsigned u32x2 __attribute__((ext_vector_type(2)));
__device__ __forceinline__ unsigned cvt_pk_bf16(float lo, float hi) { f32x2 v = {lo, hi}; bf16x2v b = __builtin_convertvector(v, bf16x2v); return __builtin_bit_cast(unsigned, b); }
#ifndef INGRP
#define INGRP 1
#endif
#ifndef HOOKGRP
#define HOOKGRP 4
#endif
#ifndef I8IN
#define I8IN 1
#endif
__device__ __forceinline__ f32x4 cvti(const f32x4 a) { const float a0 = a[0], a1 = a[1], a2 = a[2], a3 = a[3];
    return (f32x4){(float)__float_as_int(a0), (float)__float_as_int(a1), (float)__float_as_int(a2), (float)__float_as_int(a3)}; }
__device__ __forceinline__ float sigm(float x) { return fmaxf(__builtin_amdgcn_rcpf(1.0f + __expf(-x)), 1e-30f); }

#if I8IN
#define CVTIN(x) cvti(x)
#else
#define CVTIN(x) (x)
#endif
struct EpiIn {
    static constexpr bool PERM = true, AFTER_DRAIN = false, HAS_MID = false; static constexpr int MID_T0 = -1, MID_T1 = -1;
    int l, S, tshift; PG8_LAS float* xch;
    __device__ __forceinline__ void operator()(const f32x4 (&acc)[2][2][4][2], const Unit& u, int wr, int wc, int fr, int fq) const {
        const int row0 = u.pm * BM + wr * 64 + fr; const AL a{}; unsigned char* ws = a.ws();
        const unsigned* wmx = (const unsigned*)(ws + WS_CTL) + CW_WMAX + l * WMAX_L + u.pn * BM + wc * 32 + 8 * fq; const float* HSp = (const float*)(ws + A_HS);
        f32x4 wsc[2][2];
#pragma unroll
        for (int bj = 0; bj < 2; ++bj)
#pragma unroll
            for (int n = 0; n < 2; ++n) { const u32x4 w = *(const GAS u32x4*)(wmx + bj * HALF + 4 * n);
                wsc[bj][n] = I8IN ? (f32x4){__uint_as_float(w.x), __uint_as_float(w.y), __uint_as_float(w.z), __uint_as_float(w.w)} * (1.0f / 127.0f) : (f32x4){1.f, 1.f, 1.f, 1.f}; }
        if (u.pn < 16) { const int tn = u.pn; bf16_t* QKb = (bf16_t*)(ws + A_QK); const float* ropeB = (const float*)(ws + WS_ROPEB); const float* ropeC = (const float*)(ws + WS_ROPEC);
            int gi, dsh = 0, kind; float scale = 1.f;
            if (tn < 2) { gi = 0; kind = 0; scale = 0.08838834764831845f * 1.4426950408889634f; } else if (tn < 4) { gi = 1; kind = 0; }
            else if (tn < 7) { gi = 2; kind = 1; scale = 0.08838834764831845f * 1.4426950408889634f; dsh = 2 * (tn - 4); } else if (tn < 10) { gi = 3; kind = 1; dsh = 2 * (tn - 7); }
            else if (tn < 13) { gi = 4; kind = 2; scale = 0.125f * 1.4426950408889634f; } else { gi = 5; kind = 2; }
            float hsv[8];
#pragma unroll
            for (int g = 0; g < 8; ++g) hsv[g] = I8IN ? HSp[u.pm * BM + (g >> 2) * HALF + wr * 64 + (g & 3) * 16 + fr] : 1.0f;
#pragma unroll
            for (int ai = 0; ai < 2; ++ai)
#pragma unroll
                for (int m = 0; m < 4; ++m)
#pragma unroll
                    for (int bj = 0; bj < 2; ++bj) { const f32x4 a4 = CVTIN(acc[ai][bj][m][0]) * wsc[bj][0], b4 = CVTIN(acc[ai][bj][m][1]) * wsc[bj][1];
                        float p = (a4[0] * a4[0] + a4[1] * a4[1]) + (a4[2] * a4[2] + a4[3] * a4[3]) + (b4[0] * b4[0] + b4[1] * b4[1]) + (b4[2] * b4[2] + b4[3] * b4[3]);
                        p += shx<16>(p); p = sum32(p);
                        if (fq == 0) xch[((ai * HALF + wr * 64 + m * 16 + fr) * 2 + bj) * 4 + wc] = p; }
            asm volatile("s_waitcnt lgkmcnt(0)\n\ts_barrier" ::: "memory");
            const float* gp = a.in(I_QNA + gi + (gi >= 2 ? 1 : 0)) + l * (kind == 2 ? 64 : 128) + ((32 * wc + 8 * fq) & (kind == 2 ? 63 : 127));
            const f32x4 g0 = *(const GAS f32x4*)gp, g1 = *(const GAS f32x4*)(gp + 4);
            const bool ropew = kind == 1 ? (wc == 0) : (kind == 2 ? ((wc & 1) == 0) : false);
            const bool ropel = kind == 1 ? true : (fq < 2), first = kind == 1 ? (fq < 2) : (fq == 0);
            const int Lsh = tshift - dsh;
#pragma unroll
            for (int ai = 0; ai < 2; ++ai)
#pragma unroll
                for (int m = 0; m < 4; ++m) { const int rl = ai * HALF + wr * 64 + m * 16 + fr, row = u.pm * BM + rl, t = row & (S - 1);
                    const float* tb = kind == 1 ? ropeB + (size_t)(t * 16 + 8 * (fq & 1)) * 2 : ropeC + (size_t)(t * 8) * 2;
                    const int drow = dsh == 0 ? row : ((row & ~(S - 1)) + ((t & ((1 << dsh) - 1)) << Lsh) + (t >> dsh));
                    const float hs = hsv[ai * 4 + m], epsr = 1e-6f * __builtin_amdgcn_rcpf(hs * hs + 1e-30f);
                    f32x4 cs[2][2];
                    if (ropew && ropel) {
#pragma unroll
                        for (int hf = 0; hf < 2; ++hf) { cs[hf][0] = *(const GAS f32x4*)(tb + 8 * hf); cs[hf][1] = *(const GAS f32x4*)(tb + 8 * hf + 4); } }
#pragma unroll
                    for (int bj = 0; bj < 2; ++bj) { const f32x4 P4 = *(const PG8_LAS f32x4*)(xch + (rl * 2 + bj) * 4);
                        const float tot = kind == 2 ? (wc < 2 ? P4[0] + P4[1] : P4[2] + P4[3]) : (P4[0] + P4[1]) + (P4[2] + P4[3]);
                        const float rstd = __builtin_amdgcn_rsqf(tot * (kind == 2 ? (1.0f / 64.0f) : (1.0f / 128.0f)) + epsr);
                        u32x4 w;
#pragma unroll
                        for (int hf = 0; hf < 2; ++hf) {
                            const f32x4 gg = (hf ? g1 : g0) * wsc[bj][hf], av = CVTIN(acc[ai][bj][m][hf]); float y[4];
#pragma unroll
                            for (int e2 = 0; e2 < 4; ++e2) y[e2] = av[e2] * rstd * gg[e2];
                            if (ropew) { float pr[4];
#pragma unroll
                                for (int e2 = 0; e2 < 4; ++e2) { if (kind == 1) { float r0, r1; shx32_pair(y[e2], r0, r1); pr[e2] = fq >= 2 ? r0 : r1; } else pr[e2] = shx<16>(y[e2]); }
                                if (ropel) { const f32x4 c0 = cs[hf][0], c1 = cs[hf][1];
                                    y[0] = first ? y[0] * c0[0] - pr[0] * c0[1] : y[0] * c0[0] + pr[0] * c0[1]; y[1] = first ? y[1] * c0[2] - pr[1] * c0[3] : y[1] * c0[2] + pr[1] * c0[3];
                                    y[2] = first ? y[2] * c1[0] - pr[2] * c1[1] : y[2] * c1[0] + pr[2] * c1[1]; y[3] = first ? y[3] * c1[2] - pr[3] * c1[3] : y[3] * c1[2] + pr[3] * c1[3]; } }
                            if (hf == 0) { w.x = cvt_pk_bf16(y[0] * scale, y[1] * scale); w.y = cvt_pk_bf16(y[2] * scale, y[3] * scale); }
                            else { w.z = cvt_pk_bf16(y[0] * scale, y[1] * scale); w.w = cvt_pk_bf16(y[2] * scale, y[3] * scale); } }
                        *(GAS u32x4*)(QKb + (size_t)drow * 4096 + tn * BM + bj * HALF + wc * 32 + 8 * fq) = w; }
                    if (INGRP == 1 || (m % INGRP) == INGRP - 1) asm volatile("" ::: "memory"); }
        } else { const int col0 = (u.pn - 16) * BM + wc * 32 + 8 * fq; bf16_t* Zv = (bf16_t*)(ws + A_Z);
            float hsv[8];
#pragma unroll
            for (int g = 0; g < 8; ++g) hsv[g] = I8IN ? HSp[row0 + (g >> 2) * HALF + (g & 3) * 16] : 1.0f;
#pragma unroll
            for (int ai = 0; ai < 2; ++ai)
#pragma unroll
                for (int m = 0; m < 4; ++m) { const int row = row0 + ai * HALF + m * 16; const float hs = hsv[ai * 4 + m]; bf16_t* rowp = Zv + (size_t)row * 2048 + col0;
#pragma unroll
                    for (int bj = 0; bj < 2; ++bj) { const f32x4 v0 = CVTIN(acc[ai][bj][m][0]) * wsc[bj][0] * hs, v1 = CVTIN(acc[ai][bj][m][1]) * wsc[bj][1] * hs;
                        u32x4 w; w.x = cvt_pk_bf16(v0[0], v0[1]); w.y = cvt_pk_bf16(v0[2], v0[3]); w.z = cvt_pk_bf16(v1[0], v1[1]); w.w = cvt_pk_bf16(v1[2], v1[3]);
                        *(GAS u32x4*)(rowp + bj * HALF) = w; } }
        }
    }
};
struct EpiGate {
    static constexpr bool PERM = true, AFTER_DRAIN = false, HAS_MID = false; static constexpr int MID_T0 = -1, MID_T1 = -1, NSTORE = 0;
    int l;
    __device__ __forceinline__ static unsigned pk4(const f32x4 s) { unsigned w = 0;
        w = __builtin_amdgcn_cvt_pk_u8_f32(__builtin_floorf(fmaxf(s[0] * 255.0f + 0.5f, 1.0f)), 0, w); w = __builtin_amdgcn_cvt_pk_u8_f32(__builtin_floorf(fmaxf(s[1] * 255.0f + 0.5f, 1.0f)), 1, w);
        w = __builtin_amdgcn_cvt_pk_u8_f32(__builtin_floorf(fmaxf(s[2] * 255.0f + 0.5f, 1.0f)), 2, w); w = __builtin_amdgcn_cvt_pk_u8_f32(__builtin_floorf(fmaxf(s[3] * 255.0f + 0.5f, 1.0f)), 3, w); return w; }
    __device__ __forceinline__ void operator()(const f32x4 (&acc)[2][2][4][2], const Unit& u, int wr, int wc, int fr, int fq) const {
        const AL a{}; unsigned char* ws = a.ws();
        const int gt = u.pn, col0 = gt * BM + wc * 32 + 8 * fq, lane = fq * 16 + fr, wave = wr * 4 + wc; const float* bgate = a.in(I_BGATE) + l * 6144;
        f32x4 bv[2][2];
#pragma unroll
        for (int bj = 0; bj < 2; ++bj)
#pragma unroll
            for (int n = 0; n < 2; ++n) bv[bj][n] = *(const GAS f32x4*)(bgate + col0 + bj * HALF + 4 * n);
        unsigned char* tp = ws + A_G + (size_t)(u.pm * 24 + gt) * 65536 + (size_t)wave * 8192 + lane * 16;
        const unsigned* wmx = (const unsigned*)(ws + WS_CTL) + CW_WMAX + l * WMAX_L + 6144 + col0; const float* HSp = (const float*)(ws + A_HS);
        f32x4 wsc[2][2];
#pragma unroll
        for (int bj = 0; bj < 2; ++bj)
#pragma unroll
            for (int n = 0; n < 2; ++n) { const u32x4 w = *(const GAS u32x4*)(wmx + bj * HALF + 4 * n);
                wsc[bj][n] = (f32x4){__uint_as_float(w.x), __uint_as_float(w.y), __uint_as_float(w.z), __uint_as_float(w.w)} * (1.0f / 127.0f); }
        float hsv[8];
#pragma unroll
        for (int g = 0; g < 8; ++g) hsv[g] = HSp[u.pm * BM + (g >> 2) * HALF + wr * 64 + (g & 3) * 16 + fr];
#pragma unroll
        for (int ai = 0; ai < 2; ++ai)
#pragma unroll
            for (int m = 0; m < 4; ++m) { const float hs = hsv[ai * 4 + m]; u32x4 w;
#pragma unroll
                for (int bj = 0; bj < 2; ++bj) { const f32x4 v0 = cvti(acc[ai][bj][m][0]) * wsc[bj][0] * hs + bv[bj][0], v1 = cvti(acc[ai][bj][m][1]) * wsc[bj][1] * hs + bv[bj][1];
                    const f32x4 s0 = {sigm(v0[0]), sigm(v0[1]), sigm(v0[2]), sigm(v0[3])}, s1 = {sigm(v1[0]), sigm(v1[1]), sigm(v1[2]), sigm(v1[3])};
                    if (bj == 0) { w.x = pk4(s0); w.y = pk4(s1); } else { w.z = pk4(s0); w.w = pk4(s1); } }
                *(GAS u32x4*)(tp + (ai * 4 + m) * 1024) = w; }
    }
};
struct EpiRelu2 {
    static constexpr bool PERM = true, AFTER_DRAIN = false, HAS_MID = false; static constexpr int MID_T0 = -1, MID_T1 = -1;
    bf16_t* O; int ldc; int l;
    __device__ __forceinline__ void operator()(const f32x4 (&acc)[2][2][4][2], const Unit& u, int wr, int wc, int fr, int fq) const {
        const int row0 = u.pm * BM + wr * 64 + fr, col0 = u.pn * BM + wc * 32 + 8 * fq;
#pragma unroll
        for (int ai = 0; ai < 2; ++ai)
#pragma unroll
            for (int m = 0; m < 4; ++m) { bf16_t* rowp = O + (size_t)(row0 + ai * HALF + m * 16) * ldc + col0;
#pragma unroll
                for (int bj = 0; bj < 2; ++bj) {
#if I8FF1
                    f32x4 v0 = cvti(acc[ai][bj][m][0]), v1 = cvti(acc[ai][bj][m][1]);
#else
                    f32x4 v0 = acc[ai][bj][m][0], v1 = acc[ai][bj][m][1];
#endif
#pragma unroll
                    for (int e = 0; e < 4; ++e) { const float a0 = v0[e] > 0.f ? v0[e] : 0.f, a1 = v1[e] > 0.f ? v1[e] : 0.f; v0[e] = a0 * a0; v1[e] = a1 * a1; }
                    u32x4 w; w.x = cvt_pk_bf16(v0[0], v0[1]); w.y = cvt_pk_bf16(v0[2], v0[3]); w.z = cvt_pk_bf16(v1[0], v1[1]); w.w = cvt_pk_bf16(v1[2], v1[3]);
                    *(GAS u32x4*)(rowp + bj * HALF) = w; } }
    }
};
struct EpiRes {
    static constexpr bool PERM = false, AFTER_DRAIN = false, HAS_MID = false; static constexpr int MID_T0 = -1, MID_T1 = -1;
    const float* xin; float* xout; const float* gbase; int seq0, tshift;
    __device__ __forceinline__ void operator()(const f32x4 (&acc)[2][2][4][2], const Unit& u, int wr, int wc, int fr, int fq) const {
        const int row0 = u.pm * BM + wr * 64 + fr, col0 = u.pn * BM + wc * 32 + 4 * fq;
        const float* gp = gbase + (size_t)(seq0 + ((u.pm * BM) >> tshift)) * 12288 + col0;
        f32x4 gv[2][2];
#pragma unroll
        for (int bj = 0; bj < 2; ++bj)
#pragma unroll
            for (int n = 0; n < 2; ++n) gv[bj][n] = *(const GAS f32x4*)(gp + bj * HALF + n * 16);
#pragma unroll
        for (int ai = 0; ai < 2; ++ai)
#pragma unroll
            for (int m = 0; m < 4; ++m) { const size_t off = (size_t)(row0 + ai * HALF + m * 16) * 2048 + col0;
#pragma unroll
                for (int bj = 0; bj < 2; ++bj)
#pragma unroll
                    for (int n = 0; n < 2; ++n) { const f32x4 xi = *(const GAS f32x4*)(xin + off + bj * HALF + n * 16);
                        *(GAS f32x4*)(xout + off + bj * HALF + n * 16) = xi + gv[bj][n] * acc[ai][bj][m][n]; } }
    }
};
template <int MODE> struct EpiBr {
    static constexpr bool PERM = false, AFTER_DRAIN = false, HAS_MID = false; static constexpr int MID_T0 = -1, MID_T1 = -1;
    float* T; bf16_t* MRG; const bf16_t* Gt; int gcol0;
    __device__ __forceinline__ void operator()(const f32x4 (&acc)[2][2][4][2], const Unit& u, int wr, int wc, int fr, int fq) const {
        const int row0 = u.pm * BM + wr * 64 + fr, col0 = u.pn * BM + wc * 32 + 4 * fq;
#pragma unroll
        for (int ai = 0; ai < 2; ++ai)
#pragma unroll
            for (int m = 0; m < 4; ++m) { const size_t row = (size_t)(row0 + ai * HALF + m * 16);
#pragma unroll
                for (int bj = 0; bj < 2; ++bj)
#pragma unroll
                    for (int n = 0; n < 2; ++n) { const int col = col0 + bj * HALF + n * 16;
                        const u32x2 gw = *(const GAS u32x2*)(Gt + row * 6144 + gcol0 + col);
                        const f32x4 g = {__uint_as_float(gw.x << 16), __uint_as_float(gw.x & 0xffff0000u), __uint_as_float(gw.y << 16), __uint_as_float(gw.y & 0xffff0000u)};
                        f32x4 v = g * acc[ai][bj][m][n];
                        if (MODE >= 1) v = v + *(const GAS f32x4*)(T + row * 2048 + col);
                        if (MODE <= 1) *(GAS f32x4*)(T + row * 2048 + col) = v;
                        else { u32x2 w; w.x = cvt_pk_bf16(v[0], v[1]); w.y = cvt_pk_bf16(v[2], v[3]); *(GAS u32x2*)(MRG + row * 2048 + col) = w; } } }
    }
};

struct EpiBrM {
    static constexpr bool PERM = true, AFTER_DRAIN = false, HAS_MID = true; static constexpr int MID_T0 = 8, MID_T1 = 12, NSTORE = 0;
    bf16_t* MRG; const unsigned char* Gt;
    __device__ __forceinline__ static f32x4 ub4(const unsigned d) { return (f32x4){(float)(d & 0xffu), (float)((d >> 8) & 0xffu), (float)((d >> 16) & 0xffu), (float)(d >> 24)}; }
    __device__ __forceinline__ static f32x4 rdiv(const f32x4 a, const f32x4 b) { return (f32x4){a[0] * __builtin_amdgcn_rcpf(b[0]), a[1] * __builtin_amdgcn_rcpf(b[1]), a[2] * __builtin_amdgcn_rcpf(b[2]), a[3] * __builtin_amdgcn_rcpf(b[3])}; }
    __device__ __forceinline__ void mid(f32x4 (&acc)[2][2][4][2], const Unit& u, int t, int wr, int wc, int fr, int fq) const {
        int off = (u.pm * 24 + u.pn + (t == MID_T0 ? 0 : 8)) * 65536 + (wr * 4 + wc) * 8192 + (fq * 16 + fr) * 16;
        asm volatile("" : "+v"(off));
        const unsigned char* gp = Gt + (unsigned)off;
        u32x4 wa[8], wb[8];
#pragma unroll
        for (int g = 0; g < 8; ++g) { wa[g] = *(const GAS u32x4*)(gp + g * 1024); wb[g] = *(const GAS u32x4*)(gp + 8 * 65536 + g * 1024); }
#pragma unroll
        for (int ai = 0; ai < 2; ++ai)
#pragma unroll
            for (int m = 0; m < 4; ++m) { const int g = ai * 4 + m;
                acc[ai][0][m][0] = acc[ai][0][m][0] * rdiv(ub4(wa[g].x), ub4(wb[g].x)); acc[ai][0][m][1] = acc[ai][0][m][1] * rdiv(ub4(wa[g].y), ub4(wb[g].y));
                acc[ai][1][m][0] = acc[ai][1][m][0] * rdiv(ub4(wa[g].z), ub4(wb[g].z)); acc[ai][1][m][1] = acc[ai][1][m][1] * rdiv(ub4(wa[g].w), ub4(wb[g].w)); }
        asm volatile("" ::: "memory");
    }
    __device__ __forceinline__ void operator()(const f32x4 (&acc)[2][2][4][2], const Unit& u, int wr, int wc, int fr, int fq) const {
        const int row0 = u.pm * BM + wr * 64 + fr, col0 = u.pn * BM + wc * 32 + 8 * fq;
        const unsigned char* gp = Gt + (size_t)(u.pm * 24 + u.pn + 16) * 65536 + (wr * 4 + wc) * 8192 + (fq * 16 + fr) * 16;
        u32x4 wgs[8];
#pragma unroll
        for (int g = 0; g < 8; ++g) wgs[g] = *(const GAS u32x4*)(gp + g * 1024);
#pragma unroll
        for (int ai = 0; ai < 2; ++ai)
#pragma unroll
            for (int m = 0; m < 4; ++m) { bf16_t* rowp = MRG + (size_t)(row0 + ai * HALF + m * 16) * 2048 + col0;
                const u32x4 wg = wgs[ai * 4 + m];
#pragma unroll
                for (int bj = 0; bj < 2; ++bj) { const f32x4 g0 = ub4(bj ? wg.z : wg.x) * (1.0f / 255.0f), g1 = ub4(bj ? wg.w : wg.y) * (1.0f / 255.0f);
                    const f32x4 v0 = acc[ai][bj][m][0] * g0, v1 = acc[ai][bj][m][1] * g1;
                    u32x4 w; w.x = cvt_pk_bf16(v0[0], v0[1]); w.y = cvt_pk_bf16(v0[2], v0[3]); w.z = cvt_pk_bf16(v1[0], v1[1]); w.w = cvt_pk_bf16(v1[2], v1[3]);
                    *(GAS u32x4*)(rowp + bj * HALF) = w; } }
    }
};
struct EpiDelta {
    static constexpr bool PERM = true, AFTER_DRAIN = false, HAS_MID = false; static constexpr int MID_T0 = -1, MID_T1 = -1;
    bf16_t* Dl; const float* gbase; int seq0, tshift; const float* HS2 = nullptr;
    __device__ __forceinline__ void operator()(const f32x4 (&acc)[2][2][4][2], const Unit& u, int wr, int wc, int fr, int fq) const {
        const int row0 = u.pm * BM + wr * 64 + fr, col0 = u.pn * BM + wc * 32 + 8 * fq;
        const float* gp = gbase + (size_t)(seq0 + ((u.pm * BM) >> tshift)) * 12288 + col0;
        f32x4 gv[2][2];
#pragma unroll
        for (int bj = 0; bj < 2; ++bj)
#pragma unroll
            for (int n = 0; n < 2; ++n) gv[bj][n] = *(const GAS f32x4*)(gp + bj * HALF + 4 * n);
        float rsv[8];
#pragma unroll
        for (int g = 0; g < 8; ++g) { rsv[g] = 1.0f; if (HS2) rsv[g] = HS2[row0 + (g >> 2) * HALF + (g & 3) * 16]; }
#pragma unroll
        for (int ai = 0; ai < 2; ++ai)
#pragma unroll
            for (int m = 0; m < 4; ++m) { bf16_t* rowp = Dl + (size_t)(row0 + ai * HALF + m * 16) * 2048 + col0;
                float rs = rsv[ai * 4 + m]; rs *= rs;
#pragma unroll
                for (int bj = 0; bj < 2; ++bj) { const f32x4 v0 = acc[ai][bj][m][0] * gv[bj][0] * rs, v1 = acc[ai][bj][m][1] * gv[bj][1] * rs;
                    u32x4 w; w.x = cvt_pk_bf16(v0[0], v0[1]); w.y = cvt_pk_bf16(v0[2], v0[3]); w.z = cvt_pk_bf16(v1[0], v1[1]); w.w = cvt_pk_bf16(v1[2], v1[3]);
                    *(GAS u32x4*)(rowp + bj * HALF) = w; } }
    }
};

struct EpiFinal {
    static constexpr bool PERM = true, AFTER_DRAIN = false, HAS_MID = false; static constexpr int MID_T0 = -1, MID_T1 = -1;
    const bf16_t* XS; float* out; const float* gbase; int seq0, tshift; const float* HS2 = nullptr;
    __device__ __forceinline__ void operator()(const f32x4 (&acc)[2][2][4][2], const Unit& u, int wr, int wc, int fr, int fq) const {
        const int row0 = u.pm * BM + wr * 64 + fr, col0 = u.pn * BM + wc * 32 + 8 * fq;
        const float* gp = gbase + (size_t)(seq0 + ((u.pm * BM) >> tshift)) * 12288 + col0;
        f32x4 gv[2][2];
#pragma unroll
        for (int bj = 0; bj < 2; ++bj)
#pragma unroll
            for (int n = 0; n < 2; ++n) gv[bj][n] = *(const GAS f32x4*)(gp + bj * HALF + 4 * n);
        float rsv[8];
#pragma unroll
        for (int g = 0; g < 8; ++g) { rsv[g] = 1.0f; if (HS2) rsv[g] = HS2[row0 + (g >> 2) * HALF + (g & 3) * 16]; }
#pragma unroll
        for (int ai = 0; ai < 2; ++ai) { u32x4 xws[4][2];
#pragma unroll
            for (int m = 0; m < 4; ++m) { const size_t off = (size_t)(row0 + ai * HALF + m * 16) * 2048 + col0; xws[m][0] = *(const GAS u32x4*)(XS + off); xws[m][1] = *(const GAS u32x4*)(XS + off + HALF); }
#pragma unroll
            for (int m = 0; m < 4; ++m) { const size_t off = (size_t)(row0 + ai * HALF + m * 16) * 2048 + col0;
                float rs = rsv[ai * 4 + m]; rs *= rs;
#pragma unroll
                for (int bj = 0; bj < 2; ++bj) { const u32x4 xw = xws[m][bj];
                    const f32x4 x0 = {__uint_as_float(xw.x << 16), __uint_as_float(xw.x & 0xffff0000u), __uint_as_float(xw.y << 16), __uint_as_float(xw.y & 0xffff0000u)};
                    const f32x4 x1 = {__uint_as_float(xw.z << 16), __uint_as_float(xw.z & 0xffff0000u), __uint_as_float(xw.w << 16), __uint_as_float(xw.w & 0xffff0000u)};
                    *(GAS f32x4*)(out + off + bj * HALF) = x0 + acc[ai][bj][m][0] * gv[bj][0] * rs;
                    *(GAS f32x4*)(out + off + bj * HALF + 4) = x1 + acc[ai][bj][m][1] * gv[bj][1] * rs; } }
            asm volatile("" ::: "memory"); }
    }
};
template <class Epi, class Sched, bool ALIGN_EPI = false, bool SP2 = false, bool I8 = false>
__device__ __forceinline__ void gemm_phase(PG8_LAS unsigned char* lds, const Gemm g, const Sched& S, const Epi& E, int tid_in) {
    int tid_ = tid_in; asm volatile("" : "+v"(tid_));
    const int tid = tid_, wid = __builtin_amdgcn_readfirstlane(tid >> 6), lane = tid & 63, wr = wid >> 2, wc = wid & 3, fr = lane & 15, fq = lane >> 4;
    const int K = g.K, nt = K / BK;
    unsigned voffA[2], voffB[2];
#pragma unroll
    for (int i = 0; i < 2; ++i) { int R, C; stage_rc(tid * 16 + i * 8192, R, C); const int Rb = Epi::PERM ? ((R & ~31) + perm32(R & 31)) : R;
        voffA[i] = (unsigned)(R * K + C) * 2u; voffB[i] = (unsigned)(Rb * K + C) * 2u; }
    const size_t kstep = (size_t)(BK * 2);
    const size_t hstep = (size_t)HALF * K * 2;
    const size_t tstep = 2 * hstep;
    const unsigned ldsw = (unsigned)wid * 1024u;
    const int aoff = lds_byte(wr * 64 + fr, fq * 8), boff = lds_byte(wc * 32 + fr, fq * 8);
#define PG8_SA(b, h) (((b) * 2 + (h)) * HTB)
#define PG8_SB(b, h) ((4 + (b) * 2 + (h)) * HTB)
#define PG8_STAGE(bufoff, gbase, voff) do { _Pragma("unroll") for (int _i = 0; _i < 2; ++_i) \
        __builtin_amdgcn_global_load_lds((const unsigned*)((const char*)(gbase) + (voff)[_i]), (PG8_LAS unsigned*)(lds + (bufoff) + ldsw + _i * 8192), 16, 0, 0); } while (0)
#define PG8_LDA(dst, b, h) do { _Pragma("unroll") for (int m = 0; m < 4; ++m) _Pragma("unroll") for (int k = 0; k < 2; ++k) dst[m][k] = *(const PG8_LAS bf16x8*)(lds + PG8_SA(b, h) + aoff + m * 2048 + k * 1024); } while (0)
#define PG8_LDB(dst, b, h) do { _Pragma("unroll") for (int n = 0; n < 2; ++n) _Pragma("unroll") for (int k = 0; k < 2; ++k) dst[n][k] = *(const PG8_LAS bf16x8*)(lds + PG8_SB(b, h) + boff + n * 2048 + k * 1024); } while (0)
#define PG8_MMA(ai, bj, At, Bt) do { __builtin_amdgcn_s_setprio(1); _Pragma("unroll") for (int m = 0; m < 4; ++m) _Pragma("unroll") for (int n = 0; n < 2; ++n) _Pragma("unroll") for (int k = 0; k < 2; ++k) { \
        if constexpr (I8) acc[ai][bj][m][n] = __builtin_bit_cast(f32x4, __builtin_amdgcn_mfma_i32_16x16x64_i8(__builtin_bit_cast(v4i_t, Bt[n][k]), __builtin_bit_cast(v4i_t, At[m][k]), __builtin_bit_cast(v4i_t, acc[ai][bj][m][n]), 0, 0, 0)); \
        else acc[ai][bj][m][n] = __builtin_amdgcn_mfma_f32_16x16x32_bf16(Bt[n][k], At[m][k], acc[ai][bj][m][n], 0, 0, 0); } \
        __builtin_amdgcn_s_setprio(0); } while (0)
#define PG8_WAIT_V(n) asm volatile("s_waitcnt vmcnt(" #n ")" ::: "memory")
#define PG8_WAIT_L(n) asm volatile("s_waitcnt lgkmcnt(" #n ")" ::: "memory")
#define PG8_BAR __builtin_amdgcn_s_barrier()
#define PG8_SCHED __builtin_amdgcn_sched_barrier(0)
    Unit cur, nxt; int ui = 0;
    if (!S.next(0, cur)) return;
    f32x4 acc[2][2][4][2];
#pragma unroll
    for (int a = 0; a < 2; ++a)
#pragma unroll
        for (int b = 0; b < 2; ++b)
#pragma unroll
            for (int m = 0; m < 4; ++m)
#pragma unroll
                for (int n = 0; n < 2; ++n) acc[a][b][m][n] = (f32x4){0.f, 0.f, 0.f, 0.f};
    typedef int v4i_t __attribute__((ext_vector_type(4)));
    bf16x8 At[4][2], B0[2][2], B1[2][2];
    const char* cA = (const char*)g.A + (size_t)cur.pm * tstep; const char* cB = (const char*)g.Bt + (size_t)cur.pn * tstep;
    S.a_ready(cur);
    if constexpr (SP2) {
        PG8_STAGE(PG8_SB(0, 0), cB, voffB); PG8_STAGE(PG8_SB(0, 1), cB + hstep, voffB); PG8_STAGE(PG8_SA(0, 0), cA, voffA); PG8_STAGE(PG8_SA(0, 1), cA + hstep, voffA);
        if (wr == 1) PG8_BAR;
        PG8_WAIT_V(2); PG8_BAR;
        PG8_STAGE(PG8_SB(1, 0), cB + kstep, voffB); PG8_STAGE(PG8_SA(1, 0), cA + kstep, voffA); PG8_STAGE(PG8_SB(1, 1), cB + hstep + kstep, voffB);
        PG8_WAIT_V(6); PG8_BAR;
    } else {
        PG8_STAGE(PG8_SB(0, 0), cB, voffB); PG8_STAGE(PG8_SA(0, 0), cA, voffA); PG8_STAGE(PG8_SB(0, 1), cB + hstep, voffB); PG8_STAGE(PG8_SA(0, 1), cA + hstep, voffA);
        if (wr == 1) PG8_BAR;
        PG8_WAIT_V(4); PG8_BAR;
        PG8_STAGE(PG8_SB(1, 0), cB + kstep, voffB); PG8_STAGE(PG8_SA(1, 0), cA + kstep, voffA); PG8_STAGE(PG8_SB(1, 1), cB + hstep + kstep, voffB);
        PG8_WAIT_V(6); PG8_BAR;
    }
    for (;;) {
        const bool has_next = S.next(ui + 1, nxt);
        const char* nA = has_next ? (const char*)g.A + (size_t)nxt.pm * tstep : cA; const char* nB = has_next ? (const char*)g.Bt + (size_t)nxt.pn * tstep : cB;
#pragma unroll 1
        for (int t = 0; t < nt; t += 2) {
            if constexpr (Epi::HAS_MID) { if (t == Epi::MID_T0 || t == Epi::MID_T1) E.mid(acc, cur, t, wr, wc, fr, fq); }
            const bool last = (t == nt - 2);
            const char* a1 = cA + (size_t)(t + 1) * kstep;
            const char* a2 = last ? nA : cA + (size_t)(t + 2) * kstep; const char* b2 = last ? nB : cB + (size_t)(t + 2) * kstep;
            const char* a3 = a2 + kstep; const char* b3 = b2 + kstep;
            if (last && has_next) S.a_ready(nxt);
            if constexpr (SP2) {
            PG8_LDB(B0, 0, 0); PG8_LDB(B1, 0, 1); PG8_SCHED; PG8_LDA(At, 0, 0); PG8_STAGE(PG8_SA(1, 1), a1 + hstep, voffA);
            PG8_WAIT_V(8); PG8_WAIT_L(0); PG8_BAR; PG8_MMA(0, 0, At, B0); PG8_MMA(0, 1, At, B1); PG8_BAR; PG8_SCHED;
            PG8_LDA(At, 0, 1); PG8_STAGE(PG8_SB(0, 0), b2, voffB); PG8_STAGE(PG8_SB(0, 1), b2 + hstep, voffB); PG8_STAGE(PG8_SA(0, 0), a2, voffA);
            PG8_WAIT_V(8); PG8_WAIT_L(0); PG8_BAR; PG8_MMA(1, 0, At, B0); PG8_MMA(1, 1, At, B1); PG8_BAR; PG8_SCHED;
            PG8_LDB(B0, 1, 0); PG8_LDB(B1, 1, 1); PG8_SCHED; PG8_LDA(At, 1, 0); PG8_STAGE(PG8_SA(0, 1), a2 + hstep, voffA);
            PG8_WAIT_V(8); PG8_WAIT_L(0); PG8_BAR; PG8_MMA(0, 0, At, B0); PG8_MMA(0, 1, At, B1); PG8_BAR; PG8_SCHED;
            PG8_LDA(At, 1, 1); PG8_STAGE(PG8_SB(1, 0), b3, voffB); PG8_STAGE(PG8_SB(1, 1), b3 + hstep, voffB); PG8_STAGE(PG8_SA(1, 0), a3, voffA);
            PG8_WAIT_V(8); PG8_WAIT_L(0); PG8_BAR; PG8_MMA(1, 0, At, B0); PG8_MMA(1, 1, At, B1); PG8_BAR; PG8_SCHED;
            } else {
            PG8_LDB(B0, 0, 0); PG8_SCHED; PG8_LDA(At, 0, 0); PG8_STAGE(PG8_SA(1, 1), a1 + hstep, voffA);
            PG8_WAIT_L(8); PG8_BAR; PG8_WAIT_L(0); PG8_MMA(0, 0, At, B0); PG8_BAR; PG8_SCHED;
            PG8_LDB(B1, 0, 1); PG8_STAGE(PG8_SB(0, 0), b2, voffB);
            PG8_BAR; PG8_WAIT_L(0); PG8_MMA(0, 1, At, B1); PG8_BAR;
            PG8_LDA(At, 0, 1); PG8_STAGE(PG8_SA(0, 0), a2, voffA);
            PG8_BAR; PG8_WAIT_L(0); PG8_MMA(1, 0, At, B0); PG8_BAR; PG8_SCHED;
            PG8_STAGE(PG8_SB(0, 1), b2 + hstep, voffB);
            PG8_WAIT_V(6); PG8_BAR; PG8_MMA(1, 1, At, B1); PG8_BAR;
            PG8_LDB(B0, 1, 0); PG8_SCHED; PG8_LDA(At, 1, 0); PG8_STAGE(PG8_SA(0, 1), a2 + hstep, voffA);
            PG8_WAIT_L(8); PG8_BAR; PG8_WAIT_L(0); PG8_MMA(0, 0, At, B0); PG8_BAR; PG8_SCHED;
            PG8_LDB(B1, 1, 1); PG8_STAGE(PG8_SB(1, 0), b3, voffB);
            PG8_BAR; PG8_WAIT_L(0); PG8_MMA(0, 1, At, B1); PG8_BAR;
            PG8_LDA(At, 1, 1); PG8_STAGE(PG8_SA(1, 0), a3, voffA);
            PG8_BAR; PG8_WAIT_L(0); PG8_MMA(1, 0, At, B0); PG8_BAR; PG8_SCHED;
            PG8_STAGE(PG8_SB(1, 1), b3 + hstep, voffB);
            PG8_WAIT_V(6); PG8_BAR; PG8_MMA(1, 1, At, B1); PG8_BAR;
            }
        }
        if constexpr (ALIGN_EPI) { if (wr == 0) PG8_BAR; }
        if constexpr (!Epi::AFTER_DRAIN) { E(acc, cur, wr, wc, fr, fq); S.done(cur); }
        if (!has_next) break;
#pragma unroll
        for (int a = 0; a < 2; ++a)
#pragma unroll
            for (int b = 0; b < 2; ++b)
#pragma unroll
                for (int m = 0; m < 4; ++m)
#pragma unroll
                    for (int n = 0; n < 2; ++n) acc[a][b][m][n] = (f32x4){0.f, 0.f, 0.f, 0.f};
        cur = nxt; cA = nA; cB = nB; ++ui;
        if constexpr (ALIGN_EPI) { if (wr == 1) PG8_BAR; }
    }
    PG8_WAIT_V(0);
    if constexpr (!ALIGN_EPI) { if (wr == 0) PG8_BAR; }
    PG8_BAR;
    if constexpr (Epi::AFTER_DRAIN) { E.fused(acc, cur, wr, wc, fr, fq, lds, wid, lane); S.done(cur); }
#undef PG8_SA
#undef PG8_SB
#undef PG8_STAGE
#undef PG8_LDA
#undef PG8_LDB
#undef PG8_MMA
#undef PG8_WAIT_V
#undef PG8_WAIT_L
#undef PG8_BAR
#undef PG8_SCHED
}
}
typedef unsigned short bf16;
typedef unsigned v4u __attribute__((ext_vector_type(4)));
typedef unsigned v2u __attribute__((ext_vector_type(2)));
typedef float f32x4 __attribute__((ext_vector_type(4)));
typedef float f32x16 __attribute__((ext_vector_type(16)));
typedef short bf16x8 __attribute__((ext_vector_type(8)));
typedef GAS unsigned gu32;
#define LDS_WAIT() asm volatile("s_waitcnt lgkmcnt(0)" ::: "memory")
#define VM_WAIT() asm volatile("s_waitcnt vmcnt(0)" ::: "memory")
__device__ __forceinline__ unsigned pk2(float lo, float hi) { return pg8::cvt_pk_bf16(lo, hi); }
__device__ __forceinline__ float bflo(unsigned w) { return __uint_as_float(w << 16); }
__device__ __forceinline__ float bfhi(unsigned w) { return __uint_as_float(w & 0xffff0000u); }
__device__ __forceinline__ float bf1(bf16 b) { return __uint_as_float((unsigned)b << 16); }
__device__ __forceinline__ float wave_sum(float v) {
    v += shx<1>(v); v += shx<2>(v); v += shx<4>(v); v += shx<8>(v); v += shx<16>(v); return sum32(v);
}
#define XB_TMO      128
#define XB_XCNT(j)  (256  + 64 * (j))
#define XB_XSUB(j)  (1280 + 64 * (j))
#define XB_XGEN(j)  (2304 + 64 * (j))
#define XB_TOP      3328
#define XB_TOPGEN   3392
#define XCD_BAR_WORDS 3456
#define XB_SPIN_CAP (1u << 18)

__device__ __forceinline__ unsigned xb_ld(unsigned* p)              { return __hip_atomic_load(p, __ATOMIC_RELAXED, __HIP_MEMORY_SCOPE_AGENT); }
__device__ __forceinline__ unsigned xb_add(unsigned* p, unsigned v) { return __hip_atomic_fetch_add(p, v, __ATOMIC_RELAXED, __HIP_MEMORY_SCOPE_AGENT); }
__device__ __forceinline__ unsigned xb_xcc_id() { return (unsigned)__builtin_amdgcn_s_getreg((3 << 11) | 20) & 0xFu; }
#define XB_SPIN(cond, bar) do { unsigned _sp = 0; while (cond) { __builtin_amdgcn_s_sleep(1); \
    if ((++_sp & 255u) == 0u) { if (xb_ld(&(bar)[XB_TMO])) break; if (_sp > XB_SPIN_CAP) { atomicAdd(&(bar)[XB_TMO], 1u); break; } } } } while (0)

struct XcdBarrier {
    unsigned* bar; unsigned x;
    volatile LAS unsigned* st;
};

__device__ __forceinline__ XcdBarrier xcd_barrier_post(unsigned* bar, volatile LAS unsigned* st, int tid) {
    XcdBarrier b; b.bar = bar; b.x = xb_xcc_id(); b.st = st;
    if (tid == 0) (void)xb_add(&bar[XB_XCNT(b.x)], 1u);
    return b;
}
__device__ __forceinline__ void xcd_barrier_complete(unsigned* bar, unsigned x, unsigned& nloc, unsigned& nx) {
    const unsigned G = gridDim.x * gridDim.y * gridDim.z;
    unsigned sum, cnt, mine, sp = 0u;
    for (;;) {
        sum = 0u; cnt = 0u; mine = 0u;
#pragma unroll
        for (unsigned j = 0; j < 16; ++j) { const unsigned c = xb_ld(&bar[XB_XCNT(j)]); sum += c; cnt += (c > 0u) ? 1u : 0u; mine = (j == x) ? c : mine; }
        if (sum == G) break;
        __builtin_amdgcn_s_sleep(1);
        if ((++sp & 255u) == 0u) { if (xb_ld(&bar[XB_TMO])) break; if (sp > XB_SPIN_CAP) { atomicAdd(&bar[XB_TMO], 1u); break; } }
    }
    nloc = mine > 0u ? mine : 1u; nx = cnt > 0u ? cnt : 1u;
}

__device__ __forceinline__ void xcd_barrier(const XcdBarrier& b, int tid) {
    asm volatile("s_waitcnt vmcnt(0)" ::: "memory");
    __syncthreads();
    if (tid == 0) {
        unsigned* bar = b.bar;
        __builtin_amdgcn_s_waitcnt(0);
        unsigned nloc = b.st[0], nx = b.st[1];
        if (nloc == 0u) { xcd_barrier_complete(bar, b.x, nloc, nx); b.st[0] = nloc; b.st[1] = nx; }
        const unsigned old = xb_add(&bar[XB_XSUB(b.x)], 1u);
        const unsigned gen = old / nloc;
        if (old + 1u == (gen + 1u) * nloc) {
            __builtin_amdgcn_fence(__ATOMIC_RELEASE, "agent");
            asm volatile("s_waitcnt vmcnt(0)" ::: "memory");
            const unsigned og = xb_add(&bar[XB_TOP], 1u);
            const unsigned tg = og / nx;
            if (og + 1u == (tg + 1u) * nx) xb_add(&bar[XB_TOPGEN], 1u);
            else XB_SPIN(xb_ld(&bar[XB_TOPGEN]) == tg, bar);
            __builtin_amdgcn_fence(__ATOMIC_ACQUIRE, "agent");
            xb_add(&bar[XB_XGEN(b.x)], 1u);
            asm volatile("s_waitcnt vmcnt(0)" ::: "memory");
        } else {
            XB_SPIN(xb_ld(&bar[XB_XGEN(b.x)]) == gen, bar);
            __builtin_amdgcn_fence(__ATOMIC_ACQUIRE, "agent");
            asm volatile("s_waitcnt vmcnt(0)" ::: "memory");
        }
    }
    __syncthreads();
}

__device__ __forceinline__ void phase_modp(const AL& a, LAS unsigned char* lds, int tid, int lane, int wave) {
    LAS float* sil = (LAS float*)lds;
    const float* wada = a.in(I_WADA); float* modp = (float*)(a.ws() + WS_MODP);
    for (int it = blockIdx.x; it < 256; it += gridDim.x) {
        const int l = it >> 7, ks = (it >> 3) & 15, cg = it & 7, k0 = ks * 128;
        for (int e = tid; e < 24 * 128; e += NWAVES * 64) { const int b = e >> 7, kk = e & 127;
            const float c = b < 8 ? a.in(I_CP)[b * 2048 + k0 + kk] : a.in(I_CS)[(b - 8) * 2048 + k0 + kk];
            sil[e] = c / (1.0f + __expf(-c)); }
        __syncthreads();
        const int n0 = cg * 1536 + wave * 192 + 3 * lane;
        float acc[24][3];
#pragma unroll
        for (int b = 0; b < 24; ++b) { acc[b][0] = 0.f; acc[b][1] = 0.f; acc[b][2] = 0.f; }
        const GAS float* wp = (const GAS float*)wada + ((size_t)l * 2048 + k0) * 12288 + n0;
#pragma unroll 8
        for (int kk = 0; kk < 128; ++kk) {
            const float w0 = wp[(size_t)kk * 12288], w1 = wp[(size_t)kk * 12288 + 1], w2 = wp[(size_t)kk * 12288 + 2];
#pragma unroll
            for (int b = 0; b < 24; ++b) { const float s = sil[b * 128 + kk]; acc[b][0] += s * w0; acc[b][1] += s * w1; acc[b][2] += s * w2; }
        }
#pragma unroll
        for (int b = 0; b < 24; ++b) { GAS float* o = (GAS float*)modp + ((size_t)(ks * 2 + l) * 24 + b) * 12288 + n0; o[0] = acc[b][0]; o[1] = acc[b][1]; o[2] = acc[b][2]; }
        __syncthreads();
    }
}
__device__ __forceinline__ int win_row(int n0) { return n0 < 1024 ? n0 : n0 < 1536 ? n0 + 3072 : n0 < 3072 ? n0 - 512 : n0 < 3840 ? n0 + 1536 : n0 < 5376 ? n0 - 1280 : n0; }
__device__ __forceinline__ void phase_colmax(const AL& a, int gw, int NGW, int lane) {
    unsigned* wmax = (unsigned*)(a.ws() + WS_CTL) + CW_WMAX;
    for (int it = gw; it < 2 * 2 * 96 * 8; it += NGW) { const int ks = it & 7, cb = (it >> 3) % 96, mat = (it / 768) & 1, l = it / 1536, n0 = 64 * cb;
        const GAS float* w = (const GAS float*)(mat ? a.in(I_WGATE) : a.in(I_WIN)) + ((size_t)l * 2048 + ks * 256) * 6144 + n0 + lane;
        float mx = 0.f;
#pragma unroll 16
        for (int k = 0; k < 256; ++k) mx = fmaxf(mx, fabsf(w[(size_t)k * 6144]));
        const int d = mat ? 6144 + n0 + lane : win_row(n0) + lane;
        atomicMax(wmax + l * WMAX_L + d, __float_as_uint(mx)); }
#if I8FF1
    for (int it = gw; it < 2 * 128 * 8; it += NGW) { const int ks = it & 7, cb = (it >> 3) & 127, l = it >> 10, n0 = 64 * cb;
        const GAS float* w = (const GAS float*)a.in(I_WFF1) + ((size_t)l * 2048 + ks * 256) * 8192 + n0 + lane;
        float mx = 0.f;
#pragma unroll 16
        for (int k = 0; k < 256; ++k) mx = fmaxf(mx, fabsf(w[(size_t)k * 8192]));
        atomicMax(wmax + l * WMAX_L + 12288 + n0 + lane, __float_as_uint(mx)); }
#endif
}
__device__ __forceinline__ unsigned pk_i8x4(f32x4 v) {
    const int a = (int)__builtin_rintf(v.x), b = (int)__builtin_rintf(v.y), c = (int)__builtin_rintf(v.z), d = (int)__builtin_rintf(v.w);
    return (unsigned)(a & 255) | ((unsigned)(b & 255) << 8) | ((unsigned)(c & 255) << 16) | ((unsigned)d << 24); }
struct TrItem { const float* src; bf16* dst; int N, ldk; const unsigned* cmax; const unsigned* ksc; };
__device__ __forceinline__ void tr_load(const TrItem& t, float (&v)[32], int lane) {
    const GAS float* s = (const GAS float*)t.src + (size_t)(lane >> 5) * t.N + (lane & 31);
#pragma unroll
    for (int i = 0; i < 32; ++i) v[i] = s[(size_t)(2 * i) * t.N];
}
__device__ __forceinline__ void tr_store(const TrItem& t, const float (&v)[32], LAS float* scr, int lane) {
#pragma unroll
    for (int i = 0; i < 32; ++i) scr[(2 * i + (lane >> 5)) * 33 + (lane & 31)] = v[i];
    LDS_WAIT(); asm volatile("" ::: "memory");
    const int c = lane & 7;
#pragma unroll
    for (int j = 0; j < 4; ++j) { const int n = (lane >> 3) + 8 * j; const LAS float* s = scr + (8 * c) * 33 + n;
        if (t.cmax) { const float cm = __uint_as_float(t.cmax[n]), inv = cm > 0.f ? 127.0f / cm : 0.f;
            v2u o; o.x = pk_i8x4((f32x4){s[0 * 33], s[1 * 33], s[2 * 33], s[3 * 33]} * inv); o.y = pk_i8x4((f32x4){s[4 * 33], s[5 * 33], s[6 * 33], s[7 * 33]} * inv);
            *(GAS v2u*)((unsigned char*)t.dst + (size_t)n * t.ldk + 8 * c) = o; }
        else { float f[8];
#pragma unroll
            for (int e = 0; e < 8; ++e) f[e] = s[e * 33];
            if (t.ksc) { const v4u k0 = *(const GAS v4u*)(t.ksc + 8 * c), k1 = *(const GAS v4u*)(t.ksc + 8 * c + 4); const unsigned kk[8] = {k0.x, k0.y, k0.z, k0.w, k1.x, k1.y, k1.z, k1.w};
#pragma unroll
                for (int e = 0; e < 8; ++e) { const float q = __uint_as_float(kk[e]) * (1.0f / 127.0f); f[e] *= q * q; } }
            v4u o; o.x = pk2(f[0], f[1]); o.y = pk2(f[2], f[3]); o.z = pk2(f[4], f[5]); o.w = pk2(f[6], f[7]);
            *(GAS v4u*)(t.dst + (size_t)n * t.ldk + 8 * c) = o; } }
    LDS_WAIT(); asm volatile("" ::: "memory");
}
__device__ __forceinline__ void phase_pro2(const AL& a, LAS unsigned char* lds, int tid, int lane, int wave, int G) {
    const int gt = blockIdx.x * (NWAVES * 64) + tid, NGT = G * NWAVES * 64;
    { float* mod = (float*)(a.ws() + WS_MOD); const float* modp = (const float*)(a.ws() + WS_MODP); const float* bada = a.in(I_BADA);
      for (int i = gt; i < 2 * 24 * 12288; i += NGT) { const int l = i / (24 * 12288), n = i % 12288; float s = bada[l * 12288 + n];
#pragma unroll
          for (int ks = 0; ks < 16; ++ks) s += modp[(size_t)ks * (2 * 24 * 12288) + i];
          mod[i] = s; } }
    { float2* rb = (float2*)(a.ws() + WS_ROPEB); float2* rc = (float2*)(a.ws() + WS_ROPEC);
      for (int i = gt; i < 4096 * 24; i += NGT) { const int pos = i / 24, j = i % 24; const bool isb = j < 16; const int ii = isb ? j : j - 16; const double half = isb ? 16.0 : 8.0;
          const double inv = exp(-(double)ii / half * 13.122363377404328);
          const double rev = (double)pos * inv * 0.15915494309189535;
          const float fr = (float)(rev - floor(rev));
          const float2 v = make_float2(__builtin_amdgcn_cosf(fr), __builtin_amdgcn_sinf(fr));
          if (isb) rb[pos * 16 + ii] = v; else rc[pos * 8 + ii] = v; } }
    if (gt < 2) { const int l = gt; float s1 = 0.f, s2 = 0.f;
        for (int i = 0; i < 64; ++i) { s1 += a.in(I_LQ1)[l * 64 + i] * a.in(I_LK1)[l * 64 + i]; s2 += a.in(I_LQ2)[l * 64 + i] * a.in(I_LK2)[l * 64 + i]; }
        const float lam_init = 0.8f - 0.6f * expf(-0.3f * (float)l);
        ((float*)(a.ws() + WS_LAM))[l] = expf(s1) - expf(s2) + lam_init;
        float gq = 0.f, gk = 0.f;
        for (int i = 0; i < 64; ++i) { gq = fmaxf(gq, fabsf(a.in(I_QNC)[l * 64 + i])); gk = fmaxf(gk, fabsf(a.in(I_KNC)[l * 64 + i])); }
        ((float*)(a.ws() + WS_LAM))[2 + l] = 8.0f * LOG2E * gq * gk * 1.02f; }
    LAS float* scr = (LAS float*)(lds + RING_OFF + wave * 16384);
    const int gw = blockIdx.x * NWAVES + wave, NGW = G * NWAVES;
    constexpr int I_IN = 32 * 192, I_BA = 8 * 64, I_BB = 4 * 64, I_BC = 12 * 64, I_OU = 32 * 64, I_F1 = 32 * 256, I_F2 = 128 * 64;
    constexpr int PER_L = 2 * I_IN + I_BA + I_BB + I_BC + I_OU + I_F1 + I_F2;
    auto decode = [&](int it) -> TrItem {
        const int l = it / PER_L; int r = it % PER_L; unsigned char* wl = a.ws() + WS_W + (size_t)l * W_LAYER;
        const float* W; bf16* WT; int K, N, row_off = 0, ldk, koff = 0, i8 = 0; bool win = false, ff2 = false;
        if (r < I_IN) { win = true; i8 = I8IN ? 1 : 0; W = a.in(I_WIN) + (size_t)l * 2048 * 6144; K = 2048; N = 6144; WT = (bf16*)(wl + WO_IG); ldk = 2048; }
        else if ((r -= I_IN) < I_IN) { i8 = 2; W = a.in(I_WGATE) + (size_t)l * 2048 * 6144; K = 2048; N = 6144; WT = (bf16*)(wl + WO_IG + (size_t)6144 * 2048 * (I8IN ? 1 : 2)); ldk = 2048; }
        else if ((r -= I_IN) < I_BA) { W = a.in(I_WBRA) + (size_t)l * 512 * 2048; K = 512; N = 2048; WT = (bf16*)(wl + WO_BRA); ldk = 1536; }
        else if ((r -= I_BA) < I_BB) { W = a.in(I_WBRB) + (size_t)l * 256 * 2048; K = 256; N = 2048; WT = (bf16*)(wl + WO_BRA); ldk = 1536; koff = 512; }
        else if ((r -= I_BB) < I_BC) { W = a.in(I_WBRC) + (size_t)l * 768 * 2048; K = 768; N = 2048; WT = (bf16*)(wl + WO_BRA); ldk = 1536; koff = 768; }
        else if ((r -= I_BC) < I_OU) { W = a.in(I_WOUT) + (size_t)l * 2048 * 2048; K = 2048; N = 2048; WT = (bf16*)(wl + WO_OUT); ldk = 2048; }
        else if ((r -= I_OU) < I_F1) { W = a.in(I_WFF1) + (size_t)l * 2048 * 8192; K = 2048; N = 8192; WT = (bf16*)(wl + WO_FF1); ldk = 2048; i8 = I8FF1 ? 3 : 0; }
        else { r -= I_F1; W = a.in(I_WFF2) + (size_t)l * 8192 * 2048; K = 8192; N = 2048; WT = (bf16*)(wl + WO_FF2); ldk = 8192; ff2 = I8FF1 != 0; }
        (void)K; const int nblk = N / 32, kb = r / nblk, nb = r % nblk, k0 = 64 * kb, n0 = 32 * nb; const int nd = win ? win_row(n0) : n0;
        TrItem t; t.src = W + (size_t)k0 * N + n0; t.N = N; t.ldk = ldk; t.cmax = nullptr; t.ksc = ff2 ? (const unsigned*)(a.ws() + WS_CTL) + CW_WMAX + l * WMAX_L + 12288 + k0 : nullptr;
        if (i8) { t.dst = (bf16*)((unsigned char*)WT + (size_t)nd * ldk + k0); t.cmax = (const unsigned*)(a.ws() + WS_CTL) + CW_WMAX + l * WMAX_L + (i8 == 3 ? 12288 : i8 == 2 ? 6144 : 0) + nd; }
        else t.dst = WT + (size_t)(row_off + nd) * ldk + koff + k0;
        return t; };
    { int it = gw; const int NIT = 2 * PER_L;
      if (it < NIT) { TrItem cur = decode(it); float v[32]; tr_load(cur, v, lane);
          for (;;) { const int nx = it + NGW; const bool more = nx < NIT; TrItem nt = cur; float vn[32];
              if (more) { nt = decode(nx); tr_load(nt, vn, lane); }
              tr_store(cur, v, scr, lane);
              if (!more) break;
              cur = nt; it = nx;
#pragma unroll
              for (int i = 0; i < 32; ++i) v[i] = vn[i]; } } }
}

__device__ __forceinline__ f32x4 up4(v2u w) { return (f32x4){bflo(w.x), bfhi(w.x), bflo(w.y), bfhi(w.y)}; }
template <bool XF32, bool HASD, bool QI8 = false>
__device__ __forceinline__ void phase_norm(const float* xf, const bf16* XS, const bf16* D, bf16* XB, const float* gn, const float* modl, int sh_off, int sc_off, int seq0, int tshift, bf16* H, int gw, int NGW, int lane, unsigned char* HI8 = nullptr, float* HS = nullptr) {
    for (int blk = gw; blk < CH / 8; blk += NGW) {
        const int r0 = blk * 8; const float* mo = modl + (size_t)(seq0 + (r0 >> tshift)) * 12288;
        f32x4 A[8], B[8];
#pragma unroll
        for (int j = 0; j < 8; ++j) { const int c = 4 * lane + 256 * j; const f32x4 g = *(const GAS f32x4*)(gn + c), sc = *(const GAS f32x4*)(mo + sc_off + c); A[j] = g * (1.0f + sc); B[j] = *(const GAS f32x4*)(mo + sh_off + c); }
        for (int r = 0; r < 8; r += 2) {
            f32x4 v0[8], v1[8]; float s0 = 0.f, s1 = 0.f;
            if (XF32) { const GAS f32x4* xr0 = (const GAS f32x4*)(xf + (size_t)(r0 + r) * 2048) + lane; const GAS f32x4* xr1 = xr0 + 512;
#pragma unroll
                for (int j = 0; j < 8; ++j) { v0[j] = xr0[64 * j]; v1[j] = xr1[64 * j]; } }
            else { const GAS v2u* xr0 = (const GAS v2u*)(XS + (size_t)(r0 + r) * 2048) + lane; const GAS v2u* xr1 = xr0 + 512; v2u e0[8], e1[8];
#pragma unroll
                for (int j = 0; j < 8; ++j) { e0[j] = xr0[64 * j]; e1[j] = xr1[64 * j]; }
#pragma unroll
                for (int j = 0; j < 8; ++j) { v0[j] = up4(e0[j]); v1[j] = up4(e1[j]); } }
            if (HASD) { const GAS v2u* d0 = (const GAS v2u*)(D + (size_t)(r0 + r) * 2048) + lane; const GAS v2u* d1 = d0 + 512; v2u e0[8], e1[8];
#pragma unroll
                for (int j = 0; j < 8; ++j) { e0[j] = d0[64 * j]; e1[j] = d1[64 * j]; }
                GAS v2u* xo0 = (GAS v2u*)(XB + (size_t)(r0 + r) * 2048) + lane; GAS v2u* xo1 = xo0 + 512;
#pragma unroll
                for (int j = 0; j < 8; ++j) { v0[j] = v0[j] + up4(e0[j]); v1[j] = v1[j] + up4(e1[j]);
                    v2u w0, w1; w0.x = pk2(v0[j].x, v0[j].y); w0.y = pk2(v0[j].z, v0[j].w); w1.x = pk2(v1[j].x, v1[j].y); w1.y = pk2(v1[j].z, v1[j].w); xo0[64 * j] = w0; xo1[64 * j] = w1; } }
#pragma unroll
            for (int j = 0; j < 8; ++j) { s0 += (v0[j].x * v0[j].x + v0[j].y * v0[j].y) + (v0[j].z * v0[j].z + v0[j].w * v0[j].w); s1 += (v1[j].x * v1[j].x + v1[j].y * v1[j].y) + (v1[j].z * v1[j].z + v1[j].w * v1[j].w); }
            const float rstd0 = rsqrtf(wave_sum(s0) * (1.0f / 2048.0f) + EPS), rstd1 = rsqrtf(wave_sum(s1) * (1.0f / 2048.0f) + EPS);
            if constexpr (QI8) {
                float m0 = 0.f, m1 = 0.f;
#pragma unroll
                for (int j = 0; j < 8; ++j) { const f32x4 p = v0[j] * rstd0 * A[j] + B[j], q = v1[j] * rstd1 * A[j] + B[j];
                    m0 = fmaxf(fmaxf(m0, fmaxf(fabsf(p.x), fabsf(p.y))), fmaxf(fabsf(p.z), fabsf(p.w))); m1 = fmaxf(fmaxf(m1, fmaxf(fabsf(q.x), fabsf(q.y))), fmaxf(fabsf(q.z), fabsf(q.w))); }
#pragma unroll
                for (int o_ = 1; o_ < 64; o_ <<= 1) { m0 = fmaxf(m0, __shfl_xor(m0, o_)); m1 = fmaxf(m1, __shfl_xor(m1, o_)); }
                const float i0 = m0 > 0.f ? 127.0f / m0 : 0.f, i1 = m1 > 0.f ? 127.0f / m1 : 0.f;
                GAS unsigned* q0 = (GAS unsigned*)(HI8 + (size_t)(r0 + r) * 2048) + lane; GAS unsigned* q1 = q0 + 512;
#pragma unroll
                for (int j = 0; j < 8; ++j) { q0[64 * j] = pk_i8x4((v0[j] * rstd0 * A[j] + B[j]) * i0); q1[64 * j] = pk_i8x4((v1[j] * rstd1 * A[j] + B[j]) * i1); }
                if (lane == 0) { HS[r0 + r] = m0 * (1.0f / 127.0f); HS[r0 + r + 1] = m1 * (1.0f / 127.0f); }
                if (H) { GAS v2u* o8 = (GAS v2u*)(H + (size_t)(r0 + r) * 2048) + lane;
#pragma unroll
                    for (int j = 0; j < 8; ++j) { const f32x4 o = v0[j] * rstd0 * A[j] + B[j], p = v1[j] * rstd1 * A[j] + B[j]; v2u w; w.x = pk2(o.x, o.y); w.y = pk2(o.z, o.w); o8[64 * j] = w; w.x = pk2(p.x, p.y); w.y = pk2(p.z, p.w); o8[512 + 64 * j] = w; } }
            } else {
            GAS v2u* o8 = (GAS v2u*)(H + (size_t)(r0 + r) * 2048) + lane;
#pragma unroll
            for (int j = 0; j < 8; ++j) { const f32x4 o = v0[j] * rstd0 * A[j] + B[j]; v2u w; w.x = pk2(o.x, o.y); w.y = pk2(o.z, o.w); o8[64 * j] = w; }
#pragma unroll
            for (int j = 0; j < 8; ++j) { const f32x4 o = v1[j] * rstd1 * A[j] + B[j]; v2u w; w.x = pk2(o.x, o.y); w.y = pk2(o.z, o.w); o8[512 + 64 * j] = w; }
            }
        }
    }
}
__device__ __forceinline__ void phase_final(const bf16* XS, const bf16* D, float* xout, int gw, int NGW, int lane) {
    for (int r = 2 * gw; r < CH; r += 2 * NGW) {
        const GAS v2u* xr0 = (const GAS v2u*)(XS + (size_t)r * 2048) + lane; const GAS v2u* xr1 = xr0 + 512; const GAS v2u* d0 = (const GAS v2u*)(D + (size_t)r * 2048) + lane; const GAS v2u* d1 = d0 + 512;
        v2u x0[8], x1[8], e0[8], e1[8];
#pragma unroll
        for (int j = 0; j < 8; ++j) { x0[j] = xr0[64 * j]; x1[j] = xr1[64 * j]; e0[j] = d0[64 * j]; e1[j] = d1[64 * j]; }
        GAS f32x4* xo0 = (GAS f32x4*)(xout + (size_t)r * 2048) + lane; GAS f32x4* xo1 = xo0 + 512;
#pragma unroll
        for (int j = 0; j < 8; ++j) { xo0[64 * j] = up4(x0[j]) + up4(e0[j]); xo1[64 * j] = up4(x1[j]) + up4(e1[j]); }
    }
}
__device__ __forceinline__ int perm_tok(int p, int dsh, int Lsh) { return dsh == 0 ? p : (((p & ((1 << Lsh) - 1)) << dsh) + (p >> Lsh)); }
__device__ __forceinline__ void prep_qk_item(const bf16* Z, bf16* QK, const AL& a, int l, int item, int S, int tshift, int lane) {
    const int slot = item & 31, rb = item >> 5;
    int srccol, dstcol, dsh = 0, kind = 0; const float* gain; float scale = 1.f;
    if (slot < 4) { srccol = 128 * slot; dstcol = 128 * slot; gain = a.in(I_QNA) + l * 128; scale = QS128; }
    else if (slot < 8) { const int j = slot - 4; srccol = 512 + 128 * j; dstcol = 512 + 128 * j; gain = a.in(I_KNA) + l * 128; }
    else if (slot < 14) { const int j = slot - 8; srccol = 1536 + 128 * j; dstcol = 1024 + 128 * j; kind = 1; gain = a.in(I_QNB) + l * 128; scale = QS128; dsh = 2 * (j >> 1); }
    else if (slot < 20) { const int j = slot - 14; srccol = 2304 + 128 * j; dstcol = 1792 + 128 * j; kind = 1; gain = a.in(I_KNB) + l * 128; dsh = 2 * (j >> 1); }
    else if (slot < 26) { const int j = slot - 20; srccol = 3840 + 128 * j; dstcol = 2560 + 128 * j; kind = 2; gain = a.in(I_QNC) + l * 64; scale = QS64; }
    else { const int j = slot - 26; srccol = 4608 + 128 * j; dstcol = 3328 + 128 * j; kind = 2; gain = a.in(I_KNC) + l * 64; }
    const int sub = lane & 15, Lsh = tshift - dsh;
    float g[8];
#pragma unroll
    for (int e = 0; e < 8; ++e) g[e] = gain[((8 * sub) & (kind == 2 ? 63 : 127)) + e];
    const float2* ropeB = (const float2*)(a.ws() + WS_ROPEB); const float2* ropeC = (const float2*)(a.ws() + WS_ROPEC);
    const int RS = kind == 1 ? 2 : 1, subg = kind == 1 ? sub : (sub & 7);
    const bool roper = kind != 0 && subg < 2 * RS, first = subg < RS; const int ib = 8 * (subg & (RS - 1));
    for (int p4 = 0; p4 < 16; p4 += 4) {
        v4u w[4]; int tt[4]; float2 cs[4][8];
#pragma unroll
        for (int q = 0; q < 4; ++q) { const int orow = rb * 64 + (p4 + q) * 4 + (lane >> 4), sl = orow >> tshift, p = orow & (S - 1);
            tt[q] = perm_tok(p, dsh, Lsh);
            w[q] = *(const GAS v4u*)(Z + (size_t)((sl << tshift) + tt[q]) * 6144 + srccol + 8 * sub); }
        if (roper) {
#pragma unroll
            for (int q = 0; q < 4; ++q) { const float2* tab = kind == 1 ? ropeB + tt[q] * 16 + ib : ropeC + tt[q] * 8 + ib;
#pragma unroll
                for (int e = 0; e < 8; ++e) cs[q][e] = tab[e]; } }
#pragma unroll
        for (int q = 0; q < 4; ++q) { const int orow = rb * 64 + (p4 + q) * 4 + (lane >> 4);
            float y[8] = {bflo(w[q].x), bfhi(w[q].x), bflo(w[q].y), bfhi(w[q].y), bflo(w[q].z), bfhi(w[q].z), bflo(w[q].w), bfhi(w[q].w)};
            float ss = 0.f;
#pragma unroll
            for (int e = 0; e < 8; ++e) ss += y[e] * y[e];
            ss += __shfl_xor(ss, 1); ss += __shfl_xor(ss, 2); ss += __shfl_xor(ss, 4);
            if (kind != 2) ss += __shfl_xor(ss, 8);
            const float rstd = rsqrtf(ss * (kind == 2 ? (1.0f / 64.0f) : (1.0f / 128.0f)) + EPS);
#pragma unroll
            for (int e = 0; e < 8; ++e) y[e] = y[e] * rstd * g[e];
            if (kind != 0) {
                float pr[8];
#pragma unroll
                for (int e = 0; e < 8; ++e) pr[e] = __shfl_xor(y[e], RS);
                if (roper) {
#pragma unroll
                    for (int e = 0; e < 8; ++e) y[e] = first ? y[e] * cs[q][e].x - pr[e] * cs[q][e].y : y[e] * cs[q][e].x + pr[e] * cs[q][e].y; }
            }
            v4u o; o.x = pk2(y[0] * scale, y[1] * scale); o.y = pk2(y[2] * scale, y[3] * scale); o.z = pk2(y[4] * scale, y[5] * scale); o.w = pk2(y[6] * scale, y[7] * scale);
            *(GAS v4u*)(QK + (size_t)orow * 4096 + dstcol + 8 * sub) = o; }
    }
}
struct VtItem { int srccol, dsh, sl, p0, vrow; };
__device__ __forceinline__ VtItem vt_decode(int item, int S, int tshift, int nvh) {
    const int dh = item & 1, vh = 10 + (item >> 1) % nvh, pb = item / (2 * nvh); VtItem v; v.dsh = 0;
    v.srccol = 128 * vh; if (vh >= 4 && vh < 10) v.dsh = 2 * ((vh - 4) >> 1);
    v.srccol += 64 * dh; const int o0 = pb * 64; v.sl = o0 >> tshift; v.p0 = o0 & (S - 1); v.vrow = (v.sl * 16 + vh) * 128 + 64 * dh; return v;
}
__device__ __forceinline__ void vt_load(const bf16* Z, const VtItem& v, int tshift, v4u (&w)[8], int lane) {
    const int Lsh = tshift - v.dsh;
#pragma unroll
    for (int pass = 0; pass < 8; ++pass) { const int i = pass * 8 + (lane >> 3), c8 = lane & 7, t = perm_tok(v.p0 + i, v.dsh, Lsh);
        w[pass] = *(const GAS v4u*)(Z + (size_t)((v.sl << tshift) + t) * 2048 + v.srccol + 8 * c8); }
}
__device__ __forceinline__ void vt_store(bf16* VT, const VtItem& v, int S, const v4u (&w)[8], LAS unsigned short* T, int lane) {
#pragma unroll
    for (int pass = 0; pass < 8; ++pass) { const int i = pass * 8 + (lane >> 3), c8 = lane & 7;
        LAS unsigned short* tp = T + (8 * c8) * 68 + i;
        tp[0 * 68] = (unsigned short)(w[pass].x & 0xffffu); tp[1 * 68] = (unsigned short)(w[pass].x >> 16); tp[2 * 68] = (unsigned short)(w[pass].y & 0xffffu); tp[3 * 68] = (unsigned short)(w[pass].y >> 16);
        tp[4 * 68] = (unsigned short)(w[pass].z & 0xffffu); tp[5 * 68] = (unsigned short)(w[pass].z >> 16); tp[6 * 68] = (unsigned short)(w[pass].w & 0xffffu); tp[7 * 68] = (unsigned short)(w[pass].w >> 16); }
    LDS_WAIT(); asm volatile("" ::: "memory");
#pragma unroll
    for (int pass = 0; pass < 16; ++pass) { const int d = pass * 4 + (lane >> 4), c4 = lane & 15;
        const v2u x = *(const LAS v2u*)(T + d * 68 + 4 * c4);
        *(GAS v2u*)(VT + (size_t)(v.vrow + d) * S + v.p0 + 4 * c4) = x; }
    LDS_WAIT(); asm volatile("" ::: "memory");
}
__device__ __forceinline__ void phase_prep(const AL& a, int l, LAS unsigned char* lds, int S, int tshift, int gw, int NGW, int wave, int lane) {
    const bf16* Z = (const bf16*)(a.ws() + A_Z); bf16* VT = (bf16*)(a.ws() + A_VT);
    LAS unsigned short* T = (LAS unsigned short*)(lds + RING_OFF + wave * 16384);
    const int nvh = 6;
    { int it = gw; const int NIT = (CH / 64) * 2 * nvh;
      if (it < NIT) { VtItem cur = vt_decode(it, S, tshift, nvh); v4u w[8]; vt_load(Z, cur, tshift, w, lane);
          for (;;) { const int nx = it + NGW; const bool more = nx < NIT; VtItem nv = cur; v4u wn[8];
              if (more) { nv = vt_decode(nx, S, tshift, nvh); vt_load(Z, nv, tshift, wn, lane); }
              vt_store(VT, cur, S, w, T, lane);
              if (!more) break;
              cur = nv; it = nx;
#pragma unroll
              for (int i = 0; i < 8; ++i) w[i] = wn[i]; } } }
}

namespace att {
#define MFMA32(a, b, c) __builtin_amdgcn_mfma_f32_32x32x16_bf16((a), (b), (c), 0, 0, 0)
__device__ __forceinline__ float ex2(float x) { return __builtin_amdgcn_exp2f(x); }
struct MaskNone { static constexpr bool MASKED = false; __device__ __forceinline__ float operator()(float v, int) const { return v; } };
struct MaskB { static constexpr bool MASKED = true; int dq;
    __device__ __forceinline__ float operator()(float v, int koff) const { const int d = dq + koff; return (d >= -64 && d <= 64) ? v : NEGB; } };
struct MaskA { static constexpr bool MASKED = true; const LAS float* brow; int kc0, qc, cs;
    __device__ __forceinline__ float operator()(float v, int koff) const { const int kc = kc0 + koff; int di = kc - qc + 15; di = di < 0 ? 0 : (di > 30 ? 30 : di);
        const float b = brow[di]; return (kc >= cs && kc < cs + 16) ? v + b : NEGB; } };

template <int NK, class MaskFn>
__device__ __forceinline__ void tile_core(const bf16x8 (&kf)[NK], const bf16x8 (&vf)[4][2], const bf16x8 (&qf)[NK], f32x16 (&o)[4], float& m, float& l, int lane, const MaskFn& mf) {
    const int hi = lane >> 5;
    f32x16 s;
#pragma unroll
    for (int r = 0; r < 16; ++r) s[r] = 0.f;
#pragma unroll
    for (int d0 = 0; d0 < NK; ++d0) s = MFMA32(kf[d0], qf[d0], s);
    float mx = NEGB;
#pragma unroll
    for (int r = 0; r < 16; ++r) { s[r] = mf(s[r], 16 * (r >> 3) + 8 * hi + (r & 7)); mx = fmaxf(mx, s[r]); }
    mx = max32(mx);
    const float mn = fmaxf(m, mx), alpha = ex2(m - mn);
    float ps = 0.f;
#pragma unroll
    for (int r = 0; r < 16; ++r) { float p = ex2(s[r] - mn); if (MaskFn::MASKED) p = s[r] <= -1e29f ? 0.f : p; s[r] = p; ps += p; }
    l = l * alpha + ps; m = mn;
    if (!__all(alpha == 1.0f)) {
#pragma unroll
        for (int db = 0; db < 4; ++db)
#pragma unroll
            for (int r = 0; r < 16; ++r) o[db][r] *= alpha;
    }
    bf16x8 pf[2];
#pragma unroll
    for (int s2 = 0; s2 < 2; ++s2) { v4u w; w.x = pk2(s[8 * s2 + 0], s[8 * s2 + 1]); w.y = pk2(s[8 * s2 + 2], s[8 * s2 + 3]); w.z = pk2(s[8 * s2 + 4], s[8 * s2 + 5]); w.w = pk2(s[8 * s2 + 6], s[8 * s2 + 7]); pf[s2] = __builtin_bit_cast(bf16x8, w); }
#pragma unroll
    for (int db = 0; db < 4; ++db)
#pragma unroll
        for (int s2 = 0; s2 < 2; ++s2) o[db] = MFMA32(vf[db][s2], pf[s2], o[db]);
}
template <int NK, class MaskFn>
__device__ __forceinline__ void tile_step(const bf16* Kt, const bf16* VTt, int S, const bf16x8 (&qf)[NK], f32x16 (&o)[4], float& m, float& l, int lane, const MaskFn& mf) {
    const int r32 = lane & 31, hi = lane >> 5;
    const int pim = (r32 & 19) | ((r32 & 4) << 1) | ((r32 & 8) >> 1);
    const bf16* kp = Kt + (size_t)pim * 4096 + 8 * hi;
    bf16x8 kf[NK];
#pragma unroll
    for (int d0 = 0; d0 < NK; ++d0) kf[d0] = *(const GAS bf16x8*)(kp + 16 * d0);
    bf16x8 vf[4][2];
    const bf16* vp = VTt + (size_t)r32 * S + 8 * hi;
#pragma unroll
    for (int db = 0; db < 4; ++db)
#pragma unroll
        for (int s2 = 0; s2 < 2; ++s2) vf[db][s2] = *(const GAS bf16x8*)(vp + (size_t)(32 * db) * S + 16 * s2);
    tile_core<NK, MaskFn>(kf, vf, qf, o, m, l, lane, mf);
}
template <int NK> __device__ __forceinline__ void load_q(const bf16* Qp, bf16x8 (&qf)[NK], int lane) {
    const bf16* q = Qp + (size_t)(lane & 31) * 4096 + 8 * (lane >> 5);
#pragma unroll
    for (int d0 = 0; d0 < NK; ++d0) qf[d0] = *(const GAS bf16x8*)(q + 16 * d0);
}
__device__ __forceinline__ void zero_o(f32x16 (&o)[4]) {
#pragma unroll
    for (int db = 0; db < 4; ++db)
#pragma unroll
        for (int r = 0; r < 16; ++r) o[db][r] = 0.f;
}
__device__ __forceinline__ void store_o_bf16(bf16* dst, const f32x16 (&o)[4], float inv, int hi) {
#pragma unroll
    for (int db = 0; db < 4; ++db)
#pragma unroll
        for (int g = 0; g < 4; ++g) { v2u w; w.x = pk2(o[db][4 * g] * inv, o[db][4 * g + 1] * inv); w.y = pk2(o[db][4 * g + 2] * inv, o[db][4 * g + 3] * inv);
            *(GAS v2u*)(dst + 32 * db + 8 * g + 4 * hi) = w; }
}
__device__ __forceinline__ void store_o_f32(float* dst, const f32x16 (&o)[4], float inv, int hi) {
#pragma unroll
    for (int db = 0; db < 4; ++db)
#pragma unroll
        for (int g = 0; g < 4; ++g) { const f32x4 v = {o[db][4 * g] * inv, o[db][4 * g + 1] * inv, o[db][4 * g + 2] * inv, o[db][4 * g + 3] * inv};
            *(GAS f32x4*)(dst + 32 * db + 8 * g + 4 * hi) = v; }
}
__device__ __forceinline__ void wave_c(const bf16* QK, const bf16* VT, float* CTMP, int sl, int map, int q0, int S, int tshift, int lane) {
    const size_t row0 = (size_t)sl << tshift; const int hi = lane >> 5;
    const bf16* Kp = QK + row0 * 4096 + 3328 + 64 * map;
    const bf16* Vp = VT + (size_t)((sl * 16 + 10 + (map >> 1)) * 128) * S;
    bf16x8 qf[4]; load_q<4>(QK + (row0 + q0) * 4096 + 2560 + 64 * map, qf, lane);
    f32x16 o[4]; zero_o(o); float m = NEGB, l = 0.f; const MaskNone mf;
    for (int kb = 0; kb < S; kb += 32) tile_step<4, MaskNone>(Kp + (size_t)kb * 4096, Vp + kb, S, qf, o, m, l, lane, mf);
    l = sum32(l);
    store_o_f32(CTMP + (row0 + q0 + (lane & 31)) * 1536 + map * 128, o, 1.0f / l, hi);
}
__device__ __forceinline__ void wave_b(const bf16* QK, const bf16* VT, bf16* BTMP, float* BLSE, int sl, int slot, int p0, int S, int tshift, int lane) {
    const size_t row0 = (size_t)sl << tshift; const int hi = lane >> 5, dsh = 2 * (slot >> 1), Lsh = tshift - dsh;
    const bf16* Kp = QK + row0 * 4096 + 1792 + 128 * slot;
    const bf16* Vp = VT + (size_t)((sl * 16 + 4 + slot) * 128) * S;
    bf16x8 qf[8]; load_q<8>(QK + (row0 + p0) * 4096 + 1024 + 128 * slot, qf, lane);
    f32x16 o[4]; zero_o(o); float m = NEGB, l = 0.f;
    const int qp = p0 + (lane & 31);
#pragma unroll 1
    for (int ti = 0; ti < 5; ++ti) { const int kb = p0 - 64 + 32 * ti;
        if (kb < 0 || kb >= S || (kb >> Lsh) != (p0 >> Lsh)) continue;
        const MaskB mf{kb - qp};
        tile_step<8, MaskB>(Kp + (size_t)kb * 4096, Vp + kb, S, qf, o, m, l, lane, mf); }
    l = sum32(l);
    const int t = perm_tok(qp, dsh, Lsh);
    store_o_bf16(BTMP + (row0 + t) * 768 + slot * 128, o, 1.0f / l, hi);
    if (hi == 0) ((GAS float*)BLSE)[(row0 + t) * 8 + slot] = (__log2f(l) + m) * LN2;
}
__device__ __forceinline__ void wave_a(const bf16* QK, const bf16* VT, bf16* OA, const LAS float* btab, int sl, int h, int r, int qh, int S, int tshift, int lane) {
    const size_t row0 = (size_t)sl << tshift; const int hi = lane >> 5, rows = S >> 6;
    int rs = r - 4; rs = rs < 0 ? 0 : (rs > rows - 8 ? rows - 8 : rs);
    const bf16* Kp = QK + row0 * 4096 + 512 + 128 * h;
    const bf16* Vp = VT + (size_t)((sl * 16 + h) * 128) * S;
    const int q0 = r * 64 + 32 * qh, qc = 32 * qh + (lane & 31);
    int cs = qc - 8; cs = cs < 0 ? 0 : (cs > 48 ? 48 : cs);
    bf16x8 qf[8]; load_q<8>(QK + (row0 + q0) * 4096 + 128 * h, qf, lane);
    f32x16 o[4]; zero_o(o); float m = NEGB, l = 0.f;
#pragma unroll 1
    for (int ti = 0; ti < 16; ++ti) { const int j = ti >> 1, chh = ti & 1, kb = (rs + j) * 64 + 32 * chh;
        const MaskA mf{btab + (rs + j - r + 7) * 31, 32 * chh, qc, cs};
        tile_step<8, MaskA>(Kp + (size_t)kb * 4096, Vp + kb, S, qf, o, m, l, lane, mf); }
    l = sum32(l);
    store_o_bf16(OA + (row0 + q0 + (lane & 31)) * 1536 + h * 128, o, 1.0f / l, hi);
}

constexpr int CST = 24576;
__device__ __forceinline__ void glds16(const void* gsrc, unsigned lds_dst) { unsigned keep;
    asm volatile("s_mov_b32 %0, m0\n\ts_mov_b32 m0, %2\n\ts_nop 0\n\tglobal_load_lds_dwordx4 %1, off\n\ts_mov_b32 m0, %0" : "=&s"(keep) : "v"(gsrc), "s"(lds_dst) : "memory"); }
__device__ __forceinline__ void c_dma(const bf16* Kp, const bf16* Vp, int S, int kb, unsigned sb, int wave, int lane) {
    { const int row = 8 * wave + (lane >> 3), c = (lane & 7) ^ ((row >> 1) & 7);
      glds16(Kp + (size_t)(kb + row) * 4096 + 8 * c, (unsigned)__builtin_amdgcn_readfirstlane(sb + wave * 1024)); }
#pragma unroll
    for (int jj = 0; jj < 2; ++jj) { const int j = wave + 8 * jj, row = 8 * j + (lane >> 3), c = (lane & 7) ^ ((row >> 1) & 7);
      glds16(Vp + (size_t)row * S + kb + 8 * c, (unsigned)__builtin_amdgcn_readfirstlane(sb + 8192 + j * 1024)); }
}
#define C_WAIT_BAR(N) asm volatile("s_waitcnt vmcnt(" #N ")\n\ts_barrier" ::: "memory")
__device__ __forceinline__ void unit_c_fast(const bf16* QK, const bf16* VT, float* CTMP, LAS unsigned char* ring, int sl, int map, int qb, int S, int tshift, int wave, int lane) {
    constexpr int CV = 0;
    const size_t row0 = (size_t)sl << tshift; const int r32 = lane & 31, hi = lane >> 5, q0 = qb * 256 + 32 * wave;
    const bf16* Kp = QK + row0 * 4096 + 3328 + 64 * map;
    const bf16* Vp = VT + (size_t)((sl * 16 + 10 + (map >> 1)) * 128) * S;
    bf16x8 qf[4]; load_q<4>(QK + (row0 + q0) * 4096 + 2560 + 64 * map, qf, lane);
    const int pim = (r32 & 19) | ((r32 & 4) << 1) | ((r32 & 8) >> 1);
    int ka[4], va[4];
#pragma unroll
    for (int d0 = 0; d0 < 4; ++d0) ka[d0] = pim * 128 + (((2 * d0 + hi) ^ ((pim >> 1) & 7)) << 4);
#pragma unroll
    for (int x = 0; x < 4; ++x) va[x] = 8192 + r32 * 128 + (((2 * x + hi) ^ ((r32 >> 1) & 7)) << 4);
    f32x16 o[4]; zero_o(o); float l = 0.f;
    const int NT = S >> 6;
#pragma unroll
    for (int d0 = 0; d0 < 4; ++d0) asm volatile("" : "+v"(qf[d0]));
    asm volatile("s_waitcnt vmcnt(0)\n\ts_barrier" ::: "memory");
    const unsigned ring_a = (unsigned)(size_t)ring;
    c_dma(Kp, Vp, S, 0, ring_a, wave, lane); c_dma(Kp, Vp, S, 64, ring_a + CST, wave, lane);
    int st_cur = 0, st_nxt2 = 2 * CST;
#pragma unroll 1
    for (int t = 0; t < NT; ++t) {
        if (t + 1 < NT) C_WAIT_BAR(3); else C_WAIT_BAR(0);
        if (t + 2 < NT) c_dma(Kp, Vp, S, (t + 2) * 64, ring_a + st_nxt2, wave, lane);
        const LAS unsigned char* sb = ring + st_cur;
        bf16x8 kf[2][4];
#pragma unroll
        for (int st = 0; st < 2; ++st)
#pragma unroll
            for (int d0 = 0; d0 < 4; ++d0) { if (CV & 2) kf[st][d0] = qf[(d0 + st) & 3]; else kf[st][d0] = *(const LAS bf16x8*)(sb + st * 4096 + ka[d0]); }
        f32x16 s[2];
#pragma unroll
        for (int st = 0; st < 2; ++st) {
#pragma unroll
            for (int r = 0; r < 16; ++r) s[st][r] = 0.f;
#pragma unroll
            for (int d0 = 0; d0 < 4; ++d0) s[st] = MFMA32(kf[st][d0], qf[d0], s[st]); }
#pragma unroll
        for (int st = 0; st < 2; ++st) {
            bf16x8 vf[4][2];
#pragma unroll
            for (int db = 0; db < 4; ++db)
#pragma unroll
                for (int s2 = 0; s2 < 2; ++s2) vf[db][s2] = *(const LAS bf16x8*)(sb + db * 4096 + va[2 * st + s2]);
#pragma unroll
            for (int r = 0; r < 16; ++r) { s[st][r] = ex2(s[st][r]); l += s[st][r]; }
            bf16x8 pf[2];
#pragma unroll
            for (int s2 = 0; s2 < 2; ++s2) { v4u w; w.x = pk2(s[st][8 * s2 + 0], s[st][8 * s2 + 1]); w.y = pk2(s[st][8 * s2 + 2], s[st][8 * s2 + 3]); w.z = pk2(s[st][8 * s2 + 4], s[st][8 * s2 + 5]); w.w = pk2(s[st][8 * s2 + 6], s[st][8 * s2 + 7]); pf[s2] = __builtin_bit_cast(bf16x8, w); }
#pragma unroll
            for (int db = 0; db < 4; ++db)
#pragma unroll
                for (int s2 = 0; s2 < 2; ++s2) o[db] = MFMA32(vf[db][s2], pf[s2], o[db]);
        }
        st_cur = st_cur == 2 * CST ? 0 : st_cur + CST; st_nxt2 = st_nxt2 == 2 * CST ? 0 : st_nxt2 + CST;
    }
    l = sum32(l);
    store_o_f32(CTMP + (row0 + q0 + r32) * 1536 + map * 128, o, 1.0f / l, hi);
}

constexpr int CST2 = 32768, CEXP = 132;
typedef short v4i16_t __attribute__((ext_vector_type(4)));
__device__ __forceinline__ v4i16_t vtr(const LAS unsigned char* p) { return __builtin_amdgcn_ds_read_tr16_b64_v4i16((LAS v4i16_t*)p); }
__device__ __forceinline__ void c2_dma(const bf16* Kp0, const bf16* Vrow, int kb, unsigned sb, int wave, int lane) {
    { const int row = 8 * wave + (lane >> 3), c = (lane & 7) ^ ((row >> 1) & 7);
      const bf16* src = Kp0 + (size_t)(kb + row) * 4096 + 8 * c;
      glds16(src, (unsigned)__builtin_amdgcn_readfirstlane(sb + wave * 1024));
      glds16(src + 64, (unsigned)__builtin_amdgcn_readfirstlane(sb + 8192 + wave * 1024)); }
#pragma unroll
    for (int jj = 0; jj < 2; ++jj) { const int j = wave + 8 * jj, st = j >> 3, row = 4 * (j & 7) + (lane >> 4), ch = (lane & 15) ^ (((row & 3) << 2) | ((row >> 2) & 3));
      glds16(Vrow + (size_t)(kb + 32 * st + row) * 2048 + 8 * ch, (unsigned)__builtin_amdgcn_readfirstlane(sb + 16384 + j * 1024)); }
}
template <int CV = 0>
__device__ __forceinline__ void unit_c_fused(const bf16* QK, const bf16* Zv, bf16* OC, const float* subln, float lam, float onemli, LAS unsigned char* ring, int sl, int h, int qb, int S, int tshift, int wave, int lane) {
    const size_t row0 = (size_t)sl << tshift; const int r32 = lane & 31, hi = lane >> 5, mp = wave >> 2, q0 = qb * 128 + 32 * (wave & 3);
    const bf16* Kp0 = QK + row0 * 4096 + 3328 + 128 * h;
    const bf16* Vrow = Zv + row0 * 2048 + 1280 + 128 * h;
    bf16x8 qf[4]; load_q<4>(QK + (row0 + q0) * 4096 + 2560 + 128 * h + 64 * mp, qf, lane);
    const int pim = (r32 & 19) | ((r32 & 4) << 1) | ((r32 & 8) >> 1);
    int ka[4];
#pragma unroll
    for (int d0 = 0; d0 < 4; ++d0) ka[d0] = mp * 8192 + pim * 128 + (((2 * d0 + hi) ^ ((pim >> 1) & 7)) << 4);
    const int tq = (lane & 15) >> 2, tp = lane & 3, tblk = (lane >> 4) & 1;
    const int vlane = 16384 + 256 * (8 * hi + tq) + 8 * (tp & 1);
    int vo[4][2];
#pragma unroll
    for (int db = 0; db < 4; ++db)
#pragma unroll
        for (int t = 0; t < 2; ++t) vo[db][t] = vlane + 1024 * t + 16 * ((((db ^ tq) & 3) << 2) | ((2 * tblk + (tp >> 1)) ^ ((2 * hi + t) & 3)));
    f32x16 o[4]; zero_o(o); float l = 0.f;
    const int NT = S >> 6;
#pragma unroll
    for (int d0 = 0; d0 < 4; ++d0) asm volatile("" : "+v"(qf[d0]));
    asm volatile("s_waitcnt vmcnt(0)\n\ts_barrier" ::: "memory");
    const unsigned ring_a = (unsigned)(size_t)ring;
    c2_dma(Kp0, Vrow, 0, ring_a, wave, lane); c2_dma(Kp0, Vrow, 64, ring_a + CST2, wave, lane);
    int st_cur = 0, st_nxt2 = 2 * CST2;
    if (CV & 16) C_WAIT_BAR(0);
#pragma unroll 1
    for (int t = 0; t < NT; ++t) {
        if (!(CV & 16)) { if (t + 1 < NT) C_WAIT_BAR(4); else C_WAIT_BAR(0); }
        const LAS unsigned char* sb = ring + st_cur;
        bf16x8 kf[2][4];
#pragma unroll
        for (int st = 0; st < 2; ++st)
#pragma unroll
            for (int d0 = 0; d0 < 4; ++d0) { if (CV & 2) kf[st][d0] = qf[(d0 + st) & 3]; else kf[st][d0] = *(const LAS bf16x8*)(sb + st * 4096 + ka[d0]); }
        f32x16 s[2];
#pragma unroll
        for (int st = 0; st < 2; ++st) {
#pragma unroll
            for (int r = 0; r < 16; ++r) s[st][r] = 0.f;
#pragma unroll
            for (int d0 = 0; d0 < 4; ++d0) s[st] = MFMA32(kf[st][d0], qf[d0], s[st]); }
        if (!(CV & 8)) if (t + 2 < NT) c2_dma(Kp0, Vrow, (t + 2) * 64, ring_a + st_nxt2, wave, lane);
#pragma unroll
        for (int st = 0; st < 2; ++st) {
            bf16x8 vf[4][2];
#pragma unroll
            for (int db = 0; db < 4; ++db)
#pragma unroll
                for (int s2 = 0; s2 < 2; ++s2) { if (CV & 4) { vf[db][s2] = qf[(db + s2) & 3]; } else { const v4i16_t lo = vtr(sb + st * 8192 + s2 * 4096 + vo[db][0]), hi4 = vtr(sb + st * 8192 + s2 * 4096 + vo[db][1]);
                    vf[db][s2] = (bf16x8){lo[0], lo[1], lo[2], lo[3], hi4[0], hi4[1], hi4[2], hi4[3]}; } }
#pragma unroll
            for (int r = 0; r < 16; ++r) { if (!(CV & 1)) s[st][r] = ex2(s[st][r]); l += s[st][r]; }
            bf16x8 pf[2];
#pragma unroll
            for (int s2 = 0; s2 < 2; ++s2) { v4u w; w.x = pk2(s[st][8 * s2 + 0], s[st][8 * s2 + 1]); w.y = pk2(s[st][8 * s2 + 2], s[st][8 * s2 + 3]); w.z = pk2(s[st][8 * s2 + 4], s[st][8 * s2 + 5]); w.w = pk2(s[st][8 * s2 + 6], s[st][8 * s2 + 7]); pf[s2] = __builtin_bit_cast(bf16x8, w); }
#pragma unroll
            for (int db = 0; db < 4; ++db)
#pragma unroll
                for (int s2 = 0; s2 < 2; ++s2) o[db] = MFMA32(vf[db][s2], pf[s2], o[db]);
        }
        st_cur = st_cur == 2 * CST2 ? 0 : st_cur + CST2; st_nxt2 = st_nxt2 == 2 * CST2 ? 0 : st_nxt2 + CST2;
    }
    l = sum32(l);
    const float inv = 1.0f / l;
    LAS float* ex = (LAS float*)ring + (32 * (wave & 3) + r32) * CEXP + 4 * hi;
    asm volatile("s_waitcnt lgkmcnt(0)\n\ts_barrier" ::: "memory");
    if (mp == 1) {
#pragma unroll
        for (int db = 0; db < 4; ++db)
#pragma unroll
            for (int g = 0; g < 4; ++g) *(LAS f32x4*)(ex + 32 * db + 8 * g) = (f32x4){o[db][4 * g] * inv, o[db][4 * g + 1] * inv, o[db][4 * g + 2] * inv, o[db][4 * g + 3] * inv};
    }
    asm volatile("s_waitcnt lgkmcnt(0)\n\ts_barrier" ::: "memory");
    if (mp == 0) {
        float ss = 0.f;
#pragma unroll
        for (int db = 0; db < 4; ++db)
#pragma unroll
            for (int g = 0; g < 4; ++g) { const f32x4 o2 = *(const LAS f32x4*)(ex + 32 * db + 8 * g);
#pragma unroll
                for (int e = 0; e < 4; ++e) { const float x = o[db][4 * g + e] * inv - lam * o2[e]; o[db][4 * g + e] = x; ss += x * x; } }
        ss = sum32(ss);
        const float rstd = rsqrtf(ss * (1.0f / 128.0f) + EPS) * onemli;
        bf16* dst = OC + (row0 + q0 + r32) * 1536 + h * 128;
#pragma unroll
        for (int db = 0; db < 4; ++db)
#pragma unroll
            for (int g = 0; g < 4; ++g) { const f32x4 gn = *(const GAS f32x4*)(subln + 32 * db + 8 * g + 4 * hi);
                v2u w; w.x = pk2(o[db][4 * g] * rstd * gn[0], o[db][4 * g + 1] * rstd * gn[1]); w.y = pk2(o[db][4 * g + 2] * rstd * gn[2], o[db][4 * g + 3] * rstd * gn[3]);
                *(GAS v2u*)(dst + 32 * db + 8 * g + 4 * hi) = w; }
    }
}

constexpr int CSTA = 32768;
typedef short a_v4i16_t __attribute__((ext_vector_type(4)));
__device__ __forceinline__ a_v4i16_t a_vtr(const LAS unsigned char* p) { return __builtin_amdgcn_ds_read_tr16_b64_v4i16((LAS a_v4i16_t*)p); }
__device__ __forceinline__ void a_dma(const bf16* Kp, const bf16* Vrow, int kb, unsigned sb, int wave, int lane) {
#pragma unroll
    for (int jj = 0; jj < 2; ++jj) { const int j = wave + 8 * jj, row = 4 * j + (lane >> 4), c = (lane & 15) ^ (row & 15);
      glds16(Kp + (size_t)(kb + row) * 4096 + 8 * c, (unsigned)__builtin_amdgcn_readfirstlane(sb + j * 1024)); }
#pragma unroll
    for (int jj = 0; jj < 2; ++jj) { const int j = wave + 8 * jj, st = j >> 3, row = 4 * (j & 7) + (lane >> 4), ch = (lane & 15) ^ (((row & 3) << 2) | ((row >> 2) & 3));
      glds16(Vrow + (size_t)(kb + 32 * st + row) * 2048 + 8 * ch, (unsigned)__builtin_amdgcn_readfirstlane(sb + 16384 + j * 1024)); }
}
__device__ __forceinline__ void unit_a_lds(const bf16* QK, const bf16* Zv, bf16* OA, const float* rpb, LAS float* btab, LAS unsigned char* ring, int sl, int h, int qb, int S, int tshift, int wave, int lane, int tid) {
    const size_t row0 = (size_t)sl << tshift; const int r32 = lane & 31, hi = lane >> 5, rows = S >> 6;
    const int r = 4 * qb + (wave >> 1), qh = wave & 1;
    int rs = r - 4; rs = rs < 0 ? 0 : (rs > rows - 8 ? rows - 8 : rs);
    int kr_lo = 4 * qb - 4; kr_lo = kr_lo < 0 ? 0 : (kr_lo > rows - 8 ? rows - 8 : kr_lo);
    int kr_hi = 4 * qb - 1; kr_hi = (kr_hi < 0 ? 0 : (kr_hi > rows - 8 ? rows - 8 : kr_hi)) + 8;
    const int NT = kr_hi - kr_lo;
    const bf16* Kp = QK + row0 * 4096 + 512 + 128 * h;
    const bf16* Vrow = Zv + row0 * 2048 + 128 * h;
    const int q0 = r * 64 + 32 * qh, qc = 32 * qh + r32;
    int cs = qc - 8; cs = cs < 0 ? 0 : (cs > 48 ? 48 : cs);
    bf16x8 qf[8]; load_q<8>(QK + (row0 + q0) * 4096 + 128 * h, qf, lane);
    const int pim = (r32 & 19) | ((r32 & 4) << 1) | ((r32 & 8) >> 1);
    const int kbase = pim * 256, kx = pim & 15;
    const int tq = (lane & 15) >> 2, tp = lane & 3, tblk = (lane >> 4) & 1, vlane = 16384 + 256 * (8 * hi + tq) + 8 * (tp & 1);
    int vo[4][2];
#pragma unroll
    for (int db = 0; db < 4; ++db)
#pragma unroll
        for (int t = 0; t < 2; ++t) vo[db][t] = vlane + 1024 * t + 16 * ((((db ^ tq) & 3) << 2) | ((2 * tblk + (tp >> 1)) ^ ((2 * hi + t) & 3)));
    f32x16 o[4]; zero_o(o); float m = NEGB, l = 0.f;
#pragma unroll
    for (int d0 = 0; d0 < 8; ++d0) asm volatile("" : "+v"(qf[d0]));
    asm volatile("s_waitcnt vmcnt(0)\n\ts_barrier" ::: "memory");
    for (int e = tid; e < 15 * 31; e += NWAVES * 64) btab[e] = rpb[e] * LOG2E;
    asm volatile("s_waitcnt vmcnt(0) lgkmcnt(0)" ::: "memory");
    const unsigned ring_a = (unsigned)(size_t)ring;
    a_dma(Kp, Vrow, kr_lo * 64, ring_a, wave, lane); a_dma(Kp, Vrow, (kr_lo + 1) * 64, ring_a + CSTA, wave, lane);
    int st_cur = 0, st_nxt2 = 2 * CSTA;
#pragma unroll 1
    for (int t = 0; t < NT; ++t) { const int kr = kr_lo + t;
        if (t + 1 < NT) C_WAIT_BAR(4); else C_WAIT_BAR(0);
        if (t + 2 < NT) a_dma(Kp, Vrow, (kr + 2) * 64, ring_a + st_nxt2, wave, lane);
        if (kr >= rs && kr < rs + 8) { const LAS unsigned char* sb = ring + st_cur;
#pragma unroll 1
            for (int chh = 0; chh < 2; ++chh) {
                bf16x8 kf[8];
#pragma unroll
                for (int d0 = 0; d0 < 8; ++d0) kf[d0] = *(const LAS bf16x8*)(sb + chh * 8192 + kbase + (((2 * d0 + hi) ^ kx) << 4));
                bf16x8 vf[4][2];
#pragma unroll
                for (int db = 0; db < 4; ++db)
#pragma unroll
                    for (int s2 = 0; s2 < 2; ++s2) { const a_v4i16_t lo = a_vtr(sb + chh * 8192 + s2 * 4096 + vo[db][0]), hi4 = a_vtr(sb + chh * 8192 + s2 * 4096 + vo[db][1]);
                        vf[db][s2] = (bf16x8){lo[0], lo[1], lo[2], lo[3], hi4[0], hi4[1], hi4[2], hi4[3]}; }
                const MaskA mf{btab + (kr - r + 7) * 31, 32 * chh, qc, cs};
                tile_core<8, MaskA>(kf, vf, qf, o, m, l, lane, mf); } }
        st_cur = st_cur == 2 * CSTA ? 0 : st_cur + CSTA; st_nxt2 = st_nxt2 == 2 * CSTA ? 0 : st_nxt2 + CSTA;
    }
    l = sum32(l);
    store_o_bf16(OA + (row0 + q0 + r32) * 1536 + h * 128, o, 1.0f / l, hi);
}

struct MaskB2 { static constexpr bool MASKED = true; int qp, kp0, Lsh, qcls;
    __device__ __forceinline__ float operator()(float v, int koff) const { const int kp = kp0 + koff, d = kp - qp; return (d >= -64 && d <= 64 && (kp >> Lsh) == qcls) ? v : NEGB; } };
__device__ __forceinline__ void b_dma(const bf16* Kp, const bf16* Vrow, int S, int dsh, int Lsh, int kp0, unsigned sb, int wave, int lane) {
#pragma unroll
    for (int jj = 0; jj < 2; ++jj) { const int j = wave + 8 * jj, row = 4 * j + (lane >> 4), c = (lane & 15) ^ (row & 15);
      int kp = kp0 + row; kp = kp < 0 ? 0 : (kp > S - 1 ? S - 1 : kp);
      glds16(Kp + (size_t)kp * 4096 + 8 * c, (unsigned)__builtin_amdgcn_readfirstlane(sb + j * 1024)); }
#pragma unroll
    for (int jj = 0; jj < 2; ++jj) { const int j = wave + 8 * jj, st = j >> 3, row = 4 * (j & 7) + (lane >> 4), ch = (lane & 15) ^ (((row & 3) << 2) | ((row >> 2) & 3));
      int kp = kp0 + 32 * st + row; kp = kp < 0 ? 0 : (kp > S - 1 ? S - 1 : kp);
      glds16(Vrow + (size_t)perm_tok(kp, dsh, Lsh) * 2048 + 8 * ch, (unsigned)__builtin_amdgcn_readfirstlane(sb + 16384 + j * 1024)); }
}
__device__ __forceinline__ void unit_b_lds(const bf16* QK, const bf16* Zv, bf16* BTMP, float* BLSE, LAS unsigned char* ring, int sl, int slot, int pb, int S, int tshift, int wave, int lane) {
    const size_t row0 = (size_t)sl << tshift; const int r32 = lane & 31, hi = lane >> 5, dsh = 2 * (slot >> 1), Lsh = tshift - dsh;
    const int p0 = pb * 256, qp = p0 + 32 * wave + r32;
    const bf16* Kp = QK + row0 * 4096 + 1792 + 128 * slot;
    const bf16* Vrow = Zv + row0 * 2048 + 512 + 128 * slot;
    bf16x8 qf[8]; load_q<8>(QK + (row0 + p0 + 32 * wave) * 4096 + 1024 + 128 * slot, qf, lane);
    const int pim = (r32 & 19) | ((r32 & 4) << 1) | ((r32 & 8) >> 1);
    const int kbase = pim * 256, kx = pim & 15;
    const int tq = (lane & 15) >> 2, tp = lane & 3, tblk = (lane >> 4) & 1, vlane = 16384 + 256 * (8 * hi + tq) + 8 * (tp & 1);
    int vo[4][2];
#pragma unroll
    for (int db = 0; db < 4; ++db)
#pragma unroll
        for (int t = 0; t < 2; ++t) vo[db][t] = vlane + 1024 * t + 16 * ((((db ^ tq) & 3) << 2) | ((2 * tblk + (tp >> 1)) ^ ((2 * hi + t) & 3)));
    f32x16 o[4]; zero_o(o); float m = NEGB, l = 0.f;
#pragma unroll
    for (int d0 = 0; d0 < 8; ++d0) asm volatile("" : "+v"(qf[d0]));
    asm volatile("s_waitcnt vmcnt(0)\n\ts_barrier" ::: "memory");
    const unsigned ring_a = (unsigned)(size_t)ring;
    const int kpo = p0 - 64;
    b_dma(Kp, Vrow, S, dsh, Lsh, kpo, ring_a, wave, lane); b_dma(Kp, Vrow, S, dsh, Lsh, kpo + 64, ring_a + CSTA, wave, lane);
    int st_cur = 0, st_nxt2 = 2 * CSTA;
    const int jlo = wave >> 1, qcls = qp >> Lsh;
#pragma unroll 1
    for (int t = 0; t < 6; ++t) {
        if (t + 1 < 6) C_WAIT_BAR(4); else C_WAIT_BAR(0);
        if (t + 2 < 6) b_dma(Kp, Vrow, S, dsh, Lsh, kpo + 64 * (t + 2), ring_a + st_nxt2, wave, lane);
        if (t >= jlo && t <= jlo + 2) { const LAS unsigned char* sb = ring + st_cur;
#pragma unroll 1
            for (int chh = 0; chh < 2; ++chh) { const int ks = 64 * t + 32 * chh;
                if (ks + 32 <= 32 * wave || ks >= 32 * wave + 160) continue;
                bf16x8 kf[8];
#pragma unroll
                for (int d0 = 0; d0 < 8; ++d0) kf[d0] = *(const LAS bf16x8*)(sb + chh * 8192 + kbase + (((2 * d0 + hi) ^ kx) << 4));
                bf16x8 vf[4][2];
#pragma unroll
                for (int db = 0; db < 4; ++db)
#pragma unroll
                    for (int s2 = 0; s2 < 2; ++s2) { const a_v4i16_t lo = a_vtr(sb + chh * 8192 + s2 * 4096 + vo[db][0]), hi4 = a_vtr(sb + chh * 8192 + s2 * 4096 + vo[db][1]);
                        vf[db][s2] = (bf16x8){lo[0], lo[1], lo[2], lo[3], hi4[0], hi4[1], hi4[2], hi4[3]}; }
                const MaskB2 mf{qp, kpo + ks, Lsh, qcls};
                tile_core<8, MaskB2>(kf, vf, qf, o, m, l, lane, mf); } }
        st_cur = st_cur == 2 * CSTA ? 0 : st_cur + CSTA; st_nxt2 = st_nxt2 == 2 * CSTA ? 0 : st_nxt2 + CSTA;
    }
    l = sum32(l);
    const int tok = perm_tok(qp, dsh, Lsh);
    store_o_bf16(BTMP + (row0 + tok) * 768 + slot * 128, o, 1.0f / l, hi);
    if (hi == 0) ((GAS float*)BLSE)[(row0 + tok) * 8 + slot] = (__log2f(l) + m) * LN2;
}
}

template <int CV = 0>
__device__ __forceinline__ void phase_attn(const AL& a, int l, LAS unsigned char* lds, int S, int tshift, int tid, int wave, int lane, int types = 7) {
    const bf16* QK = (const bf16*)(a.ws() + A_QK); const bf16* VT = (const bf16*)(a.ws() + A_VT);
    const int nqb = S >> 8, nseq = CH >> tshift;
    const int G = gridDim.x, vid = (G % 8 == 0) ? (blockIdx.x % 8) * (G / 8) + blockIdx.x / 8 : blockIdx.x;
    if (types & 1) { float* CTMP = (float*)(a.ws() + A_CTMP); const float cbound = ((const float*)(a.ws() + WS_LAM))[2 + l];
      if (cbound <= 64.0f) { const int nq2 = S >> 7;
          const float lam = ((const float*)(a.ws() + WS_LAM))[l], onemli = 1.0f - (0.8f - 0.6f * expf(-0.3f * (float)l));
          bf16* OC = (bf16*)(a.ws() + A_OA) + 768; const float* subln = a.in(I_SUBLN) + l * 128;
          for (int u = vid; u < nseq * 6 * nq2; u += G) { const int qb = u % nq2, h = (u / nq2) % 6, sl = u / (nq2 * 6);
              att::unit_c_fused<CV>(QK, (const bf16*)(a.ws() + A_Z), OC, subln, lam, onemli, lds + RING_OFF, sl, h, qb, S, tshift, wave, lane); }
      } else {
          for (int u = vid; u < nseq * 12 * nqb; u += G) { const int qb = u % nqb, map = (u / nqb) % 12, sl = u / (nqb * 12);
              att::wave_c(QK, VT, CTMP, sl, map, qb * 256 + 32 * wave, S, tshift, lane); } } }
    if (types & 2) { bf16* OA = (bf16*)(a.ws() + A_OA); LAS float* btab = (LAS float*)(lds + LDSCTL_OFF + 1024);
      for (int u = vid; u < nseq * 4 * nqb; u += G) { const int qb = u % nqb, h = (u / nqb) % 4, sl = u / (nqb * 4);
          att::unit_a_lds(QK, (const bf16*)(a.ws() + A_Z), OA, a.in(I_RPB) + (size_t)(l * 4 + h) * 465, btab, lds + RING_OFF, sl, h, qb, S, tshift, wave, lane, tid); }
      __syncthreads(); }
    if (types & 4) { bf16* BTMP = (bf16*)(a.ws() + A_BTMP); float* BLSE = (float*)(a.ws() + A_BLSE);
      for (int u = vid; u < nseq * 6 * nqb; u += G) { const int pb = u % nqb, slot = (u / nqb) % 6, sl = u / (nqb * 6);
          att::unit_b_lds(QK, (const bf16*)(a.ws() + A_Z), BTMP, BLSE, lds + RING_OFF, sl, slot, pb, S, tshift, wave, lane); }
      __syncthreads(); }
}
__device__ __forceinline__ void phase_combine(const AL& a, int l, int gw, int NGW, int lane) {
    const bool do_c = ((const float*)(a.ws() + WS_LAM))[2 + l] > 64.0f;
    const int nsh = do_c ? 3 : 1, nsm = (1 << nsh) - 1;
    const bf16* BTMP = (const bf16*)(a.ws() + A_BTMP); const float* BLSE = (const float*)(a.ws() + A_BLSE); const float* CTMP = (const float*)(a.ws() + A_CTMP);
    bf16* OB = (bf16*)(a.ws() + A_OA) + 512; bf16* OC = (bf16*)(a.ws() + A_OA) + 768;
    const float lam = ((const float*)(a.ws() + WS_LAM))[l], lam_init = 0.8f - 0.6f * expf(-0.3f * (float)l);
    const float* subln = a.in(I_SUBLN) + l * 128;
    const int sub = lane & 15, d0 = 8 * sub;
    const int NIT = (CH / 4) << nsh;
    if ((NGW & 7) == 0) {
        const int slot = gw & nsm;
        if (slot < 2) { const int hg = slot;
            for (int it = gw; it < NIT; it += 2 * NGW) { const bool two = it + NGW < NIT;
                const size_t rowa = (size_t)(it >> nsh) * 4 + (lane >> 4), rowb = two ? (size_t)((it + NGW) >> nsh) * 4 + (lane >> 4) : rowa;
                float la[3], lb[3]; v4u xa[3], xb[3];
#pragma unroll
                for (int g = 0; g < 3; ++g) { la[g] = ((const GAS float*)BLSE)[rowa * 8 + 2 * g + hg]; lb[g] = ((const GAS float*)BLSE)[rowb * 8 + 2 * g + hg];
                    xa[g] = *(const GAS v4u*)(BTMP + rowa * 768 + (2 * g + hg) * 128 + d0); xb[g] = *(const GAS v4u*)(BTMP + rowb * 768 + (2 * g + hg) * 128 + d0); }
#pragma unroll
                for (int q = 0; q < 2; ++q) { if (q == 1 && !two) break;
                    const float l0 = q ? lb[0] : la[0], l1 = q ? lb[1] : la[1], l2 = q ? lb[2] : la[2]; const v4u a0 = q ? xb[0] : xa[0], a1 = q ? xb[1] : xa[1], a2 = q ? xb[2] : xa[2];
                    const float mx = fmaxf(l0, fmaxf(l1, l2)); float w0 = __expf(l0 - mx), w1 = __expf(l1 - mx), w2 = __expf(l2 - mx);
                    const float inv = 1.0f / (w0 + w1 + w2); w0 *= inv; w1 *= inv; w2 *= inv;
                    v4u o;
                    o.x = pk2(w0 * bflo(a0.x) + w1 * bflo(a1.x) + w2 * bflo(a2.x), w0 * bfhi(a0.x) + w1 * bfhi(a1.x) + w2 * bfhi(a2.x));
                    o.y = pk2(w0 * bflo(a0.y) + w1 * bflo(a1.y) + w2 * bflo(a2.y), w0 * bfhi(a0.y) + w1 * bfhi(a1.y) + w2 * bfhi(a2.y));
                    o.z = pk2(w0 * bflo(a0.z) + w1 * bflo(a1.z) + w2 * bflo(a2.z), w0 * bfhi(a0.z) + w1 * bfhi(a1.z) + w2 * bfhi(a2.z));
                    o.w = pk2(w0 * bflo(a0.w) + w1 * bflo(a1.w) + w2 * bflo(a2.w), w0 * bfhi(a0.w) + w1 * bfhi(a1.w) + w2 * bfhi(a2.w));
                    *(GAS v4u*)(OB + (q ? rowb : rowa) * 1536 + hg * 128 + d0) = o; } }
        } else { const int h = slot - 2;
            const f32x4 g0 = *(const GAS f32x4*)(subln + d0), g1 = *(const GAS f32x4*)(subln + d0 + 4);
            for (int it = gw; it < NIT; it += 2 * NGW) { const bool two = it + NGW < NIT;
                const size_t rowa = (size_t)(it >> nsh) * 4 + (lane >> 4), rowb = two ? (size_t)((it + NGW) >> nsh) * 4 + (lane >> 4) : rowa;
                const float* pa = CTMP + rowa * 1536 + (2 * h) * 128 + d0; const float* pb = CTMP + rowb * 1536 + (2 * h) * 128 + d0;
                const f32x4 a10 = *(const f32x4*)pa, a11 = *(const GAS f32x4*)(pa + 4), a20 = *(const GAS f32x4*)(pa + 128), a21 = *(const GAS f32x4*)(pa + 132);
                const f32x4 b10 = *(const f32x4*)pb, b11 = *(const GAS f32x4*)(pb + 4), b20 = *(const GAS f32x4*)(pb + 128), b21 = *(const GAS f32x4*)(pb + 132);
#pragma unroll
                for (int q = 0; q < 2; ++q) { if (q == 1 && !two) break;
                    const f32x4 x0 = q ? b10 - lam * b20 : a10 - lam * a20, x1 = q ? b11 - lam * b21 : a11 - lam * a21;
                    float ss = (x0.x * x0.x + x0.y * x0.y) + (x0.z * x0.z + x0.w * x0.w) + (x1.x * x1.x + x1.y * x1.y) + (x1.z * x1.z + x1.w * x1.w);
                    ss += shx<1>(ss); ss += shx<2>(ss); ss += shx<4>(ss); ss += shx<8>(ss);
                    const float rstd = rsqrtf(ss * (1.0f / 128.0f) + EPS) * (1.0f - lam_init);
                    v4u o; o.x = pk2(x0.x * rstd * g0.x, x0.y * rstd * g0.y); o.y = pk2(x0.z * rstd * g0.z, x0.w * rstd * g0.w);
                    o.z = pk2(x1.x * rstd * g1.x, x1.y * rstd * g1.y); o.w = pk2(x1.z * rstd * g1.z, x1.w * rstd * g1.w);
                    *(GAS v4u*)(OC + (q ? rowb : rowa) * 1536 + h * 128 + d0) = o; } }
        }
        return;
    }
    for (int it = gw; it < NIT; it += NGW) { const int slot = it & nsm; const size_t row = (size_t)(it >> nsh) * 4 + (lane >> 4);
        if (slot < 2) { const int hg = slot;
            const float l0 = BLSE[row * 8 + hg], l1 = BLSE[row * 8 + 2 + hg], l2 = BLSE[row * 8 + 4 + hg];
            const float mx = fmaxf(l0, fmaxf(l1, l2)); float w0 = __expf(l0 - mx), w1 = __expf(l1 - mx), w2 = __expf(l2 - mx);
            const float inv = 1.0f / (w0 + w1 + w2); w0 *= inv; w1 *= inv; w2 *= inv;
            const v4u a0 = *(const GAS v4u*)(BTMP + row * 768 + (0 + hg) * 128 + d0), a1 = *(const GAS v4u*)(BTMP + row * 768 + (2 + hg) * 128 + d0), a2 = *(const GAS v4u*)(BTMP + row * 768 + (4 + hg) * 128 + d0);
            v4u o;
            o.x = pk2(w0 * bflo(a0.x) + w1 * bflo(a1.x) + w2 * bflo(a2.x), w0 * bfhi(a0.x) + w1 * bfhi(a1.x) + w2 * bfhi(a2.x));
            o.y = pk2(w0 * bflo(a0.y) + w1 * bflo(a1.y) + w2 * bflo(a2.y), w0 * bfhi(a0.y) + w1 * bfhi(a1.y) + w2 * bfhi(a2.y));
            o.z = pk2(w0 * bflo(a0.z) + w1 * bflo(a1.z) + w2 * bflo(a2.z), w0 * bfhi(a0.z) + w1 * bfhi(a1.z) + w2 * bfhi(a2.z));
            o.w = pk2(w0 * bflo(a0.w) + w1 * bflo(a1.w) + w2 * bflo(a2.w), w0 * bfhi(a0.w) + w1 * bfhi(a1.w) + w2 * bfhi(a2.w));
            *(GAS v4u*)(OB + row * 1536 + hg * 128 + d0) = o;
        } else { const int h = slot - 2;
            const float* p1 = CTMP + row * 1536 + (2 * h) * 128 + d0; const float* p2 = p1 + 128;
            const f32x4 x0 = *(const f32x4*)p1 - lam * *(const f32x4*)p2, x1 = *(const GAS f32x4*)(p1 + 4) - lam * *(const GAS f32x4*)(p2 + 4);
            float ss = (x0.x * x0.x + x0.y * x0.y) + (x0.z * x0.z + x0.w * x0.w) + (x1.x * x1.x + x1.y * x1.y) + (x1.z * x1.z + x1.w * x1.w);
            ss += shx<1>(ss); ss += shx<2>(ss); ss += shx<4>(ss); ss += shx<8>(ss);
            const float rstd = rsqrtf(ss * (1.0f / 128.0f) + EPS) * (1.0f - lam_init);
            const f32x4 g0 = *(const GAS f32x4*)(subln + d0), g1 = *(const GAS f32x4*)(subln + d0 + 4);
            v4u o; o.x = pk2(x0.x * rstd * g0.x, x0.y * rstd * g0.y); o.y = pk2(x0.z * rstd * g0.z, x0.w * rstd * g0.w);
            o.z = pk2(x1.x * rstd * g1.x, x1.y * rstd * g1.y); o.w = pk2(x1.z * rstd * g1.z, x1.w * rstd * g1.w);
            *(GAS v4u*)(OC + row * 1536 + h * 128 + d0) = o;
        }
    }
}
#define CHECK_HOOK(stage, c, l) do {} while (0)
#define CHECK_FINAL() do {} while (0)

#ifndef PHMASK
#define PHMASK 0xFFFF
#endif
#define PH(k) ((PHMASK >> (k)) & 1)
#ifndef DUPMASK
#define DUPMASK 0
#endif
#define DUP(k) ((DUPMASK >> (k)) & 1)
#ifndef BARX
#define BARX 1
#endif
__device__ __forceinline__ int lane_id_now() { unsigned z = 0u; asm volatile("" : "+v"(z)); return (int)__builtin_amdgcn_mbcnt_hi(~0u, __builtin_amdgcn_mbcnt_lo(~0u, z)); }
__global__ void __launch_bounds__(NWAVES * 64, 2) fwd(Args kargs) {
    extern __shared__ __attribute__((aligned(16))) unsigned char lds_raw[];
    LAS unsigned char* lds = (LAS unsigned char*)lds_raw;
    volatile LAS unsigned* MISC = (volatile LAS unsigned*)(lds + MISC_OFF);
    int wave = __builtin_amdgcn_readfirstlane((int)threadIdx.x >> 6);
#define LANE_ID() lane_id_now()
    int lane = LANE_ID(), tid = wave * 64 + lane;
    for (int u = tid; u < (LDS_BYTES - LDSCTL_OFF) / 4; u += NWAVES * 64) ((LAS unsigned*)(lds + LDSCTL_OFF))[u] = 0u;
    __syncthreads();
    const AL a{};
    XcdBarrier bar = xcd_barrier_post((unsigned*)(a.ws() + WS_CTL) + CW_BAR, MISC + 8, tid);
#define GRID_BAR() do { for (int b_ = 0; b_ < BARX; ++b_) xcd_barrier(bar, wave * 64 + LANE_ID()); } while (0)
    int G = gridDim.x, bid = (int)blockIdx.x;
#define LAUNDER() do { asm volatile("" : "+s"(G), "+s"(bid)); asm volatile("" : "+s"(wave)); lane = LANE_ID(); asm volatile("" : "+v"(lane)); tid = wave * 64 + lane; } while (0)
#ifndef WGM_BIG
#define WGM_BIG 8
#endif
#ifndef STAG_TICKS
#define STAG_TICKS 0
#endif
#define STAGGER() do { if (STAG_TICKS > 0) { const unsigned long long t0_ = __builtin_amdgcn_s_memrealtime(); const unsigned long long w_ = (unsigned long long)(((bid >> 3) & 3) * STAG_TICKS); \
    while (__builtin_amdgcn_s_memrealtime() - t0_ < w_) __builtin_amdgcn_s_sleep(8); } } while (0)
#define GW (bid * NWAVES + wave)
#define NGW_ (G * NWAVES)

    if (PH(0)) { phase_modp(a, lds, tid, lane, wave); phase_colmax(a, (int)blockIdx.x * NWAVES + wave, (int)gridDim.x * NWAVES, lane); }
    if (DUP(0)) { __syncthreads(); phase_modp(a, lds, tid, lane, wave); }
    GRID_BAR();
    if (PH(1)) phase_pro2(a, lds, tid, lane, wave, G);
    if (DUP(1)) { __syncthreads(); phase_pro2(a, lds, tid, lane, wave, G); }
    GRID_BAR();
    CHECK_HOOK(0, 0, 0);

#pragma unroll 1
    for (int cl = 0; cl < NCHUNK * 2; ++cl) {
        int c = cl >> 1, l = cl & 1;
        asm volatile("" : "+s"(c), "+s"(l));
#define R0 (c * CH)
#define PROMPT (R0 < 32768)
#define S_ (PROMPT ? 4096 : 2048)
#define TSH (PROMPT ? 12 : 11)
#define SEQ0 (PROMPT ? (R0 >> 12) : 8 + ((R0 - 32768) >> 11))
#define XIN0 (PROMPT ? a.in(I_XP) + (size_t)R0 * DM : a.in(I_XS) + (size_t)(R0 - 32768) * DM)
#define XO (a.out() + (size_t)R0 * DM)
#define XCUR (l == 0 ? XIN0 : (const float*)XO)
#define MODL ((const float*)(a.ws() + WS_MOD) + (size_t)l * 24 * 12288)
#define WL (a.ws() + WS_W + (size_t)l * W_LAYER)
        if (PH(2)) { LAUNDER();
            if (l == 0) { phase_norm<true, false, true>(XIN0, nullptr, nullptr, nullptr, a.in(I_N1G) + l * DM, MODL, 0, 2048, SEQ0, TSH, I8IN ? nullptr : (bf16*)(a.ws() + A_H), GW, NGW_, lane, a.ws() + A_HI8, (float*)(a.ws() + A_HS)); }
            else phase_norm<false, true, true>(nullptr, (const bf16*)(a.ws() + A_X), (const bf16*)(a.ws() + A_VT), (bf16*)(a.ws() + A_X), a.in(I_N1G) + l * DM, MODL, 0, 2048, SEQ0, TSH, I8IN ? nullptr : (bf16*)(a.ws() + A_H), GW, NGW_, lane, a.ws() + A_HI8, (float*)(a.ws() + A_HS)); }
        GRID_BAR(); CHECK_HOOK(1, c, l);
        for (int rep_ = 0; rep_ < (PH(3) ? 1 + DUP(3) : 0); ++rep_) { LAUNDER(); unsigned char* ws = a.ws(); pg8::StaticOrder So; So.init(CH, INC, G, bid, WGM_BIG);
          pg8::EpiIn E{l, S_, TSH, (LAS float*)(lds + LDSCTL_OFF + 1024)}; STAGGER();
#if I8IN
          pg8::Gemm g{(const pg8::bf16_t*)(ws + A_HI8), (const pg8::bf16_t*)(WL + WO_IG), CH, INC, DM / 2};
          pg8::gemm_phase<pg8::EpiIn, pg8::StaticOrder, true, true, true>(lds + RING_OFF, g, So, E, tid); }
#else
          pg8::Gemm g{(const pg8::bf16_t*)(ws + A_H), (const pg8::bf16_t*)(WL + WO_IG), CH, INC, DM};
          pg8::gemm_phase<pg8::EpiIn, pg8::StaticOrder, true, true, false>(lds + RING_OFF, g, So, E, tid); }
#endif
        GRID_BAR(); CHECK_HOOK(2, c, l);
        if (__builtin_amdgcn_readfirstlane(__float_as_int(((const float*)(a.ws() + WS_LAM))[2 + l])) > 0x42800000) {
            if (PH(4)) { LAUNDER(); phase_prep(a, l, lds, S_, TSH, GW, NGW_, wave, lane); }
            GRID_BAR(); }
#ifdef CVARX
        { LAUNDER(); phase_attn<CVARX>(a, l, lds, S_, TSH, tid, wave, lane, 1); __syncthreads(); }
#endif
        if (PH(5)) { LAUNDER(); phase_attn(a, l, lds, S_, TSH, tid, wave, lane); }
        if (DUP(5)) { LAUNDER(); __syncthreads(); phase_attn(a, l, lds, S_, TSH, tid, wave, lane); }
        if (DUP(12) || DUP(13) || DUP(14)) { LAUNDER(); __syncthreads(); phase_attn(a, l, lds, S_, TSH, tid, wave, lane, DUP(12) | (DUP(13) << 1) | (DUP(14) << 2)); }
        GRID_BAR(); CHECK_HOOK(4, c, l);
        if (PH(6)) { LAUNDER(); phase_combine(a, l, GW, NGW_, lane); }
        if (DUP(6)) { LAUNDER(); __syncthreads(); phase_combine(a, l, GW, NGW_, lane); }
        GRID_BAR(); CHECK_HOOK(5, c, l);
        if (PH(7)) {
          { LAUNDER(); unsigned char* ws = a.ws(); pg8::GateOrder So; So.init(CH, DM, G, bid);
            pg8::Gemm g{(const pg8::bf16_t*)(ws + A_HI8), (const pg8::bf16_t*)(WL + WO_IG + (size_t)INC * DM * (I8IN ? 1 : 2)), CH, INC, DM / 2}; pg8::EpiGate E{l};
            pg8::gemm_phase<pg8::EpiGate, pg8::GateOrder, true, true, true>(lds + RING_OFF, g, So, E, tid); }
          { LAUNDER(); unsigned char* ws = a.ws(); pg8::StaticOrder So; So.init(CH, DM, G, bid);
            pg8::Gemm g{(const pg8::bf16_t*)(ws + A_OA), (const pg8::bf16_t*)(WL + WO_BRA), CH, DM, 1536}; pg8::EpiBrM E{(pg8::bf16_t*)(ws + A_QK), (const unsigned char*)(ws + A_G)};
            pg8::gemm_phase<pg8::EpiBrM, pg8::StaticOrder, true, true>(lds + RING_OFF, g, So, E, tid); } }
        GRID_BAR(); CHECK_HOOK(6, c, l);
        if (PH(8)) { LAUNDER(); unsigned char* ws = a.ws(); pg8::Gemm g{(const pg8::bf16_t*)(ws + A_QK), (const pg8::bf16_t*)(WL + WO_OUT), CH, DM, DM}; pg8::StaticOrder So; So.init(CH, DM, G, bid);
          pg8::EpiDelta E{(pg8::bf16_t*)(ws + A_VT), MODL + 2 * 2048, SEQ0, TSH};
          for (int rep_ = 0; rep_ < 1 + DUP(8); ++rep_) pg8::gemm_phase<pg8::EpiDelta, pg8::StaticOrder, true, true>(lds + RING_OFF, g, So, E, tid); }
        GRID_BAR(); CHECK_HOOK(7, c, l);
        if (PH(9)) { LAUNDER();
            if (l == 0) phase_norm<true, true, I8FF1 != 0>(XIN0, nullptr, (const bf16*)(a.ws() + A_VT), (bf16*)(a.ws() + A_X), a.in(I_N2G) + l * DM, MODL, 3 * 2048, 4 * 2048, SEQ0, TSH, I8FF1 ? nullptr : (bf16*)(a.ws() + A_H), GW, NGW_, lane, a.ws() + A_HI8, (float*)(a.ws() + A_HS));
            else phase_norm<false, true, I8FF1 != 0>(nullptr, (const bf16*)(a.ws() + A_X), (const bf16*)(a.ws() + A_VT), (bf16*)(a.ws() + A_X), a.in(I_N2G) + l * DM, MODL, 3 * 2048, 4 * 2048, SEQ0, TSH, I8FF1 ? nullptr : (bf16*)(a.ws() + A_H), GW, NGW_, lane, a.ws() + A_HI8, (float*)(a.ws() + A_HS)); }
        GRID_BAR(); CHECK_HOOK(8, c, l);
        for (int rep_ = 0; rep_ < (PH(10) ? 1 + DUP(10) : 0); ++rep_) { LAUNDER(); unsigned char* ws = a.ws(); pg8::StaticOrder So; So.init(CH, DFF, G, bid, WGM_BIG);
          pg8::EpiRelu2 E{(pg8::bf16_t*)(ws + A_U), DFF, l}; STAGGER();
#if I8FF1
          pg8::Gemm g{(const pg8::bf16_t*)(ws + A_HI8), (const pg8::bf16_t*)(WL + WO_FF1), CH, DFF, DM / 2};
          pg8::gemm_phase<pg8::EpiRelu2, pg8::StaticOrder, true, true, true>(lds + RING_OFF, g, So, E, tid); }
#else
          pg8::Gemm g{(const pg8::bf16_t*)(ws + A_H), (const pg8::bf16_t*)(WL + WO_FF1), CH, DFF, DM};
          pg8::gemm_phase<pg8::EpiRelu2, pg8::StaticOrder, true, true>(lds + RING_OFF, g, So, E, tid); }
#endif
        GRID_BAR(); CHECK_HOOK(9, c, l);
        if (PH(11)) { LAUNDER(); unsigned char* ws = a.ws(); pg8::Gemm g{(const pg8::bf16_t*)(ws + A_U), (const pg8::bf16_t*)(WL + WO_FF2), CH, DM, DFF}; pg8::StaticOrder So; So.init(CH, DM, G, bid);
          if (l == 0) { pg8::EpiDelta E{(pg8::bf16_t*)(ws + A_VT), MODL + 5 * 2048, SEQ0, TSH, I8FF1 ? (const float*)(ws + A_HS) : nullptr};
              for (int rep_ = 0; rep_ < 1 + DUP(11); ++rep_) pg8::gemm_phase<pg8::EpiDelta, pg8::StaticOrder, true, true>(lds + RING_OFF, g, So, E, tid); }
          else { pg8::EpiFinal E{(const pg8::bf16_t*)(ws + A_X), XO, MODL + 5 * 2048, SEQ0, TSH, I8FF1 ? (const float*)(ws + A_HS) : nullptr};
              for (int rep_ = 0; rep_ < 1 + DUP(11); ++rep_) pg8::gemm_phase<pg8::EpiFinal, pg8::StaticOrder, true, true>(lds + RING_OFF, g, So, E, tid); } }
        GRID_BAR(); CHECK_HOOK(10, c, l);
    }
    CHECK_FINAL();
}

extern "C" void kernel_launch(void* const* d_in, const int* in_sizes, int n_in, void* d_out, int out_size, void* d_ws, size_t ws_size, hipStream_t stream) {
    static int grid = 0;
    if (grid == 0) {
        if (n_in != 29 || out_size != MTOT * DM || ws_size < WS_END) { fprintf(stderr, "kernel_launch: unexpected shapes (n_in %d out %d ws %zu need %zu)\n", n_in, out_size, ws_size, (size_t)WS_END); grid = -1; return; }
        int dev = 0, cus = 0, per_cu = 0;
        if (hipGetDevice(&dev) != hipSuccess || hipDeviceGetAttribute(&cus, hipDeviceAttributeMultiprocessorCount, dev) != hipSuccess) { grid = -1; return; }
        if (hipFuncSetAttribute((const void*)fwd, hipFuncAttributeMaxDynamicSharedMemorySize, LDS_BYTES) != hipSuccess) { grid = -1; return; }
        if (hipOccupancyMaxActiveBlocksPerMultiprocessor(&per_cu, (const void*)fwd, NWAVES * 64, LDS_BYTES) != hipSuccess || per_cu < 1) { fprintf(stderr, "kernel_launch: occupancy query says %d\n", per_cu); }
        (void)hipGetLastError();
        grid = cus;
    }
    if (grid < 0) return;
    if (hipMemsetAsync((char*)d_ws + WS_CTL, 0, CTL_ZERO_BYTES, stream) != hipSuccess) return;
    Args a{};
    for (int i = 0; i < 29; ++i) a.in[i] = (const float*)d_in[i];
    a.out = (float*)d_out; a.ws = (unsigned char*)d_ws;
    hipLaunchKernelGGL(fwd, dim3(grid), dim3(NWAVES * 64), LDS_BYTES, stream, a);
}
```

```cpp
#include <hip/hip_runtime.h>
#include <hip/hip_bf16.h>
#include <cstdio>
#include <cstdint>
#include <cmath>

constexpr int NWAVES = 8;
constexpr int DM = 2048, NSEQ = 24, MTOT = 65536, DFF = 8192, INC = 6144;
#ifndef MK_CH
#define MK_CH 32768
#endif
constexpr int CH = MK_CH;
constexpr int NCHUNK = MTOT / CH;
constexpr float EPS = 1e-6f, LOG2E = 1.4426950408889634f, LN2 = 0.6931471805599453f;
constexpr float QS128 = 0.08838834764831845f * LOG2E, QS64 = 0.125f * LOG2E;
constexpr float NEGB = -1e30f;

constexpr size_t MiB = 1u << 20;
constexpr size_t WS_CTL = 0, CTL_ZERO_BYTES = 1 * MiB;
constexpr size_t WS_MOD = 1 * MiB;
constexpr size_t WS_ROPEB = 4 * MiB, WS_ROPEC = WS_ROPEB + 512 * 1024;
constexpr size_t WS_LAM = 5 * MiB;
constexpr size_t WS_MODP = 6 * MiB;
constexpr size_t WS_W = 48 * MiB, W_LAYER = 126 * MiB;
constexpr size_t WO_IG = 0, WO_BRA = 48 * MiB, WO_BRB = 50 * MiB, WO_BRC = 51 * MiB, WO_OUT = 54 * MiB, WO_FF1 = 62 * MiB, WO_FF2 = 94 * MiB;
constexpr size_t WS_ACT = 304 * MiB;
constexpr size_t CHS = (size_t)CH;
constexpr size_t A_H = WS_ACT;
constexpr size_t A_Z = A_H + (MK_CH > 16384 ? 0 : CHS * 2048 * 2);
constexpr size_t A_QK = A_Z + CHS * 6144 * 2;
constexpr size_t A_VT = A_QK + CHS * 4096 * 2;
constexpr size_t A_G = A_VT + CHS * 2048 * 2;
constexpr size_t A_OA = A_G + CHS * 6144 * 2;
constexpr size_t A_OB = A_OA + CHS * 512 * 2;
constexpr size_t A_OC = A_OB + CHS * 256 * 2;
constexpr size_t A_X = A_OC + CHS * 768 * 2;
constexpr size_t A_HI8 = A_X + CHS * 2048 * 2;
constexpr size_t A_HS = A_HI8 + CHS * 2048;
constexpr size_t WS_END = A_HS + (1u << 20);
constexpr size_t A_BTMP = A_Z + CHS * 2048 * 2;
constexpr size_t A_BLSE = A_BTMP + CHS * 768 * 2;
constexpr size_t A_CTMP = A_BLSE + CHS * 8 * 4;
static_assert(A_CTMP + CHS * 1536 * 4 <= A_QK, "attention temporaries fit in Z");
constexpr size_t A_TMPF = A_QK;
constexpr size_t A_U = A_Z;
static_assert(CHS * 8192 * 2 <= (A_VT - A_Z), "u fits in Z + QK");
constexpr int CW_BAR = 4096;
constexpr int CW_WMAX = 131072;
#ifndef I8FF1
#define I8FF1 1
#endif
constexpr int WMAX_L = 20480;
constexpr int CW_CHK = 65536;

constexpr int RING_OFF = 0, RING_BYTES = 131072;
constexpr int LDSCTL_OFF = RING_BYTES, MISC_OFF = LDSCTL_OFF + 320;
constexpr int LDS_BYTES = 147456;

#define LAS __attribute__((address_space(3)))
#define GAS __attribute__((address_space(1)))
struct Args { const float* in[29]; float* out; unsigned char* ws; };
typedef const __attribute__((address_space(4))) unsigned long long* kargp_t;
struct AL {
    __device__ __forceinline__ static kargp_t kp() { kargp_t p = (kargp_t)__builtin_amdgcn_kernarg_segment_ptr(); asm volatile("" : "+s"(p)); return p; }
    __device__ __forceinline__ const float* in(int i) const { return (const float*)kp()[i]; }
    __device__ __forceinline__ float* out() const { return (float*)kp()[29]; }
    __device__ __forceinline__ unsigned char* ws() const { return (unsigned char*)kp()[30]; } };
enum { I_XP = 0, I_XS, I_CP, I_CS, I_N1G, I_WADA, I_BADA, I_WIN, I_QNA, I_KNA, I_RPB, I_QNB, I_KNB, I_QNC, I_KNC, I_LQ1, I_LK1, I_LQ2, I_LK2, I_SUBLN,
       I_WBRA, I_WBRB, I_WBRC, I_WGATE, I_BGATE, I_WOUT, I_N2G, I_WFF1, I_WFF2 };


template <int N> __device__ __forceinline__ float shx(float v) { return __shfl_xor(v, N); }
__device__ __forceinline__ void shx32_pair(float v, float& a, float& b) { const float o = __shfl_xor(v, 32); const bool hi = (__lane_id() >> 5) != 0; a = hi ? o : v; b = hi ? v : o; }
__device__ __forceinline__ float sum32(float v) { return v + __shfl_xor(v, 32); }
__device__ __forceinline__ float max32(float v) { return fmaxf(v, __shfl_xor(v, 32)); }
#ifndef WGM_SMALL
#define WGM_SMALL 4
#endif
namespace pg8 {
#define PG8_LAS __attribute__((address_space(3)))
typedef unsigned short bf16_t;
typedef short bf16x8 __attribute__((ext_vector_type(8)));
typedef float f32x4 __attribute__((ext_vector_type(4)));
typedef unsigned u32x4 __attribute__((ext_vector_type(4)));
constexpr int BM = 256, BK = 64, HALF = 128, HTB = HALF * BK * 2  , STAGE_BYTES = 8 * HTB, NXCD = 8, WGM = WGM_SMALL;

__host__ __device__ __forceinline__ int lds_byte(int r, int c) { const int st = (r >> 4) * 2 + (c >> 5), rr = r & 15, cc = c & 31, ob = rr * 64 + cc * 2; return st * 1024 + (ob ^ (((ob >> 9) & 1) << 5)); }
__host__ __device__ __forceinline__ void stage_rc(int b, int& R, int& C) { const int st = b / 1024, sb = b % 1024, swz = sb ^ (((sb >> 9) & 1) << 5); R = (st >> 1) * 16 + swz / 64; C = (st & 1) * 32 + (swz % 64) / 2; }
__host__ __device__ __forceinline__ int perm32(int rho) { const int n = rho >> 4, i = rho & 15; return 8 * (i >> 2) + 4 * n + (i & 3); }

struct Unit { int pm, pn; };
struct Gemm { const bf16_t* A; const bf16_t* Bt; int M, N, K; };

struct StaticOrder {
    int nM, nN, nwg, G, c, wgm;
    __host__ __device__ void init(int M, int N, int G_, int c_, int wgm_ = WGM) { nM = M / BM; nN = N / BM; nwg = nM * nN; G = G_; c = c_; wgm = wgm_; }
    __host__ __device__ bool next(int i, Unit& u) const {
        const long L = (long)i * G + c; if (L >= nwg) return false;
        int wgid = (int)L; { const int q = nwg / NXCD, r = nwg % NXCD, xcd = wgid % NXCD, off = wgid / NXCD; wgid = (xcd < r ? xcd * (q + 1) : r * (q + 1) + (xcd - r) * q) + off; }
        const int nig = wgm * nN, gid = wgid / nig, fm = gid * wgm, gsz = (nM - fm) < wgm ? (nM - fm) : wgm;
        u.pm = fm + ((wgid % nig) % gsz); u.pn = (wgid % nig) / gsz; return true;
    }
    __device__ __forceinline__ void a_ready(const Unit&) const {}
    __device__ __forceinline__ void done(const Unit&) const {}
};

struct GateOrder {
    StaticOrder br; int n;
    __host__ __device__ void init(int M, int N, int G_, int c_) { br.init(M, N, G_, c_); n = (br.nwg + G_ - 1 - c_) / G_; if (n < 0) n = 0; }
    __host__ __device__ bool next(int i, Unit& u) const { if (i >= 3 * n) return false; Unit b; br.next(i / 3, b); u.pm = b.pm; u.pn = b.pn + 8 * (i % 3); return true; }
    __device__ __forceinline__ void a_ready(const Unit&) const {}
    __device__ __forceinline__ void done(const Unit&) const {}
};

typedef float f32x2 __attribute__((ext_vector_type(2)));
typedef __bf16 bf16x2v __attribute__((ext_vector_type(2)));
typedef unsigned u32x2 __attribute__((ext_vector_type(2)));
__device__ __forceinline__ unsigned cvt_pk_bf16(float lo, float hi) { f32x2 v = {lo, hi}; bf16x2v b = __builtin_convertvector(v, bf16x2v); return __builtin_bit_cast(unsigned, b); }
#ifndef INGRP
#define INGRP 1
#endif
#ifndef HOOKGRP
#define HOOKGRP 4
#endif
#ifndef I8IN
#define I8IN 1
#endif
__device__ __forceinline__ f32x4 cvti(const f32x4 a) { const float a0 = a[0], a1 = a[1], a2 = a[2], a3 = a[3];
    return (f32x4){(float)__float_as_int(a0), (float)__float_as_int(a1), (float)__float_as_int(a2), (float)__float_as_int(a3)}; }
__device__ __forceinline__ float sigm(float x) { return fmaxf(__builtin_amdgcn_rcpf(1.0f + __expf(-x)), 1e-30f); }

#if I8IN
#define CVTIN(x) cvti(x)
#else
#define CVTIN(x) (x)
#endif
struct EpiIn {
    static constexpr bool PERM = true, AFTER_DRAIN = false, HAS_MID = false; static constexpr int MID_T0 = -1, MID_T1 = -1;
    int l, S, tshift; PG8_LAS float* xch;
    __device__ __forceinline__ void operator()(const f32x4 (&acc)[2][2][4][2], const Unit& u, int wr, int wc, int fr, int fq) const {
        const int row0 = u.pm * BM + wr * 64 + fr; const AL a{}; unsigned char* ws = a.ws();
        const unsigned* wmx = (const unsigned*)(ws + WS_CTL) + CW_WMAX + l * WMAX_L + u.pn * BM + wc * 32 + 8 * fq; const float* HSp = (const float*)(ws + A_HS);
        f32x4 wsc[2][2];
#pragma unroll
        for (int bj = 0; bj < 2; ++bj)
#pragma unroll
            for (int n = 0; n < 2; ++n) { const u32x4 w = *(const GAS u32x4*)(wmx + bj * HALF + 4 * n);
                wsc[bj][n] = I8IN ? (f32x4){__uint_as_float(w.x), __uint_as_float(w.y), __uint_as_float(w.z), __uint_as_float(w.w)} * (1.0f / 127.0f) : (f32x4){1.f, 1.f, 1.f, 1.f}; }
        if (u.pn < 16) { const int tn = u.pn; bf16_t* QKb = (bf16_t*)(ws + A_QK); const float* ropeB = (const float*)(ws + WS_ROPEB); const float* ropeC = (const float*)(ws + WS_ROPEC);
            int gi, dsh = 0, kind; float scale = 1.f;
            if (tn < 2) { gi = 0; kind = 0; scale = 0.08838834764831845f * 1.4426950408889634f; } else if (tn < 4) { gi = 1; kind = 0; }
            else if (tn < 7) { gi = 2; kind = 1; scale = 0.08838834764831845f * 1.4426950408889634f; dsh = 2 * (tn - 4); } else if (tn < 10) { gi = 3; kind = 1; dsh = 2 * (tn - 7); }
            else if (tn < 13) { gi = 4; kind = 2; scale = 0.125f * 1.4426950408889634f; } else { gi = 5; kind = 2; }
            float hsv[8];
#pragma unroll
            for (int g = 0; g < 8; ++g) hsv[g] = I8IN ? HSp[u.pm * BM + (g >> 2) * HALF + wr * 64 + (g & 3) * 16 + fr] : 1.0f;
#pragma unroll
            for (int ai = 0; ai < 2; ++ai)
#pragma unroll
                for (int m = 0; m < 4; ++m)
#pragma unroll
                    for (int bj = 0; bj < 2; ++bj) { const f32x4 a4 = CVTIN(acc[ai][bj][m][0]) * wsc[bj][0], b4 = CVTIN(acc[ai][bj][m][1]) * wsc[bj][1];
                        float p = (a4[0] * a4[0] + a4[1] * a4[1]) + (a4[2] * a4[2] + a4[3] * a4[3]) + (b4[0] * b4[0] + b4[1] * b4[1]) + (b4[2] * b4[2] + b4[3] * b4[3]);
                        p += shx<16>(p); p = sum32(p);
                        if (fq == 0) xch[((ai * HALF + wr * 64 + m * 16 + fr) * 2 + bj) * 4 + wc] = p; }
            asm volatile("s_waitcnt lgkmcnt(0)\n\ts_barrier" ::: "memory");
            const float* gp = a.in(I_QNA + gi + (gi >= 2 ? 1 : 0)) + l * (kind == 2 ? 64 : 128) + ((32 * wc + 8 * fq) & (kind == 2 ? 63 : 127));
            const f32x4 g0 = *(const GAS f32x4*)gp, g1 = *(const GAS f32x4*)(gp + 4);
            const bool ropew = kind == 1 ? (wc == 0) : (kind == 2 ? ((wc & 1) == 0) : false);
            const bool ropel = kind == 1 ? true : (fq < 2), first = kind == 1 ? (fq < 2) : (fq == 0);
            const int Lsh = tshift - dsh;
#pragma unroll
            for (int ai = 0; ai < 2; ++ai)
#pragma unroll
                for (int m = 0; m < 4; ++m) { const int rl = ai * HALF + wr * 64 + m * 16 + fr, row = u.pm * BM + rl, t = row & (S - 1);
                    const float* tb = kind == 1 ? ropeB + (size_t)(t * 16 + 8 * (fq & 1)) * 2 : ropeC + (size_t)(t * 8) * 2;
                    const int drow = dsh == 0 ? row : ((row & ~(S - 1)) + ((t & ((1 << dsh) - 1)) << Lsh) + (t >> dsh));
                    const float hs = hsv[ai * 4 + m], epsr = 1e-6f * __builtin_amdgcn_rcpf(hs * hs + 1e-30f);
                    f32x4 cs[2][2];
                    if (ropew && ropel) {
#pragma unroll
                        for (int hf = 0; hf < 2; ++hf) { cs[hf][0] = *(const GAS f32x4*)(tb + 8 * hf); cs[hf][1] = *(const GAS f32x4*)(tb + 8 * hf + 4); } }
#pragma unroll
                    for (int bj = 0; bj < 2; ++bj) { const f32x4 P4 = *(const PG8_LAS f32x4*)(xch + (rl * 2 + bj) * 4);
                        const float tot = kind == 2 ? (wc < 2 ? P4[0] + P4[1] : P4[2] + P4[3]) : (P4[0] + P4[1]) + (P4[2] + P4[3]);
                        const float rstd = __builtin_amdgcn_rsqf(tot * (kind == 2 ? (1.0f / 64.0f) : (1.0f / 128.0f)) + epsr);
                        u32x4 w;
#pragma unroll
                        for (int hf = 0; hf < 2; ++hf) {
                            const f32x4 gg = (hf ? g1 : g0) * wsc[bj][hf], av = CVTIN(acc[ai][bj][m][hf]); float y[4];
#pragma unroll
                            for (int e2 = 0; e2 < 4; ++e2) y[e2] = av[e2] * rstd * gg[e2];
                            if (ropew) { float pr[4];
#pragma unroll
                                for (int e2 = 0; e2 < 4; ++e2) { if (kind == 1) { float r0, r1; shx32_pair(y[e2], r0, r1); pr[e2] = fq >= 2 ? r0 : r1; } else pr[e2] = shx<16>(y[e2]); }
                                if (ropel) { const f32x4 c0 = cs[hf][0], c1 = cs[hf][1];
                                    y[0] = first ? y[0] * c0[0] - pr[0] * c0[1] : y[0] * c0[0] + pr[0] * c0[1]; y[1] = first ? y[1] * c0[2] - pr[1] * c0[3] : y[1] * c0[2] + pr[1] * c0[3];
                                    y[2] = first ? y[2] * c1[0] - pr[2] * c1[1] : y[2] * c1[0] + pr[2] * c1[1]; y[3] = first ? y[3] * c1[2] - pr[3] * c1[3] : y[3] * c1[2] + pr[3] * c1[3]; } }
                            if (hf == 0) { w.x = cvt_pk_bf16(y[0] * scale, y[1] * scale); w.y = cvt_pk_bf16(y[2] * scale, y[3] * scale); }
                            else { w.z = cvt_pk_bf16(y[0] * scale, y[1] * scale); w.w = cvt_pk_bf16(y[2] * scale, y[3] * scale); } }
                        *(GAS u32x4*)(QKb + (size_t)drow * 4096 + tn * BM + bj * HALF + wc * 32 + 8 * fq) = w; }
                    if (INGRP == 1 || (m % INGRP) == INGRP - 1) asm volatile("" ::: "memory"); }
        } else { const int col0 = (u.pn - 16) * BM + wc * 32 + 8 * fq; bf16_t* Zv = (bf16_t*)(ws + A_Z);
            float hsv[8];
#pragma unroll
            for (int g = 0; g < 8; ++g) hsv[g] = I8IN ? HSp[row0 + (g >> 2) * HALF + (g & 3) * 16] : 1.0f;
#pragma unroll
            for (int ai = 0; ai < 2; ++ai)
#pragma unroll
                for (int m = 0; m < 4; ++m) { const int row = row0 + ai * HALF + m * 16; const float hs = hsv[ai * 4 + m]; bf16_t* rowp = Zv + (size_t)row * 2048 + col0;
#pragma unroll
                    for (int bj = 0; bj < 2; ++bj) { const f32x4 v0 = CVTIN(acc[ai][bj][m][0]) * wsc[bj][0] * hs, v1 = CVTIN(acc[ai][bj][m][1]) * wsc[bj][1] * hs;
                        u32x4 w; w.x = cvt_pk_bf16(v0[0], v0[1]); w.y = cvt_pk_bf16(v0[2], v0[3]); w.z = cvt_pk_bf16(v1[0], v1[1]); w.w = cvt_pk_bf16(v1[2], v1[3]);
                        *(GAS u32x4*)(rowp + bj * HALF) = w; } }
        }
    }
};
struct EpiGate {
    static constexpr bool PERM = true, AFTER_DRAIN = false, HAS_MID = false; static constexpr int MID_T0 = -1, MID_T1 = -1, NSTORE = 0;
    int l;
    __device__ __forceinline__ static unsigned pk4(const f32x4 s) { unsigned w = 0;
        w = __builtin_amdgcn_cvt_pk_u8_f32(__builtin_floorf(fmaxf(s[0] * 255.0f + 0.5f, 1.0f)), 0, w); w = __builtin_amdgcn_cvt_pk_u8_f32(__builtin_floorf(fmaxf(s[1] * 255.0f + 0.5f, 1.0f)), 1, w);
        w = __builtin_amdgcn_cvt_pk_u8_f32(__builtin_floorf(fmaxf(s[2] * 255.0f + 0.5f, 1.0f)), 2, w); w = __builtin_amdgcn_cvt_pk_u8_f32(__builtin_floorf(fmaxf(s[3] * 255.0f + 0.5f, 1.0f)), 3, w); return w; }
    __device__ __forceinline__ void operator()(const f32x4 (&acc)[2][2][4][2], const Unit& u, int wr, int wc, int fr, int fq) const {
        const AL a{}; unsigned char* ws = a.ws();
        const int gt = u.pn, col0 = gt * BM + wc * 32 + 8 * fq, lane = fq * 16 + fr, wave = wr * 4 + wc; const float* bgate = a.in(I_BGATE) + l * 6144;
        f32x4 bv[2][2];
#pragma unroll
        for (int bj = 0; bj < 2; ++bj)
#pragma unroll
            for (int n = 0; n < 2; ++n) bv[bj][n] = *(const GAS f32x4*)(bgate + col0 + bj * HALF + 4 * n);
        unsigned char* tp = ws + A_G + (size_t)(u.pm * 24 + gt) * 65536 + (size_t)wave * 8192 + lane * 16;
        const unsigned* wmx = (const unsigned*)(ws + WS_CTL) + CW_WMAX + l * WMAX_L + 6144 + col0; const float* HSp = (const float*)(ws + A_HS);
        f32x4 wsc[2][2];
#pragma unroll
        for (int bj = 0; bj < 2; ++bj)
#pragma unroll
            for (int n = 0; n < 2; ++n) { const u32x4 w = *(const GAS u32x4*)(wmx + bj * HALF + 4 * n);
                wsc[bj][n] = (f32x4){__uint_as_float(w.x), __uint_as_float(w.y), __uint_as_float(w.z), __uint_as_float(w.w)} * (1.0f / 127.0f); }
        float hsv[8];
#pragma unroll
        for (int g = 0; g < 8; ++g) hsv[g] = HSp[u.pm * BM + (g >> 2) * HALF + wr * 64 + (g & 3) * 16 + fr];
#pragma unroll
        for (int ai = 0; ai < 2; ++ai)
#pragma unroll
            for (int m = 0; m < 4; ++m) { const float hs = hsv[ai * 4 + m]; u32x4 w;
#pragma unroll
                for (int bj = 0; bj < 2; ++bj) { const f32x4 v0 = cvti(acc[ai][bj][m][0]) * wsc[bj][0] * hs + bv[bj][0], v1 = cvti(acc[ai][bj][m][1]) * wsc[bj][1] * hs + bv[bj][1];
                    const f32x4 s0 = {sigm(v0[0]), sigm(v0[1]), sigm(v0[2]), sigm(v0[3])}, s1 = {sigm(v1[0]), sigm(v1[1]), sigm(v1[2]), sigm(v1[3])};
                    if (bj == 0) { w.x = pk4(s0); w.y = pk4(s1); } else { w.z = pk4(s0); w.w = pk4(s1); } }
                *(GAS u32x4*)(tp + (ai * 4 + m) * 1024) = w; }
    }
};
struct EpiRelu2 {
    static constexpr bool PERM = true, AFTER_DRAIN = false, HAS_MID = false; static constexpr int MID_T0 = -1, MID_T1 = -1;
    bf16_t* O; int ldc; int l;
    __device__ __forceinline__ void operator()(const f32x4 (&acc)[2][2][4][2], const Unit& u, int wr, int wc, int fr, int fq) const {
        const int row0 = u.pm * BM + wr * 64 + fr, col0 = u.pn * BM + wc * 32 + 8 * fq;
#pragma unroll
        for (int ai = 0; ai < 2; ++ai)
#pragma unroll
            for (int m = 0; m < 4; ++m) { bf16_t* rowp = O + (size_t)(row0 + ai * HALF + m * 16) * ldc + col0;
#pragma unroll
                for (int bj = 0; bj < 2; ++bj) {
#if I8FF1
                    f32x4 v0 = cvti(acc[ai][bj][m][0]), v1 = cvti(acc[ai][bj][m][1]);
#else
                    f32x4 v0 = acc[ai][bj][m][0], v1 = acc[ai][bj][m][1];
#endif
#pragma unroll
                    for (int e = 0; e < 4; ++e) { const float a0 = v0[e] > 0.f ? v0[e] : 0.f, a1 = v1[e] > 0.f ? v1[e] : 0.f; v0[e] = a0 * a0; v1[e] = a1 * a1; }
                    u32x4 w; w.x = cvt_pk_bf16(v0[0], v0[1]); w.y = cvt_pk_bf16(v0[2], v0[3]); w.z = cvt_pk_bf16(v1[0], v1[1]); w.w = cvt_pk_bf16(v1[2], v1[3]);
                    *(GAS u32x4*)(rowp + bj * HALF) = w; } }
    }
};
struct EpiRes {
    static constexpr bool PERM = false, AFTER_DRAIN = false, HAS_MID = false; static constexpr int MID_T0 = -1, MID_T1 = -1;
    const float* xin; float* xout; const float* gbase; int seq0, tshift;
    __device__ __forceinline__ void operator()(const f32x4 (&acc)[2][2][4][2], const Unit& u, int wr, int wc, int fr, int fq) const {
        const int row0 = u.pm * BM + wr * 64 + fr, col0 = u.pn * BM + wc * 32 + 4 * fq;
        const float* gp = gbase + (size_t)(seq0 + ((u.pm * BM) >> tshift)) * 12288 + col0;
        f32x4 gv[2][2];
#pragma unroll
        for (int bj = 0; bj < 2; ++bj)
#pragma unroll
            for (int n = 0; n < 2; ++n) gv[bj][n] = *(const GAS f32x4*)(gp + bj * HALF + n * 16);
#pragma unroll
        for (int ai = 0; ai < 2; ++ai)
#pragma unroll
            for (int m = 0; m < 4; ++m) { const size_t off = (size_t)(row0 + ai * HALF + m * 16) * 2048 + col0;
#pragma unroll
                for (int bj = 0; bj < 2; ++bj)
#pragma unroll
                    for (int n = 0; n < 2; ++n) { const f32x4 xi = *(const GAS f32x4*)(xin + off + bj * HALF + n * 16);
                        *(GAS f32x4*)(xout + off + bj * HALF + n * 16) = xi + gv[bj][n] * acc[ai][bj][m][n]; } }
    }
};
template <int MODE> struct EpiBr {
    static constexpr bool PERM = false, AFTER_DRAIN = false, HAS_MID = false; static constexpr int MID_T0 = -1, MID_T1 = -1;
    float* T; bf16_t* MRG; const bf16_t* Gt; int gcol0;
    __device__ __forceinline__ void operator()(const f32x4 (&acc)[2][2][4][2], const Unit& u, int wr, int wc, int fr, int fq) const {
        const int row0 = u.pm * BM + wr * 64 + fr, col0 = u.pn * BM + wc * 32 + 4 * fq;
#pragma unroll
        for (int ai = 0; ai < 2; ++ai)
#pragma unroll
            for (int m = 0; m < 4; ++m) { const size_t row = (size_t)(row0 + ai * HALF + m * 16);
#pragma unroll
                for (int bj = 0; bj < 2; ++bj)
#pragma unroll
                    for (int n = 0; n < 2; ++n) { const int col = col0 + bj * HALF + n * 16;
                        const u32x2 gw = *(const GAS u32x2*)(Gt + row * 6144 + gcol0 + col);
                        const f32x4 g = {__uint_as_float(gw.x << 16), __uint_as_float(gw.x & 0xffff0000u), __uint_as_float(gw.y << 16), __uint_as_float(gw.y & 0xffff0000u)};
                        f32x4 v = g * acc[ai][bj][m][n];
                        if (MODE >= 1) v = v + *(const GAS f32x4*)(T + row * 2048 + col);
                        if (MODE <= 1) *(GAS f32x4*)(T + row * 2048 + col) = v;
                        else { u32x2 w; w.x = cvt_pk_bf16(v[0], v[1]); w.y = cvt_pk_bf16(v[2], v[3]); *(GAS u32x2*)(MRG + row * 2048 + col) = w; } } }
    }
};

struct EpiBrM {
    static constexpr bool PERM = true, AFTER_DRAIN = false, HAS_MID = true; static constexpr int MID_T0 = 8, MID_T1 = 12, NSTORE = 0;
    bf16_t* MRG; const unsigned char* Gt;
    __device__ __forceinline__ static f32x4 ub4(const unsigned d) { return (f32x4){(float)(d & 0xffu), (float)((d >> 8) & 0xffu), (float)((d >> 16) & 0xffu), (float)(d >> 24)}; }
    __device__ __forceinline__ static f32x4 rdiv(const f32x4 a, const f32x4 b) { return (f32x4){a[0] * __builtin_amdgcn_rcpf(b[0]), a[1] * __builtin_amdgcn_rcpf(b[1]), a[2] * __builtin_amdgcn_rcpf(b[2]), a[3] * __builtin_amdgcn_rcpf(b[3])}; }
    __device__ __forceinline__ void mid(f32x4 (&acc)[2][2][4][2], const Unit& u, int t, int wr, int wc, int fr, int fq) const {
        int off = (u.pm * 24 + u.pn + (t == MID_T0 ? 0 : 8)) * 65536 + (wr * 4 + wc) * 8192 + (fq * 16 + fr) * 16;
        asm volatile("" : "+v"(off));
        const unsigned char* gp = Gt + (unsigned)off;
        u32x4 wa[8], wb[8];
#pragma unroll
        for (int g = 0; g < 8; ++g) { wa[g] = *(const GAS u32x4*)(gp + g * 1024); wb[g] = *(const GAS u32x4*)(gp + 8 * 65536 + g * 1024); }
#pragma unroll
        for (int ai = 0; ai < 2; ++ai)
#pragma unroll
            for (int m = 0; m < 4; ++m) { const int g = ai * 4 + m;
                acc[ai][0][m][0] = acc[ai][0][m][0] * rdiv(ub4(wa[g].x), ub4(wb[g].x)); acc[ai][0][m][1] = acc[ai][0][m][1] * rdiv(ub4(wa[g].y), ub4(wb[g].y));
                acc[ai][1][m][0] = acc[ai][1][m][0] * rdiv(ub4(wa[g].z), ub4(wb[g].z)); acc[ai][1][m][1] = acc[ai][1][m][1] * rdiv(ub4(wa[g].w), ub4(wb[g].w)); }
        asm volatile("" ::: "memory");
    }
    __device__ __forceinline__ void operator()(const f32x4 (&acc)[2][2][4][2], const Unit& u, int wr, int wc, int fr, int fq) const {
        const int row0 = u.pm * BM + wr * 64 + fr, col0 = u.pn * BM + wc * 32 + 8 * fq;
        const unsigned char* gp = Gt + (size_t)(u.pm * 24 + u.pn + 16) * 65536 + (wr * 4 + wc) * 8192 + (fq * 16 + fr) * 16;
        u32x4 wgs[8];
#pragma unroll
        for (int g = 0; g < 8; ++g) wgs[g] = *(const GAS u32x4*)(gp + g * 1024);
#pragma unroll
        for (int ai = 0; ai < 2; ++ai)
#pragma unroll
            for (int m = 0; m < 4; ++m) { bf16_t* rowp = MRG + (size_t)(row0 + ai * HALF + m * 16) * 2048 + col0;
                const u32x4 wg = wgs[ai * 4 + m];
#pragma unroll
                for (int bj = 0; bj < 2; ++bj) { const f32x4 g0 = ub4(bj ? wg.z : wg.x) * (1.0f / 255.0f), g1 = ub4(bj ? wg.w : wg.y) * (1.0f / 255.0f);
                    const f32x4 v0 = acc[ai][bj][m][0] * g0, v1 = acc[ai][bj][m][1] * g1;
                    u32x4 w; w.x = cvt_pk_bf16(v0[0], v0[1]); w.y = cvt_pk_bf16(v0[2], v0[3]); w.z = cvt_pk_bf16(v1[0], v1[1]); w.w = cvt_pk_bf16(v1[2], v1[3]);
                    *(GAS u32x4*)(rowp + bj * HALF) = w; } }
    }
};
struct EpiDelta {
    static constexpr bool PERM = true, AFTER_DRAIN = false, HAS_MID = false; static constexpr int MID_T0 = -1, MID_T1 = -1;
    bf16_t* Dl; const float* gbase; int seq0, tshift; const float* HS2 = nullptr;
    __device__ __forceinline__ void operator()(const f32x4 (&acc)[2][2][4][2], const Unit& u, int wr, int wc, int fr, int fq) const {
        const int row0 = u.pm * BM + wr * 64 + fr, col0 = u.pn * BM + wc * 32 + 8 * fq;
        const float* gp = gbase + (size_t)(seq0 + ((u.pm * BM) >> tshift)) * 12288 + col0;
        f32x4 gv[2][2];
#pragma unroll
        for (int bj = 0; bj < 2; ++bj)
#pragma unroll
            for (int n = 0; n < 2; ++n) gv[bj][n] = *(const GAS f32x4*)(gp + bj * HALF + 4 * n);
        float rsv[8];
#pragma unroll
        for (int g = 0; g < 8; ++g) { rsv[g] = 1.0f; if (HS2) rsv[g] = HS2[row0 + (g >> 2) * HALF + (g & 3) * 16]; }
#pragma unroll
        for (int ai = 0; ai < 2; ++ai)
#pragma unroll
            for (int m = 0; m < 4; ++m) { bf16_t* rowp = Dl + (size_t)(row0 + ai * HALF + m * 16) * 2048 + col0;
                float rs = rsv[ai * 4 + m]; rs *= rs;
#pragma unroll
                for (int bj = 0; bj < 2; ++bj) { const f32x4 v0 = acc[ai][bj][m][0] * gv[bj][0] * rs, v1 = acc[ai][bj][m][1] * gv[bj][1] * rs;
                    u32x4 w; w.x = cvt_pk_bf16(v0[0], v0[1]); w.y = cvt_pk_bf16(v0[2], v0[3]); w.z = cvt_pk_bf16(v1[0], v1[1]); w.w = cvt_pk_bf16(v1[2], v1[3]);
                    *(GAS u32x4*)(rowp + bj * HALF) = w; } }
    }
};

struct EpiFinal {
    static constexpr bool PERM = true, AFTER_DRAIN = false, HAS_MID = false; static constexpr int MID_T0 = -1, MID_T1 = -1;
    const bf16_t* XS; float* out; const float* gbase; int seq0, tshift; const float* HS2 = nullptr;
    __device__ __forceinline__ void operator()(const f32x4 (&acc)[2][2][4][2], const Unit& u, int wr, int wc, int fr, int fq) const {
        const int row0 = u.pm * BM + wr * 64 + fr, col0 = u.pn * BM + wc * 32 + 8 * fq;
        const float* gp = gbase + (size_t)(seq0 + ((u.pm * BM) >> tshift)) * 12288 + col0;
        f32x4 gv[2][2];
#pragma unroll
        for (int bj = 0; bj < 2; ++bj)
#pragma unroll
            for (int n = 0; n < 2; ++n) gv[bj][n] = *(const GAS f32x4*)(gp + bj * HALF + 4 * n);
        float rsv[8];
#pragma unroll
        for (int g = 0; g < 8; ++g) { rsv[g] = 1.0f; if (HS2) rsv[g] = HS2[row0 + (g >> 2) * HALF + (g & 3) * 16]; }
#pragma unroll
        for (int ai = 0; ai < 2; ++ai) { u32x4 xws[4][2];
#pragma unroll
            for (int m = 0; m < 4; ++m) { const size_t off = (size_t)(row0 + ai * HALF + m * 16) * 2048 + col0; xws[m][0] = *(const GAS u32x4*)(XS + off); xws[m][1] = *(const GAS u32x4*)(XS + off + HALF); }
#pragma unroll
            for (int m = 0; m < 4; ++m) { const size_t off = (size_t)(row0 + ai * HALF + m * 16) * 2048 + col0;
                float rs = rsv[ai * 4 + m]; rs *= rs;
#pragma unroll
                for (int bj = 0; bj < 2; ++bj) { const u32x4 xw = xws[m][bj];
                    const f32x4 x0 = {__uint_as_float(xw.x << 16), __uint_as_float(xw.x & 0xffff0000u), __uint_as_float(xw.y << 16), __uint_as_float(xw.y & 0xffff0000u)};
                    const f32x4 x1 = {__uint_as_float(xw.z << 16), __uint_as_float(xw.z & 0xffff0000u), __uint_as_float(xw.w << 16), __uint_as_float(xw.w & 0xffff0000u)};
                    *(GAS f32x4*)(out + off + bj * HALF) = x0 + acc[ai][bj][m][0] * gv[bj][0] * rs;
                    *(GAS f32x4*)(out + off + bj * HALF + 4) = x1 + acc[ai][bj][m][1] * gv[bj][1] * rs; } }
            asm volatile("" ::: "memory"); }
    }
};
template <class Epi, class Sched, bool ALIGN_EPI = false, bool SP2 = false, bool I8 = false>
__device__ __forceinline__ void gemm_phase(PG8_LAS unsigned char* lds, const Gemm g, const Sched& S, const Epi& E, int tid_in) {
    int tid_ = tid_in; asm volatile("" : "+v"(tid_));
    const int tid = tid_, wid = __builtin_amdgcn_readfirstlane(tid >> 6), lane = tid & 63, wr = wid >> 2, wc = wid & 3, fr = lane & 15, fq = lane >> 4;
    const int K = g.K, nt = K / BK;
    unsigned voffA[2], voffB[2];
#pragma unroll
    for (int i = 0; i < 2; ++i) { int R, C; stage_rc(tid * 16 + i * 8192, R, C); const int Rb = Epi::PERM ? ((R & ~31) + perm32(R & 31)) : R;
        voffA[i] = (unsigned)(R * K + C) * 2u; voffB[i] = (unsigned)(Rb * K + C) * 2u; }
    const size_t kstep = (size_t)(BK * 2);
    const size_t hstep = (size_t)HALF * K * 2;
    const size_t tstep = 2 * hstep;
    const unsigned ldsw = (unsigned)wid * 1024u;
    const int aoff = lds_byte(wr * 64 + fr, fq * 8), boff = lds_byte(wc * 32 + fr, fq * 8);
#define PG8_SA(b, h) (((b) * 2 + (h)) * HTB)
#define PG8_SB(b, h) ((4 + (b) * 2 + (h)) * HTB)
#define PG8_STAGE(bufoff, gbase, voff) do { _Pragma("unroll") for (int _i = 0; _i < 2; ++_i) \
        __builtin_amdgcn_global_load_lds((const unsigned*)((const char*)(gbase) + (voff)[_i]), (PG8_LAS unsigned*)(lds + (bufoff) + ldsw + _i * 8192), 16, 0, 0); } while (0)
#define PG8_LDA(dst, b, h) do { _Pragma("unroll") for (int m = 0; m < 4; ++m) _Pragma("unroll") for (int k = 0; k < 2; ++k) dst[m][k] = *(const PG8_LAS bf16x8*)(lds + PG8_SA(b, h) + aoff + m * 2048 + k * 1024); } while (0)
#define PG8_LDB(dst, b, h) do { _Pragma("unroll") for (int n = 0; n < 2; ++n) _Pragma("unroll") for (int k = 0; k < 2; ++k) dst[n][k] = *(const PG8_LAS bf16x8*)(lds + PG8_SB(b, h) + boff + n * 2048 + k * 1024); } while (0)
#define PG8_MMA(ai, bj, At, Bt) do { __builtin_amdgcn_s_setprio(1); _Pragma("unroll") for (int m = 0; m < 4; ++m) _Pragma("unroll") for (int n = 0; n < 2; ++n) _Pragma("unroll") for (int k = 0; k < 2; ++k) { \
        if constexpr (I8) acc[ai][bj][m][n] = __builtin_bit_cast(f32x4, __builtin_amdgcn_mfma_i32_16x16x64_i8(__builtin_bit_cast(v4i_t, Bt[n][k]), __builtin_bit_cast(v4i_t, At[m][k]), __builtin_bit_cast(v4i_t, acc[ai][bj][m][n]), 0, 0, 0)); \
        else acc[ai][bj][m][n] = __builtin_amdgcn_mfma_f32_16x16x32_bf16(Bt[n][k], At[m][k], acc[ai][bj][m][n], 0, 0, 0); } \
        __builtin_amdgcn_s_setprio(0); } while (0)
#define PG8_WAIT_V(n) asm volatile("s_waitcnt vmcnt(" #n ")" ::: "memory")
#define PG8_WAIT_L(n) asm volatile("s_waitcnt lgkmcnt(" #n ")" ::: "memory")
#define PG8_BAR __builtin_amdgcn_s_barrier()
#define PG8_SCHED __builtin_amdgcn_sched_barrier(0)
    Unit cur, nxt; int ui = 0;
    if (!S.next(0, cur)) return;
    f32x4 acc[2][2][4][2];
#pragma unroll
    for (int a = 0; a < 2; ++a)
#pragma unroll
        for (int b = 0; b < 2; ++b)
#pragma unroll
            for (int m = 0; m < 4; ++m)
#pragma unroll
                for (int n = 0; n < 2; ++n) acc[a][b][m][n] = (f32x4){0.f, 0.f, 0.f, 0.f};
    typedef int v4i_t __attribute__((ext_vector_type(4)));
    bf16x8 At[4][2], B0[2][2], B1[2][2];
    const char* cA = (const char*)g.A + (size_t)cur.pm * tstep; const char* cB = (const char*)g.Bt + (size_t)cur.pn * tstep;
    S.a_ready(cur);
    if constexpr (SP2) {
        PG8_STAGE(PG8_SB(0, 0), cB, voffB); PG8_STAGE(PG8_SB(0, 1), cB + hstep, voffB); PG8_STAGE(PG8_SA(0, 0), cA, voffA); PG8_STAGE(PG8_SA(0, 1), cA + hstep, voffA);
        if (wr == 1) PG8_BAR;
        PG8_WAIT_V(2); PG8_BAR;
        PG8_STAGE(PG8_SB(1, 0), cB + kstep, voffB); PG8_STAGE(PG8_SA(1, 0), cA + kstep, voffA); PG8_STAGE(PG8_SB(1, 1), cB + hstep + kstep, voffB);
        PG8_WAIT_V(6); PG8_BAR;
    } else {
        PG8_STAGE(PG8_SB(0, 0), cB, voffB); PG8_STAGE(PG8_SA(0, 0), cA, voffA); PG8_STAGE(PG8_SB(0, 1), cB + hstep, voffB); PG8_STAGE(PG8_SA(0, 1), cA + hstep, voffA);
        if (wr == 1) PG8_BAR;
        PG8_WAIT_V(4); PG8_BAR;
        PG8_STAGE(PG8_SB(1, 0), cB + kstep, voffB); PG8_STAGE(PG8_SA(1, 0), cA + kstep, voffA); PG8_STAGE(PG8_SB(1, 1), cB + hstep + kstep, voffB);
        PG8_WAIT_V(6); PG8_BAR;
    }
    for (;;) {
        const bool has_next = S.next(ui + 1, nxt);
        const char* nA = has_next ? (const char*)g.A + (size_t)nxt.pm * tstep : cA; const char* nB = has_next ? (const char*)g.Bt + (size_t)nxt.pn * tstep : cB;
#pragma unroll 1
        for (int t = 0; t < nt; t += 2) {
            if constexpr (Epi::HAS_MID) { if (t == Epi::MID_T0 || t == Epi::MID_T1) E.mid(acc, cur, t, wr, wc, fr, fq); }
            const bool last = (t == nt - 2);
            const char* a1 = cA + (size_t)(t + 1) * kstep;
            const char* a2 = last ? nA : cA + (size_t)(t + 2) * kstep; const char* b2 = last ? nB : cB + (size_t)(t + 2) * kstep;
            const char* a3 = a2 + kstep; const char* b3 = b2 + kstep;
            if (last && has_next) S.a_ready(nxt);
            if constexpr (SP2) {
            PG8_LDB(B0, 0, 0); PG8_LDB(B1, 0, 1); PG8_SCHED; PG8_LDA(At, 0, 0); PG8_STAGE(PG8_SA(1, 1), a1 + hstep, voffA);
            PG8_WAIT_V(8); PG8_WAIT_L(0); PG8_BAR; PG8_MMA(0, 0, At, B0); PG8_MMA(0, 1, At, B1); PG8_BAR; PG8_SCHED;
            PG8_LDA(At, 0, 1); PG8_STAGE(PG8_SB(0, 0), b2, voffB); PG8_STAGE(PG8_SB(0, 1), b2 + hstep, voffB); PG8_STAGE(PG8_SA(0, 0), a2, voffA);
            PG8_WAIT_V(8); PG8_WAIT_L(0); PG8_BAR; PG8_MMA(1, 0, At, B0); PG8_MMA(1, 1, At, B1); PG8_BAR; PG8_SCHED;
            PG8_LDB(B0, 1, 0); PG8_LDB(B1, 1, 1); PG8_SCHED; PG8_LDA(At, 1, 0); PG8_STAGE(PG8_SA(0, 1), a2 + hstep, voffA);
            PG8_WAIT_V(8); PG8_WAIT_L(0); PG8_BAR; PG8_MMA(0, 0, At, B0); PG8_MMA(0, 1, At, B1); PG8_BAR; PG8_SCHED;
            PG8_LDA(At, 1, 1); PG8_STAGE(PG8_SB(1, 0), b3, voffB); PG8_STAGE(PG8_SB(1, 1), b3 + hstep, voffB); PG8_STAGE(PG8_SA(1, 0), a3, voffA);
            PG8_WAIT_V(8); PG8_WAIT_L(0); PG8_BAR; PG8_MMA(1, 0, At, B0); PG8_MMA(1, 1, At, B1); PG8_BAR; PG8_SCHED;
            } else {
            PG8_LDB(B0, 0, 0); PG8_SCHED; PG8_LDA(At, 0, 0); PG8_STAGE(PG8_SA(1, 1), a1 + hstep, voffA);
            PG8_WAIT_L(8); PG8_BAR; PG8_WAIT_L(0); PG8_MMA(0, 0, At, B0); PG8_BAR; PG8_SCHED;
            PG8_LDB(B1, 0, 1); PG8_STAGE(PG8_SB(0, 0), b2, voffB);
            PG8_BAR; PG8_WAIT_L(0); PG8_MMA(0, 1, At, B1); PG8_BAR;
            PG8_LDA(At, 0, 1); PG8_STAGE(PG8_SA(0, 0), a2, voffA);
            PG8_BAR; PG8_WAIT_L(0); PG8_MMA(1, 0, At, B0); PG8_BAR; PG8_SCHED;
            PG8_STAGE(PG8_SB(0, 1), b2 + hstep, voffB);
            PG8_WAIT_V(6); PG8_BAR; PG8_MMA(1, 1, At, B1); PG8_BAR;
            PG8_LDB(B0, 1, 0); PG8_SCHED; PG8_LDA(At, 1, 0); PG8_STAGE(PG8_SA(0, 1), a2 + hstep, voffA);
            PG8_WAIT_L(8); PG8_BAR; PG8_WAIT_L(0); PG8_MMA(0, 0, At, B0); PG8_BAR; PG8_SCHED;
            PG8_LDB(B1, 1, 1); PG8_STAGE(PG8_SB(1, 0), b3, voffB);
            PG8_BAR; PG8_WAIT_L(0); PG8_MMA(0, 1, At, B1); PG8_BAR;
            PG8_LDA(At, 1, 1); PG8_STAGE(PG8_SA(1, 0), a3, voffA);
            PG8_BAR; PG8_WAIT_L(0); PG8_MMA(1, 0, At, B0); PG8_BAR; PG8_SCHED;
            PG8_STAGE(PG8_SB(1, 1), b3 + hstep, voffB);
            PG8_WAIT_V(6); PG8_BAR; PG8_MMA(1, 1, At, B1); PG8_BAR;
            }
        }
        if constexpr (ALIGN_EPI) { if (wr == 0) PG8_BAR; }
        if constexpr (!Epi::AFTER_DRAIN) { E(acc, cur, wr, wc, fr, fq); S.done(cur); }
        if (!has_next) break;
#pragma unroll
        for (int a = 0; a < 2; ++a)
#pragma unroll
            for (int b = 0; b < 2; ++b)
#pragma unroll
                for (int m = 0; m < 4; ++m)
#pragma unroll
                    for (int n = 0; n < 2; ++n) acc[a][b][m][n] = (f32x4){0.f, 0.f, 0.f, 0.f};
        cur = nxt; cA = nA; cB = nB; ++ui;
        if constexpr (ALIGN_EPI) { if (wr == 1) PG8_BAR; }
    }
    PG8_WAIT_V(0);
    if constexpr (!ALIGN_EPI) { if (wr == 0) PG8_BAR; }
    PG8_BAR;
    if constexpr (Epi::AFTER_DRAIN) { E.fused(acc, cur, wr, wc, fr, fq, lds, wid, lane); S.done(cur); }
#undef PG8_SA
#undef PG8_SB
#undef PG8_STAGE
#undef PG8_LDA
#undef PG8_LDB
#undef PG8_MMA
#undef PG8_WAIT_V
#undef PG8_WAIT_L
#undef PG8_BAR
#undef PG8_SCHED
}
}
typedef unsigned short bf16;
typedef unsigned v4u __attribute__((ext_vector_type(4)));
typedef unsigned v2u __attribute__((ext_vector_type(2)));
typedef float f32x4 __attribute__((ext_vector_type(4)));
typedef float f32x16 __attribute__((ext_vector_type(16)));
typedef short bf16x8 __attribute__((ext_vector_type(8)));
typedef GAS unsigned gu32;
#define LDS_WAIT() asm volatile("s_waitcnt lgkmcnt(0)" ::: "memory")
#define VM_WAIT() asm volatile("s_waitcnt vmcnt(0)" ::: "memory")
__device__ __forceinline__ unsigned pk2(float lo, float hi) { return pg8::cvt_pk_bf16(lo, hi); }
__device__ __forceinline__ float bflo(unsigned w) { return __uint_as_float(w << 16); }
__device__ __forceinline__ float bfhi(unsigned w) { return __uint_as_float(w & 0xffff0000u); }
__device__ __forceinline__ float bf1(bf16 b) { return __uint_as_float((unsigned)b << 16); }
__device__ __forceinline__ float wave_sum(float v) {
    v += shx<1>(v); v += shx<2>(v); v += shx<4>(v); v += shx<8>(v); v += shx<16>(v); return sum32(v);
}
#define XB_TMO      128
#define XB_XCNT(j)  (256  + 64 * (j))
#define XB_XSUB(j)  (1280 + 64 * (j))
#define XB_XGEN(j)  (2304 + 64 * (j))
#define XB_TOP      3328
#define XB_TOPGEN   3392
#define XCD_BAR_WORDS 3456
#define XB_SPIN_CAP (1u << 18)

__device__ __forceinline__ unsigned xb_ld(unsigned* p)              { return __hip_atomic_load(p, __ATOMIC_RELAXED, __HIP_MEMORY_SCOPE_AGENT); }
__device__ __forceinline__ unsigned xb_add(unsigned* p, unsigned v) { return __hip_atomic_fetch_add(p, v, __ATOMIC_RELAXED, __HIP_MEMORY_SCOPE_AGENT); }
__device__ __forceinline__ unsigned xb_xcc_id() { return (unsigned)__builtin_amdgcn_s_getreg((3 << 11) | 20) & 0xFu; }
#define XB_SPIN(cond, bar) do { unsigned _sp = 0; while (cond) { __builtin_amdgcn_s_sleep(1); \
    if ((++_sp & 255u) == 0u) { if (xb_ld(&(bar)[XB_TMO])) break; if (_sp > XB_SPIN_CAP) { atomicAdd(&(bar)[XB_TMO], 1u); break; } } } } while (0)

struct XcdBarrier {
    unsigned* bar; unsigned x;
    volatile LAS unsigned* st;
};

__device__ __forceinline__ XcdBarrier xcd_barrier_post(unsigned* bar, volatile LAS unsigned* st, int tid) {
    XcdBarrier b; b.bar = bar; b.x = xb_xcc_id(); b.st = st;
    if (tid == 0) (void)xb_add(&bar[XB_XCNT(b.x)], 1u);
    return b;
}
__device__ __forceinline__ void xcd_barrier_complete(unsigned* bar, unsigned x, unsigned& nloc, unsigned& nx) {
    const unsigned G = gridDim.x * gridDim.y * gridDim.z;
    unsigned sum, cnt, mine, sp = 0u;
    for (;;) {
        sum = 0u; cnt = 0u; mine = 0u;
#pragma unroll
        for (unsigned j = 0; j < 16; ++j) { const unsigned c = xb_ld(&bar[XB_XCNT(j)]); sum += c; cnt += (c > 0u) ? 1u : 0u; mine = (j == x) ? c : mine; }
        if (sum == G) break;
        __builtin_amdgcn_s_sleep(1);
        if ((++sp & 255u) == 0u) { if (xb_ld(&bar[XB_TMO])) break; if (sp > XB_SPIN_CAP) { atomicAdd(&bar[XB_TMO], 1u); break; } }
    }
    nloc = mine > 0u ? mine : 1u; nx = cnt > 0u ? cnt : 1u;
}

__device__ __forceinline__ void xcd_barrier(const XcdBarrier& b, int tid) {
    asm volatile("s_waitcnt vmcnt(0)" ::: "memory");
    __syncthreads();
    if (tid == 0) {
        unsigned* bar = b.bar;
        __builtin_amdgcn_s_waitcnt(0);
        unsigned nloc = b.st[0], nx = b.st[1];
        if (nloc == 0u) { xcd_barrier_complete(bar, b.x, nloc, nx); b.st[0] = nloc; b.st[1] = nx; }
        const unsigned old = xb_add(&bar[XB_XSUB(b.x)], 1u);
        const unsigned gen = old / nloc;
        if (old + 1u == (gen + 1u) * nloc) {
            __builtin_amdgcn_fence(__ATOMIC_RELEASE, "agent");
            asm volatile("s_waitcnt vmcnt(0)" ::: "memory");
            const unsigned og = xb_add(&bar[XB_TOP], 1u);
            const unsigned tg = og / nx;
            if (og + 1u == (tg + 1u) * nx) xb_add(&bar[XB_TOPGEN], 1u);
            else XB_SPIN(xb_ld(&bar[XB_TOPGEN]) == tg, bar);
            __builtin_amdgcn_fence(__ATOMIC_ACQUIRE, "agent");
            xb_add(&bar[XB_XGEN(b.x)], 1u);
            asm volatile("s_waitcnt vmcnt(0)" ::: "memory");
        } else {
            XB_SPIN(xb_ld(&bar[XB_XGEN(b.x)]) == gen, bar);
            __builtin_amdgcn_fence(__ATOMIC_ACQUIRE, "agent");
            asm volatile("s_waitcnt vmcnt(0)" ::: "memory");
        }
    }
    __syncthreads();
}

__device__ __forceinline__ void phase_modp(const AL& a, LAS unsigned char* lds, int tid, int lane, int wave) {
    LAS float* sil = (LAS float*)lds;
    const float* wada = a.in(I_WADA); float* modp = (float*)(a.ws() + WS_MODP);
    for (int it = blockIdx.x; it < 256; it += gridDim.x) {
        const int l = it >> 7, ks = (it >> 3) & 15, cg = it & 7, k0 = ks * 128;
        for (int e = tid; e < 24 * 128; e += NWAVES * 64) { const int b = e >> 7, kk = e & 127;
            const float c = b < 8 ? a.in(I_CP)[b * 2048 + k0 + kk] : a.in(I_CS)[(b - 8) * 2048 + k0 + kk];
            sil[e] = c / (1.0f + __expf(-c)); }
        __syncthreads();
        const int n0 = cg * 1536 + wave * 192 + 3 * lane;
        float acc[24][3];
#pragma unroll
        for (int b = 0; b < 24; ++b) { acc[b][0] = 0.f; acc[b][1] = 0.f; acc[b][2] = 0.f; }
        const GAS float* wp = (const GAS float*)wada + ((size_t)l * 2048 + k0) * 12288 + n0;
#pragma unroll 8
        for (int kk = 0; kk < 128; ++kk) {
            const float w0 = wp[(size_t)kk * 12288], w1 = wp[(size_t)kk * 12288 + 1], w2 = wp[(size_t)kk * 12288 + 2];
#pragma unroll
            for (int b = 0; b < 24; ++b) { const float s = sil[b * 128 + kk]; acc[b][0] += s * w0; acc[b][1] += s * w1; acc[b][2] += s * w2; }
        }
#pragma unroll
        for (int b = 0; b < 24; ++b) { GAS float* o = (GAS float*)modp + ((size_t)(ks * 2 + l) * 24 + b) * 12288 + n0; o[0] = acc[b][0]; o[1] = acc[b][1]; o[2] = acc[b][2]; }
        __syncthreads();
    }
}
__device__ __forceinline__ int win_row(int n0) { return n0 < 1024 ? n0 : n0 < 1536 ? n0 + 3072 : n0 < 3072 ? n0 - 512 : n0 < 3840 ? n0 + 1536 : n0 < 5376 ? n0 - 1280 : n0; }
__device__ __forceinline__ void phase_colmax(const AL& a, int gw, int NGW, int lane) {
    unsigned* wmax = (unsigned*)(a.ws() + WS_CTL) + CW_WMAX;
    for (int it = gw; it < 2 * 2 * 96 * 8; it += NGW) { const int ks = it & 7, cb = (it >> 3) % 96, mat = (it / 768) & 1, l = it / 1536, n0 = 64 * cb;
        const GAS float* w = (const GAS float*)(mat ? a.in(I_WGATE) : a.in(I_WIN)) + ((size_t)l * 2048 + ks * 256) * 6144 + n0 + lane;
        float mx = 0.f;
#pragma unroll 16
        for (int k = 0; k < 256; ++k) mx = fmaxf(mx, fabsf(w[(size_t)k * 6144]));
        const int d = mat ? 6144 + n0 + lane : win_row(n0) + lane;
        atomicMax(wmax + l * WMAX_L + d, __float_as_uint(mx)); }
#if I8FF1
    for (int it = gw; it < 2 * 128 * 8; it += NGW) { const int ks = it & 7, cb = (it >> 3) & 127, l = it >> 10, n0 = 64 * cb;
        const GAS float* w = (const GAS float*)a.in(I_WFF1) + ((size_t)l * 2048 + ks * 256) * 8192 + n0 + lane;
        float mx = 0.f;
#pragma unroll 16
        for (int k = 0; k < 256; ++k) mx = fmaxf(mx, fabsf(w[(size_t)k * 8192]));
        atomicMax(wmax + l * WMAX_L + 12288 + n0 + lane, __float_as_uint(mx)); }
#endif
}
__device__ __forceinline__ unsigned pk_i8x4(f32x4 v) {
    const int a = (int)__builtin_rintf(v.x), b = (int)__builtin_rintf(v.y), c = (int)__builtin_rintf(v.z), d = (int)__builtin_rintf(v.w);
    return (unsigned)(a & 255) | ((unsigned)(b & 255) << 8) | ((unsigned)(c & 255) << 16) | ((unsigned)d << 24); }
struct TrItem { const float* src; bf16* dst; int N, ldk; const unsigned* cmax; const unsigned* ksc; };
__device__ __forceinline__ void tr_load(const TrItem& t, float (&v)[32], int lane) {
    const GAS float* s = (const GAS float*)t.src + (size_t)(lane >> 5) * t.N + (lane & 31);
#pragma unroll
    for (int i = 0; i < 32; ++i) v[i] = s[(size_t)(2 * i) * t.N];
}
__device__ __forceinline__ void tr_store(const TrItem& t, const float (&v)[32], LAS float* scr, int lane) {
#pragma unroll
    for (int i = 0; i < 32; ++i) scr[(2 * i + (lane >> 5)) * 33 + (lane & 31)] = v[i];
    LDS_WAIT(); asm volatile("" ::: "memory");
    const int c = lane & 7;
#pragma unroll
    for (int j = 0; j < 4; ++j) { const int n = (lane >> 3) + 8 * j; const LAS float* s = scr + (8 * c) * 33 + n;
        if (t.cmax) { const float cm = __uint_as_float(t.cmax[n]), inv = cm > 0.f ? 127.0f / cm : 0.f;
            v2u o; o.x = pk_i8x4((f32x4){s[0 * 33], s[1 * 33], s[2 * 33], s[3 * 33]} * inv); o.y = pk_i8x4((f32x4){s[4 * 33], s[5 * 33], s[6 * 33], s[7 * 33]} * inv);
            *(GAS v2u*)((unsigned char*)t.dst + (size_t)n * t.ldk + 8 * c) = o; }
        else { float f[8];
#pragma unroll
            for (int e = 0; e < 8; ++e) f[e] = s[e * 33];
            if (t.ksc) { const v4u k0 = *(const GAS v4u*)(t.ksc + 8 * c), k1 = *(const GAS v4u*)(t.ksc + 8 * c + 4); const unsigned kk[8] = {k0.x, k0.y, k0.z, k0.w, k1.x, k1.y, k1.z, k1.w};
#pragma unroll
                for (int e = 0; e < 8; ++e) { const float q = __uint_as_float(kk[e]) * (1.0f / 127.0f); f[e] *= q * q; } }
            v4u o; o.x = pk2(f[0], f[1]); o.y = pk2(f[2], f[3]); o.z = pk2(f[4], f[5]); o.w = pk2(f[6], f[7]);
            *(GAS v4u*)(t.dst + (size_t)n * t.ldk + 8 * c) = o; } }
    LDS_WAIT(); asm volatile("" ::: "memory");
}
__device__ __forceinline__ void phase_pro2(const AL& a, LAS unsigned char* lds, int tid, int lane, int wave, int G) {
    const int gt = blockIdx.x * (NWAVES * 64) + tid, NGT = G * NWAVES * 64;
    { float* mod = (float*)(a.ws() + WS_MOD); const float* modp = (const float*)(a.ws() + WS_MODP); const float* bada = a.in(I_BADA);
      for (int i = gt; i < 2 * 24 * 12288; i += NGT) { const int l = i / (24 * 12288), n = i % 12288; float s = bada[l * 12288 + n];
#pragma unroll
          for (int ks = 0; ks < 16; ++ks) s += modp[(size_t)ks * (2 * 24 * 12288) + i];
          mod[i] = s; } }
    { float2* rb = (float2*)(a.ws() + WS_ROPEB); float2* rc = (float2*)(a.ws() + WS_ROPEC);
      for (int i = gt; i < 4096 * 24; i += NGT) { const int pos = i / 24, j = i % 24; const bool isb = j < 16; const int ii = isb ? j : j - 16; const double half = isb ? 16.0 : 8.0;
          const double inv = exp(-(double)ii / half * 13.122363377404328);
          const double rev = (double)pos * inv * 0.15915494309189535;
          const float fr = (float)(rev - floor(rev));
          const float2 v = make_float2(__builtin_amdgcn_cosf(fr), __builtin_amdgcn_sinf(fr));
          if (isb) rb[pos * 16 + ii] = v; else rc[pos * 8 + ii] = v; } }
    if (gt < 2) { const int l = gt; float s1 = 0.f, s2 = 0.f;
        for (int i = 0; i < 64; ++i) { s1 += a.in(I_LQ1)[l * 64 + i] * a.in(I_LK1)[l * 64 + i]; s2 += a.in(I_LQ2)[l * 64 + i] * a.in(I_LK2)[l * 64 + i]; }
        const float lam_init = 0.8f - 0.6f * expf(-0.3f * (float)l);
        ((float*)(a.ws() + WS_LAM))[l] = expf(s1) - expf(s2) + lam_init;
        float gq = 0.f, gk = 0.f;
        for (int i = 0; i < 64; ++i) { gq = fmaxf(gq, fabsf(a.in(I_QNC)[l * 64 + i])); gk = fmaxf(gk, fabsf(a.in(I_KNC)[l * 64 + i])); }
        ((float*)(a.ws() + WS_LAM))[2 + l] = 8.0f * LOG2E * gq * gk * 1.02f; }
    LAS float* scr = (LAS float*)(lds + RING_OFF + wave * 16384);
    const int gw = blockIdx.x * NWAVES + wave, NGW = G * NWAVES;
    constexpr int I_IN = 32 * 192, I_BA = 8 * 64, I_BB = 4 * 64, I_BC = 12 * 64, I_OU = 32 * 64, I_F1 = 32 * 256, I_F2 = 128 * 64;
    constexpr int PER_L = 2 * I_IN + I_BA + I_BB + I_BC + I_OU + I_F1 + I_F2;
    auto decode = [&](int it) -> TrItem {
        const int l = it / PER_L; int r = it % PER_L; unsigned char* wl = a.ws() + WS_W + (size_t)l * W_LAYER;
        const float* W; bf16* WT; int K, N, row_off = 0, ldk, koff = 0, i8 = 0; bool win = false, ff2 = false;
        if (r < I_IN) { win = true; i8 = I8IN ? 1 : 0; W = a.in(I_WIN) + (size_t)l * 2048 * 6144; K = 2048; N = 6144; WT = (bf16*)(wl + WO_IG); ldk = 2048; }
        else if ((r -= I_IN) < I_IN) { i8 = 2; W = a.in(I_WGATE) + (size_t)l * 2048 * 6144; K = 2048; N = 6144; WT = (bf16*)(wl + WO_IG + (size_t)6144 * 2048 * (I8IN ? 1 : 2)); ldk = 2048; }
        else if ((r -= I_IN) < I_BA) { W = a.in(I_WBRA) + (size_t)l * 512 * 2048; K = 512; N = 2048; WT = (bf16*)(wl + WO_BRA); ldk = 1536; }
        else if ((r -= I_BA) < I_BB) { W = a.in(I_WBRB) + (size_t)l * 256 * 2048; K = 256; N = 2048; WT = (bf16*)(wl + WO_BRA); ldk = 1536; koff = 512; }
        else if ((r -= I_BB) < I_BC) { W = a.in(I_WBRC) + (size_t)l * 768 * 2048; K = 768; N = 2048; WT = (bf16*)(wl + WO_BRA); ldk = 1536; koff = 768; }
        else if ((r -= I_BC) < I_OU) { W = a.in(I_WOUT) + (size_t)l * 2048 * 2048; K = 2048; N = 2048; WT = (bf16*)(wl + WO_OUT); ldk = 2048; }
        else if ((r -= I_OU) < I_F1) { W = a.in(I_WFF1) + (size_t)l * 2048 * 8192; K = 2048; N = 8192; WT = (bf16*)(wl + WO_FF1); ldk = 2048; i8 = I8FF1 ? 3 : 0; }
        else { r -= I_F1; W = a.in(I_WFF2) + (size_t)l * 8192 * 2048; K = 8192; N = 2048; WT = (bf16*)(wl + WO_FF2); ldk = 8192; ff2 = I8FF1 != 0; }
        (void)K; const int nblk = N / 32, kb = r / nblk, nb = r % nblk, k0 = 64 * kb, n0 = 32 * nb; const int nd = win ? win_row(n0) : n0;
        TrItem t; t.src = W + (size_t)k0 * N + n0; t.N = N; t.ldk = ldk; t.cmax = nullptr; t.ksc = ff2 ? (const unsigned*)(a.ws() + WS_CTL) + CW_WMAX + l * WMAX_L + 12288 + k0 : nullptr;
        if (i8) { t.dst = (bf16*)((unsigned char*)WT + (size_t)nd * ldk + k0); t.cmax = (const unsigned*)(a.ws() + WS_CTL) + CW_WMAX + l * WMAX_L + (i8 == 3 ? 12288 : i8 == 2 ? 6144 : 0) + nd; }
        else t.dst = WT + (size_t)(row_off + nd) * ldk + koff + k0;
        return t; };
    { int it = gw; const int NIT = 2 * PER_L;
      if (it < NIT) { TrItem cur = decode(it); float v[32]; tr_load(cur, v, lane);
          for (;;) { const int nx = it + NGW; const bool more = nx < NIT; TrItem nt = cur; float vn[32];
              if (more) { nt = decode(nx); tr_load(nt, vn, lane); }
              tr_store(cur, v, scr, lane);
              if (!more) break;
              cur = nt; it = nx;
#pragma unroll
              for (int i = 0; i < 32; ++i) v[i] = vn[i]; } } }
}

__device__ __forceinline__ f32x4 up4(v2u w) { return (f32x4){bflo(w.x), bfhi(w.x), bflo(w.y), bfhi(w.y)}; }
template <bool XF32, bool HASD, bool QI8 = false>
__device__ __forceinline__ void phase_norm(const float* xf, const bf16* XS, const bf16* D, bf16* XB, const float* gn, const float* modl, int sh_off, int sc_off, int seq0, int tshift, bf16* H, int gw, int NGW, int lane, unsigned char* HI8 = nullptr, float* HS = nullptr) {
    for (int blk = gw; blk < CH / 8; blk += NGW) {
        const int r0 = blk * 8; const float* mo = modl + (size_t)(seq0 + (r0 >> tshift)) * 12288;
        f32x4 A[8], B[8];
#pragma unroll
        for (int j = 0; j < 8; ++j) { const int c = 4 * lane + 256 * j; const f32x4 g = *(const GAS f32x4*)(gn + c), sc = *(const GAS f32x4*)(mo + sc_off + c); A[j] = g * (1.0f + sc); B[j] = *(const GAS f32x4*)(mo + sh_off + c); }
        for (int r = 0; r < 8; r += 2) {
            f32x4 v0[8], v1[8]; float s0 = 0.f, s1 = 0.f;
            if (XF32) { const GAS f32x4* xr0 = (const GAS f32x4*)(xf + (size_t)(r0 + r) * 2048) + lane; const GAS f32x4* xr1 = xr0 + 512;
#pragma unroll
                for (int j = 0; j < 8; ++j) { v0[j] = xr0[64 * j]; v1[j] = xr1[64 * j]; } }
            else { const GAS v2u* xr0 = (const GAS v2u*)(XS + (size_t)(r0 + r) * 2048) + lane; const GAS v2u* xr1 = xr0 + 512; v2u e0[8], e1[8];
#pragma unroll
                for (int j = 0; j < 8; ++j) { e0[j] = xr0[64 * j]; e1[j] = xr1[64 * j]; }
#pragma unroll
                for (int j = 0; j < 8; ++j) { v0[j] = up4(e0[j]); v1[j] = up4(e1[j]); } }
            if (HASD) { const GAS v2u* d0 = (const GAS v2u*)(D + (size_t)(r0 + r) * 2048) + lane; const GAS v2u* d1 = d0 + 512; v2u e0[8], e1[8];
#pragma unroll
                for (int j = 0; j < 8; ++j) { e0[j] = d0[64 * j]; e1[j] = d1[64 * j]; }
                GAS v2u* xo0 = (GAS v2u*)(XB + (size_t)(r0 + r) * 2048) + lane; GAS v2u* xo1 = xo0 + 512;
#pragma unroll
                for (int j = 0; j < 8; ++j) { v0[j] = v0[j] + up4(e0[j]); v1[j] = v1[j] + up4(e1[j]);
                    v2u w0, w1; w0.x = pk2(v0[j].x, v0[j].y); w0.y = pk2(v0[j].z, v0[j].w); w1.x = pk2(v1[j].x, v1[j].y); w1.y = pk2(v1[j].z, v1[j].w); xo0[64 * j] = w0; xo1[64 * j] = w1; } }
#pragma unroll
            for (int j = 0; j < 8; ++j) { s0 += (v0[j].x * v0[j].x + v0[j].y * v0[j].y) + (v0[j].z * v0[j].z + v0[j].w * v0[j].w); s1 += (v1[j].x * v1[j].x + v1[j].y * v1[j].y) + (v1[j].z * v1[j].z + v1[j].w * v1[j].w); }
            const float rstd0 = rsqrtf(wave_sum(s0) * (1.0f / 2048.0f) + EPS), rstd1 = rsqrtf(wave_sum(s1) * (1.0f / 2048.0f) + EPS);
            if constexpr (QI8) {
                float m0 = 0.f, m1 = 0.f;
#pragma unroll
                for (int j = 0; j < 8; ++j) { const f32x4 p = v0[j] * rstd0 * A[j] + B[j], q = v1[j] * rstd1 * A[j] + B[j];
                    m0 = fmaxf(fmaxf(m0, fmaxf(fabsf(p.x), fabsf(p.y))), fmaxf(fabsf(p.z), fabsf(p.w))); m1 = fmaxf(fmaxf(m1, fmaxf(fabsf(q.x), fabsf(q.y))), fmaxf(fabsf(q.z), fabsf(q.w))); }
#pragma unroll
                for (int o_ = 1; o_ < 64; o_ <<= 1) { m0 = fmaxf(m0, __shfl_xor(m0, o_)); m1 = fmaxf(m1, __shfl_xor(m1, o_)); }
                const float i0 = m0 > 0.f ? 127.0f / m0 : 0.f, i1 = m1 > 0.f ? 127.0f / m1 : 0.f;
                GAS unsigned* q0 = (GAS unsigned*)(HI8 + (size_t)(r0 + r) * 2048) + lane; GAS unsigned* q1 = q0 + 512;
#pragma unroll
                for (int j = 0; j < 8; ++j) { q0[64 * j] = pk_i8x4((v0[j] * rstd0 * A[j] + B[j]) * i0); q1[64 * j] = pk_i8x4((v1[j] * rstd1 * A[j] + B[j]) * i1); }
                if (lane == 0) { HS[r0 + r] = m0 * (1.0f / 127.0f); HS[r0 + r + 1] = m1 * (1.0f / 127.0f); }
                if (H) { GAS v2u* o8 = (GAS v2u*)(H + (size_t)(r0 + r) * 2048) + lane;
#pragma unroll
                    for (int j = 0; j < 8; ++j) { const f32x4 o = v0[j] * rstd0 * A[j] + B[j], p = v1[j] * rstd1 * A[j] + B[j]; v2u w; w.x = pk2(o.x, o.y); w.y = pk2(o.z, o.w); o8[64 * j] = w; w.x = pk2(p.x, p.y); w.y = pk2(p.z, p.w); o8[512 + 64 * j] = w; } }
            } else {
            GAS v2u* o8 = (GAS v2u*)(H + (size_t)(r0 + r) * 2048) + lane;
#pragma unroll
            for (int j = 0; j < 8; ++j) { const f32x4 o = v0[j] * rstd0 * A[j] + B[j]; v2u w; w.x = pk2(o.x, o.y); w.y = pk2(o.z, o.w); o8[64 * j] = w; }
#pragma unroll
            for (int j = 0; j < 8; ++j) { const f32x4 o = v1[j] * rstd1 * A[j] + B[j]; v2u w; w.x = pk2(o.x, o.y); w.y = pk2(o.z, o.w); o8[512 + 64 * j] = w; }
            }
        }
    }
}
__device__ __forceinline__ void phase_final(const bf16* XS, const bf16* D, float* xout, int gw, int NGW, int lane) {
    for (int r = 2 * gw; r < CH; r += 2 * NGW) {
        const GAS v2u* xr0 = (const GAS v2u*)(XS + (size_t)r * 2048) + lane; const GAS v2u* xr1 = xr0 + 512; const GAS v2u* d0 = (const GAS v2u*)(D + (size_t)r * 2048) + lane; const GAS v2u* d1 = d0 + 512;
        v2u x0[8], x1[8], e0[8], e1[8];
#pragma unroll
        for (int j = 0; j < 8; ++j) { x0[j] = xr0[64 * j]; x1[j] = xr1[64 * j]; e0[j] = d0[64 * j]; e1[j] = d1[64 * j]; }
        GAS f32x4* xo0 = (GAS f32x4*)(xout + (size_t)r * 2048) + lane; GAS f32x4* xo1 = xo0 + 512;
#pragma unroll
        for (int j = 0; j < 8; ++j) { xo0[64 * j] = up4(x0[j]) + up4(e0[j]); xo1[64 * j] = up4(x1[j]) + up4(e1[j]); }
    }
}
__device__ __forceinline__ int perm_tok(int p, int dsh, int Lsh) { return dsh == 0 ? p : (((p & ((1 << Lsh) - 1)) << dsh) + (p >> Lsh)); }
__device__ __forceinline__ void prep_qk_item(const bf16* Z, bf16* QK, const AL& a, int l, int item, int S, int tshift, int lane) {
    const int slot = item & 31, rb = item >> 5;
    int srccol, dstcol, dsh = 0, kind = 0; const float* gain; float scale = 1.f;
    if (slot < 4) { srccol = 128 * slot; dstcol = 128 * slot; gain = a.in(I_QNA) + l * 128; scale = QS128; }
    else if (slot < 8) { const int j = slot - 4; srccol = 512 + 128 * j; dstcol = 512 + 128 * j; gain = a.in(I_KNA) + l * 128; }
    else if (slot < 14) { const int j = slot - 8; srccol = 1536 + 128 * j; dstcol = 1024 + 128 * j; kind = 1; gain = a.in(I_QNB) + l * 128; scale = QS128; dsh = 2 * (j >> 1); }
    else if (slot < 20) { const int j = slot - 14; srccol = 2304 + 128 * j; dstcol = 1792 + 128 * j; kind = 1; gain = a.in(I_KNB) + l * 128; dsh = 2 * (j >> 1); }
    else if (slot < 26) { const int j = slot - 20; srccol = 3840 + 128 * j; dstcol = 2560 + 128 * j; kind = 2; gain = a.in(I_QNC) + l * 64; scale = QS64; }
    else { const int j = slot - 26; srccol = 4608 + 128 * j; dstcol = 3328 + 128 * j; kind = 2; gain = a.in(I_KNC) + l * 64; }
    const int sub = lane & 15, Lsh = tshift - dsh;
    float g[8];
#pragma unroll
    for (int e = 0; e < 8; ++e) g[e] = gain[((8 * sub) & (kind == 2 ? 63 : 127)) + e];
    const float2* ropeB = (const float2*)(a.ws() + WS_ROPEB); const float2* ropeC = (const float2*)(a.ws() + WS_ROPEC);
    const int RS = kind == 1 ? 2 : 1, subg = kind == 1 ? sub : (sub & 7);
    const bool roper = kind != 0 && subg < 2 * RS, first = subg < RS; const int ib = 8 * (subg & (RS - 1));
    for (int p4 = 0; p4 < 16; p4 += 4) {
        v4u w[4]; int tt[4]; float2 cs[4][8];
#pragma unroll
        for (int q = 0; q < 4; ++q) { const int orow = rb * 64 + (p4 + q) * 4 + (lane >> 4), sl = orow >> tshift, p = orow & (S - 1);
            tt[q] = perm_tok(p, dsh, Lsh);
            w[q] = *(const GAS v4u*)(Z + (size_t)((sl << tshift) + tt[q]) * 6144 + srccol + 8 * sub); }
        if (roper) {
#pragma unroll
            for (int q = 0; q < 4; ++q) { const float2* tab = kind == 1 ? ropeB + tt[q] * 16 + ib : ropeC + tt[q] * 8 + ib;
#pragma unroll
                for (int e = 0; e < 8; ++e) cs[q][e] = tab[e]; } }
#pragma unroll
        for (int q = 0; q < 4; ++q) { const int orow = rb * 64 + (p4 + q) * 4 + (lane >> 4);
            float y[8] = {bflo(w[q].x), bfhi(w[q].x), bflo(w[q].y), bfhi(w[q].y), bflo(w[q].z), bfhi(w[q].z), bflo(w[q].w), bfhi(w[q].w)};
            float ss = 0.f;
#pragma unroll
            for (int e = 0; e < 8; ++e) ss += y[e] * y[e];
            ss += __shfl_xor(ss, 1); ss += __shfl_xor(ss, 2); ss += __shfl_xor(ss, 4);
            if (kind != 2) ss += __shfl_xor(ss, 8);
            const float rstd = rsqrtf(ss * (kind == 2 ? (1.0f / 64.0f) : (1.0f / 128.0f)) + EPS);
#pragma unroll
            for (int e = 0; e < 8; ++e) y[e] = y[e] * rstd * g[e];
            if (kind != 0) {
                float pr[8];
#pragma unroll
                for (int e = 0; e < 8; ++e) pr[e] = __shfl_xor(y[e], RS);
                if (roper) {
#pragma unroll
                    for (int e = 0; e < 8; ++e) y[e] = first ? y[e] * cs[q][e].x - pr[e] * cs[q][e].y : y[e] * cs[q][e].x + pr[e] * cs[q][e].y; }
            }
            v4u o; o.x = pk2(y[0] * scale, y[1] * scale); o.y = pk2(y[2] * scale, y[3] * scale); o.z = pk2(y[4] * scale, y[5] * scale); o.w = pk2(y[6] * scale, y[7] * scale);
            *(GAS v4u*)(QK + (size_t)orow * 4096 + dstcol + 8 * sub) = o; }
    }
}
struct VtItem { int srccol, dsh, sl, p0, vrow; };
__device__ __forceinline__ VtItem vt_decode(int item, int S, int tshift, int nvh) {
    const int dh = item & 1, vh = 10 + (item >> 1) % nvh, pb = item / (2 * nvh); VtItem v; v.dsh = 0;
    v.srccol = 128 * vh; if (vh >= 4 && vh < 10) v.dsh = 2 * ((vh - 4) >> 1);
    v.srccol += 64 * dh; const int o0 = pb * 64; v.sl = o0 >> tshift; v.p0 = o0 & (S - 1); v.vrow = (v.sl * 16 + vh) * 128 + 64 * dh; return v;
}
__device__ __forceinline__ void vt_load(const bf16* Z, const VtItem& v, int tshift, v4u (&w)[8], int lane) {
    const int Lsh = tshift - v.dsh;
#pragma unroll
    for (int pass = 0; pass < 8; ++pass) { const int i = pass * 8 + (lane >> 3), c8 = lane & 7, t = perm_tok(v.p0 + i, v.dsh, Lsh);
        w[pass] = *(const GAS v4u*)(Z + (size_t)((v.sl << tshift) + t) * 2048 + v.srccol + 8 * c8); }
}
__device__ __forceinline__ void vt_store(bf16* VT, const VtItem& v, int S, const v4u (&w)[8], LAS unsigned short* T, int lane) {
#pragma unroll
    for (int pass = 0; pass < 8; ++pass) { const int i = pass * 8 + (lane >> 3), c8 = lane & 7;
        LAS unsigned short* tp = T + (8 * c8) * 68 + i;
        tp[0 * 68] = (unsigned short)(w[pass].x & 0xffffu); tp[1 * 68] = (unsigned short)(w[pass].x >> 16); tp[2 * 68] = (unsigned short)(w[pass].y & 0xffffu); tp[3 * 68] = (unsigned short)(w[pass].y >> 16);
        tp[4 * 68] = (unsigned short)(w[pass].z & 0xffffu); tp[5 * 68] = (unsigned short)(w[pass].z >> 16); tp[6 * 68] = (unsigned short)(w[pass].w & 0xffffu); tp[7 * 68] = (unsigned short)(w[pass].w >> 16); }
    LDS_WAIT(); asm volatile("" ::: "memory");
#pragma unroll
    for (int pass = 0; pass < 16; ++pass) { const int d = pass * 4 + (lane >> 4), c4 = lane & 15;
        const v2u x = *(const LAS v2u*)(T + d * 68 + 4 * c4);
        *(GAS v2u*)(VT + (size_t)(v.vrow + d) * S + v.p0 + 4 * c4) = x; }
    LDS_WAIT(); asm volatile("" ::: "memory");
}
__device__ __forceinline__ void phase_prep(const AL& a, int l, LAS unsigned char* lds, int S, int tshift, int gw, int NGW, int wave, int lane) {
    const bf16* Z = (const bf16*)(a.ws() + A_Z); bf16* VT = (bf16*)(a.ws() + A_VT);
    LAS unsigned short* T = (LAS unsigned short*)(lds + RING_OFF + wave * 16384);
    const int nvh = 6;
    { int it = gw; const int NIT = (CH / 64) * 2 * nvh;
      if (it < NIT) { VtItem cur = vt_decode(it, S, tshift, nvh); v4u w[8]; vt_load(Z, cur, tshift, w, lane);
          for (;;) { const int nx = it + NGW; const bool more = nx < NIT; VtItem nv = cur; v4u wn[8];
              if (more) { nv = vt_decode(nx, S, tshift, nvh); vt_load(Z, nv, tshift, wn, lane); }
              vt_store(VT, cur, S, w, T, lane);
              if (!more) break;
              cur = nv; it = nx;
#pragma unroll
              for (int i = 0; i < 8; ++i) w[i] = wn[i]; } } }
}

namespace att {
#define MFMA32(a, b, c) __builtin_amdgcn_mfma_f32_32x32x16_bf16((a), (b), (c), 0, 0, 0)
__device__ __forceinline__ float ex2(float x) { return __builtin_amdgcn_exp2f(x); }
struct MaskNone { static constexpr bool MASKED = false; __device__ __forceinline__ float operator()(float v, int) const { return v; } };
struct MaskB { static constexpr bool MASKED = true; int dq;
    __device__ __forceinline__ float operator()(float v, int koff) const { const int d = dq + koff; return (d >= -64 && d <= 64) ? v : NEGB; } };
struct MaskA { static constexpr bool MASKED = true; const LAS float* brow; int kc0, qc, cs;
    __device__ __forceinline__ float operator()(float v, int koff) const { const int kc = kc0 + koff; int di = kc - qc + 15; di = di < 0 ? 0 : (di > 30 ? 30 : di);
        const float b = brow[di]; return (kc >= cs && kc < cs + 16) ? v + b : NEGB; } };

template <int NK, class MaskFn>
__device__ __forceinline__ void tile_core(const bf16x8 (&kf)[NK], const bf16x8 (&vf)[4][2], const bf16x8 (&qf)[NK], f32x16 (&o)[4], float& m, float& l, int lane, const MaskFn& mf) {
    const int hi = lane >> 5;
    f32x16 s;
#pragma unroll
    for (int r = 0; r < 16; ++r) s[r] = 0.f;
#pragma unroll
    for (int d0 = 0; d0 < NK; ++d0) s = MFMA32(kf[d0], qf[d0], s);
    float mx = NEGB;
#pragma unroll
    for (int r = 0; r < 16; ++r) { s[r] = mf(s[r], 16 * (r >> 3) + 8 * hi + (r & 7)); mx = fmaxf(mx, s[r]); }
    mx = max32(mx);
    const float mn = fmaxf(m, mx), alpha = ex2(m - mn);
    float ps = 0.f;
#pragma unroll
    for (int r = 0; r < 16; ++r) { float p = ex2(s[r] - mn); if (MaskFn::MASKED) p = s[r] <= -1e29f ? 0.f : p; s[r] = p; ps += p; }
    l = l * alpha + ps; m = mn;
    if (!__all(alpha == 1.0f)) {
#pragma unroll
        for (int db = 0; db < 4; ++db)
#pragma unroll
            for (int r = 0; r < 16; ++r) o[db][r] *= alpha;
    }
    bf16x8 pf[2];
#pragma unroll
    for (int s2 = 0; s2 < 2; ++s2) { v4u w; w.x = pk2(s[8 * s2 + 0], s[8 * s2 + 1]); w.y = pk2(s[8 * s2 + 2], s[8 * s2 + 3]); w.z = pk2(s[8 * s2 + 4], s[8 * s2 + 5]); w.w = pk2(s[8 * s2 + 6], s[8 * s2 + 7]); pf[s2] = __builtin_bit_cast(bf16x8, w); }
#pragma unroll
    for (int db = 0; db < 4; ++db)
#pragma unroll
        for (int s2 = 0; s2 < 2; ++s2) o[db] = MFMA32(vf[db][s2], pf[s2], o[db]);
}
template <int NK, class MaskFn>
__device__ __forceinline__ void tile_step(const bf16* Kt, const bf16* VTt, int S, const bf16x8 (&qf)[NK], f32x16 (&o)[4], float& m, float& l, int lane, const MaskFn& mf) {
    const int r32 = lane & 31, hi = lane >> 5;
    const int pim = (r32 & 19) | ((r32 & 4) << 1) | ((r32 & 8) >> 1);
    const bf16* kp = Kt + (size_t)pim * 4096 + 8 * hi;
    bf16x8 kf[NK];
#pragma unroll
    for (int d0 = 0; d0 < NK; ++d0) kf[d0] = *(const GAS bf16x8*)(kp + 16 * d0);
    bf16x8 vf[4][2];
    const bf16* vp = VTt + (size_t)r32 * S + 8 * hi;
#pragma unroll
    for (int db = 0; db < 4; ++db)
#pragma unroll
        for (int s2 = 0; s2 < 2; ++s2) vf[db][s2] = *(const GAS bf16x8*)(vp + (size_t)(32 * db) * S + 16 * s2);
    tile_core<NK, MaskFn>(kf, vf, qf, o, m, l, lane, mf);
}
template <int NK> __device__ __forceinline__ void load_q(const bf16* Qp, bf16x8 (&qf)[NK], int lane) {
    const bf16* q = Qp + (size_t)(lane & 31) * 4096 + 8 * (lane >> 5);
#pragma unroll
    for (int d0 = 0; d0 < NK; ++d0) qf[d0] = *(const GAS bf16x8*)(q + 16 * d0);
}
__device__ __forceinline__ void zero_o(f32x16 (&o)[4]) {
#pragma unroll
    for (int db = 0; db < 4; ++db)
#pragma unroll
        for (int r = 0; r < 16; ++r) o[db][r] = 0.f;
}
__device__ __forceinline__ void store_o_bf16(bf16* dst, const f32x16 (&o)[4], float inv, int hi) {
#pragma unroll
    for (int db = 0; db < 4; ++db)
#pragma unroll
        for (int g = 0; g < 4; ++g) { v2u w; w.x = pk2(o[db][4 * g] * inv, o[db][4 * g + 1] * inv); w.y = pk2(o[db][4 * g + 2] * inv, o[db][4 * g + 3] * inv);
            *(GAS v2u*)(dst + 32 * db + 8 * g + 4 * hi) = w; }
}
__device__ __forceinline__ void store_o_f32(float* dst, const f32x16 (&o)[4], float inv, int hi) {
#pragma unroll
    for (int db = 0; db < 4; ++db)
#pragma unroll
        for (int g = 0; g < 4; ++g) { const f32x4 v = {o[db][4 * g] * inv, o[db][4 * g + 1] * inv, o[db][4 * g + 2] * inv, o[db][4 * g + 3] * inv};
            *(GAS f32x4*)(dst + 32 * db + 8 * g + 4 * hi) = v; }
}
__device__ __forceinline__ void wave_c(const bf16* QK, const bf16* VT, float* CTMP, int sl, int map, int q0, int S, int tshift, int lane) {
    const size_t row0 = (size_t)sl << tshift; const int hi = lane >> 5;
    const bf16* Kp = QK + row0 * 4096 + 3328 + 64 * map;
    const bf16* Vp = VT + (size_t)((sl * 16 + 10 + (map >> 1)) * 128) * S;
    bf16x8 qf[4]; load_q<4>(QK + (row0 + q0) * 4096 + 2560 + 64 * map, qf, lane);
    f32x16 o[4]; zero_o(o); float m = NEGB, l = 0.f; const MaskNone mf;
    for (int kb = 0; kb < S; kb += 32) tile_step<4, MaskNone>(Kp + (size_t)kb * 4096, Vp + kb, S, qf, o, m, l, lane, mf);
    l = sum32(l);
    store_o_f32(CTMP + (row0 + q0 + (lane & 31)) * 1536 + map * 128, o, 1.0f / l, hi);
}
__device__ __forceinline__ void wave_b(const bf16* QK, const bf16* VT, bf16* BTMP, float* BLSE, int sl, int slot, int p0, int S, int tshift, int lane) {
    const size_t row0 = (size_t)sl << tshift; const int hi = lane >> 5, dsh = 2 * (slot >> 1), Lsh = tshift - dsh;
    const bf16* Kp = QK + row0 * 4096 + 1792 + 128 * slot;
    const bf16* Vp = VT + (size_t)((sl * 16 + 4 + slot) * 128) * S;
    bf16x8 qf[8]; load_q<8>(QK + (row0 + p0) * 4096 + 1024 + 128 * slot, qf, lane);
    f32x16 o[4]; zero_o(o); float m = NEGB, l = 0.f;
    const int qp = p0 + (lane & 31);
#pragma unroll 1
    for (int ti = 0; ti < 5; ++ti) { const int kb = p0 - 64 + 32 * ti;
        if (kb < 0 || kb >= S || (kb >> Lsh) != (p0 >> Lsh)) continue;
        const MaskB mf{kb - qp};
        tile_step<8, MaskB>(Kp + (size_t)kb * 4096, Vp + kb, S, qf, o, m, l, lane, mf); }
    l = sum32(l);
    const int t = perm_tok(qp, dsh, Lsh);
    store_o_bf16(BTMP + (row0 + t) * 768 + slot * 128, o, 1.0f / l, hi);
    if (hi == 0) ((GAS float*)BLSE)[(row0 + t) * 8 + slot] = (__log2f(l) + m) * LN2;
}
__device__ __forceinline__ void wave_a(const bf16* QK, const bf16* VT, bf16* OA, const LAS float* btab, int sl, int h, int r, int qh, int S, int tshift, int lane) {
    const size_t row0 = (size_t)sl << tshift; const int hi = lane >> 5, rows = S >> 6;
    int rs = r - 4; rs = rs < 0 ? 0 : (rs > rows - 8 ? rows - 8 : rs);
    const bf16* Kp = QK + row0 * 4096 + 512 + 128 * h;
    const bf16* Vp = VT + (size_t)((sl * 16 + h) * 128) * S;
    const int q0 = r * 64 + 32 * qh, qc = 32 * qh + (lane & 31);
    int cs = qc - 8; cs = cs < 0 ? 0 : (cs > 48 ? 48 : cs);
    bf16x8 qf[8]; load_q<8>(QK + (row0 + q0) * 4096 + 128 * h, qf, lane);
    f32x16 o[4]; zero_o(o); float m = NEGB, l = 0.f;
#pragma unroll 1
    for (int ti = 0; ti < 16; ++ti) { const int j = ti >> 1, chh = ti & 1, kb = (rs + j) * 64 + 32 * chh;
        const MaskA mf{btab + (rs + j - r + 7) * 31, 32 * chh, qc, cs};
        tile_step<8, MaskA>(Kp + (size_t)kb * 4096, Vp + kb, S, qf, o, m, l, lane, mf); }
    l = sum32(l);
    store_o_bf16(OA + (row0 + q0 + (lane & 31)) * 1536 + h * 128, o, 1.0f / l, hi);
}

constexpr int CST = 24576;
__device__ __forceinline__ void glds16(const void* gsrc, unsigned lds_dst) { unsigned keep;
    asm volatile("s_mov_b32 %0, m0\n\ts_mov_b32 m0, %2\n\ts_nop 0\n\tglobal_load_lds_dwordx4 %1, off\n\ts_mov_b32 m0, %0" : "=&s"(keep) : "v"(gsrc), "s"(lds_dst) : "memory"); }
__device__ __forceinline__ void c_dma(const bf16* Kp, const bf16* Vp, int S, int kb, unsigned sb, int wave, int lane) {
    { const int row = 8 * wave + (lane >> 3), c = (lane & 7) ^ ((row >> 1) & 7);
      glds16(Kp + (size_t)(kb + row) * 4096 + 8 * c, (unsigned)__builtin_amdgcn_readfirstlane(sb + wave * 1024)); }
#pragma unroll
    for (int jj = 0; jj < 2; ++jj) { const int j = wave + 8 * jj, row = 8 * j + (lane >> 3), c = (lane & 7) ^ ((row >> 1) & 7);
      glds16(Vp + (size_t)row * S + kb + 8 * c, (unsigned)__builtin_amdgcn_readfirstlane(sb + 8192 + j * 1024)); }
}
#define C_WAIT_BAR(N) asm volatile("s_waitcnt vmcnt(" #N ")\n\ts_barrier" ::: "memory")
__device__ __forceinline__ void unit_c_fast(const bf16* QK, const bf16* VT, float* CTMP, LAS unsigned char* ring, int sl, int map, int qb, int S, int tshift, int wave, int lane) {
    constexpr int CV = 0;
    const size_t row0 = (size_t)sl << tshift; const int r32 = lane & 31, hi = lane >> 5, q0 = qb * 256 + 32 * wave;
    const bf16* Kp = QK + row0 * 4096 + 3328 + 64 * map;
    const bf16* Vp = VT + (size_t)((sl * 16 + 10 + (map >> 1)) * 128) * S;
    bf16x8 qf[4]; load_q<4>(QK + (row0 + q0) * 4096 + 2560 + 64 * map, qf, lane);
    const int pim = (r32 & 19) | ((r32 & 4) << 1) | ((r32 & 8) >> 1);
    int ka[4], va[4];
#pragma unroll
    for (int d0 = 0; d0 < 4; ++d0) ka[d0] = pim * 128 + (((2 * d0 + hi) ^ ((pim >> 1) & 7)) << 4);
#pragma unroll
    for (int x = 0; x < 4; ++x) va[x] = 8192 + r32 * 128 + (((2 * x + hi) ^ ((r32 >> 1) & 7)) << 4);
    f32x16 o[4]; zero_o(o); float l = 0.f;
    const int NT = S >> 6;
#pragma unroll
    for (int d0 = 0; d0 < 4; ++d0) asm volatile("" : "+v"(qf[d0]));
    asm volatile("s_waitcnt vmcnt(0)\n\ts_barrier" ::: "memory");
    const unsigned ring_a = (unsigned)(size_t)ring;
    c_dma(Kp, Vp, S, 0, ring_a, wave, lane); c_dma(Kp, Vp, S, 64, ring_a + CST, wave, lane);
    int st_cur = 0, st_nxt2 = 2 * CST;
#pragma unroll 1
    for (int t = 0; t < NT; ++t) {
        if (t + 1 < NT) C_WAIT_BAR(3); else C_WAIT_BAR(0);
        if (t + 2 < NT) c_dma(Kp, Vp, S, (t + 2) * 64, ring_a + st_nxt2, wave, lane);
        const LAS unsigned char* sb = ring + st_cur;
        bf16x8 kf[2][4];
#pragma unroll
        for (int st = 0; st < 2; ++st)
#pragma unroll
            for (int d0 = 0; d0 < 4; ++d0) { if (CV & 2) kf[st][d0] = qf[(d0 + st) & 3]; else kf[st][d0] = *(const LAS bf16x8*)(sb + st * 4096 + ka[d0]); }
        f32x16 s[2];
#pragma unroll
        for (int st = 0; st < 2; ++st) {
#pragma unroll
            for (int r = 0; r < 16; ++r) s[st][r] = 0.f;
#pragma unroll
            for (int d0 = 0; d0 < 4; ++d0) s[st] = MFMA32(kf[st][d0], qf[d0], s[st]); }
#pragma unroll
        for (int st = 0; st < 2; ++st) {
            bf16x8 vf[4][2];
#pragma unroll
            for (int db = 0; db < 4; ++db)
#pragma unroll
                for (int s2 = 0; s2 < 2; ++s2) vf[db][s2] = *(const LAS bf16x8*)(sb + db * 4096 + va[2 * st + s2]);
#pragma unroll
            for (int r = 0; r < 16; ++r) { s[st][r] = ex2(s[st][r]); l += s[st][r]; }
            bf16x8 pf[2];
#pragma unroll
            for (int s2 = 0; s2 < 2; ++s2) { v4u w; w.x = pk2(s[st][8 * s2 + 0], s[st][8 * s2 + 1]); w.y = pk2(s[st][8 * s2 + 2], s[st][8 * s2 + 3]); w.z = pk2(s[st][8 * s2 + 4], s[st][8 * s2 + 5]); w.w = pk2(s[st][8 * s2 + 6], s[st][8 * s2 + 7]); pf[s2] = __builtin_bit_cast(bf16x8, w); }
#pragma unroll
            for (int db = 0; db < 4; ++db)
#pragma unroll
                for (int s2 = 0; s2 < 2; ++s2) o[db] = MFMA32(vf[db][s2], pf[s2], o[db]);
        }
        st_cur = st_cur == 2 * CST ? 0 : st_cur + CST; st_nxt2 = st_nxt2 == 2 * CST ? 0 : st_nxt2 + CST;
    }
    l = sum32(l);
    store_o_f32(CTMP + (row0 + q0 + r32) * 1536 + map * 128, o, 1.0f / l, hi);
}

constexpr int CST2 = 32768, CEXP = 132;
typedef short v4i16_t __attribute__((ext_vector_type(4)));
__device__ __forceinline__ v4i16_t vtr(const LAS unsigned char* p) { return __builtin_amdgcn_ds_read_tr16_b64_v4i16((LAS v4i16_t*)p); }
__device__ __forceinline__ void c2_dma(const bf16* Kp0, const bf16* Vrow, int kb, unsigned sb, int wave, int lane) {
    { const int row = 8 * wave + (lane >> 3), c = (lane & 7) ^ ((row >> 1) & 7);
      const bf16* src = Kp0 + (size_t)(kb + row) * 4096 + 8 * c;
      glds16(src, (unsigned)__builtin_amdgcn_readfirstlane(sb + wave * 1024));
      glds16(src + 64, (unsigned)__builtin_amdgcn_readfirstlane(sb + 8192 + wave * 1024)); }
#pragma unroll
    for (int jj = 0; jj < 2; ++jj) { const int j = wave + 8 * jj, st = j >> 3, row = 4 * (j & 7) + (lane >> 4), ch = (lane & 15) ^ (((row & 3) << 2) | ((row >> 2) & 3));
      glds16(Vrow + (size_t)(kb + 32 * st + row) * 2048 + 8 * ch, (unsigned)__builtin_amdgcn_readfirstlane(sb + 16384 + j * 1024)); }
}
template <int CV = 0>
__device__ __forceinline__ void unit_c_fused(const bf16* QK, const bf16* Zv, bf16* OC, const float* subln, float lam, float onemli, LAS unsigned char* ring, int sl, int h, int qb, int S, int tshift, int wave, int lane) {
    const size_t row0 = (size_t)sl << tshift; const int r32 = lane & 31, hi = lane >> 5, mp = wave >> 2, q0 = qb * 128 + 32 * (wave & 3);
    const bf16* Kp0 = QK + row0 * 4096 + 3328 + 128 * h;
    const bf16* Vrow = Zv + row0 * 2048 + 1280 + 128 * h;
    bf16x8 qf[4]; load_q<4>(QK + (row0 + q0) * 4096 + 2560 + 128 * h + 64 * mp, qf, lane);
    const int pim = (r32 & 19) | ((r32 & 4) << 1) | ((r32 & 8) >> 1);
    int ka[4];
#pragma unroll
    for (int d0 = 0; d0 < 4; ++d0) ka[d0] = mp * 8192 + pim * 128 + (((2 * d0 + hi) ^ ((pim >> 1) & 7)) << 4);
    const int tq = (lane & 15) >> 2, tp = lane & 3, tblk = (lane >> 4) & 1;
    const int vlane = 16384 + 256 * (8 * hi + tq) + 8 * (tp & 1);
    int vo[4][2];
#pragma unroll
    for (int db = 0; db < 4; ++db)
#pragma unroll
        for (int t = 0; t < 2; ++t) vo[db][t] = vlane + 1024 * t + 16 * ((((db ^ tq) & 3) << 2) | ((2 * tblk + (tp >> 1)) ^ ((2 * hi + t) & 3)));
    f32x16 o[4]; zero_o(o); float l = 0.f;
    const int NT = S >> 6;
#pragma unroll
    for (int d0 = 0; d0 < 4; ++d0) asm volatile("" : "+v"(qf[d0]));
    asm volatile("s_waitcnt vmcnt(0)\n\ts_barrier" ::: "memory");
    const unsigned ring_a = (unsigned)(size_t)ring;
    c2_dma(Kp0, Vrow, 0, ring_a, wave, lane); c2_dma(Kp0, Vrow, 64, ring_a + CST2, wave, lane);
    int st_cur = 0, st_nxt2 = 2 * CST2;
    if (CV & 16) C_WAIT_BAR(0);
#pragma unroll 1
    for (int t = 0; t < NT; ++t) {
        if (!(CV & 16)) { if (t + 1 < NT) C_WAIT_BAR(4); else C_WAIT_BAR(0); }
        const LAS unsigned char* sb = ring + st_cur;
        bf16x8 kf[2][4];
#pragma unroll
        for (int st = 0; st < 2; ++st)
#pragma unroll
            for (int d0 = 0; d0 < 4; ++d0) { if (CV & 2) kf[st][d0] = qf[(d0 + st) & 3]; else kf[st][d0] = *(const LAS bf16x8*)(sb + st * 4096 + ka[d0]); }
        f32x16 s[2];
#pragma unroll
        for (int st = 0; st < 2; ++st) {
#pragma unroll
            for (int r = 0; r < 16; ++r) s[st][r] = 0.f;
#pragma unroll
            for (int d0 = 0; d0 < 4; ++d0) s[st] = MFMA32(kf[st][d0], qf[d0], s[st]); }
        if (!(CV & 8)) if (t + 2 < NT) c2_dma(Kp0, Vrow, (t + 2) * 64, ring_a + st_nxt2, wave, lane);
#pragma unroll
        for (int st = 0; st < 2; ++st) {
            bf16x8 vf[4][2];
#pragma unroll
            for (int db = 0; db < 4; ++db)
#pragma unroll
                for (int s2 = 0; s2 < 2; ++s2) { if (CV & 4) { vf[db][s2] = qf[(db + s2) & 3]; } else { const v4i16_t lo = vtr(sb + st * 8192 + s2 * 4096 + vo[db][0]), hi4 = vtr(sb + st * 8192 + s2 * 4096 + vo[db][1]);
                    vf[db][s2] = (bf16x8){lo[0], lo[1], lo[2], lo[3], hi4[0], hi4[1], hi4[2], hi4[3]}; } }
#pragma unroll
            for (int r = 0; r < 16; ++r) { if (!(CV & 1)) s[st][r] = ex2(s[st][r]); l += s[st][r]; }
            bf16x8 pf[2];
#pragma unroll
            for (int s2 = 0; s2 < 2; ++s2) { v4u w; w.x = pk2(s[st][8 * s2 + 0], s[st][8 * s2 + 1]); w.y = pk2(s[st][8 * s2 + 2], s[st][8 * s2 + 3]); w.z = pk2(s[st][8 * s2 + 4], s[st][8 * s2 + 5]); w.w = pk2(s[st][8 * s2 + 6], s[st][8 * s2 + 7]); pf[s2] = __builtin_bit_cast(bf16x8, w); }
#pragma unroll
            for (int db = 0; db < 4; ++db)
#pragma unroll
                for (int s2 = 0; s2 < 2; ++s2) o[db] = MFMA32(vf[db][s2], pf[s2], o[db]);
        }
        st_cur = st_cur == 2 * CST2 ? 0 : st_cur + CST2; st_nxt2 = st_nxt2 == 2 * CST2 ? 0 : st_nxt2 + CST2;
    }
    l = sum32(l);
    const float inv = 1.0f / l;
    f32x4 gnv[16];
    if (mp == 0) {
#pragma unroll
        for (int db = 0; db < 4; ++db)
#pragma unroll
            for (int g = 0; g < 4; ++g) gnv[db * 4 + g] = *(const GAS f32x4*)(subln + 32 * db + 8 * g + 4 * hi); }
    LAS float* ex = (LAS float*)ring + (32 * (wave & 3) + r32) * CEXP + 4 * hi;
    asm volatile("s_waitcnt lgkmcnt(0)\n\ts_barrier" ::: "memory");
    if (mp == 1) {
#pragma unroll
        for (int db = 0; db < 4; ++db)
#pragma unroll
            for (int g = 0; g < 4; ++g) *(LAS f32x4*)(ex + 32 * db + 8 * g) = (f32x4){o[db][4 * g] * inv, o[db][4 * g + 1] * inv, o[db][4 * g + 2] * inv, o[db][4 * g + 3] * inv};
    }
    asm volatile("s_waitcnt lgkmcnt(0)\n\ts_barrier" ::: "memory");
    if (mp == 0) {
        float ss = 0.f;
#pragma unroll
        for (int db = 0; db < 4; ++db)
#pragma unroll
            for (int g = 0; g < 4; ++g) { const f32x4 o2 = *(const LAS f32x4*)(ex + 32 * db + 8 * g);
#pragma unroll
                for (int e = 0; e < 4; ++e) { const float x = o[db][4 * g + e] * inv - lam * o2[e]; o[db][4 * g + e] = x; ss += x * x; } }
        ss = sum32(ss);
        const float rstd = rsqrtf(ss * (1.0f / 128.0f) + EPS) * onemli;
        bf16* dst = OC + (row0 + q0 + r32) * 1536 + h * 128;
#pragma unroll
        for (int db = 0; db < 4; ++db)
#pragma unroll
            for (int g = 0; g < 4; ++g) { const f32x4 gn = gnv[db * 4 + g];
                v2u w; w.x = pk2(o[db][4 * g] * rstd * gn[0], o[db][4 * g + 1] * rstd * gn[1]); w.y = pk2(o[db][4 * g + 2] * rstd * gn[2], o[db][4 * g + 3] * rstd * gn[3]);
                *(GAS v2u*)(dst + 32 * db + 8 * g + 4 * hi) = w; }
    }
}

constexpr int CSTA = 32768;
typedef short a_v4i16_t __attribute__((ext_vector_type(4)));
__device__ __forceinline__ a_v4i16_t a_vtr(const LAS unsigned char* p) { return __builtin_amdgcn_ds_read_tr16_b64_v4i16((LAS a_v4i16_t*)p); }
__device__ __forceinline__ void a_dma(const bf16* Kp, const bf16* Vrow, int kb, unsigned sb, int wave, int lane) {
#pragma unroll
    for (int jj = 0; jj < 2; ++jj) { const int j = wave + 8 * jj, row = 4 * j + (lane >> 4), c = (lane & 15) ^ (row & 15);
      glds16(Kp + (size_t)(kb + row) * 4096 + 8 * c, (unsigned)__builtin_amdgcn_readfirstlane(sb + j * 1024)); }
#pragma unroll
    for (int jj = 0; jj < 2; ++jj) { const int j = wave + 8 * jj, st = j >> 3, row = 4 * (j & 7) + (lane >> 4), ch = (lane & 15) ^ (((row & 3) << 2) | ((row >> 2) & 3));
      glds16(Vrow + (size_t)(kb + 32 * st + row) * 2048 + 8 * ch, (unsigned)__builtin_amdgcn_readfirstlane(sb + 16384 + j * 1024)); }
}
__device__ __forceinline__ void unit_a_lds(const bf16* QK, const bf16* Zv, bf16* OA, const float* rpb, LAS float* btab, LAS unsigned char* ring, int sl, int h, int qb, int S, int tshift, int wave, int lane, int tid) {
    const size_t row0 = (size_t)sl << tshift; const int r32 = lane & 31, hi = lane >> 5, rows = S >> 6;
    const int r = 4 * qb + (wave >> 1), qh = wave & 1;
    int rs = r - 4; rs = rs < 0 ? 0 : (rs > rows - 8 ? rows - 8 : rs);
    int kr_lo = 4 * qb - 4; kr_lo = kr_lo < 0 ? 0 : (kr_lo > rows - 8 ? rows - 8 : kr_lo);
    int kr_hi = 4 * qb - 1; kr_hi = (kr_hi < 0 ? 0 : (kr_hi > rows - 8 ? rows - 8 : kr_hi)) + 8;
    const int NT = kr_hi - kr_lo;
    const bf16* Kp = QK + row0 * 4096 + 512 + 128 * h;
    const bf16* Vrow = Zv + row0 * 2048 + 128 * h;
    const int q0 = r * 64 + 32 * qh, qc = 32 * qh + r32;
    int cs = qc - 8; cs = cs < 0 ? 0 : (cs > 48 ? 48 : cs);
    bf16x8 qf[8]; load_q<8>(QK + (row0 + q0) * 4096 + 128 * h, qf, lane);
    const int pim = (r32 & 19) | ((r32 & 4) << 1) | ((r32 & 8) >> 1);
    const int kbase = pim * 256, kx = pim & 15;
    const int tq = (lane & 15) >> 2, tp = lane & 3, tblk = (lane >> 4) & 1, vlane = 16384 + 256 * (8 * hi + tq) + 8 * (tp & 1);
    int vo[4][2];
#pragma unroll
    for (int db = 0; db < 4; ++db)
#pragma unroll
        for (int t = 0; t < 2; ++t) vo[db][t] = vlane + 1024 * t + 16 * ((((db ^ tq) & 3) << 2) | ((2 * tblk + (tp >> 1)) ^ ((2 * hi + t) & 3)));
    f32x16 o[4]; zero_o(o); float m = NEGB, l = 0.f;
#pragma unroll
    for (int d0 = 0; d0 < 8; ++d0) asm volatile("" : "+v"(qf[d0]));
    asm volatile("s_waitcnt vmcnt(0)\n\ts_barrier" ::: "memory");
    for (int e = tid; e < 15 * 31; e += NWAVES * 64) btab[e] = rpb[e] * LOG2E;
    asm volatile("s_waitcnt vmcnt(0) lgkmcnt(0)" ::: "memory");
    const unsigned ring_a = (unsigned)(size_t)ring;
    a_dma(Kp, Vrow, kr_lo * 64, ring_a, wave, lane); a_dma(Kp, Vrow, (kr_lo + 1) * 64, ring_a + CSTA, wave, lane);
    int st_cur = 0, st_nxt2 = 2 * CSTA;
#pragma unroll 1
    for (int t = 0; t < NT; ++t) { const int kr = kr_lo + t;
        if (t + 1 < NT) C_WAIT_BAR(4); else C_WAIT_BAR(0);
        if (t + 2 < NT) a_dma(Kp, Vrow, (kr + 2) * 64, ring_a + st_nxt2, wave, lane);
        if (kr >= rs && kr < rs + 8) { const LAS unsigned char* sb = ring + st_cur;
#pragma unroll 1
            for (int chh = 0; chh < 2; ++chh) {
                bf16x8 kf[8];
#pragma unroll
                for (int d0 = 0; d0 < 8; ++d0) kf[d0] = *(const LAS bf16x8*)(sb + chh * 8192 + kbase + (((2 * d0 + hi) ^ kx) << 4));
                bf16x8 vf[4][2];
#pragma unroll
                for (int db = 0; db < 4; ++db)
#pragma unroll
                    for (int s2 = 0; s2 < 2; ++s2) { const a_v4i16_t lo = a_vtr(sb + chh * 8192 + s2 * 4096 + vo[db][0]), hi4 = a_vtr(sb + chh * 8192 + s2 * 4096 + vo[db][1]);
                        vf[db][s2] = (bf16x8){lo[0], lo[1], lo[2], lo[3], hi4[0], hi4[1], hi4[2], hi4[3]}; }
                const MaskA mf{btab + (kr - r + 7) * 31, 32 * chh, qc, cs};
                tile_core<8, MaskA>(kf, vf, qf, o, m, l, lane, mf); } }
        st_cur = st_cur == 2 * CSTA ? 0 : st_cur + CSTA; st_nxt2 = st_nxt2 == 2 * CSTA ? 0 : st_nxt2 + CSTA;
    }
    l = sum32(l);
    store_o_bf16(OA + (row0 + q0 + r32) * 1536 + h * 128, o, 1.0f / l, hi);
}

struct MaskB2 { static constexpr bool MASKED = true; int qp, kp0, Lsh, qcls;
    __device__ __forceinline__ float operator()(float v, int koff) const { const int kp = kp0 + koff, d = kp - qp; return (d >= -64 && d <= 64 && (kp >> Lsh) == qcls) ? v : NEGB; } };
__device__ __forceinline__ void b_dma(const bf16* Kp, const bf16* Vrow, int S, int dsh, int Lsh, int kp0, unsigned sb, int wave, int lane) {
#pragma unroll
    for (int jj = 0; jj < 2; ++jj) { const int j = wave + 8 * jj, row = 4 * j + (lane >> 4), c = (lane & 15) ^ (row & 15);
      int kp = kp0 + row; kp = kp < 0 ? 0 : (kp > S - 1 ? S - 1 : kp);
      glds16(Kp + (size_t)kp * 4096 + 8 * c, (unsigned)__builtin_amdgcn_readfirstlane(sb + j * 1024)); }
#pragma unroll
    for (int jj = 0; jj < 2; ++jj) { const int j = wave + 8 * jj, st = j >> 3, row = 4 * (j & 7) + (lane >> 4), ch = (lane & 15) ^ (((row & 3) << 2) | ((row >> 2) & 3));
      int kp = kp0 + 32 * st + row; kp = kp < 0 ? 0 : (kp > S - 1 ? S - 1 : kp);
      glds16(Vrow + (size_t)perm_tok(kp, dsh, Lsh) * 2048 + 8 * ch, (unsigned)__builtin_amdgcn_readfirstlane(sb + 16384 + j * 1024)); }
}
__device__ __forceinline__ void unit_b_lds(const bf16* QK, const bf16* Zv, bf16* BTMP, float* BLSE, LAS unsigned char* ring, int sl, int slot, int pb, int S, int tshift, int wave, int lane) {
    const size_t row0 = (size_t)sl << tshift; const int r32 = lane & 31, hi = lane >> 5, dsh = 2 * (slot >> 1), Lsh = tshift - dsh;
    const int p0 = pb * 256, qp = p0 + 32 * wave + r32;
    const bf16* Kp = QK + row0 * 4096 + 1792 + 128 * slot;
    const bf16* Vrow = Zv + row0 * 2048 + 512 + 128 * slot;
    bf16x8 qf[8]; load_q<8>(QK + (row0 + p0 + 32 * wave) * 4096 + 1024 + 128 * slot, qf, lane);
    const int pim = (r32 & 19) | ((r32 & 4) << 1) | ((r32 & 8) >> 1);
    const int kbase = pim * 256, kx = pim & 15;
    const int tq = (lane & 15) >> 2, tp = lane & 3, tblk = (lane >> 4) & 1, vlane = 16384 + 256 * (8 * hi + tq) + 8 * (tp & 1);
    int vo[4][2];
#pragma unroll
    for (int db = 0; db < 4; ++db)
#pragma unroll
        for (int t = 0; t < 2; ++t) vo[db][t] = vlane + 1024 * t + 16 * ((((db ^ tq) & 3) << 2) | ((2 * tblk + (tp >> 1)) ^ ((2 * hi + t) & 3)));
    f32x16 o[4]; zero_o(o); float m = NEGB, l = 0.f;
#pragma unroll
    for (int d0 = 0; d0 < 8; ++d0) asm volatile("" : "+v"(qf[d0]));
    asm volatile("s_waitcnt vmcnt(0)\n\ts_barrier" ::: "memory");
    const unsigned ring_a = (unsigned)(size_t)ring;
    const int kpo = p0 - 64;
    b_dma(Kp, Vrow, S, dsh, Lsh, kpo, ring_a, wave, lane); b_dma(Kp, Vrow, S, dsh, Lsh, kpo + 64, ring_a + CSTA, wave, lane);
    int st_cur = 0, st_nxt2 = 2 * CSTA;
    const int jlo = wave >> 1, qcls = qp >> Lsh;
#pragma unroll 1
    for (int t = 0; t < 6; ++t) {
        if (t + 1 < 6) C_WAIT_BAR(4); else C_WAIT_BAR(0);
        if (t + 2 < 6) b_dma(Kp, Vrow, S, dsh, Lsh, kpo + 64 * (t + 2), ring_a + st_nxt2, wave, lane);
        if (t >= jlo && t <= jlo + 2) { const LAS unsigned char* sb = ring + st_cur;
#pragma unroll 1
            for (int chh = 0; chh < 2; ++chh) { const int ks = 64 * t + 32 * chh;
                if (ks + 32 <= 32 * wave || ks >= 32 * wave + 160) continue;
                bf16x8 kf[8];
#pragma unroll
                for (int d0 = 0; d0 < 8; ++d0) kf[d0] = *(const LAS bf16x8*)(sb + chh * 8192 + kbase + (((2 * d0 + hi) ^ kx) << 4));
                bf16x8 vf[4][2];
#pragma unroll
                for (int db = 0; db < 4; ++db)
#pragma unroll
                    for (int s2 = 0; s2 < 2; ++s2) { const a_v4i16_t lo = a_vtr(sb + chh * 8192 + s2 * 4096 + vo[db][0]), hi4 = a_vtr(sb + chh * 8192 + s2 * 4096 + vo[db][1]);
                        vf[db][s2] = (bf16x8){lo[0], lo[1], lo[2], lo[3], hi4[0], hi4[1], hi4[2], hi4[3]}; }
                const MaskB2 mf{qp, kpo + ks, Lsh, qcls};
                tile_core<8, MaskB2>(kf, vf, qf, o, m, l, lane, mf); } }
        st_cur = st_cur == 2 * CSTA ? 0 : st_cur + CSTA; st_nxt2 = st_nxt2 == 2 * CSTA ? 0 : st_nxt2 + CSTA;
    }
    l = sum32(l);
    const int tok = perm_tok(qp, dsh, Lsh);
    store_o_bf16(BTMP + (row0 + tok) * 768 + slot * 128, o, 1.0f / l, hi);
    if (hi == 0) ((GAS float*)BLSE)[(row0 + tok) * 8 + slot] = (__log2f(l) + m) * LN2;
}
}

template <int CV = 0>
__device__ __forceinline__ void phase_attn(const AL& a, int l, LAS unsigned char* lds, int S, int tshift, int tid, int wave, int lane, int types = 7) {
    const bf16* QK = (const bf16*)(a.ws() + A_QK); const bf16* VT = (const bf16*)(a.ws() + A_VT);
    const int nqb = S >> 8, nseq = CH >> tshift;
    const int G = gridDim.x, vid = (G % 8 == 0) ? (blockIdx.x % 8) * (G / 8) + blockIdx.x / 8 : blockIdx.x;
    if (types & 1) { float* CTMP = (float*)(a.ws() + A_CTMP); const float cbound = ((const float*)(a.ws() + WS_LAM))[2 + l];
      if (cbound <= 64.0f) { const int nq2 = S >> 7;
          const float lam = ((const float*)(a.ws() + WS_LAM))[l], onemli = 1.0f - (0.8f - 0.6f * expf(-0.3f * (float)l));
          bf16* OC = (bf16*)(a.ws() + A_OA) + 768; const float* subln = a.in(I_SUBLN) + l * 128;
          for (int u = vid; u < nseq * 6 * nq2; u += G) { const int qb = u % nq2, h = (u / nq2) % 6, sl = u / (nq2 * 6);
              att::unit_c_fused<CV>(QK, (const bf16*)(a.ws() + A_Z), OC, subln, lam, onemli, lds + RING_OFF, sl, h, qb, S, tshift, wave, lane); }
      } else {
          for (int u = vid; u < nseq * 12 * nqb; u += G) { const int qb = u % nqb, map = (u / nqb) % 12, sl = u / (nqb * 12);
              att::wave_c(QK, VT, CTMP, sl, map, qb * 256 + 32 * wave, S, tshift, lane); } } }
    if (types & 2) { bf16* OA = (bf16*)(a.ws() + A_OA); LAS float* btab = (LAS float*)(lds + LDSCTL_OFF + 1024);
      for (int u = vid; u < nseq * 4 * nqb; u += G) { const int qb = u % nqb, h = (u / nqb) % 4, sl = u / (nqb * 4);
          att::unit_a_lds(QK, (const bf16*)(a.ws() + A_Z), OA, a.in(I_RPB) + (size_t)(l * 4 + h) * 465, btab, lds + RING_OFF, sl, h, qb, S, tshift, wave, lane, tid); }
      __syncthreads(); }
    if (types & 4) { bf16* BTMP = (bf16*)(a.ws() + A_BTMP); float* BLSE = (float*)(a.ws() + A_BLSE);
      for (int u = vid; u < nseq * 6 * nqb; u += G) { const int pb = u % nqb, slot = (u / nqb) % 6, sl = u / (nqb * 6);
          att::unit_b_lds(QK, (const bf16*)(a.ws() + A_Z), BTMP, BLSE, lds + RING_OFF, sl, slot, pb, S, tshift, wave, lane); }
      __syncthreads(); }
}
__device__ __forceinline__ void phase_combine(const AL& a, int l, int gw, int NGW, int lane) {
    const bool do_c = ((const float*)(a.ws() + WS_LAM))[2 + l] > 64.0f;
    const int nsh = do_c ? 3 : 1, nsm = (1 << nsh) - 1;
    const bf16* BTMP = (const bf16*)(a.ws() + A_BTMP); const float* BLSE = (const float*)(a.ws() + A_BLSE); const float* CTMP = (const float*)(a.ws() + A_CTMP);
    bf16* OB = (bf16*)(a.ws() + A_OA) + 512; bf16* OC = (bf16*)(a.ws() + A_OA) + 768;
    const float lam = ((const float*)(a.ws() + WS_LAM))[l], lam_init = 0.8f - 0.6f * expf(-0.3f * (float)l);
    const float* subln = a.in(I_SUBLN) + l * 128;
    const int sub = lane & 15, d0 = 8 * sub;
    const int NIT = (CH / 4) << nsh;
    if ((NGW & 7) == 0) {
        const int slot = gw & nsm;
        if (slot < 2) { const int hg = slot;
            for (int it = gw; it < NIT; it += 2 * NGW) { const bool two = it + NGW < NIT;
                const size_t rowa = (size_t)(it >> nsh) * 4 + (lane >> 4), rowb = two ? (size_t)((it + NGW) >> nsh) * 4 + (lane >> 4) : rowa;
                float la[3], lb[3]; v4u xa[3], xb[3];
#pragma unroll
                for (int g = 0; g < 3; ++g) { la[g] = ((const GAS float*)BLSE)[rowa * 8 + 2 * g + hg]; lb[g] = ((const GAS float*)BLSE)[rowb * 8 + 2 * g + hg];
                    xa[g] = *(const GAS v4u*)(BTMP + rowa * 768 + (2 * g + hg) * 128 + d0); xb[g] = *(const GAS v4u*)(BTMP + rowb * 768 + (2 * g + hg) * 128 + d0); }
#pragma unroll
                for (int q = 0; q < 2; ++q) { if (q == 1 && !two) break;
                    const float l0 = q ? lb[0] : la[0], l1 = q ? lb[1] : la[1], l2 = q ? lb[2] : la[2]; const v4u a0 = q ? xb[0] : xa[0], a1 = q ? xb[1] : xa[1], a2 = q ? xb[2] : xa[2];
                    const float mx = fmaxf(l0, fmaxf(l1, l2)); float w0 = __expf(l0 - mx), w1 = __expf(l1 - mx), w2 = __expf(l2 - mx);
                    const float inv = 1.0f / (w0 + w1 + w2); w0 *= inv; w1 *= inv; w2 *= inv;
                    v4u o;
                    o.x = pk2(w0 * bflo(a0.x) + w1 * bflo(a1.x) + w2 * bflo(a2.x), w0 * bfhi(a0.x) + w1 * bfhi(a1.x) + w2 * bfhi(a2.x));
                    o.y = pk2(w0 * bflo(a0.y) + w1 * bflo(a1.y) + w2 * bflo(a2.y), w0 * bfhi(a0.y) + w1 * bfhi(a1.y) + w2 * bfhi(a2.y));
                    o.z = pk2(w0 * bflo(a0.z) + w1 * bflo(a1.z) + w2 * bflo(a2.z), w0 * bfhi(a0.z) + w1 * bfhi(a1.z) + w2 * bfhi(a2.z));
                    o.w = pk2(w0 * bflo(a0.w) + w1 * bflo(a1.w) + w2 * bflo(a2.w), w0 * bfhi(a0.w) + w1 * bfhi(a1.w) + w2 * bfhi(a2.w));
                    *(GAS v4u*)(OB + (q ? rowb : rowa) * 1536 + hg * 128 + d0) = o; } }
        } else { const int h = slot - 2;
            const f32x4 g0 = *(const GAS f32x4*)(subln + d0), g1 = *(const GAS f32x4*)(subln + d0 + 4);
            for (int it = gw; it < NIT; it += 2 * NGW) { const bool two = it + NGW < NIT;
                const size_t rowa = (size_t)(it >> nsh) * 4 + (lane >> 4), rowb = two ? (size_t)((it + NGW) >> nsh) * 4 + (lane >> 4) : rowa;
                const float* pa = CTMP + rowa * 1536 + (2 * h) * 128 + d0; const float* pb = CTMP + rowb * 1536 + (2 * h) * 128 + d0;
                const f32x4 a10 = *(const f32x4*)pa, a11 = *(const GAS f32x4*)(pa + 4), a20 = *(const GAS f32x4*)(pa + 128), a21 = *(const GAS f32x4*)(pa + 132);
                const f32x4 b10 = *(const f32x4*)pb, b11 = *(const GAS f32x4*)(pb + 4), b20 = *(const GAS f32x4*)(pb + 128), b21 = *(const GAS f32x4*)(pb + 132);
#pragma unroll
                for (int q = 0; q < 2; ++q) { if (q == 1 && !two) break;
                    const f32x4 x0 = q ? b10 - lam * b20 : a10 - lam * a20, x1 = q ? b11 - lam * b21 : a11 - lam * a21;
                    float ss = (x0.x * x0.x + x0.y * x0.y) + (x0.z * x0.z + x0.w * x0.w) + (x1.x * x1.x + x1.y * x1.y) + (x1.z * x1.z + x1.w * x1.w);
                    ss += shx<1>(ss); ss += shx<2>(ss); ss += shx<4>(ss); ss += shx<8>(ss);
                    const float rstd = rsqrtf(ss * (1.0f / 128.0f) + EPS) * (1.0f - lam_init);
                    v4u o; o.x = pk2(x0.x * rstd * g0.x, x0.y * rstd * g0.y); o.y = pk2(x0.z * rstd * g0.z, x0.w * rstd * g0.w);
                    o.z = pk2(x1.x * rstd * g1.x, x1.y * rstd * g1.y); o.w = pk2(x1.z * rstd * g1.z, x1.w * rstd * g1.w);
                    *(GAS v4u*)(OC + (q ? rowb : rowa) * 1536 + h * 128 + d0) = o; } }
        }
        return;
    }
    for (int it = gw; it < NIT; it += NGW) { const int slot = it & nsm; const size_t row = (size_t)(it >> nsh) * 4 + (lane >> 4);
        if (slot < 2) { const int hg = slot;
            const float l0 = BLSE[row * 8 + hg], l1 = BLSE[row * 8 + 2 + hg], l2 = BLSE[row * 8 + 4 + hg];
            const float mx = fmaxf(l0, fmaxf(l1, l2)); float w0 = __expf(l0 - mx), w1 = __expf(l1 - mx), w2 = __expf(l2 - mx);
            const float inv = 1.0f / (w0 + w1 + w2); w0 *= inv; w1 *= inv; w2 *= inv;
            const v4u a0 = *(const GAS v4u*)(BTMP + row * 768 + (0 + hg) * 128 + d0), a1 = *(const GAS v4u*)(BTMP + row * 768 + (2 + hg) * 128 + d0), a2 = *(const GAS v4u*)(BTMP + row * 768 + (4 + hg) * 128 + d0);
            v4u o;
            o.x = pk2(w0 * bflo(a0.x) + w1 * bflo(a1.x) + w2 * bflo(a2.x), w0 * bfhi(a0.x) + w1 * bfhi(a1.x) + w2 * bfhi(a2.x));
            o.y = pk2(w0 * bflo(a0.y) + w1 * bflo(a1.y) + w2 * bflo(a2.y), w0 * bfhi(a0.y) + w1 * bfhi(a1.y) + w2 * bfhi(a2.y));
            o.z = pk2(w0 * bflo(a0.z) + w1 * bflo(a1.z) + w2 * bflo(a2.z), w0 * bfhi(a0.z) + w1 * bfhi(a1.z) + w2 * bfhi(a2.z));
            o.w = pk2(w0 * bflo(a0.w) + w1 * bflo(a1.w) + w2 * bflo(a2.w), w0 * bfhi(a0.w) + w1 * bfhi(a1.w) + w2 * bfhi(a2.w));
            *(GAS v4u*)(OB + row * 1536 + hg * 128 + d0) = o;
        } else { const int h = slot - 2;
            const float* p1 = CTMP + row * 1536 + (2 * h) * 128 + d0; const float* p2 = p1 + 128;
            const f32x4 x0 = *(const f32x4*)p1 - lam * *(const f32x4*)p2, x1 = *(const GAS f32x4*)(p1 + 4) - lam * *(const GAS f32x4*)(p2 + 4);
            float ss = (x0.x * x0.x + x0.y * x0.y) + (x0.z * x0.z + x0.w * x0.w) + (x1.x * x1.x + x1.y * x1.y) + (x1.z * x1.z + x1.w * x1.w);
            ss += shx<1>(ss); ss += shx<2>(ss); ss += shx<4>(ss); ss += shx<8>(ss);
            const float rstd = rsqrtf(ss * (1.0f / 128.0f) + EPS) * (1.0f - lam_init);
            const f32x4 g0 = *(const GAS f32x4*)(subln + d0), g1 = *(const GAS f32x4*)(subln + d0 + 4);
            v4u o; o.x = pk2(x0.x * rstd * g0.x, x0.y * rstd * g0.y); o.y = pk2(x0.z * rstd * g0.z, x0.w * rstd * g0.w);
            o.z = pk2(x1.x * rstd * g1.x, x1.y * rstd * g1.y); o.w = pk2(x1.z * rstd * g1.z, x1.w * rstd * g1.w);
            *(GAS v4u*)(OC + row * 1536 + h * 128 + d0) = o;
        }
    }
}
#define CHECK_HOOK(stage, c, l) do {} while (0)
#define CHECK_FINAL() do {} while (0)

#ifndef PHMASK
#define PHMASK 0xFFFF
#endif
#define PH(k) ((PHMASK >> (k)) & 1)
#ifndef DUPMASK
#define DUPMASK 0
#endif
#define DUP(k) ((DUPMASK >> (k)) & 1)
#ifndef BARX
#define BARX 1
#endif
__device__ __forceinline__ int lane_id_now() { unsigned z = 0u; asm volatile("" : "+v"(z)); return (int)__builtin_amdgcn_mbcnt_hi(~0u, __builtin_amdgcn_mbcnt_lo(~0u, z)); }
__global__ void __launch_bounds__(NWAVES * 64, 2) fwd(Args kargs) {
    extern __shared__ __attribute__((aligned(16))) unsigned char lds_raw[];
    LAS unsigned char* lds = (LAS unsigned char*)lds_raw;
    volatile LAS unsigned* MISC = (volatile LAS unsigned*)(lds + MISC_OFF);
    int wave = __builtin_amdgcn_readfirstlane((int)threadIdx.x >> 6);
#define LANE_ID() lane_id_now()
    int lane = LANE_ID(), tid = wave * 64 + lane;
    for (int u = tid; u < (LDS_BYTES - LDSCTL_OFF) / 4; u += NWAVES * 64) ((LAS unsigned*)(lds + LDSCTL_OFF))[u] = 0u;
    __syncthreads();
    const AL a{};
    XcdBarrier bar = xcd_barrier_post((unsigned*)(a.ws() + WS_CTL) + CW_BAR, MISC + 8, tid);
#define GRID_BAR() do { for (int b_ = 0; b_ < BARX; ++b_) xcd_barrier(bar, wave * 64 + LANE_ID()); } while (0)
    int G = gridDim.x, bid = (int)blockIdx.x;
#define LAUNDER() do { asm volatile("" : "+s"(G), "+s"(bid)); asm volatile("" : "+s"(wave)); lane = LANE_ID(); asm volatile("" : "+v"(lane)); tid = wave * 64 + lane; } while (0)
#ifndef WGM_BIG
#define WGM_BIG 8
#endif
#ifndef STAG_TICKS
#define STAG_TICKS 0
#endif
#define STAGGER() do { if (STAG_TICKS > 0) { const unsigned long long t0_ = __builtin_amdgcn_s_memrealtime(); const unsigned long long w_ = (unsigned long long)(((bid >> 3) & 3) * STAG_TICKS); \
    while (__builtin_amdgcn_s_memrealtime() - t0_ < w_) __builtin_amdgcn_s_sleep(8); } } while (0)
#define GW (bid * NWAVES + wave)
#define NGW_ (G * NWAVES)

    if (PH(0)) { phase_modp(a, lds, tid, lane, wave); phase_colmax(a, (int)blockIdx.x * NWAVES + wave, (int)gridDim.x * NWAVES, lane); }
    if (DUP(0)) { __syncthreads(); phase_modp(a, lds, tid, lane, wave); }
    GRID_BAR();
    if (PH(1)) phase_pro2(a, lds, tid, lane, wave, G);
    if (DUP(1)) { __syncthreads(); phase_pro2(a, lds, tid, lane, wave, G); }
    GRID_BAR();
    CHECK_HOOK(0, 0, 0);

#pragma unroll 1
    for (int cl = 0; cl < NCHUNK * 2; ++cl) {
        int c = cl >> 1, l = cl & 1;
        asm volatile("" : "+s"(c), "+s"(l));
#define R0 (c * CH)
#define PROMPT (R0 < 32768)
#define S_ (PROMPT ? 4096 : 2048)
#define TSH (PROMPT ? 12 : 11)
#define SEQ0 (PROMPT ? (R0 >> 12) : 8 + ((R0 - 32768) >> 11))
#define XIN0 (PROMPT ? a.in(I_XP) + (size_t)R0 * DM : a.in(I_XS) + (size_t)(R0 - 32768) * DM)
#define XO (a.out() + (size_t)R0 * DM)
#define XCUR (l == 0 ? XIN0 : (const float*)XO)
#define MODL ((const float*)(a.ws() + WS_MOD) + (size_t)l * 24 * 12288)
#define WL (a.ws() + WS_W + (size_t)l * W_LAYER)
        if (PH(2)) { LAUNDER();
            if (l == 0) { phase_norm<true, false, true>(XIN0, nullptr, nullptr, nullptr, a.in(I_N1G) + l * DM, MODL, 0, 2048, SEQ0, TSH, I8IN ? nullptr : (bf16*)(a.ws() + A_H), GW, NGW_, lane, a.ws() + A_HI8, (float*)(a.ws() + A_HS)); }
            else phase_norm<false, true, true>(nullptr, (const bf16*)(a.ws() + A_X), (const bf16*)(a.ws() + A_VT), (bf16*)(a.ws() + A_X), a.in(I_N1G) + l * DM, MODL, 0, 2048, SEQ0, TSH, I8IN ? nullptr : (bf16*)(a.ws() + A_H), GW, NGW_, lane, a.ws() + A_HI8, (float*)(a.ws() + A_HS)); }
        GRID_BAR(); CHECK_HOOK(1, c, l);
        for (int rep_ = 0; rep_ < (PH(3) ? 1 + DUP(3) : 0); ++rep_) { LAUNDER(); unsigned char* ws = a.ws(); pg8::StaticOrder So; So.init(CH, INC, G, bid, WGM_BIG);
          pg8::EpiIn E{l, S_, TSH, (LAS float*)(lds + LDSCTL_OFF + 1024)}; STAGGER();
#if I8IN
          pg8::Gemm g{(const pg8::bf16_t*)(ws + A_HI8), (const pg8::bf16_t*)(WL + WO_IG), CH, INC, DM / 2};
          pg8::gemm_phase<pg8::EpiIn, pg8::StaticOrder, true, true, true>(lds + RING_OFF, g, So, E, tid); }
#else
          pg8::Gemm g{(const pg8::bf16_t*)(ws + A_H), (const pg8::bf16_t*)(WL + WO_IG), CH, INC, DM};
          pg8::gemm_phase<pg8::EpiIn, pg8::StaticOrder, true, true, false>(lds + RING_OFF, g, So, E, tid); }
#endif
        GRID_BAR(); CHECK_HOOK(2, c, l);
        if (__builtin_amdgcn_readfirstlane(__float_as_int(((const float*)(a.ws() + WS_LAM))[2 + l])) > 0x42800000) {
            if (PH(4)) { LAUNDER(); phase_prep(a, l, lds, S_, TSH, GW, NGW_, wave, lane); }
            GRID_BAR(); }
#ifdef CVARX
        { LAUNDER(); phase_attn<CVARX>(a, l, lds, S_, TSH, tid, wave, lane, 1); __syncthreads(); }
#endif
        if (PH(5)) { LAUNDER(); phase_attn(a, l, lds, S_, TSH, tid, wave, lane); }
        if (DUP(5)) { LAUNDER(); __syncthreads(); phase_attn(a, l, lds, S_, TSH, tid, wave, lane); }
        if (DUP(12) || DUP(13) || DUP(14)) { LAUNDER(); __syncthreads(); phase_attn(a, l, lds, S_, TSH, tid, wave, lane, DUP(12) | (DUP(13) << 1) | (DUP(14) << 2)); }
        GRID_BAR(); CHECK_HOOK(4, c, l);
        if (PH(6)) { LAUNDER(); phase_combine(a, l, GW, NGW_, lane); }
        if (DUP(6)) { LAUNDER(); __syncthreads(); phase_combine(a, l, GW, NGW_, lane); }
        GRID_BAR(); CHECK_HOOK(5, c, l);
        if (PH(7)) {
          { LAUNDER(); unsigned char* ws = a.ws(); pg8::GateOrder So; So.init(CH, DM, G, bid);
            pg8::Gemm g{(const pg8::bf16_t*)(ws + A_HI8), (const pg8::bf16_t*)(WL + WO_IG + (size_t)INC * DM * (I8IN ? 1 : 2)), CH, INC, DM / 2}; pg8::EpiGate E{l};
            pg8::gemm_phase<pg8::EpiGate, pg8::GateOrder, true, true, true>(lds + RING_OFF, g, So, E, tid); }
          { LAUNDER(); unsigned char* ws = a.ws(); pg8::StaticOrder So; So.init(CH, DM, G, bid);
            pg8::Gemm g{(const pg8::bf16_t*)(ws + A_OA), (const pg8::bf16_t*)(WL + WO_BRA), CH, DM, 1536}; pg8::EpiBrM E{(pg8::bf16_t*)(ws + A_QK), (const unsigned char*)(ws + A_G)};
            pg8::gemm_phase<pg8::EpiBrM, pg8::StaticOrder, true, true>(lds + RING_OFF, g, So, E, tid); } }
        GRID_BAR(); CHECK_HOOK(6, c, l);
        if (PH(8)) { LAUNDER(); unsigned char* ws = a.ws(); pg8::Gemm g{(const pg8::bf16_t*)(ws + A_QK), (const pg8::bf16_t*)(WL + WO_OUT), CH, DM, DM}; pg8::StaticOrder So; So.init(CH, DM, G, bid);
          pg8::EpiDelta E{(pg8::bf16_t*)(ws + A_VT), MODL + 2 * 2048, SEQ0, TSH};
          for (int rep_ = 0; rep_ < 1 + DUP(8); ++rep_) pg8::gemm_phase<pg8::EpiDelta, pg8::StaticOrder, true, true>(lds + RING_OFF, g, So, E, tid); }
        GRID_BAR(); CHECK_HOOK(7, c, l);
        if (PH(9)) { LAUNDER();
            if (l == 0) phase_norm<true, true, I8FF1 != 0>(XIN0, nullptr, (const bf16*)(a.ws() + A_VT), (bf16*)(a.ws() + A_X), a.in(I_N2G) + l * DM, MODL, 3 * 2048, 4 * 2048, SEQ0, TSH, I8FF1 ? nullptr : (bf16*)(a.ws() + A_H), GW, NGW_, lane, a.ws() + A_HI8, (float*)(a.ws() + A_HS));
            else phase_norm<false, true, I8FF1 != 0>(nullptr, (const bf16*)(a.ws() + A_X), (const bf16*)(a.ws() + A_VT), (bf16*)(a.ws() + A_X), a.in(I_N2G) + l * DM, MODL, 3 * 2048, 4 * 2048, SEQ0, TSH, I8FF1 ? nullptr : (bf16*)(a.ws() + A_H), GW, NGW_, lane, a.ws() + A_HI8, (float*)(a.ws() + A_HS)); }
        GRID_BAR(); CHECK_HOOK(8, c, l);
        for (int rep_ = 0; rep_ < (PH(10) ? 1 + DUP(10) : 0); ++rep_) { LAUNDER(); unsigned char* ws = a.ws(); pg8::StaticOrder So; So.init(CH, DFF, G, bid, WGM_BIG);
          pg8::EpiRelu2 E{(pg8::bf16_t*)(ws + A_U), DFF, l}; STAGGER();
#if I8FF1
          pg8::Gemm g{(const pg8::bf16_t*)(ws + A_HI8), (const pg8::bf16_t*)(WL + WO_FF1), CH, DFF, DM / 2};
          pg8::gemm_phase<pg8::EpiRelu2, pg8::StaticOrder, true, true, true>(lds + RING_OFF, g, So, E, tid); }
#else
          pg8::Gemm g{(const pg8::bf16_t*)(ws + A_H), (const pg8::bf16_t*)(WL + WO_FF1), CH, DFF, DM};
          pg8::gemm_phase<pg8::EpiRelu2, pg8::StaticOrder, true, true>(lds + RING_OFF, g, So, E, tid); }
#endif
        GRID_BAR(); CHECK_HOOK(9, c, l);
        if (PH(11)) { LAUNDER(); unsigned char* ws = a.ws(); pg8::Gemm g{(const pg8::bf16_t*)(ws + A_U), (const pg8::bf16_t*)(WL + WO_FF2), CH, DM, DFF}; pg8::StaticOrder So; So.init(CH, DM, G, bid);
          if (l == 0) { pg8::EpiDelta E{(pg8::bf16_t*)(ws + A_VT), MODL + 5 * 2048, SEQ0, TSH, I8FF1 ? (const float*)(ws + A_HS) : nullptr};
              for (int rep_ = 0; rep_ < 1 + DUP(11); ++rep_) pg8::gemm_phase<pg8::EpiDelta, pg8::StaticOrder, true, true>(lds + RING_OFF, g, So, E, tid); }
          else { pg8::EpiFinal E{(const pg8::bf16_t*)(ws + A_X), XO, MODL + 5 * 2048, SEQ0, TSH, I8FF1 ? (const float*)(ws + A_HS) : nullptr};
              for (int rep_ = 0; rep_ < 1 + DUP(11); ++rep_) pg8::gemm_phase<pg8::EpiFinal, pg8::StaticOrder, true, true>(lds + RING_OFF, g, So, E, tid); } }
        GRID_BAR(); CHECK_HOOK(10, c, l);
    }
    CHECK_FINAL();
}

extern "C" void kernel_launch(void* const* d_in, const int* in_sizes, int n_in, void* d_out, int out_size, void* d_ws, size_t ws_size, hipStream_t stream) {
    static int grid = 0;
    if (grid == 0) {
        if (n_in != 29 || out_size != MTOT * DM || ws_size < WS_END) { fprintf(stderr, "kernel_launch: unexpected shapes (n_in %d out %d ws %zu need %zu)\n", n_in, out_size, ws_size, (size_t)WS_END); grid = -1; return; }
        int dev = 0, cus = 0, per_cu = 0;
        if (hipGetDevice(&dev) != hipSuccess || hipDeviceGetAttribute(&cus, hipDeviceAttributeMultiprocessorCount, dev) != hipSuccess) { grid = -1; return; }
        if (hipFuncSetAttribute((const void*)fwd, hipFuncAttributeMaxDynamicSharedMemorySize, LDS_BYTES) != hipSuccess) { grid = -1; return; }
        if (hipOccupancyMaxActiveBlocksPerMultiprocessor(&per_cu, (const void*)fwd, NWAVES * 64, LDS_BYTES) != hipSuccess || per_cu < 1) { fprintf(stderr, "kernel_launch: occupancy query says %d\n", per_cu); }
        (void)hipGetLastError();
        grid = cus;
    }
    if (grid < 0) return;
    if (hipMemsetAsync((char*)d_ws + WS_CTL, 0, CTL_ZERO_BYTES, stream) != hipSuccess) return;
    Args a{};
    for (int i = 0; i < 29; ++i) a.in[i] = (const float*)d_in[i];
    a.out = (float*)d_out; a.ws = (unsigned char*)d_ws;
    hipLaunchKernelGGL(fwd, dim3(grid), dim3(NWAVES * 64), LDS_BYTES, stream, a);
}
```

```cpp
#include <hip/hip_runtime.h>
#include <hip/hip_bf16.h>
#include <cstdio>
#include <cstdint>
#include <cmath>

constexpr int NWAVES = 8;
constexpr int DM = 2048, NSEQ = 24, MTOT = 65536, DFF = 8192, INC = 6144;
#ifndef MK_CH
#define MK_CH 32768
#endif
constexpr int CH = MK_CH;
constexpr int NCHUNK = MTOT / CH;
constexpr float EPS = 1e-6f, LOG2E = 1.4426950408889634f, LN2 = 0.6931471805599453f;
constexpr float QS128 = 0.08838834764831845f * LOG2E, QS64 = 0.125f * LOG2E;
constexpr float NEGB = -1e30f;

constexpr size_t MiB = 1u << 20;
constexpr size_t WS_CTL = 0, CTL_ZERO_BYTES = 1 * MiB;
constexpr size_t WS_MOD = 1 * MiB;
constexpr size_t WS_ROPEB = 4 * MiB, WS_ROPEC = WS_ROPEB + 512 * 1024;
constexpr size_t WS_LAM = 5 * MiB;
constexpr size_t WS_MODP = 6 * MiB;
constexpr size_t WS_W = 48 * MiB, W_LAYER = 126 * MiB;
constexpr size_t WO_IG = 0, WO_BRA = 48 * MiB, WO_BRB = 50 * MiB, WO_BRC = 51 * MiB, WO_OUT = 54 * MiB, WO_FF1 = 62 * MiB, WO_FF2 = 94 * MiB;
constexpr size_t WS_ACT = 304 * MiB;
constexpr size_t CHS = (size_t)CH;
constexpr size_t A_H = WS_ACT;
constexpr size_t A_Z = A_H + (MK_CH > 16384 ? 0 : CHS * 2048 * 2);
constexpr size_t A_QK = A_Z + CHS * 6144 * 2;
constexpr size_t A_VT = A_QK + CHS * 4096 * 2;
constexpr size_t A_G = A_VT + CHS * 2048 * 2;
constexpr size_t A_OA = A_G + CHS * 6144 * 2;
constexpr size_t A_OB = A_OA + CHS * 512 * 2;
constexpr size_t A_OC = A_OB + CHS * 256 * 2;
constexpr size_t A_X = A_OC + CHS * 768 * 2;
constexpr size_t A_HI8 = A_X + CHS * 2048 * 2;
constexpr size_t A_HS = A_HI8 + CHS * 2048;
constexpr size_t WS_END = A_HS + (1u << 20);
constexpr size_t A_BTMP = A_Z + CHS * 2048 * 2;
constexpr size_t A_BLSE = A_BTMP + CHS * 768 * 2;
constexpr size_t A_CTMP = A_BLSE + CHS * 8 * 4;
static_assert(A_CTMP + CHS * 1536 * 4 <= A_QK, "attention temporaries fit in Z");
constexpr size_t A_TMPF = A_QK;
constexpr size_t A_U = A_Z;
static_assert(CHS * 8192 * 2 <= (A_VT - A_Z), "u fits in Z + QK");
constexpr int CW_BAR = 4096;
constexpr int CW_WMAX = 131072;
#ifndef I8FF1
#define I8FF1 1
#endif
constexpr int WMAX_L = 20480;
constexpr int CW_GRP = 16384;
constexpr int CW_CHK = 65536;

constexpr int RING_OFF = 0, RING_BYTES = 131072;
constexpr int LDSCTL_OFF = RING_BYTES, MISC_OFF = LDSCTL_OFF + 320;
constexpr int LDS_BYTES = 147456;

#define LAS __attribute__((address_space(3)))
#define GAS __attribute__((address_space(1)))
struct Args { const float* in[29]; float* out; unsigned char* ws; };
typedef const __attribute__((address_space(4))) unsigned long long* kargp_t;
struct AL {
    __device__ __forceinline__ static kargp_t kp() { kargp_t p = (kargp_t)__builtin_amdgcn_kernarg_segment_ptr(); asm volatile("" : "+s"(p)); return p; }
    __device__ __forceinline__ const float* in(int i) const { return (const float*)kp()[i]; }
    __device__ __forceinline__ float* out() const { return (float*)kp()[29]; }
    __device__ __forceinline__ unsigned char* ws() const { return (unsigned char*)kp()[30]; } };
enum { I_XP = 0, I_XS, I_CP, I_CS, I_N1G, I_WADA, I_BADA, I_WIN, I_QNA, I_KNA, I_RPB, I_QNB, I_KNB, I_QNC, I_KNC, I_LQ1, I_LK1, I_LQ2, I_LK2, I_SUBLN,
       I_WBRA, I_WBRB, I_WBRC, I_WGATE, I_BGATE, I_WOUT, I_N2G, I_WFF1, I_WFF2 };


template <int N> __device__ __forceinline__ float shx(float v) { return __shfl_xor(v, N); }
__device__ __forceinline__ void shx32_pair(float v, float& a, float& b) { const float o = __shfl_xor(v, 32); const bool hi = (__lane_id() >> 5) != 0; a = hi ? o : v; b = hi ? v : o; }
__device__ __forceinline__ float sum32(float v) { return v + __shfl_xor(v, 32); }
__device__ __forceinline__ float max32(float v) { return fmaxf(v, __shfl_xor(v, 32)); }
#ifndef WGM_SMALL
#define WGM_SMALL 4
#endif
namespace pg8 {
#define PG8_LAS __attribute__((address_space(3)))
typedef unsigned short bf16_t;
typedef short bf16x8 __attribute__((ext_vector_type(8)));
typedef float f32x4 __attribute__((ext_vector_type(4)));
typedef unsigned u32x4 __attribute__((ext_vector_type(4)));
constexpr int BM = 256, BK = 64, HALF = 128, HTB = HALF * BK * 2  , STAGE_BYTES = 8 * HTB, NXCD = 8, WGM = WGM_SMALL;

__host__ __device__ __forceinline__ int lds_byte(int r, int c) { const int st = (r >> 4) * 2 + (c >> 5), rr = r & 15, cc = c & 31, ob = rr * 64 + cc * 2; return st * 1024 + (ob ^ (((ob >> 9) & 1) << 5)); }
__host__ __device__ __forceinline__ void stage_rc(int b, int& R, int& C) { const int st = b / 1024, sb = b % 1024, swz = sb ^ (((sb >> 9) & 1) << 5); R = (st >> 1) * 16 + swz / 64; C = (st & 1) * 32 + (swz % 64) / 2; }
__host__ __device__ __forceinline__ int perm32(int rho) { const int n = rho >> 4, i = rho & 15; return 8 * (i >> 2) + 4 * n + (i & 3); }

struct Unit { int pm, pn; };
struct Gemm { const bf16_t* A; const bf16_t* Bt; int M, N, K; };

struct StaticOrder {
    int nM, nN, nwg, G, c, wgm;
    __host__ __device__ void init(int M, int N, int G_, int c_, int wgm_ = WGM) { nM = M / BM; nN = N / BM; nwg = nM * nN; G = G_; c = c_; wgm = wgm_; }
    __host__ __device__ bool next(int i, Unit& u) const {
        const long L = (long)i * G + c; if (L >= nwg) return false;
        int wgid = (int)L; { const int q = nwg / NXCD, r = nwg % NXCD, xcd = wgid % NXCD, off = wgid / NXCD; wgid = (xcd < r ? xcd * (q + 1) : r * (q + 1) + (xcd - r) * q) + off; }
        const int nig = wgm * nN, gid = wgid / nig, fm = gid * wgm, gsz = (nM - fm) < wgm ? (nM - fm) : wgm;
        u.pm = fm + ((wgid % nig) % gsz); u.pn = (wgid % nig) / gsz; return true;
    }
    __device__ __forceinline__ void a_ready(const Unit&) const {}
    __device__ __forceinline__ void done(const Unit&) const {}
};

struct GateOrder {
    StaticOrder br; int n;
    __host__ __device__ void init(int M, int N, int G_, int c_) { br.init(M, N, G_, c_); n = (br.nwg + G_ - 1 - c_) / G_; if (n < 0) n = 0; }
    __host__ __device__ bool next(int i, Unit& u) const { if (i >= 3 * n) return false; Unit b; br.next(i / 3, b); u.pm = b.pm; u.pn = b.pn + 8 * (i % 3); return true; }
    __device__ __forceinline__ void a_ready(const Unit&) const {}
    __device__ __forceinline__ void done(const Unit&) const {}
};

typedef float f32x2 __attribute__((ext_vector_type(2)));
typedef __bf16 bf16x2v __attribute__((ext_vector_type(2)));
typedef unsigned u32x2 __attribute__((ext_vector_type(2)));
__device__ __forceinline__ unsigned cvt_pk_bf16(float lo, float hi) { f32x2 v = {lo, hi}; bf16x2v b = __builtin_convertvector(v, bf16x2v); return __builtin_bit_cast(unsigned, b); }
#ifndef INGRP
#define INGRP 1
#endif
#ifndef HOOKGRP
#define HOOKGRP 4
#endif
#ifndef I8IN
#define I8IN 1
#endif
__device__ __forceinline__ f32x4 cvti(const f32x4 a) { const float a0 = a[0], a1 = a[1], a2 = a[2], a3 = a[3];
    return (f32x4){(float)__float_as_int(a0), (float)__float_as_int(a1), (float)__float_as_int(a2), (float)__float_as_int(a3)}; }
__device__ __forceinline__ float sigm(float x) { return fmaxf(__builtin_amdgcn_rcpf(1.0f + __expf(-x)), 1e-30f); }

#if I8IN
#define CVTIN(x) cvti(x)
#else
#define CVTIN(x) (x)
#endif
struct EpiIn {
    static constexpr bool PERM = true, AFTER_DRAIN = false, HAS_MID = false; static constexpr int MID_T0 = -1, MID_T1 = -1;
    int l, S, tshift; PG8_LAS float* xch;
    __device__ __forceinline__ void operator()(const f32x4 (&acc)[2][2][4][2], const Unit& u, int wr, int wc, int fr, int fq) const {
        const int row0 = u.pm * BM + wr * 64 + fr; const AL a{}; unsigned char* ws = a.ws();
        const unsigned* wmx = (const unsigned*)(ws + WS_CTL) + CW_WMAX + l * WMAX_L + u.pn * BM + wc * 32 + 8 * fq; const float* HSp = (const float*)(ws + A_HS);
        f32x4 wsc[2][2];
#pragma unroll
        for (int bj = 0; bj < 2; ++bj)
#pragma unroll
            for (int n = 0; n < 2; ++n) { const u32x4 w = *(const GAS u32x4*)(wmx + bj * HALF + 4 * n);
                wsc[bj][n] = I8IN ? (f32x4){__uint_as_float(w.x), __uint_as_float(w.y), __uint_as_float(w.z), __uint_as_float(w.w)} * (1.0f / 127.0f) : (f32x4){1.f, 1.f, 1.f, 1.f}; }
        if (u.pn < 16) { const int tn = u.pn; bf16_t* QKb = (bf16_t*)(ws + A_QK); const float* ropeB = (const float*)(ws + WS_ROPEB); const float* ropeC = (const float*)(ws + WS_ROPEC);
            int gi, dsh = 0, kind; float scale = 1.f;
            if (tn < 2) { gi = 0; kind = 0; scale = 0.08838834764831845f * 1.4426950408889634f; } else if (tn < 4) { gi = 1; kind = 0; }
            else if (tn < 7) { gi = 2; kind = 1; scale = 0.08838834764831845f * 1.4426950408889634f; dsh = 2 * (tn - 4); } else if (tn < 10) { gi = 3; kind = 1; dsh = 2 * (tn - 7); }
            else if (tn < 13) { gi = 4; kind = 2; scale = 0.125f * 1.4426950408889634f; } else { gi = 5; kind = 2; }
            float hsv[8];
#pragma unroll
            for (int g = 0; g < 8; ++g) hsv[g] = I8IN ? HSp[u.pm * BM + (g >> 2) * HALF + wr * 64 + (g & 3) * 16 + fr] : 1.0f;
#pragma unroll
            for (int ai = 0; ai < 2; ++ai)
#pragma unroll
                for (int m = 0; m < 4; ++m)
#pragma unroll
                    for (int bj = 0; bj < 2; ++bj) { const f32x4 a4 = CVTIN(acc[ai][bj][m][0]) * wsc[bj][0], b4 = CVTIN(acc[ai][bj][m][1]) * wsc[bj][1];
                        float p = (a4[0] * a4[0] + a4[1] * a4[1]) + (a4[2] * a4[2] + a4[3] * a4[3]) + (b4[0] * b4[0] + b4[1] * b4[1]) + (b4[2] * b4[2] + b4[3] * b4[3]);
                        p += shx<16>(p); p = sum32(p);
                        if (fq == 0) xch[((ai * HALF + wr * 64 + m * 16 + fr) * 2 + bj) * 4 + wc] = p; }
            asm volatile("s_waitcnt lgkmcnt(0)\n\ts_barrier" ::: "memory");
            const float* gp = a.in(I_QNA + gi + (gi >= 2 ? 1 : 0)) + l * (kind == 2 ? 64 : 128) + ((32 * wc + 8 * fq) & (kind == 2 ? 63 : 127));
            const f32x4 g0 = *(const GAS f32x4*)gp, g1 = *(const GAS f32x4*)(gp + 4);
            const bool ropew = kind == 1 ? (wc == 0) : (kind == 2 ? ((wc & 1) == 0) : false);
            const bool ropel = kind == 1 ? true : (fq < 2), first = kind == 1 ? (fq < 2) : (fq == 0);
            const int Lsh = tshift - dsh;
#pragma unroll
            for (int ai = 0; ai < 2; ++ai)
#pragma unroll
                for (int m = 0; m < 4; ++m) { const int rl = ai * HALF + wr * 64 + m * 16 + fr, row = u.pm * BM + rl, t = row & (S - 1);
                    const float* tb = kind == 1 ? ropeB + (size_t)(t * 16 + 8 * (fq & 1)) * 2 : ropeC + (size_t)(t * 8) * 2;
                    const int drow = dsh == 0 ? row : ((row & ~(S - 1)) + ((t & ((1 << dsh) - 1)) << Lsh) + (t >> dsh));
                    const float hs = hsv[ai * 4 + m], epsr = 1e-6f * __builtin_amdgcn_rcpf(hs * hs + 1e-30f);
                    f32x4 cs[2][2];
                    if (ropew && ropel) {
#pragma unroll
                        for (int hf = 0; hf < 2; ++hf) { cs[hf][0] = *(const GAS f32x4*)(tb + 8 * hf); cs[hf][1] = *(const GAS f32x4*)(tb + 8 * hf + 4); } }
#pragma unroll
                    for (int bj = 0; bj < 2; ++bj) { const f32x4 P4 = *(const PG8_LAS f32x4*)(xch + (rl * 2 + bj) * 4);
                        const float tot = kind == 2 ? (wc < 2 ? P4[0] + P4[1] : P4[2] + P4[3]) : (P4[0] + P4[1]) + (P4[2] + P4[3]);
                        const float rstd = __builtin_amdgcn_rsqf(tot * (kind == 2 ? (1.0f / 64.0f) : (1.0f / 128.0f)) + epsr);
                        u32x4 w;
#pragma unroll
                        for (int hf = 0; hf < 2; ++hf) {
                            const f32x4 gg = (hf ? g1 : g0) * wsc[bj][hf], av = CVTIN(acc[ai][bj][m][hf]); float y[4];
#pragma unroll
                            for (int e2 = 0; e2 < 4; ++e2) y[e2] = av[e2] * rstd * gg[e2];
                            if (ropew) { float pr[4];
#pragma unroll
                                for (int e2 = 0; e2 < 4; ++e2) { if (kind == 1) { float r0, r1; shx32_pair(y[e2], r0, r1); pr[e2] = fq >= 2 ? r0 : r1; } else pr[e2] = shx<16>(y[e2]); }
                                if (ropel) { const f32x4 c0 = cs[hf][0], c1 = cs[hf][1];
                                    y[0] = first ? y[0] * c0[0] - pr[0] * c0[1] : y[0] * c0[0] + pr[0] * c0[1]; y[1] = first ? y[1] * c0[2] - pr[1] * c0[3] : y[1] * c0[2] + pr[1] * c0[3];
                                    y[2] = first ? y[2] * c1[0] - pr[2] * c1[1] : y[2] * c1[0] + pr[2] * c1[1]; y[3] = first ? y[3] * c1[2] - pr[3] * c1[3] : y[3] * c1[2] + pr[3] * c1[3]; } }
                            if (hf == 0) { w.x = cvt_pk_bf16(y[0] * scale, y[1] * scale); w.y = cvt_pk_bf16(y[2] * scale, y[3] * scale); }
                            else { w.z = cvt_pk_bf16(y[0] * scale, y[1] * scale); w.w = cvt_pk_bf16(y[2] * scale, y[3] * scale); } }
                        *(GAS u32x4*)(QKb + (size_t)drow * 4096 + tn * BM + bj * HALF + wc * 32 + 8 * fq) = w; }
                    if (INGRP == 1 || (m % INGRP) == INGRP - 1) asm volatile("" ::: "memory"); }
        } else { const int col0 = (u.pn - 16) * BM + wc * 32 + 8 * fq; bf16_t* Zv = (bf16_t*)(ws + A_Z);
            float hsv[8];
#pragma unroll
            for (int g = 0; g < 8; ++g) hsv[g] = I8IN ? HSp[row0 + (g >> 2) * HALF + (g & 3) * 16] : 1.0f;
#pragma unroll
            for (int ai = 0; ai < 2; ++ai)
#pragma unroll
                for (int m = 0; m < 4; ++m) { const int row = row0 + ai * HALF + m * 16; const float hs = hsv[ai * 4 + m]; bf16_t* rowp = Zv + (size_t)row * 2048 + col0;
#pragma unroll
                    for (int bj = 0; bj < 2; ++bj) { const f32x4 v0 = CVTIN(acc[ai][bj][m][0]) * wsc[bj][0] * hs, v1 = CVTIN(acc[ai][bj][m][1]) * wsc[bj][1] * hs;
                        u32x4 w; w.x = cvt_pk_bf16(v0[0], v0[1]); w.y = cvt_pk_bf16(v0[2], v0[3]); w.z = cvt_pk_bf16(v1[0], v1[1]); w.w = cvt_pk_bf16(v1[2], v1[3]);
                        *(GAS u32x4*)(rowp + bj * HALF) = w; } }
        }
    }
};
struct EpiGate {
    static constexpr bool PERM = true, AFTER_DRAIN = false, HAS_MID = false; static constexpr int MID_T0 = -1, MID_T1 = -1, NSTORE = 0;
    int l;
    __device__ __forceinline__ static unsigned pk4(const f32x4 s) { unsigned w = 0;
        w = __builtin_amdgcn_cvt_pk_u8_f32(__builtin_floorf(fmaxf(s[0] * 255.0f + 0.5f, 1.0f)), 0, w); w = __builtin_amdgcn_cvt_pk_u8_f32(__builtin_floorf(fmaxf(s[1] * 255.0f + 0.5f, 1.0f)), 1, w);
        w = __builtin_amdgcn_cvt_pk_u8_f32(__builtin_floorf(fmaxf(s[2] * 255.0f + 0.5f, 1.0f)), 2, w); w = __builtin_amdgcn_cvt_pk_u8_f32(__builtin_floorf(fmaxf(s[3] * 255.0f + 0.5f, 1.0f)), 3, w); return w; }
    __device__ __forceinline__ void operator()(const f32x4 (&acc)[2][2][4][2], const Unit& u, int wr, int wc, int fr, int fq) const {
        const AL a{}; unsigned char* ws = a.ws();
        const int gt = u.pn, col0 = gt * BM + wc * 32 + 8 * fq, lane = fq * 16 + fr, wave = wr * 4 + wc; const float* bgate = a.in(I_BGATE) + l * 6144;
        f32x4 bv[2][2];
#pragma unroll
        for (int bj = 0; bj < 2; ++bj)
#pragma unroll
            for (int n = 0; n < 2; ++n) bv[bj][n] = *(const GAS f32x4*)(bgate + col0 + bj * HALF + 4 * n);
        unsigned char* tp = ws + A_G + (size_t)(u.pm * 24 + gt) * 65536 + (size_t)wave * 8192 + lane * 16;
        const unsigned* wmx = (const unsigned*)(ws + WS_CTL) + CW_WMAX + l * WMAX_L + 6144 + col0; const float* HSp = (const float*)(ws + A_HS);
        f32x4 wsc[2][2];
#pragma unroll
        for (int bj = 0; bj < 2; ++bj)
#pragma unroll
            for (int n = 0; n < 2; ++n) { const u32x4 w = *(const GAS u32x4*)(wmx + bj * HALF + 4 * n);
                wsc[bj][n] = (f32x4){__uint_as_float(w.x), __uint_as_float(w.y), __uint_as_float(w.z), __uint_as_float(w.w)} * (1.0f / 127.0f); }
        float hsv[8];
#pragma unroll
        for (int g = 0; g < 8; ++g) hsv[g] = HSp[u.pm * BM + (g >> 2) * HALF + wr * 64 + (g & 3) * 16 + fr];
#pragma unroll
        for (int ai = 0; ai < 2; ++ai)
#pragma unroll
            for (int m = 0; m < 4; ++m) { const float hs = hsv[ai * 4 + m]; u32x4 w;
#pragma unroll
                for (int bj = 0; bj < 2; ++bj) { const f32x4 v0 = cvti(acc[ai][bj][m][0]) * wsc[bj][0] * hs + bv[bj][0], v1 = cvti(acc[ai][bj][m][1]) * wsc[bj][1] * hs + bv[bj][1];
                    const f32x4 s0 = {sigm(v0[0]), sigm(v0[1]), sigm(v0[2]), sigm(v0[3])}, s1 = {sigm(v1[0]), sigm(v1[1]), sigm(v1[2]), sigm(v1[3])};
                    if (bj == 0) { w.x = pk4(s0); w.y = pk4(s1); } else { w.z = pk4(s0); w.w = pk4(s1); } }
                *(GAS u32x4*)(tp + (ai * 4 + m) * 1024) = w; }
    }
};
struct EpiRelu2 {
    static constexpr bool PERM = true, AFTER_DRAIN = false, HAS_MID = false; static constexpr int MID_T0 = -1, MID_T1 = -1;
    bf16_t* O; int ldc; int l;
    __device__ __forceinline__ void operator()(const f32x4 (&acc)[2][2][4][2], const Unit& u, int wr, int wc, int fr, int fq) const {
        const int row0 = u.pm * BM + wr * 64 + fr, col0 = u.pn * BM + wc * 32 + 8 * fq;
#pragma unroll
        for (int ai = 0; ai < 2; ++ai)
#pragma unroll
            for (int m = 0; m < 4; ++m) { bf16_t* rowp = O + (size_t)(row0 + ai * HALF + m * 16) * ldc + col0;
#pragma unroll
                for (int bj = 0; bj < 2; ++bj) {
#if I8FF1
                    f32x4 v0 = cvti(acc[ai][bj][m][0]), v1 = cvti(acc[ai][bj][m][1]);
#else
                    f32x4 v0 = acc[ai][bj][m][0], v1 = acc[ai][bj][m][1];
#endif
#pragma unroll
                    for (int e = 0; e < 4; ++e) { const float a0 = v0[e] > 0.f ? v0[e] : 0.f, a1 = v1[e] > 0.f ? v1[e] : 0.f; v0[e] = a0 * a0; v1[e] = a1 * a1; }
                    u32x4 w; w.x = cvt_pk_bf16(v0[0], v0[1]); w.y = cvt_pk_bf16(v0[2], v0[3]); w.z = cvt_pk_bf16(v1[0], v1[1]); w.w = cvt_pk_bf16(v1[2], v1[3]);
                    *(GAS u32x4*)(rowp + bj * HALF) = w; } }
    }
};
struct EpiRes {
    static constexpr bool PERM = false, AFTER_DRAIN = false, HAS_MID = false; static constexpr int MID_T0 = -1, MID_T1 = -1;
    const float* xin; float* xout; const float* gbase; int seq0, tshift;
    __device__ __forceinline__ void operator()(const f32x4 (&acc)[2][2][4][2], const Unit& u, int wr, int wc, int fr, int fq) const {
        const int row0 = u.pm * BM + wr * 64 + fr, col0 = u.pn * BM + wc * 32 + 4 * fq;
        const float* gp = gbase + (size_t)(seq0 + ((u.pm * BM) >> tshift)) * 12288 + col0;
        f32x4 gv[2][2];
#pragma unroll
        for (int bj = 0; bj < 2; ++bj)
#pragma unroll
            for (int n = 0; n < 2; ++n) gv[bj][n] = *(const GAS f32x4*)(gp + bj * HALF + n * 16);
#pragma unroll
        for (int ai = 0; ai < 2; ++ai)
#pragma unroll
            for (int m = 0; m < 4; ++m) { const size_t off = (size_t)(row0 + ai * HALF + m * 16) * 2048 + col0;
#pragma unroll
                for (int bj = 0; bj < 2; ++bj)
#pragma unroll
                    for (int n = 0; n < 2; ++n) { const f32x4 xi = *(const GAS f32x4*)(xin + off + bj * HALF + n * 16);
                        *(GAS f32x4*)(xout + off + bj * HALF + n * 16) = xi + gv[bj][n] * acc[ai][bj][m][n]; } }
    }
};
template <int MODE> struct EpiBr {
    static constexpr bool PERM = false, AFTER_DRAIN = false, HAS_MID = false; static constexpr int MID_T0 = -1, MID_T1 = -1;
    float* T; bf16_t* MRG; const bf16_t* Gt; int gcol0;
    __device__ __forceinline__ void operator()(const f32x4 (&acc)[2][2][4][2], const Unit& u, int wr, int wc, int fr, int fq) const {
        const int row0 = u.pm * BM + wr * 64 + fr, col0 = u.pn * BM + wc * 32 + 4 * fq;
#pragma unroll
        for (int ai = 0; ai < 2; ++ai)
#pragma unroll
            for (int m = 0; m < 4; ++m) { const size_t row = (size_t)(row0 + ai * HALF + m * 16);
#pragma unroll
                for (int bj = 0; bj < 2; ++bj)
#pragma unroll
                    for (int n = 0; n < 2; ++n) { const int col = col0 + bj * HALF + n * 16;
                        const u32x2 gw = *(const GAS u32x2*)(Gt + row * 6144 + gcol0 + col);
                        const f32x4 g = {__uint_as_float(gw.x << 16), __uint_as_float(gw.x & 0xffff0000u), __uint_as_float(gw.y << 16), __uint_as_float(gw.y & 0xffff0000u)};
                        f32x4 v = g * acc[ai][bj][m][n];
                        if (MODE >= 1) v = v + *(const GAS f32x4*)(T + row * 2048 + col);
                        if (MODE <= 1) *(GAS f32x4*)(T + row * 2048 + col) = v;
                        else { u32x2 w; w.x = cvt_pk_bf16(v[0], v[1]); w.y = cvt_pk_bf16(v[2], v[3]); *(GAS u32x2*)(MRG + row * 2048 + col) = w; } } }
    }
};

struct EpiBrM {
    static constexpr bool PERM = true, AFTER_DRAIN = false, HAS_MID = true; static constexpr int MID_T0 = 8, MID_T1 = 12, NSTORE = 0;
    bf16_t* MRG; const unsigned char* Gt;
    __device__ __forceinline__ static f32x4 ub4(const unsigned d) { return (f32x4){(float)(d & 0xffu), (float)((d >> 8) & 0xffu), (float)((d >> 16) & 0xffu), (float)(d >> 24)}; }
    __device__ __forceinline__ static f32x4 rdiv(const f32x4 a, const f32x4 b) { return (f32x4){a[0] * __builtin_amdgcn_rcpf(b[0]), a[1] * __builtin_amdgcn_rcpf(b[1]), a[2] * __builtin_amdgcn_rcpf(b[2]), a[3] * __builtin_amdgcn_rcpf(b[3])}; }
    __device__ __forceinline__ void mid(f32x4 (&acc)[2][2][4][2], const Unit& u, int t, int wr, int wc, int fr, int fq) const {
        int off = (u.pm * 24 + u.pn + (t == MID_T0 ? 0 : 8)) * 65536 + (wr * 4 + wc) * 8192 + (fq * 16 + fr) * 16;
        asm volatile("" : "+v"(off));
        const unsigned char* gp = Gt + (unsigned)off;
        u32x4 wa[8], wb[8];
#pragma unroll
        for (int g = 0; g < 8; ++g) { wa[g] = *(const GAS u32x4*)(gp + g * 1024); wb[g] = *(const GAS u32x4*)(gp + 8 * 65536 + g * 1024); }
#pragma unroll
        for (int ai = 0; ai < 2; ++ai)
#pragma unroll
            for (int m = 0; m < 4; ++m) { const int g = ai * 4 + m;
                acc[ai][0][m][0] = acc[ai][0][m][0] * rdiv(ub4(wa[g].x), ub4(wb[g].x)); acc[ai][0][m][1] = acc[ai][0][m][1] * rdiv(ub4(wa[g].y), ub4(wb[g].y));
                acc[ai][1][m][0] = acc[ai][1][m][0] * rdiv(ub4(wa[g].z), ub4(wb[g].z)); acc[ai][1][m][1] = acc[ai][1][m][1] * rdiv(ub4(wa[g].w), ub4(wb[g].w)); }
        asm volatile("" ::: "memory");
    }
    __device__ __forceinline__ void operator()(const f32x4 (&acc)[2][2][4][2], const Unit& u, int wr, int wc, int fr, int fq) const {
        const int row0 = u.pm * BM + wr * 64 + fr, col0 = u.pn * BM + wc * 32 + 8 * fq;
        const unsigned char* gp = Gt + (size_t)(u.pm * 24 + u.pn + 16) * 65536 + (wr * 4 + wc) * 8192 + (fq * 16 + fr) * 16;
        u32x4 wgs[8];
#pragma unroll
        for (int g = 0; g < 8; ++g) wgs[g] = *(const GAS u32x4*)(gp + g * 1024);
#pragma unroll
        for (int ai = 0; ai < 2; ++ai)
#pragma unroll
            for (int m = 0; m < 4; ++m) { bf16_t* rowp = MRG + (size_t)(row0 + ai * HALF + m * 16) * 2048 + col0;
                const u32x4 wg = wgs[ai * 4 + m];
#pragma unroll
                for (int bj = 0; bj < 2; ++bj) { const f32x4 g0 = ub4(bj ? wg.z : wg.x) * (1.0f / 255.0f), g1 = ub4(bj ? wg.w : wg.y) * (1.0f / 255.0f);
                    const f32x4 v0 = acc[ai][bj][m][0] * g0, v1 = acc[ai][bj][m][1] * g1;
                    u32x4 w; w.x = cvt_pk_bf16(v0[0], v0[1]); w.y = cvt_pk_bf16(v0[2], v0[3]); w.z = cvt_pk_bf16(v1[0], v1[1]); w.w = cvt_pk_bf16(v1[2], v1[3]);
                    *(GAS u32x4*)(rowp + bj * HALF) = w; } }
    }
};
struct EpiDelta {
    static constexpr bool PERM = true, AFTER_DRAIN = false, HAS_MID = false; static constexpr int MID_T0 = -1, MID_T1 = -1;
    bf16_t* Dl; const float* gbase; int seq0, tshift; const float* HS2 = nullptr;
    __device__ __forceinline__ void operator()(const f32x4 (&acc)[2][2][4][2], const Unit& u, int wr, int wc, int fr, int fq) const {
        const int row0 = u.pm * BM + wr * 64 + fr, col0 = u.pn * BM + wc * 32 + 8 * fq;
        const float* gp = gbase + (size_t)(seq0 + ((u.pm * BM) >> tshift)) * 12288 + col0;
        f32x4 gv[2][2];
#pragma unroll
        for (int bj = 0; bj < 2; ++bj)
#pragma unroll
            for (int n = 0; n < 2; ++n) gv[bj][n] = *(const GAS f32x4*)(gp + bj * HALF + 4 * n);
        float rsv[8];
#pragma unroll
        for (int g = 0; g < 8; ++g) { rsv[g] = 1.0f; if (HS2) rsv[g] = HS2[row0 + (g >> 2) * HALF + (g & 3) * 16]; }
#pragma unroll
        for (int ai = 0; ai < 2; ++ai)
#pragma unroll
            for (int m = 0; m < 4; ++m) { bf16_t* rowp = Dl + (size_t)(row0 + ai * HALF + m * 16) * 2048 + col0;
                float rs = rsv[ai * 4 + m]; rs *= rs;
#pragma unroll
                for (int bj = 0; bj < 2; ++bj) { const f32x4 v0 = acc[ai][bj][m][0] * gv[bj][0] * rs, v1 = acc[ai][bj][m][1] * gv[bj][1] * rs;
                    u32x4 w; w.x = cvt_pk_bf16(v0[0], v0[1]); w.y = cvt_pk_bf16(v0[2], v0[3]); w.z = cvt_pk_bf16(v1[0], v1[1]); w.w = cvt_pk_bf16(v1[2], v1[3]);
                    *(GAS u32x4*)(rowp + bj * HALF) = w; } }
    }
};

struct EpiFinal {
    static constexpr bool PERM = true, AFTER_DRAIN = false, HAS_MID = false; static constexpr int MID_T0 = -1, MID_T1 = -1;
    const bf16_t* XS; float* out; const float* gbase; int seq0, tshift; const float* HS2 = nullptr;
    __device__ __forceinline__ void operator()(const f32x4 (&acc)[2][2][4][2], const Unit& u, int wr, int wc, int fr, int fq) const {
        const int row0 = u.pm * BM + wr * 64 + fr, col0 = u.pn * BM + wc * 32 + 8 * fq;
        const float* gp = gbase + (size_t)(seq0 + ((u.pm * BM) >> tshift)) * 12288 + col0;
        f32x4 gv[2][2];
#pragma unroll
        for (int bj = 0; bj < 2; ++bj)
#pragma unroll
            for (int n = 0; n < 2; ++n) gv[bj][n] = *(const GAS f32x4*)(gp + bj * HALF + 4 * n);
        float rsv[8];
#pragma unroll
        for (int g = 0; g < 8; ++g) { rsv[g] = 1.0f; if (HS2) rsv[g] = HS2[row0 + (g >> 2) * HALF + (g & 3) * 16]; }
#pragma unroll
        for (int ai = 0; ai < 2; ++ai) { u32x4 xws[4][2];
#pragma unroll
            for (int m = 0; m < 4; ++m) { const size_t off = (size_t)(row0 + ai * HALF + m * 16) * 2048 + col0; xws[m][0] = *(const GAS u32x4*)(XS + off); xws[m][1] = *(const GAS u32x4*)(XS + off + HALF); }
#pragma unroll
            for (int m = 0; m < 4; ++m) { const size_t off = (size_t)(row0 + ai * HALF + m * 16) * 2048 + col0;
                float rs = rsv[ai * 4 + m]; rs *= rs;
#pragma unroll
                for (int bj = 0; bj < 2; ++bj) { const u32x4 xw = xws[m][bj];
                    const f32x4 x0 = {__uint_as_float(xw.x << 16), __uint_as_float(xw.x & 0xffff0000u), __uint_as_float(xw.y << 16), __uint_as_float(xw.y & 0xffff0000u)};
                    const f32x4 x1 = {__uint_as_float(xw.z << 16), __uint_as_float(xw.z & 0xffff0000u), __uint_as_float(xw.w << 16), __uint_as_float(xw.w & 0xffff0000u)};
                    *(GAS f32x4*)(out + off + bj * HALF) = x0 + acc[ai][bj][m][0] * gv[bj][0] * rs;
                    *(GAS f32x4*)(out + off + bj * HALF + 4) = x1 + acc[ai][bj][m][1] * gv[bj][1] * rs; } }
            asm volatile("" ::: "memory"); }
    }
};
template <class Epi, class Sched, bool ALIGN_EPI = false, bool SP2 = false, bool I8 = false>
__device__ __forceinline__ void gemm_phase(PG8_LAS unsigned char* lds, const Gemm g, const Sched& S, const Epi& E, int tid_in) {
    int tid_ = tid_in; asm volatile("" : "+v"(tid_));
    const int tid = tid_, wid = __builtin_amdgcn_readfirstlane(tid >> 6), lane = tid & 63, wr = wid >> 2, wc = wid & 3, fr = lane & 15, fq = lane >> 4;
    const int K = g.K, nt = K / BK;
    unsigned voffA[2], voffB[2];
#pragma unroll
    for (int i = 0; i < 2; ++i) { int R, C; stage_rc(tid * 16 + i * 8192, R, C); const int Rb = Epi::PERM ? ((R & ~31) + perm32(R & 31)) : R;
        voffA[i] = (unsigned)(R * K + C) * 2u; voffB[i] = (unsigned)(Rb * K + C) * 2u; }
    const size_t kstep = (size_t)(BK * 2);
    const size_t hstep = (size_t)HALF * K * 2;
    const size_t tstep = 2 * hstep;
    const unsigned ldsw = (unsigned)wid * 1024u;
    const int aoff = lds_byte(wr * 64 + fr, fq * 8), boff = lds_byte(wc * 32 + fr, fq * 8);
#define PG8_SA(b, h) (((b) * 2 + (h)) * HTB)
#define PG8_SB(b, h) ((4 + (b) * 2 + (h)) * HTB)
#define PG8_STAGE(bufoff, gbase, voff) do { _Pragma("unroll") for (int _i = 0; _i < 2; ++_i) \
        __builtin_amdgcn_global_load_lds((const unsigned*)((const char*)(gbase) + (voff)[_i]), (PG8_LAS unsigned*)(lds + (bufoff) + ldsw + _i * 8192), 16, 0, 0); } while (0)
#define PG8_LDA(dst, b, h) do { _Pragma("unroll") for (int m = 0; m < 4; ++m) _Pragma("unroll") for (int k = 0; k < 2; ++k) dst[m][k] = *(const PG8_LAS bf16x8*)(lds + PG8_SA(b, h) + aoff + m * 2048 + k * 1024); } while (0)
#define PG8_LDB(dst, b, h) do { _Pragma("unroll") for (int n = 0; n < 2; ++n) _Pragma("unroll") for (int k = 0; k < 2; ++k) dst[n][k] = *(const PG8_LAS bf16x8*)(lds + PG8_SB(b, h) + boff + n * 2048 + k * 1024); } while (0)
#define PG8_MMA(ai, bj, At, Bt) do { __builtin_amdgcn_s_setprio(1); _Pragma("unroll") for (int m = 0; m < 4; ++m) _Pragma("unroll") for (int n = 0; n < 2; ++n) _Pragma("unroll") for (int k = 0; k < 2; ++k) { \
        if constexpr (I8) acc[ai][bj][m][n] = __builtin_bit_cast(f32x4, __builtin_amdgcn_mfma_i32_16x16x64_i8(__builtin_bit_cast(v4i_t, Bt[n][k]), __builtin_bit_cast(v4i_t, At[m][k]), __builtin_bit_cast(v4i_t, acc[ai][bj][m][n]), 0, 0, 0)); \
        else acc[ai][bj][m][n] = __builtin_amdgcn_mfma_f32_16x16x32_bf16(Bt[n][k], At[m][k], acc[ai][bj][m][n], 0, 0, 0); } \
        __builtin_amdgcn_s_setprio(0); } while (0)
#define PG8_WAIT_V(n) asm volatile("s_waitcnt vmcnt(" #n ")" ::: "memory")
#define PG8_WAIT_L(n) asm volatile("s_waitcnt lgkmcnt(" #n ")" ::: "memory")
#define PG8_BAR __builtin_amdgcn_s_barrier()
#define PG8_SCHED __builtin_amdgcn_sched_barrier(0)
    Unit cur, nxt; int ui = 0;
    if (!S.next(0, cur)) return;
    f32x4 acc[2][2][4][2];
#pragma unroll
    for (int a = 0; a < 2; ++a)
#pragma unroll
        for (int b = 0; b < 2; ++b)
#pragma unroll
            for (int m = 0; m < 4; ++m)
#pragma unroll
                for (int n = 0; n < 2; ++n) acc[a][b][m][n] = (f32x4){0.f, 0.f, 0.f, 0.f};
    typedef int v4i_t __attribute__((ext_vector_type(4)));
    bf16x8 At[4][2], B0[2][2], B1[2][2];
    const char* cA = (const char*)g.A + (size_t)cur.pm * tstep; const char* cB = (const char*)g.Bt + (size_t)cur.pn * tstep;
    S.a_ready(cur);
    if constexpr (SP2) {
        PG8_STAGE(PG8_SB(0, 0), cB, voffB); PG8_STAGE(PG8_SB(0, 1), cB + hstep, voffB); PG8_STAGE(PG8_SA(0, 0), cA, voffA); PG8_STAGE(PG8_SA(0, 1), cA + hstep, voffA);
        if (wr == 1) PG8_BAR;
        PG8_WAIT_V(2); PG8_BAR;
        PG8_STAGE(PG8_SB(1, 0), cB + kstep, voffB); PG8_STAGE(PG8_SA(1, 0), cA + kstep, voffA); PG8_STAGE(PG8_SB(1, 1), cB + hstep + kstep, voffB);
        PG8_WAIT_V(6); PG8_BAR;
    } else {
        PG8_STAGE(PG8_SB(0, 0), cB, voffB); PG8_STAGE(PG8_SA(0, 0), cA, voffA); PG8_STAGE(PG8_SB(0, 1), cB + hstep, voffB); PG8_STAGE(PG8_SA(0, 1), cA + hstep, voffA);
        if (wr == 1) PG8_BAR;
        PG8_WAIT_V(4); PG8_BAR;
        PG8_STAGE(PG8_SB(1, 0), cB + kstep, voffB); PG8_STAGE(PG8_SA(1, 0), cA + kstep, voffA); PG8_STAGE(PG8_SB(1, 1), cB + hstep + kstep, voffB);
        PG8_WAIT_V(6); PG8_BAR;
    }
    for (;;) {
        const bool has_next = S.next(ui + 1, nxt);
        const char* nA = has_next ? (const char*)g.A + (size_t)nxt.pm * tstep : cA; const char* nB = has_next ? (const char*)g.Bt + (size_t)nxt.pn * tstep : cB;
#pragma unroll 1
        for (int t = 0; t < nt; t += 2) {
            if constexpr (Epi::HAS_MID) { if (t == Epi::MID_T0 || t == Epi::MID_T1) E.mid(acc, cur, t, wr, wc, fr, fq); }
            const bool last = (t == nt - 2);
            const char* a1 = cA + (size_t)(t + 1) * kstep;
            const char* a2 = last ? nA : cA + (size_t)(t + 2) * kstep; const char* b2 = last ? nB : cB + (size_t)(t + 2) * kstep;
            const char* a3 = a2 + kstep; const char* b3 = b2 + kstep;
            if (last && has_next) S.a_ready(nxt);
            if constexpr (SP2) {
            PG8_LDB(B0, 0, 0); PG8_LDB(B1, 0, 1); PG8_SCHED; PG8_LDA(At, 0, 0); PG8_STAGE(PG8_SA(1, 1), a1 + hstep, voffA);
            PG8_WAIT_V(8); PG8_WAIT_L(0); PG8_BAR; PG8_MMA(0, 0, At, B0); PG8_MMA(0, 1, At, B1); PG8_BAR; PG8_SCHED;
            PG8_LDA(At, 0, 1); PG8_STAGE(PG8_SB(0, 0), b2, voffB); PG8_STAGE(PG8_SB(0, 1), b2 + hstep, voffB); PG8_STAGE(PG8_SA(0, 0), a2, voffA);
            PG8_WAIT_V(8); PG8_WAIT_L(0); PG8_BAR; PG8_MMA(1, 0, At, B0); PG8_MMA(1, 1, At, B1); PG8_BAR; PG8_SCHED;
            PG8_LDB(B0, 1, 0); PG8_LDB(B1, 1, 1); PG8_SCHED; PG8_LDA(At, 1, 0); PG8_STAGE(PG8_SA(0, 1), a2 + hstep, voffA);
            PG8_WAIT_V(8); PG8_WAIT_L(0); PG8_BAR; PG8_MMA(0, 0, At, B0); PG8_MMA(0, 1, At, B1); PG8_BAR; PG8_SCHED;
            PG8_LDA(At, 1, 1); PG8_STAGE(PG8_SB(1, 0), b3, voffB); PG8_STAGE(PG8_SB(1, 1), b3 + hstep, voffB); PG8_STAGE(PG8_SA(1, 0), a3, voffA);
            PG8_WAIT_V(8); PG8_WAIT_L(0); PG8_BAR; PG8_MMA(1, 0, At, B0); PG8_MMA(1, 1, At, B1); PG8_BAR; PG8_SCHED;
            } else {
            PG8_LDB(B0, 0, 0); PG8_SCHED; PG8_LDA(At, 0, 0); PG8_STAGE(PG8_SA(1, 1), a1 + hstep, voffA);
            PG8_WAIT_L(8); PG8_BAR; PG8_WAIT_L(0); PG8_MMA(0, 0, At, B0); PG8_BAR; PG8_SCHED;
            PG8_LDB(B1, 0, 1); PG8_STAGE(PG8_SB(0, 0), b2, voffB);
            PG8_BAR; PG8_WAIT_L(0); PG8_MMA(0, 1, At, B1); PG8_BAR;
            PG8_LDA(At, 0, 1); PG8_STAGE(PG8_SA(0, 0), a2, voffA);
            PG8_BAR; PG8_WAIT_L(0); PG8_MMA(1, 0, At, B0); PG8_BAR; PG8_SCHED;
            PG8_STAGE(PG8_SB(0, 1), b2 + hstep, voffB);
            PG8_WAIT_V(6); PG8_BAR; PG8_MMA(1, 1, At, B1); PG8_BAR;
            PG8_LDB(B0, 1, 0); PG8_SCHED; PG8_LDA(At, 1, 0); PG8_STAGE(PG8_SA(0, 1), a2 + hstep, voffA);
            PG8_WAIT_L(8); PG8_BAR; PG8_WAIT_L(0); PG8_MMA(0, 0, At, B0); PG8_BAR; PG8_SCHED;
            PG8_LDB(B1, 1, 1); PG8_STAGE(PG8_SB(1, 0), b3, voffB);
            PG8_BAR; PG8_WAIT_L(0); PG8_MMA(0, 1, At, B1); PG8_BAR;
            PG8_LDA(At, 1, 1); PG8_STAGE(PG8_SA(1, 0), a3, voffA);
            PG8_BAR; PG8_WAIT_L(0); PG8_MMA(1, 0, At, B0); PG8_BAR; PG8_SCHED;
            PG8_STAGE(PG8_SB(1, 1), b3 + hstep, voffB);
            PG8_WAIT_V(6); PG8_BAR; PG8_MMA(1, 1, At, B1); PG8_BAR;
            }
        }
        if constexpr (ALIGN_EPI) { if (wr == 0) PG8_BAR; }
        if constexpr (!Epi::AFTER_DRAIN) { E(acc, cur, wr, wc, fr, fq); S.done(cur); }
        if (!has_next) break;
#pragma unroll
        for (int a = 0; a < 2; ++a)
#pragma unroll
            for (int b = 0; b < 2; ++b)
#pragma unroll
                for (int m = 0; m < 4; ++m)
#pragma unroll
                    for (int n = 0; n < 2; ++n) acc[a][b][m][n] = (f32x4){0.f, 0.f, 0.f, 0.f};
        cur = nxt; cA = nA; cB = nB; ++ui;
        if constexpr (ALIGN_EPI) { if (wr == 1) PG8_BAR; }
    }
    PG8_WAIT_V(0);
    if constexpr (!ALIGN_EPI) { if (wr == 0) PG8_BAR; }
    PG8_BAR;
    if constexpr (Epi::AFTER_DRAIN) { E.fused(acc, cur, wr, wc, fr, fq, lds, wid, lane); S.done(cur); }
#undef PG8_SA
#undef PG8_SB
#undef PG8_STAGE
#undef PG8_LDA
#undef PG8_LDB
#undef PG8_MMA
#undef PG8_WAIT_V
#undef PG8_WAIT_L
#undef PG8_BAR
#undef PG8_SCHED
}
}
typedef unsigned short bf16;
typedef unsigned v4u __attribute__((ext_vector_type(4)));
typedef unsigned v2u __attribute__((ext_vector_type(2)));
typedef float f32x4 __attribute__((ext_vector_type(4)));
typedef float f32x16 __attribute__((ext_vector_type(16)));
typedef short bf16x8 __attribute__((ext_vector_type(8)));
typedef GAS unsigned gu32;
#define LDS_WAIT() asm volatile("s_waitcnt lgkmcnt(0)" ::: "memory")
#define VM_WAIT() asm volatile("s_waitcnt vmcnt(0)" ::: "memory")
__device__ __forceinline__ unsigned pk2(float lo, float hi) { return pg8::cvt_pk_bf16(lo, hi); }
__device__ __forceinline__ float bflo(unsigned w) { return __uint_as_float(w << 16); }
__device__ __forceinline__ float bfhi(unsigned w) { return __uint_as_float(w & 0xffff0000u); }
__device__ __forceinline__ float bf1(bf16 b) { return __uint_as_float((unsigned)b << 16); }
__device__ __forceinline__ float wave_sum(float v) {
    v += shx<1>(v); v += shx<2>(v); v += shx<4>(v); v += shx<8>(v); v += shx<16>(v); return sum32(v);
}
#define XB_TMO      128
#define XB_XCNT(j)  (256  + 64 * (j))
#define XB_XSUB(j)  (1280 + 64 * (j))
#define XB_XGEN(j)  (2304 + 64 * (j))
#define XB_TOP      3328
#define XB_TOPGEN   3392
#define XCD_BAR_WORDS 3456
#define XB_SPIN_CAP (1u << 18)

__device__ __forceinline__ unsigned xb_ld(unsigned* p)              { return __hip_atomic_load(p, __ATOMIC_RELAXED, __HIP_MEMORY_SCOPE_AGENT); }
__device__ __forceinline__ unsigned xb_add(unsigned* p, unsigned v) { return __hip_atomic_fetch_add(p, v, __ATOMIC_RELAXED, __HIP_MEMORY_SCOPE_AGENT); }
__device__ __forceinline__ unsigned xb_xcc_id() { return (unsigned)__builtin_amdgcn_s_getreg((3 << 11) | 20) & 0xFu; }
#define XB_SPIN(cond, bar) do { unsigned _sp = 0; while (cond) { __builtin_amdgcn_s_sleep(1); \
    if ((++_sp & 255u) == 0u) { if (xb_ld(&(bar)[XB_TMO])) break; if (_sp > XB_SPIN_CAP) { atomicAdd(&(bar)[XB_TMO], 1u); break; } } } } while (0)

struct XcdBarrier {
    unsigned* bar; unsigned x;
    volatile LAS unsigned* st;
};

__device__ __forceinline__ XcdBarrier xcd_barrier_post(unsigned* bar, volatile LAS unsigned* st, int tid) {
    XcdBarrier b; b.bar = bar; b.x = xb_xcc_id(); b.st = st;
    if (tid == 0) (void)xb_add(&bar[XB_XCNT(b.x)], 1u);
    return b;
}
__device__ __forceinline__ void xcd_barrier_complete(unsigned* bar, unsigned x, unsigned& nloc, unsigned& nx) {
    const unsigned G = gridDim.x * gridDim.y * gridDim.z;
    unsigned sum, cnt, mine, sp = 0u;
    for (;;) {
        sum = 0u; cnt = 0u; mine = 0u;
#pragma unroll
        for (unsigned j = 0; j < 16; ++j) { const unsigned c = xb_ld(&bar[XB_XCNT(j)]); sum += c; cnt += (c > 0u) ? 1u : 0u; mine = (j == x) ? c : mine; }
        if (sum == G) break;
        __builtin_amdgcn_s_sleep(1);
        if ((++sp & 255u) == 0u) { if (xb_ld(&bar[XB_TMO])) break; if (sp > XB_SPIN_CAP) { atomicAdd(&bar[XB_TMO], 1u); break; } }
    }
    nloc = mine > 0u ? mine : 1u; nx = cnt > 0u ? cnt : 1u;
}

__device__ __forceinline__ void xcd_barrier(const XcdBarrier& b, int tid) {
    asm volatile("s_waitcnt vmcnt(0)" ::: "memory");
    __syncthreads();
    if (tid == 0) {
        unsigned* bar = b.bar;
        __builtin_amdgcn_s_waitcnt(0);
        unsigned nloc = b.st[0], nx = b.st[1];
        if (nloc == 0u) { xcd_barrier_complete(bar, b.x, nloc, nx); b.st[0] = nloc; b.st[1] = nx; }
        const unsigned old = xb_add(&bar[XB_XSUB(b.x)], 1u);
        const unsigned gen = old / nloc;
        if (old + 1u == (gen + 1u) * nloc) {
            __builtin_amdgcn_fence(__ATOMIC_RELEASE, "agent");
            asm volatile("s_waitcnt vmcnt(0)" ::: "memory");
            const unsigned og = xb_add(&bar[XB_TOP], 1u);
            const unsigned tg = og / nx;
            if (og + 1u == (tg + 1u) * nx) xb_add(&bar[XB_TOPGEN], 1u);
            else XB_SPIN(xb_ld(&bar[XB_TOPGEN]) == tg, bar);
            __builtin_amdgcn_fence(__ATOMIC_ACQUIRE, "agent");
            xb_add(&bar[XB_XGEN(b.x)], 1u);
            asm volatile("s_waitcnt vmcnt(0)" ::: "memory");
        } else {
            XB_SPIN(xb_ld(&bar[XB_XGEN(b.x)]) == gen, bar);
            __builtin_amdgcn_fence(__ATOMIC_ACQUIRE, "agent");
            asm volatile("s_waitcnt vmcnt(0)" ::: "memory");
        }
    }
    __syncthreads();
}

__device__ __forceinline__ void group_handoff(unsigned* bar, unsigned* cnt, unsigned target, int tid) {
    asm volatile("s_waitcnt vmcnt(0)" ::: "memory");
    __syncthreads();
    if (tid == 0) {
        (void)xb_add(cnt, 1u);
        XB_SPIN(xb_ld(cnt) < target, bar);
        __builtin_amdgcn_fence(__ATOMIC_ACQUIRE, "agent");
        asm volatile("s_waitcnt vmcnt(0)" ::: "memory");
    }
    __syncthreads();
}

__device__ __forceinline__ void phase_modp(const AL& a, LAS unsigned char* lds, int tid, int lane, int wave) {
    LAS float* sil = (LAS float*)lds;
    const float* wada = a.in(I_WADA); float* modp = (float*)(a.ws() + WS_MODP);
    for (int it = blockIdx.x; it < 256; it += gridDim.x) {
        const int l = it >> 7, ks = (it >> 3) & 15, cg = it & 7, k0 = ks * 128;
        for (int e = tid; e < 24 * 128; e += NWAVES * 64) { const int b = e >> 7, kk = e & 127;
            const float c = b < 8 ? a.in(I_CP)[b * 2048 + k0 + kk] : a.in(I_CS)[(b - 8) * 2048 + k0 + kk];
            sil[e] = c / (1.0f + __expf(-c)); }
        __syncthreads();
        const int n0 = cg * 1536 + wave * 192 + 3 * lane;
        float acc[24][3];
#pragma unroll
        for (int b = 0; b < 24; ++b) { acc[b][0] = 0.f; acc[b][1] = 0.f; acc[b][2] = 0.f; }
        const GAS float* wp = (const GAS float*)wada + ((size_t)l * 2048 + k0) * 12288 + n0;
#pragma unroll 8
        for (int kk = 0; kk < 128; ++kk) {
            const float w0 = wp[(size_t)kk * 12288], w1 = wp[(size_t)kk * 12288 + 1], w2 = wp[(size_t)kk * 12288 + 2];
#pragma unroll
            for (int b = 0; b < 24; ++b) { const float s = sil[b * 128 + kk]; acc[b][0] += s * w0; acc[b][1] += s * w1; acc[b][2] += s * w2; }
        }
#pragma unroll
        for (int b = 0; b < 24; ++b) { GAS float* o = (GAS float*)modp + ((size_t)(ks * 2 + l) * 24 + b) * 12288 + n0; o[0] = acc[b][0]; o[1] = acc[b][1]; o[2] = acc[b][2]; }
        __syncthreads();
    }
}
__device__ __forceinline__ int win_row(int n0) { return n0 < 1024 ? n0 : n0 < 1536 ? n0 + 3072 : n0 < 3072 ? n0 - 512 : n0 < 3840 ? n0 + 1536 : n0 < 5376 ? n0 - 1280 : n0; }
__device__ __forceinline__ void phase_colmax(const AL& a, int gw, int NGW, int lane) {
    unsigned* wmax = (unsigned*)(a.ws() + WS_CTL) + CW_WMAX;
    for (int it = gw; it < 2 * 2 * 96 * 8; it += NGW) { const int ks = it & 7, cb = (it >> 3) % 96, mat = (it / 768) & 1, l = it / 1536, n0 = 64 * cb;
        const GAS float* w = (const GAS float*)(mat ? a.in(I_WGATE) : a.in(I_WIN)) + ((size_t)l * 2048 + ks * 256) * 6144 + n0 + lane;
        float mx = 0.f;
#pragma unroll 16
        for (int k = 0; k < 256; ++k) mx = fmaxf(mx, fabsf(w[(size_t)k * 6144]));
        const int d = mat ? 6144 + n0 + lane : win_row(n0) + lane;
        atomicMax(wmax + l * WMAX_L + d, __float_as_uint(mx)); }
#if I8FF1
    for (int it = gw; it < 2 * 128 * 8; it += NGW) { const int ks = it & 7, cb = (it >> 3) & 127, l = it >> 10, n0 = 64 * cb;
        const GAS float* w = (const GAS float*)a.in(I_WFF1) + ((size_t)l * 2048 + ks * 256) * 8192 + n0 + lane;
        float mx = 0.f;
#pragma unroll 16
        for (int k = 0; k < 256; ++k) mx = fmaxf(mx, fabsf(w[(size_t)k * 8192]));
        atomicMax(wmax + l * WMAX_L + 12288 + n0 + lane, __float_as_uint(mx)); }
#endif
}
__device__ __forceinline__ unsigned pk_i8x4(f32x4 v) {
    const int a = (int)__builtin_rintf(v.x), b = (int)__builtin_rintf(v.y), c = (int)__builtin_rintf(v.z), d = (int)__builtin_rintf(v.w);
    return (unsigned)(a & 255) | ((unsigned)(b & 255) << 8) | ((unsigned)(c & 255) << 16) | ((unsigned)d << 24); }
struct TrItem { const float* src; bf16* dst; int N, ldk; const unsigned* cmax; const unsigned* ksc; };
__device__ __forceinline__ void tr_load(const TrItem& t, float (&v)[32], int lane) {
    const GAS float* s = (const GAS float*)t.src + (size_t)(lane >> 5) * t.N + (lane & 31);
#pragma unroll
    for (int i = 0; i < 32; ++i) v[i] = s[(size_t)(2 * i) * t.N];
}
__device__ __forceinline__ void tr_store(const TrItem& t, const float (&v)[32], LAS float* scr, int lane) {
#pragma unroll
    for (int i = 0; i < 32; ++i) scr[(2 * i + (lane >> 5)) * 33 + (lane & 31)] = v[i];
    LDS_WAIT(); asm volatile("" ::: "memory");
    const int c = lane & 7;
#pragma unroll
    for (int j = 0; j < 4; ++j) { const int n = (lane >> 3) + 8 * j; const LAS float* s = scr + (8 * c) * 33 + n;
        if (t.cmax) { const float cm = __uint_as_float(t.cmax[n]), inv = cm > 0.f ? 127.0f / cm : 0.f;
            v2u o; o.x = pk_i8x4((f32x4){s[0 * 33], s[1 * 33], s[2 * 33], s[3 * 33]} * inv); o.y = pk_i8x4((f32x4){s[4 * 33], s[5 * 33], s[6 * 33], s[7 * 33]} * inv);
            *(GAS v2u*)((unsigned char*)t.dst + (size_t)n * t.ldk + 8 * c) = o; }
        else { float f[8];
#pragma unroll
            for (int e = 0; e < 8; ++e) f[e] = s[e * 33];
            if (t.ksc) { const v4u k0 = *(const GAS v4u*)(t.ksc + 8 * c), k1 = *(const GAS v4u*)(t.ksc + 8 * c + 4); const unsigned kk[8] = {k0.x, k0.y, k0.z, k0.w, k1.x, k1.y, k1.z, k1.w};
#pragma unroll
                for (int e = 0; e < 8; ++e) { const float q = __uint_as_float(kk[e]) * (1.0f / 127.0f); f[e] *= q * q; } }
            v4u o; o.x = pk2(f[0], f[1]); o.y = pk2(f[2], f[3]); o.z = pk2(f[4], f[5]); o.w = pk2(f[6], f[7]);
            *(GAS v4u*)(t.dst + (size_t)n * t.ldk + 8 * c) = o; } }
    LDS_WAIT(); asm volatile("" ::: "memory");
}
__device__ __forceinline__ void phase_pro2(const AL& a, LAS unsigned char* lds, int tid, int lane, int wave, int G) {
    const int gt = blockIdx.x * (NWAVES * 64) + tid, NGT = G * NWAVES * 64;
    { float* mod = (float*)(a.ws() + WS_MOD); const float* modp = (const float*)(a.ws() + WS_MODP); const float* bada = a.in(I_BADA);
      for (int i = gt; i < 2 * 24 * 12288; i += NGT) { const int l = i / (24 * 12288), n = i % 12288; float s = bada[l * 12288 + n];
#pragma unroll
          for (int ks = 0; ks < 16; ++ks) s += modp[(size_t)ks * (2 * 24 * 12288) + i];
          mod[i] = s; } }
    { float2* rb = (float2*)(a.ws() + WS_ROPEB); float2* rc = (float2*)(a.ws() + WS_ROPEC);
      for (int i = gt; i < 4096 * 24; i += NGT) { const int pos = i / 24, j = i % 24; const bool isb = j < 16; const int ii = isb ? j : j - 16; const double half = isb ? 16.0 : 8.0;
          const double inv = exp(-(double)ii / half * 13.122363377404328);
          const double rev = (double)pos * inv * 0.15915494309189535;
          const float fr = (float)(rev - floor(rev));
          const float2 v = make_float2(__builtin_amdgcn_cosf(fr), __builtin_amdgcn_sinf(fr));
          if (isb) rb[pos * 16 + ii] = v; else rc[pos * 8 + ii] = v; } }
    if (gt < 2) { const int l = gt; float s1 = 0.f, s2 = 0.f;
        for (int i = 0; i < 64; ++i) { s1 += a.in(I_LQ1)[l * 64 + i] * a.in(I_LK1)[l * 64 + i]; s2 += a.in(I_LQ2)[l * 64 + i] * a.in(I_LK2)[l * 64 + i]; }
        const float lam_init = 0.8f - 0.6f * expf(-0.3f * (float)l);
        ((float*)(a.ws() + WS_LAM))[l] = expf(s1) - expf(s2) + lam_init;
        float gq = 0.f, gk = 0.f;
        for (int i = 0; i < 64; ++i) { gq = fmaxf(gq, fabsf(a.in(I_QNC)[l * 64 + i])); gk = fmaxf(gk, fabsf(a.in(I_KNC)[l * 64 + i])); }
        ((float*)(a.ws() + WS_LAM))[2 + l] = 8.0f * LOG2E * gq * gk * 1.02f; }
    LAS float* scr = (LAS float*)(lds + RING_OFF + wave * 16384);
    const int gw = blockIdx.x * NWAVES + wave, NGW = G * NWAVES;
    constexpr int I_IN = 32 * 192, I_BA = 8 * 64, I_BB = 4 * 64, I_BC = 12 * 64, I_OU = 32 * 64, I_F1 = 32 * 256, I_F2 = 128 * 64;
    constexpr int PER_L = 2 * I_IN + I_BA + I_BB + I_BC + I_OU + I_F1 + I_F2;
    auto decode = [&](int it) -> TrItem {
        const int l = it / PER_L; int r = it % PER_L; unsigned char* wl = a.ws() + WS_W + (size_t)l * W_LAYER;
        const float* W; bf16* WT; int K, N, row_off = 0, ldk, koff = 0, i8 = 0; bool win = false, ff2 = false;
        if (r < I_IN) { win = true; i8 = I8IN ? 1 : 0; W = a.in(I_WIN) + (size_t)l * 2048 * 6144; K = 2048; N = 6144; WT = (bf16*)(wl + WO_IG); ldk = 2048; }
        else if ((r -= I_IN) < I_IN) { i8 = 2; W = a.in(I_WGATE) + (size_t)l * 2048 * 6144; K = 2048; N = 6144; WT = (bf16*)(wl + WO_IG + (size_t)6144 * 2048 * (I8IN ? 1 : 2)); ldk = 2048; }
        else if ((r -= I_IN) < I_BA) { W = a.in(I_WBRA) + (size_t)l * 512 * 2048; K = 512; N = 2048; WT = (bf16*)(wl + WO_BRA); ldk = 1536; }
        else if ((r -= I_BA) < I_BB) { W = a.in(I_WBRB) + (size_t)l * 256 * 2048; K = 256; N = 2048; WT = (bf16*)(wl + WO_BRA); ldk = 1536; koff = 512; }
        else if ((r -= I_BB) < I_BC) { W = a.in(I_WBRC) + (size_t)l * 768 * 2048; K = 768; N = 2048; WT = (bf16*)(wl + WO_BRA); ldk = 1536; koff = 768; }
        else if ((r -= I_BC) < I_OU) { W = a.in(I_WOUT) + (size_t)l * 2048 * 2048; K = 2048; N = 2048; WT = (bf16*)(wl + WO_OUT); ldk = 2048; }
        else if ((r -= I_OU) < I_F1) { W = a.in(I_WFF1) + (size_t)l * 2048 * 8192; K = 2048; N = 8192; WT = (bf16*)(wl + WO_FF1); ldk = 2048; i8 = I8FF1 ? 3 : 0; }
        else { r -= I_F1; W = a.in(I_WFF2) + (size_t)l * 8192 * 2048; K = 8192; N = 2048; WT = (bf16*)(wl + WO_FF2); ldk = 8192; ff2 = I8FF1 != 0; }
        (void)K; const int nblk = N / 32, kb = r / nblk, nb = r % nblk, k0 = 64 * kb, n0 = 32 * nb; const int nd = win ? win_row(n0) : n0;
        TrItem t; t.src = W + (size_t)k0 * N + n0; t.N = N; t.ldk = ldk; t.cmax = nullptr; t.ksc = ff2 ? (const unsigned*)(a.ws() + WS_CTL) + CW_WMAX + l * WMAX_L + 12288 + k0 : nullptr;
        if (i8) { t.dst = (bf16*)((unsigned char*)WT + (size_t)nd * ldk + k0); t.cmax = (const unsigned*)(a.ws() + WS_CTL) + CW_WMAX + l * WMAX_L + (i8 == 3 ? 12288 : i8 == 2 ? 6144 : 0) + nd; }
        else t.dst = WT + (size_t)(row_off + nd) * ldk + koff + k0;
        return t; };
    { int it = gw; const int NIT = 2 * PER_L;
      if (it < NIT) { TrItem cur = decode(it); float v[32]; tr_load(cur, v, lane);
          for (;;) { const int nx = it + NGW; const bool more = nx < NIT; TrItem nt = cur; float vn[32];
              if (more) { nt = decode(nx); tr_load(nt, vn, lane); }
              tr_store(cur, v, scr, lane);
              if (!more) break;
              cur = nt; it = nx;
#pragma unroll
              for (int i = 0; i < 32; ++i) v[i] = vn[i]; } } }
}

__device__ __forceinline__ f32x4 up4(v2u w) { return (f32x4){bflo(w.x), bfhi(w.x), bflo(w.y), bfhi(w.y)}; }
template <bool XF32, bool HASD, bool QI8 = false>
__device__ __forceinline__ void phase_norm(const float* xf, const bf16* XS, const bf16* D, bf16* XB, const float* gn, const float* modl, int sh_off, int sc_off, int seq0, int tshift, bf16* H, int gw, int NGW, int lane, unsigned char* HI8 = nullptr, float* HS = nullptr, int bend = CH / 8) {
    for (int blk = gw; blk < bend; blk += NGW) {
        const int r0 = blk * 8; const float* mo = modl + (size_t)(seq0 + (r0 >> tshift)) * 12288;
        f32x4 A[8], B[8];
#pragma unroll
        for (int j = 0; j < 8; ++j) { const int c = 4 * lane + 256 * j; const f32x4 g = *(const GAS f32x4*)(gn + c), sc = *(const GAS f32x4*)(mo + sc_off + c); A[j] = g * (1.0f + sc); B[j] = *(const GAS f32x4*)(mo + sh_off + c); }
        for (int r = 0; r < 8; r += 2) {
            f32x4 v0[8], v1[8]; float s0 = 0.f, s1 = 0.f;
            if (XF32) { const GAS f32x4* xr0 = (const GAS f32x4*)(xf + (size_t)(r0 + r) * 2048) + lane; const GAS f32x4* xr1 = xr0 + 512;
#pragma unroll
                for (int j = 0; j < 8; ++j) { v0[j] = xr0[64 * j]; v1[j] = xr1[64 * j]; } }
            else { const GAS v2u* xr0 = (const GAS v2u*)(XS + (size_t)(r0 + r) * 2048) + lane; const GAS v2u* xr1 = xr0 + 512; v2u e0[8], e1[8];
#pragma unroll
                for (int j = 0; j < 8; ++j) { e0[j] = xr0[64 * j]; e1[j] = xr1[64 * j]; }
#pragma unroll
                for (int j = 0; j < 8; ++j) { v0[j] = up4(e0[j]); v1[j] = up4(e1[j]); } }
            if (HASD) { const GAS v2u* d0 = (const GAS v2u*)(D + (size_t)(r0 + r) * 2048) + lane; const GAS v2u* d1 = d0 + 512; v2u e0[8], e1[8];
#pragma unroll
                for (int j = 0; j < 8; ++j) { e0[j] = d0[64 * j]; e1[j] = d1[64 * j]; }
                GAS v2u* xo0 = (GAS v2u*)(XB + (size_t)(r0 + r) * 2048) + lane; GAS v2u* xo1 = xo0 + 512;
#pragma unroll
                for (int j = 0; j < 8; ++j) { v0[j] = v0[j] + up4(e0[j]); v1[j] = v1[j] + up4(e1[j]);
                    v2u w0, w1; w0.x = pk2(v0[j].x, v0[j].y); w0.y = pk2(v0[j].z, v0[j].w); w1.x = pk2(v1[j].x, v1[j].y); w1.y = pk2(v1[j].z, v1[j].w); xo0[64 * j] = w0; xo1[64 * j] = w1; } }
#pragma unroll
            for (int j = 0; j < 8; ++j) { s0 += (v0[j].x * v0[j].x + v0[j].y * v0[j].y) + (v0[j].z * v0[j].z + v0[j].w * v0[j].w); s1 += (v1[j].x * v1[j].x + v1[j].y * v1[j].y) + (v1[j].z * v1[j].z + v1[j].w * v1[j].w); }
            const float rstd0 = rsqrtf(wave_sum(s0) * (1.0f / 2048.0f) + EPS), rstd1 = rsqrtf(wave_sum(s1) * (1.0f / 2048.0f) + EPS);
            if constexpr (QI8) {
                float m0 = 0.f, m1 = 0.f;
#pragma unroll
                for (int j = 0; j < 8; ++j) { const f32x4 p = v0[j] * rstd0 * A[j] + B[j], q = v1[j] * rstd1 * A[j] + B[j];
                    m0 = fmaxf(fmaxf(m0, fmaxf(fabsf(p.x), fabsf(p.y))), fmaxf(fabsf(p.z), fabsf(p.w))); m1 = fmaxf(fmaxf(m1, fmaxf(fabsf(q.x), fabsf(q.y))), fmaxf(fabsf(q.z), fabsf(q.w))); }
#pragma unroll
                for (int o_ = 1; o_ < 64; o_ <<= 1) { m0 = fmaxf(m0, __shfl_xor(m0, o_)); m1 = fmaxf(m1, __shfl_xor(m1, o_)); }
                const float i0 = m0 > 0.f ? 127.0f / m0 : 0.f, i1 = m1 > 0.f ? 127.0f / m1 : 0.f;
                GAS unsigned* q0 = (GAS unsigned*)(HI8 + (size_t)(r0 + r) * 2048) + lane; GAS unsigned* q1 = q0 + 512;
#pragma unroll
                for (int j = 0; j < 8; ++j) {
                    __hip_atomic_store(q0 + 64 * j, pk_i8x4((v0[j] * rstd0 * A[j] + B[j]) * i0), __ATOMIC_RELAXED, __HIP_MEMORY_SCOPE_AGENT); __hip_atomic_store(q1 + 64 * j, pk_i8x4((v1[j] * rstd1 * A[j] + B[j]) * i1), __ATOMIC_RELAXED, __HIP_MEMORY_SCOPE_AGENT); }
                if (lane == 0) { __hip_atomic_store((GAS unsigned*)(HS + r0 + r), __float_as_uint(m0 * (1.0f / 127.0f)), __ATOMIC_RELAXED, __HIP_MEMORY_SCOPE_AGENT); __hip_atomic_store((GAS unsigned*)(HS + r0 + r + 1), __float_as_uint(m1 * (1.0f / 127.0f)), __ATOMIC_RELAXED, __HIP_MEMORY_SCOPE_AGENT); }
                if (H) { GAS v2u* o8 = (GAS v2u*)(H + (size_t)(r0 + r) * 2048) + lane;
#pragma unroll
                    for (int j = 0; j < 8; ++j) { const f32x4 o = v0[j] * rstd0 * A[j] + B[j], p = v1[j] * rstd1 * A[j] + B[j]; v2u w; w.x = pk2(o.x, o.y); w.y = pk2(o.z, o.w); o8[64 * j] = w; w.x = pk2(p.x, p.y); w.y = pk2(p.z, p.w); o8[512 + 64 * j] = w; } }
            } else {
            GAS v2u* o8 = (GAS v2u*)(H + (size_t)(r0 + r) * 2048) + lane;
#pragma unroll
            for (int j = 0; j < 8; ++j) { const f32x4 o = v0[j] * rstd0 * A[j] + B[j]; v2u w; w.x = pk2(o.x, o.y); w.y = pk2(o.z, o.w); o8[64 * j] = w; }
#pragma unroll
            for (int j = 0; j < 8; ++j) { const f32x4 o = v1[j] * rstd1 * A[j] + B[j]; v2u w; w.x = pk2(o.x, o.y); w.y = pk2(o.z, o.w); o8[512 + 64 * j] = w; }
            }
        }
    }
}
__device__ __forceinline__ void phase_final(const bf16* XS, const bf16* D, float* xout, int gw, int NGW, int lane) {
    for (int r = 2 * gw; r < CH; r += 2 * NGW) {
        const GAS v2u* xr0 = (const GAS v2u*)(XS + (size_t)r * 2048) + lane; const GAS v2u* xr1 = xr0 + 512; const GAS v2u* d0 = (const GAS v2u*)(D + (size_t)r * 2048) + lane; const GAS v2u* d1 = d0 + 512;
        v2u x0[8], x1[8], e0[8], e1[8];
#pragma unroll
        for (int j = 0; j < 8; ++j) { x0[j] = xr0[64 * j]; x1[j] = xr1[64 * j]; e0[j] = d0[64 * j]; e1[j] = d1[64 * j]; }
        GAS f32x4* xo0 = (GAS f32x4*)(xout + (size_t)r * 2048) + lane; GAS f32x4* xo1 = xo0 + 512;
#pragma unroll
        for (int j = 0; j < 8; ++j) { xo0[64 * j] = up4(x0[j]) + up4(e0[j]); xo1[64 * j] = up4(x1[j]) + up4(e1[j]); }
    }
}
__device__ __forceinline__ int perm_tok(int p, int dsh, int Lsh) { return dsh == 0 ? p : (((p & ((1 << Lsh) - 1)) << dsh) + (p >> Lsh)); }
__device__ __forceinline__ void prep_qk_item(const bf16* Z, bf16* QK, const AL& a, int l, int item, int S, int tshift, int lane) {
    const int slot = item & 31, rb = item >> 5;
    int srccol, dstcol, dsh = 0, kind = 0; const float* gain; float scale = 1.f;
    if (slot < 4) { srccol = 128 * slot; dstcol = 128 * slot; gain = a.in(I_QNA) + l * 128; scale = QS128; }
    else if (slot < 8) { const int j = slot - 4; srccol = 512 + 128 * j; dstcol = 512 + 128 * j; gain = a.in(I_KNA) + l * 128; }
    else if (slot < 14) { const int j = slot - 8; srccol = 1536 + 128 * j; dstcol = 1024 + 128 * j; kind = 1; gain = a.in(I_QNB) + l * 128; scale = QS128; dsh = 2 * (j >> 1); }
    else if (slot < 20) { const int j = slot - 14; srccol = 2304 + 128 * j; dstcol = 1792 + 128 * j; kind = 1; gain = a.in(I_KNB) + l * 128; dsh = 2 * (j >> 1); }
    else if (slot < 26) { const int j = slot - 20; srccol = 3840 + 128 * j; dstcol = 2560 + 128 * j; kind = 2; gain = a.in(I_QNC) + l * 64; scale = QS64; }
    else { const int j = slot - 26; srccol = 4608 + 128 * j; dstcol = 3328 + 128 * j; kind = 2; gain = a.in(I_KNC) + l * 64; }
    const int sub = lane & 15, Lsh = tshift - dsh;
    float g[8];
#pragma unroll
    for (int e = 0; e < 8; ++e) g[e] = gain[((8 * sub) & (kind == 2 ? 63 : 127)) + e];
    const float2* ropeB = (const float2*)(a.ws() + WS_ROPEB); const float2* ropeC = (const float2*)(a.ws() + WS_ROPEC);
    const int RS = kind == 1 ? 2 : 1, subg = kind == 1 ? sub : (sub & 7);
    const bool roper = kind != 0 && subg < 2 * RS, first = subg < RS; const int ib = 8 * (subg & (RS - 1));
    for (int p4 = 0; p4 < 16; p4 += 4) {
        v4u w[4]; int tt[4]; float2 cs[4][8];
#pragma unroll
        for (int q = 0; q < 4; ++q) { const int orow = rb * 64 + (p4 + q) * 4 + (lane >> 4), sl = orow >> tshift, p = orow & (S - 1);
            tt[q] = perm_tok(p, dsh, Lsh);
            w[q] = *(const GAS v4u*)(Z + (size_t)((sl << tshift) + tt[q]) * 6144 + srccol + 8 * sub); }
        if (roper) {
#pragma unroll
            for (int q = 0; q < 4; ++q) { const float2* tab = kind == 1 ? ropeB + tt[q] * 16 + ib : ropeC + tt[q] * 8 + ib;
#pragma unroll
                for (int e = 0; e < 8; ++e) cs[q][e] = tab[e]; } }
#pragma unroll
        for (int q = 0; q < 4; ++q) { const int orow = rb * 64 + (p4 + q) * 4 + (lane >> 4);
            float y[8] = {bflo(w[q].x), bfhi(w[q].x), bflo(w[q].y), bfhi(w[q].y), bflo(w[q].z), bfhi(w[q].z), bflo(w[q].w), bfhi(w[q].w)};
            float ss = 0.f;
#pragma unroll
            for (int e = 0; e < 8; ++e) ss += y[e] * y[e];
            ss += __shfl_xor(ss, 1); ss += __shfl_xor(ss, 2); ss += __shfl_xor(ss, 4);
            if (kind != 2) ss += __shfl_xor(ss, 8);
            const float rstd = rsqrtf(ss * (kind == 2 ? (1.0f / 64.0f) : (1.0f / 128.0f)) + EPS);
#pragma unroll
            for (int e = 0; e < 8; ++e) y[e] = y[e] * rstd * g[e];
            if (kind != 0) {
                float pr[8];
#pragma unroll
                for (int e = 0; e < 8; ++e) pr[e] = __shfl_xor(y[e], RS);
                if (roper) {
#pragma unroll
                    for (int e = 0; e < 8; ++e) y[e] = first ? y[e] * cs[q][e].x - pr[e] * cs[q][e].y : y[e] * cs[q][e].x + pr[e] * cs[q][e].y; }
            }
            v4u o; o.x = pk2(y[0] * scale, y[1] * scale); o.y = pk2(y[2] * scale, y[3] * scale); o.z = pk2(y[4] * scale, y[5] * scale); o.w = pk2(y[6] * scale, y[7] * scale);
            *(GAS v4u*)(QK + (size_t)orow * 4096 + dstcol + 8 * sub) = o; }
    }
}
struct VtItem { int srccol, dsh, sl, p0, vrow; };
__device__ __forceinline__ VtItem vt_decode(int item, int S, int tshift, int nvh) {
    const int dh = item & 1, vh = 10 + (item >> 1) % nvh, pb = item / (2 * nvh); VtItem v; v.dsh = 0;
    v.srccol = 128 * vh; if (vh >= 4 && vh < 10) v.dsh = 2 * ((vh - 4) >> 1);
    v.srccol += 64 * dh; const int o0 = pb * 64; v.sl = o0 >> tshift; v.p0 = o0 & (S - 1); v.vrow = (v.sl * 16 + vh) * 128 + 64 * dh; return v;
}
__device__ __forceinline__ void vt_load(const bf16* Z, const VtItem& v, int tshift, v4u (&w)[8], int lane) {
    const int Lsh = tshift - v.dsh;
#pragma unroll
    for (int pass = 0; pass < 8; ++pass) { const int i = pass * 8 + (lane >> 3), c8 = lane & 7, t = perm_tok(v.p0 + i, v.dsh, Lsh);
        w[pass] = *(const GAS v4u*)(Z + (size_t)((v.sl << tshift) + t) * 2048 + v.srccol + 8 * c8); }
}
__device__ __forceinline__ void vt_store(bf16* VT, const VtItem& v, int S, const v4u (&w)[8], LAS unsigned short* T, int lane) {
#pragma unroll
    for (int pass = 0; pass < 8; ++pass) { const int i = pass * 8 + (lane >> 3), c8 = lane & 7;
        LAS unsigned short* tp = T + (8 * c8) * 68 + i;
        tp[0 * 68] = (unsigned short)(w[pass].x & 0xffffu); tp[1 * 68] = (unsigned short)(w[pass].x >> 16); tp[2 * 68] = (unsigned short)(w[pass].y & 0xffffu); tp[3 * 68] = (unsigned short)(w[pass].y >> 16);
        tp[4 * 68] = (unsigned short)(w[pass].z & 0xffffu); tp[5 * 68] = (unsigned short)(w[pass].z >> 16); tp[6 * 68] = (unsigned short)(w[pass].w & 0xffffu); tp[7 * 68] = (unsigned short)(w[pass].w >> 16); }
    LDS_WAIT(); asm volatile("" ::: "memory");
#pragma unroll
    for (int pass = 0; pass < 16; ++pass) { const int d = pass * 4 + (lane >> 4), c4 = lane & 15;
        const v2u x = *(const LAS v2u*)(T + d * 68 + 4 * c4);
        *(GAS v2u*)(VT + (size_t)(v.vrow + d) * S + v.p0 + 4 * c4) = x; }
    LDS_WAIT(); asm volatile("" ::: "memory");
}
__device__ __forceinline__ void phase_prep(const AL& a, int l, LAS unsigned char* lds, int S, int tshift, int gw, int NGW, int wave, int lane) {
    const bf16* Z = (const bf16*)(a.ws() + A_Z); bf16* VT = (bf16*)(a.ws() + A_VT);
    LAS unsigned short* T = (LAS unsigned short*)(lds + RING_OFF + wave * 16384);
    const int nvh = 6;
    { int it = gw; const int NIT = (CH / 64) * 2 * nvh;
      if (it < NIT) { VtItem cur = vt_decode(it, S, tshift, nvh); v4u w[8]; vt_load(Z, cur, tshift, w, lane);
          for (;;) { const int nx = it + NGW; const bool more = nx < NIT; VtItem nv = cur; v4u wn[8];
              if (more) { nv = vt_decode(nx, S, tshift, nvh); vt_load(Z, nv, tshift, wn, lane); }
              vt_store(VT, cur, S, w, T, lane);
              if (!more) break;
              cur = nv; it = nx;
#pragma unroll
              for (int i = 0; i < 8; ++i) w[i] = wn[i]; } } }
}

namespace att {
#define MFMA32(a, b, c) __builtin_amdgcn_mfma_f32_32x32x16_bf16((a), (b), (c), 0, 0, 0)
__device__ __forceinline__ float ex2(float x) { return __builtin_amdgcn_exp2f(x); }
struct MaskNone { static constexpr bool MASKED = false; __device__ __forceinline__ float operator()(float v, int) const { return v; } };
struct MaskB { static constexpr bool MASKED = true; int dq;
    __device__ __forceinline__ float operator()(float v, int koff) const { const int d = dq + koff; return (d >= -64 && d <= 64) ? v : NEGB; } };
struct MaskA { static constexpr bool MASKED = true; const LAS float* brow; int kc0, qc, cs;
    __device__ __forceinline__ float operator()(float v, int koff) const { const int kc = kc0 + koff; int di = kc - qc + 15; di = di < 0 ? 0 : (di > 30 ? 30 : di);
        const float b = brow[di]; return (kc >= cs && kc < cs + 16) ? v + b : NEGB; } };

template <int NK, class MaskFn>
__device__ __forceinline__ void tile_core(const bf16x8 (&kf)[NK], const bf16x8 (&vf)[4][2], const bf16x8 (&qf)[NK], f32x16 (&o)[4], float& m, float& l, int lane, const MaskFn& mf) {
    const int hi = lane >> 5;
    f32x16 s;
#pragma unroll
    for (int r = 0; r < 16; ++r) s[r] = 0.f;
#pragma unroll
    for (int d0 = 0; d0 < NK; ++d0) s = MFMA32(kf[d0], qf[d0], s);
    float mx = NEGB;
#pragma unroll
    for (int r = 0; r < 16; ++r) { s[r] = mf(s[r], 16 * (r >> 3) + 8 * hi + (r & 7)); mx = fmaxf(mx, s[r]); }
    mx = max32(mx);
    const float mn = fmaxf(m, mx), alpha = ex2(m - mn);
    float ps = 0.f;
#pragma unroll
    for (int r = 0; r < 16; ++r) { float p = ex2(s[r] - mn); if (MaskFn::MASKED) p = s[r] <= -1e29f ? 0.f : p; s[r] = p; ps += p; }
    l = l * alpha + ps; m = mn;
    if (!__all(alpha == 1.0f)) {
#pragma unroll
        for (int db = 0; db < 4; ++db)
#pragma unroll
            for (int r = 0; r < 16; ++r) o[db][r] *= alpha;
    }
    bf16x8 pf[2];
#pragma unroll
    for (int s2 = 0; s2 < 2; ++s2) { v4u w; w.x = pk2(s[8 * s2 + 0], s[8 * s2 + 1]); w.y = pk2(s[8 * s2 + 2], s[8 * s2 + 3]); w.z = pk2(s[8 * s2 + 4], s[8 * s2 + 5]); w.w = pk2(s[8 * s2 + 6], s[8 * s2 + 7]); pf[s2] = __builtin_bit_cast(bf16x8, w); }
#pragma unroll
    for (int db = 0; db < 4; ++db)
#pragma unroll
        for (int s2 = 0; s2 < 2; ++s2) o[db] = MFMA32(vf[db][s2], pf[s2], o[db]);
}
template <int NK, class MaskFn>
__device__ __forceinline__ void tile_step(const bf16* Kt, const bf16* VTt, int S, const bf16x8 (&qf)[NK], f32x16 (&o)[4], float& m, float& l, int lane, const MaskFn& mf) {
    const int r32 = lane & 31, hi = lane >> 5;
    const int pim = (r32 & 19) | ((r32 & 4) << 1) | ((r32 & 8) >> 1);
    const bf16* kp = Kt + (size_t)pim * 4096 + 8 * hi;
    bf16x8 kf[NK];
#pragma unroll
    for (int d0 = 0; d0 < NK; ++d0) kf[d0] = *(const GAS bf16x8*)(kp + 16 * d0);
    bf16x8 vf[4][2];
    const bf16* vp = VTt + (size_t)r32 * S + 8 * hi;
#pragma unroll
    for (int db = 0; db < 4; ++db)
#pragma unroll
        for (int s2 = 0; s2 < 2; ++s2) vf[db][s2] = *(const GAS bf16x8*)(vp + (size_t)(32 * db) * S + 16 * s2);
    tile_core<NK, MaskFn>(kf, vf, qf, o, m, l, lane, mf);
}
template <int NK> __device__ __forceinline__ void load_q(const bf16* Qp, bf16x8 (&qf)[NK], int lane) {
    const bf16* q = Qp + (size_t)(lane & 31) * 4096 + 8 * (lane >> 5);
#pragma unroll
    for (int d0 = 0; d0 < NK; ++d0) qf[d0] = *(const GAS bf16x8*)(q + 16 * d0);
}
__device__ __forceinline__ void zero_o(f32x16 (&o)[4]) {
#pragma unroll
    for (int db = 0; db < 4; ++db)
#pragma unroll
        for (int r = 0; r < 16; ++r) o[db][r] = 0.f;
}
__device__ __forceinline__ void store_o_bf16(bf16* dst, const f32x16 (&o)[4], float inv, int hi) {
#pragma unroll
    for (int db = 0; db < 4; ++db)
#pragma unroll
        for (int g = 0; g < 4; ++g) { v2u w; w.x = pk2(o[db][4 * g] * inv, o[db][4 * g + 1] * inv); w.y = pk2(o[db][4 * g + 2] * inv, o[db][4 * g + 3] * inv);
            *(GAS v2u*)(dst + 32 * db + 8 * g + 4 * hi) = w; }
}
__device__ __forceinline__ void store_o_f32(float* dst, const f32x16 (&o)[4], float inv, int hi) {
#pragma unroll
    for (int db = 0; db < 4; ++db)
#pragma unroll
        for (int g = 0; g < 4; ++g) { const f32x4 v = {o[db][4 * g] * inv, o[db][4 * g + 1] * inv, o[db][4 * g + 2] * inv, o[db][4 * g + 3] * inv};
            *(GAS f32x4*)(dst + 32 * db + 8 * g + 4 * hi) = v; }
}
__device__ __forceinline__ void wave_c(const bf16* QK, const bf16* VT, float* CTMP, int sl, int map, int q0, int S, int tshift, int lane) {
    const size_t row0 = (size_t)sl << tshift; const int hi = lane >> 5;
    const bf16* Kp = QK + row0 * 4096 + 3328 + 64 * map;
    const bf16* Vp = VT + (size_t)((sl * 16 + 10 + (map >> 1)) * 128) * S;
    bf16x8 qf[4]; load_q<4>(QK + (row0 + q0) * 4096 + 2560 + 64 * map, qf, lane);
    f32x16 o[4]; zero_o(o); float m = NEGB, l = 0.f; const MaskNone mf;
    for (int kb = 0; kb < S; kb += 32) tile_step<4, MaskNone>(Kp + (size_t)kb * 4096, Vp + kb, S, qf, o, m, l, lane, mf);
    l = sum32(l);
    store_o_f32(CTMP + (row0 + q0 + (lane & 31)) * 1536 + map * 128, o, 1.0f / l, hi);
}
__device__ __forceinline__ void wave_b(const bf16* QK, const bf16* VT, bf16* BTMP, float* BLSE, int sl, int slot, int p0, int S, int tshift, int lane) {
    const size_t row0 = (size_t)sl << tshift; const int hi = lane >> 5, dsh = 2 * (slot >> 1), Lsh = tshift - dsh;
    const bf16* Kp = QK + row0 * 4096 + 1792 + 128 * slot;
    const bf16* Vp = VT + (size_t)((sl * 16 + 4 + slot) * 128) * S;
    bf16x8 qf[8]; load_q<8>(QK + (row0 + p0) * 4096 + 1024 + 128 * slot, qf, lane);
    f32x16 o[4]; zero_o(o); float m = NEGB, l = 0.f;
    const int qp = p0 + (lane & 31);
#pragma unroll 1
    for (int ti = 0; ti < 5; ++ti) { const int kb = p0 - 64 + 32 * ti;
        if (kb < 0 || kb >= S || (kb >> Lsh) != (p0 >> Lsh)) continue;
        const MaskB mf{kb - qp};
        tile_step<8, MaskB>(Kp + (size_t)kb * 4096, Vp + kb, S, qf, o, m, l, lane, mf); }
    l = sum32(l);
    const int t = perm_tok(qp, dsh, Lsh);
    store_o_bf16(BTMP + (row0 + t) * 768 + slot * 128, o, 1.0f / l, hi);
    if (hi == 0) ((GAS float*)BLSE)[(row0 + t) * 8 + slot] = (__log2f(l) + m) * LN2;
}
__device__ __forceinline__ void wave_a(const bf16* QK, const bf16* VT, bf16* OA, const LAS float* btab, int sl, int h, int r, int qh, int S, int tshift, int lane) {
    const size_t row0 = (size_t)sl << tshift; const int hi = lane >> 5, rows = S >> 6;
    int rs = r - 4; rs = rs < 0 ? 0 : (rs > rows - 8 ? rows - 8 : rs);
    const bf16* Kp = QK + row0 * 4096 + 512 + 128 * h;
    const bf16* Vp = VT + (size_t)((sl * 16 + h) * 128) * S;
    const int q0 = r * 64 + 32 * qh, qc = 32 * qh + (lane & 31);
    int cs = qc - 8; cs = cs < 0 ? 0 : (cs > 48 ? 48 : cs);
    bf16x8 qf[8]; load_q<8>(QK + (row0 + q0) * 4096 + 128 * h, qf, lane);
    f32x16 o[4]; zero_o(o); float m = NEGB, l = 0.f;
#pragma unroll 1
    for (int ti = 0; ti < 16; ++ti) { const int j = ti >> 1, chh = ti & 1, kb = (rs + j) * 64 + 32 * chh;
        const MaskA mf{btab + (rs + j - r + 7) * 31, 32 * chh, qc, cs};
        tile_step<8, MaskA>(Kp + (size_t)kb * 4096, Vp + kb, S, qf, o, m, l, lane, mf); }
    l = sum32(l);
    store_o_bf16(OA + (row0 + q0 + (lane & 31)) * 1536 + h * 128, o, 1.0f / l, hi);
}

constexpr int CST = 24576;
__device__ __forceinline__ void glds16(const void* gsrc, unsigned lds_dst) { unsigned keep;
    asm volatile("s_mov_b32 %0, m0\n\ts_mov_b32 m0, %2\n\ts_nop 0\n\tglobal_load_lds_dwordx4 %1, off\n\ts_mov_b32 m0, %0" : "=&s"(keep) : "v"(gsrc), "s"(lds_dst) : "memory"); }
__device__ __forceinline__ void c_dma(const bf16* Kp, const bf16* Vp, int S, int kb, unsigned sb, int wave, int lane) {
    { const int row = 8 * wave + (lane >> 3), c = (lane & 7) ^ ((row >> 1) & 7);
      glds16(Kp + (size_t)(kb + row) * 4096 + 8 * c, (unsigned)__builtin_amdgcn_readfirstlane(sb + wave * 1024)); }
#pragma unroll
    for (int jj = 0; jj < 2; ++jj) { const int j = wave + 8 * jj, row = 8 * j + (lane >> 3), c = (lane & 7) ^ ((row >> 1) & 7);
      glds16(Vp + (size_t)row * S + kb + 8 * c, (unsigned)__builtin_amdgcn_readfirstlane(sb + 8192 + j * 1024)); }
}
#define C_WAIT_BAR(N) asm volatile("s_waitcnt vmcnt(" #N ")\n\ts_barrier" ::: "memory")
__device__ __forceinline__ void unit_c_fast(const bf16* QK, const bf16* VT, float* CTMP, LAS unsigned char* ring, int sl, int map, int qb, int S, int tshift, int wave, int lane) {
    constexpr int CV = 0;
    const size_t row0 = (size_t)sl << tshift; const int r32 = lane & 31, hi = lane >> 5, q0 = qb * 256 + 32 * wave;
    const bf16* Kp = QK + row0 * 4096 + 3328 + 64 * map;
    const bf16* Vp = VT + (size_t)((sl * 16 + 10 + (map >> 1)) * 128) * S;
    bf16x8 qf[4]; load_q<4>(QK + (row0 + q0) * 4096 + 2560 + 64 * map, qf, lane);
    const int pim = (r32 & 19) | ((r32 & 4) << 1) | ((r32 & 8) >> 1);
    int ka[4], va[4];
#pragma unroll
    for (int d0 = 0; d0 < 4; ++d0) ka[d0] = pim * 128 + (((2 * d0 + hi) ^ ((pim >> 1) & 7)) << 4);
#pragma unroll
    for (int x = 0; x < 4; ++x) va[x] = 8192 + r32 * 128 + (((2 * x + hi) ^ ((r32 >> 1) & 7)) << 4);
    f32x16 o[4]; zero_o(o); float l = 0.f;
    const int NT = S >> 6;
#pragma unroll
    for (int d0 = 0; d0 < 4; ++d0) asm volatile("" : "+v"(qf[d0]));
    asm volatile("s_waitcnt vmcnt(0)\n\ts_barrier" ::: "memory");
    const unsigned ring_a = (unsigned)(size_t)ring;
    c_dma(Kp, Vp, S, 0, ring_a, wave, lane); c_dma(Kp, Vp, S, 64, ring_a + CST, wave, lane);
    int st_cur = 0, st_nxt2 = 2 * CST;
#pragma unroll 1
    for (int t = 0; t < NT; ++t) {
        if (t + 1 < NT) C_WAIT_BAR(3); else C_WAIT_BAR(0);
        if (t + 2 < NT) c_dma(Kp, Vp, S, (t + 2) * 64, ring_a + st_nxt2, wave, lane);
        const LAS unsigned char* sb = ring + st_cur;
        bf16x8 kf[2][4];
#pragma unroll
        for (int st = 0; st < 2; ++st)
#pragma unroll
            for (int d0 = 0; d0 < 4; ++d0) { if (CV & 2) kf[st][d0] = qf[(d0 + st) & 3]; else kf[st][d0] = *(const LAS bf16x8*)(sb + st * 4096 + ka[d0]); }
        f32x16 s[2];
#pragma unroll
        for (int st = 0; st < 2; ++st) {
#pragma unroll
            for (int r = 0; r < 16; ++r) s[st][r] = 0.f;
#pragma unroll
            for (int d0 = 0; d0 < 4; ++d0) s[st] = MFMA32(kf[st][d0], qf[d0], s[st]); }
#pragma unroll
        for (int st = 0; st < 2; ++st) {
            bf16x8 vf[4][2];
#pragma unroll
            for (int db = 0; db < 4; ++db)
#pragma unroll
                for (int s2 = 0; s2 < 2; ++s2) vf[db][s2] = *(const LAS bf16x8*)(sb + db * 4096 + va[2 * st + s2]);
#pragma unroll
            for (int r = 0; r < 16; ++r) { s[st][r] = ex2(s[st][r]); l += s[st][r]; }
            bf16x8 pf[2];
#pragma unroll
            for (int s2 = 0; s2 < 2; ++s2) { v4u w; w.x = pk2(s[st][8 * s2 + 0], s[st][8 * s2 + 1]); w.y = pk2(s[st][8 * s2 + 2], s[st][8 * s2 + 3]); w.z = pk2(s[st][8 * s2 + 4], s[st][8 * s2 + 5]); w.w = pk2(s[st][8 * s2 + 6], s[st][8 * s2 + 7]); pf[s2] = __builtin_bit_cast(bf16x8, w); }
#pragma unroll
            for (int db = 0; db < 4; ++db)
#pragma unroll
                for (int s2 = 0; s2 < 2; ++s2) o[db] = MFMA32(vf[db][s2], pf[s2], o[db]);
        }
        st_cur = st_cur == 2 * CST ? 0 : st_cur + CST; st_nxt2 = st_nxt2 == 2 * CST ? 0 : st_nxt2 + CST;
    }
    l = sum32(l);
    store_o_f32(CTMP + (row0 + q0 + r32) * 1536 + map * 128, o, 1.0f / l, hi);
}

constexpr int CST2 = 32768, CEXP = 132;
typedef short v4i16_t __attribute__((ext_vector_type(4)));
__device__ __forceinline__ v4i16_t vtr(const LAS unsigned char* p) { return __builtin_amdgcn_ds_read_tr16_b64_v4i16((LAS v4i16_t*)p); }
__device__ __forceinline__ void c2_dma(const bf16* Kp0, const bf16* Vrow, int kb, unsigned sb, int wave, int lane) {
    { const int row = 8 * wave + (lane >> 3), c = (lane & 7) ^ ((row >> 1) & 7);
      const bf16* src = Kp0 + (size_t)(kb + row) * 4096 + 8 * c;
      glds16(src, (unsigned)__builtin_amdgcn_readfirstlane(sb + wave * 1024));
      glds16(src + 64, (unsigned)__builtin_amdgcn_readfirstlane(sb + 8192 + wave * 1024)); }
#pragma unroll
    for (int jj = 0; jj < 2; ++jj) { const int j = wave + 8 * jj, st = j >> 3, row = 4 * (j & 7) + (lane >> 4), ch = (lane & 15) ^ (((row & 3) << 2) | ((row >> 2) & 3));
      glds16(Vrow + (size_t)(kb + 32 * st + row) * 2048 + 8 * ch, (unsigned)__builtin_amdgcn_readfirstlane(sb + 16384 + j * 1024)); }
}
template <int CV = 0>
__device__ __forceinline__ void unit_c_fused(const bf16* QK, const bf16* Zv, bf16* OC, const float* subln, float lam, float onemli, LAS unsigned char* ring, int sl, int h, int qb, int S, int tshift, int wave, int lane) {
    const size_t row0 = (size_t)sl << tshift; const int r32 = lane & 31, hi = lane >> 5, mp = wave >> 2, q0 = qb * 128 + 32 * (wave & 3);
    const bf16* Kp0 = QK + row0 * 4096 + 3328 + 128 * h;
    const bf16* Vrow = Zv + row0 * 2048 + 1280 + 128 * h;
    bf16x8 qf[4]; load_q<4>(QK + (row0 + q0) * 4096 + 2560 + 128 * h + 64 * mp, qf, lane);
    const int pim = (r32 & 19) | ((r32 & 4) << 1) | ((r32 & 8) >> 1);
    int ka[4];
#pragma unroll
    for (int d0 = 0; d0 < 4; ++d0) ka[d0] = mp * 8192 + pim * 128 + (((2 * d0 + hi) ^ ((pim >> 1) & 7)) << 4);
    const int tq = (lane & 15) >> 2, tp = lane & 3, tblk = (lane >> 4) & 1;
    const int vlane = 16384 + 256 * (8 * hi + tq) + 8 * (tp & 1);
    int vo[4][2];
#pragma unroll
    for (int db = 0; db < 4; ++db)
#pragma unroll
        for (int t = 0; t < 2; ++t) vo[db][t] = vlane + 1024 * t + 16 * ((((db ^ tq) & 3) << 2) | ((2 * tblk + (tp >> 1)) ^ ((2 * hi + t) & 3)));
    f32x16 o[4]; zero_o(o); float l = 0.f;
    const int NT = S >> 6;
#pragma unroll
    for (int d0 = 0; d0 < 4; ++d0) asm volatile("" : "+v"(qf[d0]));
    asm volatile("s_waitcnt vmcnt(0)\n\ts_barrier" ::: "memory");
    const unsigned ring_a = (unsigned)(size_t)ring;
    c2_dma(Kp0, Vrow, 0, ring_a, wave, lane); c2_dma(Kp0, Vrow, 64, ring_a + CST2, wave, lane);
    int st_cur = 0, st_nxt2 = 2 * CST2;
    if (CV & 16) C_WAIT_BAR(0);
#pragma unroll 1
    for (int t = 0; t < NT; ++t) {
        if (!(CV & 16)) { if (t + 1 < NT) C_WAIT_BAR(4); else C_WAIT_BAR(0); }
        const LAS unsigned char* sb = ring + st_cur;
        bf16x8 kf[2][4];
#pragma unroll
        for (int st = 0; st < 2; ++st)
#pragma unroll
            for (int d0 = 0; d0 < 4; ++d0) { if (CV & 2) kf[st][d0] = qf[(d0 + st) & 3]; else kf[st][d0] = *(const LAS bf16x8*)(sb + st * 4096 + ka[d0]); }
        f32x16 s[2];
#pragma unroll
        for (int st = 0; st < 2; ++st) {
#pragma unroll
            for (int r = 0; r < 16; ++r) s[st][r] = 0.f;
#pragma unroll
            for (int d0 = 0; d0 < 4; ++d0) s[st] = MFMA32(kf[st][d0], qf[d0], s[st]); }
        if (!(CV & 8)) if (t + 2 < NT) c2_dma(Kp0, Vrow, (t + 2) * 64, ring_a + st_nxt2, wave, lane);
#pragma unroll
        for (int st = 0; st < 2; ++st) {
            bf16x8 vf[4][2];
#pragma unroll
            for (int db = 0; db < 4; ++db)
#pragma unroll
                for (int s2 = 0; s2 < 2; ++s2) { if (CV & 4) { vf[db][s2] = qf[(db + s2) & 3]; } else { const v4i16_t lo = vtr(sb + st * 8192 + s2 * 4096 + vo[db][0]), hi4 = vtr(sb + st * 8192 + s2 * 4096 + vo[db][1]);
                    vf[db][s2] = (bf16x8){lo[0], lo[1], lo[2], lo[3], hi4[0], hi4[1], hi4[2], hi4[3]}; } }
#pragma unroll
            for (int r = 0; r < 16; ++r) { if (!(CV & 1)) s[st][r] = ex2(s[st][r]); l += s[st][r]; }
            bf16x8 pf[2];
#pragma unroll
            for (int s2 = 0; s2 < 2; ++s2) { v4u w; w.x = pk2(s[st][8 * s2 + 0], s[st][8 * s2 + 1]); w.y = pk2(s[st][8 * s2 + 2], s[st][8 * s2 + 3]); w.z = pk2(s[st][8 * s2 + 4], s[st][8 * s2 + 5]); w.w = pk2(s[st][8 * s2 + 6], s[st][8 * s2 + 7]); pf[s2] = __builtin_bit_cast(bf16x8, w); }
#pragma unroll
            for (int db = 0; db < 4; ++db)
#pragma unroll
                for (int s2 = 0; s2 < 2; ++s2) o[db] = MFMA32(vf[db][s2], pf[s2], o[db]);
        }
        st_cur = st_cur == 2 * CST2 ? 0 : st_cur + CST2; st_nxt2 = st_nxt2 == 2 * CST2 ? 0 : st_nxt2 + CST2;
    }
    l = sum32(l);
    const float inv = 1.0f / l;
    f32x4 gnv[16];
    if (mp == 0) {
#pragma unroll
        for (int db = 0; db < 4; ++db)
#pragma unroll
            for (int g = 0; g < 4; ++g) gnv[db * 4 + g] = *(const GAS f32x4*)(subln + 32 * db + 8 * g + 4 * hi); }
    LAS float* ex = (LAS float*)ring + (32 * (wave & 3) + r32) * CEXP + 4 * hi;
    asm volatile("s_waitcnt lgkmcnt(0)\n\ts_barrier" ::: "memory");
    if (mp == 1) {
#pragma unroll
        for (int db = 0; db < 4; ++db)
#pragma unroll
            for (int g = 0; g < 4; ++g) *(LAS f32x4*)(ex + 32 * db + 8 * g) = (f32x4){o[db][4 * g] * inv, o[db][4 * g + 1] * inv, o[db][4 * g + 2] * inv, o[db][4 * g + 3] * inv};
    }
    asm volatile("s_waitcnt lgkmcnt(0)\n\ts_barrier" ::: "memory");
    if (mp == 0) {
        float ss = 0.f;
#pragma unroll
        for (int db = 0; db < 4; ++db)
#pragma unroll
            for (int g = 0; g < 4; ++g) { const f32x4 o2 = *(const LAS f32x4*)(ex + 32 * db + 8 * g);
#pragma unroll
                for (int e = 0; e < 4; ++e) { const float x = o[db][4 * g + e] * inv - lam * o2[e]; o[db][4 * g + e] = x; ss += x * x; } }
        ss = sum32(ss);
        const float rstd = rsqrtf(ss * (1.0f / 128.0f) + EPS) * onemli;
        bf16* dst = OC + (row0 + q0 + r32) * 1536 + h * 128;
#pragma unroll
        for (int db = 0; db < 4; ++db)
#pragma unroll
            for (int g = 0; g < 4; ++g) { const f32x4 gn = gnv[db * 4 + g];
                v2u w; w.x = pk2(o[db][4 * g] * rstd * gn[0], o[db][4 * g + 1] * rstd * gn[1]); w.y = pk2(o[db][4 * g + 2] * rstd * gn[2], o[db][4 * g + 3] * rstd * gn[3]);
                *(GAS v2u*)(dst + 32 * db + 8 * g + 4 * hi) = w; }
    }
}

constexpr int CSTA = 32768;
typedef short a_v4i16_t __attribute__((ext_vector_type(4)));
__device__ __forceinline__ a_v4i16_t a_vtr(const LAS unsigned char* p) { return __builtin_amdgcn_ds_read_tr16_b64_v4i16((LAS a_v4i16_t*)p); }
__device__ __forceinline__ void a_dma(const bf16* Kp, const bf16* Vrow, int kb, unsigned sb, int wave, int lane) {
#pragma unroll
    for (int jj = 0; jj < 2; ++jj) { const int j = wave + 8 * jj, row = 4 * j + (lane >> 4), c = (lane & 15) ^ (row & 15);
      glds16(Kp + (size_t)(kb + row) * 4096 + 8 * c, (unsigned)__builtin_amdgcn_readfirstlane(sb + j * 1024)); }
#pragma unroll
    for (int jj = 0; jj < 2; ++jj) { const int j = wave + 8 * jj, st = j >> 3, row = 4 * (j & 7) + (lane >> 4), ch = (lane & 15) ^ (((row & 3) << 2) | ((row >> 2) & 3));
      glds16(Vrow + (size_t)(kb + 32 * st + row) * 2048 + 8 * ch, (unsigned)__builtin_amdgcn_readfirstlane(sb + 16384 + j * 1024)); }
}
__device__ __forceinline__ void unit_a_lds(const bf16* QK, const bf16* Zv, bf16* OA, const float* rpb, LAS float* btab, LAS unsigned char* ring, int sl, int h, int qb, int S, int tshift, int wave, int lane, int tid) {
    const size_t row0 = (size_t)sl << tshift; const int r32 = lane & 31, hi = lane >> 5, rows = S >> 6;
    const int r = 4 * qb + (wave >> 1), qh = wave & 1;
    int rs = r - 4; rs = rs < 0 ? 0 : (rs > rows - 8 ? rows - 8 : rs);
    int kr_lo = 4 * qb - 4; kr_lo = kr_lo < 0 ? 0 : (kr_lo > rows - 8 ? rows - 8 : kr_lo);
    int kr_hi = 4 * qb - 1; kr_hi = (kr_hi < 0 ? 0 : (kr_hi > rows - 8 ? rows - 8 : kr_hi)) + 8;
    const int NT = kr_hi - kr_lo;
    const bf16* Kp = QK + row0 * 4096 + 512 + 128 * h;
    const bf16* Vrow = Zv + row0 * 2048 + 128 * h;
    const int q0 = r * 64 + 32 * qh, qc = 32 * qh + r32;
    int cs = qc - 8; cs = cs < 0 ? 0 : (cs > 48 ? 48 : cs);
    bf16x8 qf[8]; load_q<8>(QK + (row0 + q0) * 4096 + 128 * h, qf, lane);
    const int pim = (r32 & 19) | ((r32 & 4) << 1) | ((r32 & 8) >> 1);
    const int kbase = pim * 256, kx = pim & 15;
    const int tq = (lane & 15) >> 2, tp = lane & 3, tblk = (lane >> 4) & 1, vlane = 16384 + 256 * (8 * hi + tq) + 8 * (tp & 1);
    int vo[4][2];
#pragma unroll
    for (int db = 0; db < 4; ++db)
#pragma unroll
        for (int t = 0; t < 2; ++t) vo[db][t] = vlane + 1024 * t + 16 * ((((db ^ tq) & 3) << 2) | ((2 * tblk + (tp >> 1)) ^ ((2 * hi + t) & 3)));
    f32x16 o[4]; zero_o(o); float m = NEGB, l = 0.f;
#pragma unroll
    for (int d0 = 0; d0 < 8; ++d0) asm volatile("" : "+v"(qf[d0]));
    asm volatile("s_waitcnt vmcnt(0)\n\ts_barrier" ::: "memory");
    for (int e = tid; e < 15 * 31; e += NWAVES * 64) btab[e] = rpb[e] * LOG2E;
    asm volatile("s_waitcnt vmcnt(0) lgkmcnt(0)" ::: "memory");
    const unsigned ring_a = (unsigned)(size_t)ring;
    a_dma(Kp, Vrow, kr_lo * 64, ring_a, wave, lane); a_dma(Kp, Vrow, (kr_lo + 1) * 64, ring_a + CSTA, wave, lane);
    int st_cur = 0, st_nxt2 = 2 * CSTA;
#pragma unroll 1
    for (int t = 0; t < NT; ++t) { const int kr = kr_lo + t;
        if (t + 1 < NT) C_WAIT_BAR(4); else C_WAIT_BAR(0);
        if (t + 2 < NT) a_dma(Kp, Vrow, (kr + 2) * 64, ring_a + st_nxt2, wave, lane);
        if (kr >= rs && kr < rs + 8) { const LAS unsigned char* sb = ring + st_cur;
#pragma unroll 1
            for (int chh = 0; chh < 2; ++chh) {
                bf16x8 kf[8];
#pragma unroll
                for (int d0 = 0; d0 < 8; ++d0) kf[d0] = *(const LAS bf16x8*)(sb + chh * 8192 + kbase + (((2 * d0 + hi) ^ kx) << 4));
                bf16x8 vf[4][2];
#pragma unroll
                for (int db = 0; db < 4; ++db)
#pragma unroll
                    for (int s2 = 0; s2 < 2; ++s2) { const a_v4i16_t lo = a_vtr(sb + chh * 8192 + s2 * 4096 + vo[db][0]), hi4 = a_vtr(sb + chh * 8192 + s2 * 4096 + vo[db][1]);
                        vf[db][s2] = (bf16x8){lo[0], lo[1], lo[2], lo[3], hi4[0], hi4[1], hi4[2], hi4[3]}; }
                const MaskA mf{btab + (kr - r + 7) * 31, 32 * chh, qc, cs};
                tile_core<8, MaskA>(kf, vf, qf, o, m, l, lane, mf); } }
        st_cur = st_cur == 2 * CSTA ? 0 : st_cur + CSTA; st_nxt2 = st_nxt2 == 2 * CSTA ? 0 : st_nxt2 + CSTA;
    }
    l = sum32(l);
    store_o_bf16(OA + (row0 + q0 + r32) * 1536 + h * 128, o, 1.0f / l, hi);
}

struct MaskB2 { static constexpr bool MASKED = true; int qp, kp0, Lsh, qcls;
    __device__ __forceinline__ float operator()(float v, int koff) const { const int kp = kp0 + koff, d = kp - qp; return (d >= -64 && d <= 64 && (kp >> Lsh) == qcls) ? v : NEGB; } };
__device__ __forceinline__ void b_dma(const bf16* Kp, const bf16* Vrow, int S, int dsh, int Lsh, int kp0, unsigned sb, int wave, int lane) {
#pragma unroll
    for (int jj = 0; jj < 2; ++jj) { const int j = wave + 8 * jj, row = 4 * j + (lane >> 4), c = (lane & 15) ^ (row & 15);
      int kp = kp0 + row; kp = kp < 0 ? 0 : (kp > S - 1 ? S - 1 : kp);
      glds16(Kp + (size_t)kp * 4096 + 8 * c, (unsigned)__builtin_amdgcn_readfirstlane(sb + j * 1024)); }
#pragma unroll
    for (int jj = 0; jj < 2; ++jj) { const int j = wave + 8 * jj, st = j >> 3, row = 4 * (j & 7) + (lane >> 4), ch = (lane & 15) ^ (((row & 3) << 2) | ((row >> 2) & 3));
      int kp = kp0 + 32 * st + row; kp = kp < 0 ? 0 : (kp > S - 1 ? S - 1 : kp);
      glds16(Vrow + (size_t)perm_tok(kp, dsh, Lsh) * 2048 + 8 * ch, (unsigned)__builtin_amdgcn_readfirstlane(sb + 16384 + j * 1024)); }
}
__device__ __forceinline__ void unit_b_lds(const bf16* QK, const bf16* Zv, bf16* BTMP, float* BLSE, LAS unsigned char* ring, int sl, int slot, int pb, int S, int tshift, int wave, int lane) {
    const size_t row0 = (size_t)sl << tshift; const int r32 = lane & 31, hi = lane >> 5, dsh = 2 * (slot >> 1), Lsh = tshift - dsh;
    const int p0 = pb * 256, qp = p0 + 32 * wave + r32;
    const bf16* Kp = QK + row0 * 4096 + 1792 + 128 * slot;
    const bf16* Vrow = Zv + row0 * 2048 + 512 + 128 * slot;
    bf16x8 qf[8]; load_q<8>(QK + (row0 + p0 + 32 * wave) * 4096 + 1024 + 128 * slot, qf, lane);
    const int pim = (r32 & 19) | ((r32 & 4) << 1) | ((r32 & 8) >> 1);
    const int kbase = pim * 256, kx = pim & 15;
    const int tq = (lane & 15) >> 2, tp = lane & 3, tblk = (lane >> 4) & 1, vlane = 16384 + 256 * (8 * hi + tq) + 8 * (tp & 1);
    int vo[4][2];
#pragma unroll
    for (int db = 0; db < 4; ++db)
#pragma unroll
        for (int t = 0; t < 2; ++t) vo[db][t] = vlane + 1024 * t + 16 * ((((db ^ tq) & 3) << 2) | ((2 * tblk + (tp >> 1)) ^ ((2 * hi + t) & 3)));
    f32x16 o[4]; zero_o(o); float m = NEGB, l = 0.f;
#pragma unroll
    for (int d0 = 0; d0 < 8; ++d0) asm volatile("" : "+v"(qf[d0]));
    asm volatile("s_waitcnt vmcnt(0)\n\ts_barrier" ::: "memory");
    const unsigned ring_a = (unsigned)(size_t)ring;
    const int kpo = p0 - 64;
    b_dma(Kp, Vrow, S, dsh, Lsh, kpo, ring_a, wave, lane); b_dma(Kp, Vrow, S, dsh, Lsh, kpo + 64, ring_a + CSTA, wave, lane);
    int st_cur = 0, st_nxt2 = 2 * CSTA;
    const int jlo = wave >> 1, qcls = qp >> Lsh;
#pragma unroll 1
    for (int t = 0; t < 6; ++t) {
        if (t + 1 < 6) C_WAIT_BAR(4); else C_WAIT_BAR(0);
        if (t + 2 < 6) b_dma(Kp, Vrow, S, dsh, Lsh, kpo + 64 * (t + 2), ring_a + st_nxt2, wave, lane);
        if (t >= jlo && t <= jlo + 2) { const LAS unsigned char* sb = ring + st_cur;
#pragma unroll 1
            for (int chh = 0; chh < 2; ++chh) { const int ks = 64 * t + 32 * chh;
                if (ks + 32 <= 32 * wave || ks >= 32 * wave + 160) continue;
                bf16x8 kf[8];
#pragma unroll
                for (int d0 = 0; d0 < 8; ++d0) kf[d0] = *(const LAS bf16x8*)(sb + chh * 8192 + kbase + (((2 * d0 + hi) ^ kx) << 4));
                bf16x8 vf[4][2];
#pragma unroll
                for (int db = 0; db < 4; ++db)
#pragma unroll
                    for (int s2 = 0; s2 < 2; ++s2) { const a_v4i16_t lo = a_vtr(sb + chh * 8192 + s2 * 4096 + vo[db][0]), hi4 = a_vtr(sb + chh * 8192 + s2 * 4096 + vo[db][1]);
                        vf[db][s2] = (bf16x8){lo[0], lo[1], lo[2], lo[3], hi4[0], hi4[1], hi4[2], hi4[3]}; }
                const MaskB2 mf{qp, kpo + ks, Lsh, qcls};
                tile_core<8, MaskB2>(kf, vf, qf, o, m, l, lane, mf); } }
        st_cur = st_cur == 2 * CSTA ? 0 : st_cur + CSTA; st_nxt2 = st_nxt2 == 2 * CSTA ? 0 : st_nxt2 + CSTA;
    }
    l = sum32(l);
    const int tok = perm_tok(qp, dsh, Lsh);
    store_o_bf16(BTMP + (row0 + tok) * 768 + slot * 128, o, 1.0f / l, hi);
    if (hi == 0) ((GAS float*)BLSE)[(row0 + tok) * 8 + slot] = (__log2f(l) + m) * LN2;
}
}

template <int CV = 0>
__device__ __forceinline__ void phase_attn(const AL& a, int l, LAS unsigned char* lds, int S, int tshift, int tid, int wave, int lane, int types = 7) {
    const bf16* QK = (const bf16*)(a.ws() + A_QK); const bf16* VT = (const bf16*)(a.ws() + A_VT);
    const int nqb = S >> 8, nseq = CH >> tshift;
    const int G = gridDim.x, vid = (G % 8 == 0) ? (blockIdx.x % 8) * (G / 8) + blockIdx.x / 8 : blockIdx.x;
    if (types & 1) { float* CTMP = (float*)(a.ws() + A_CTMP); const float cbound = ((const float*)(a.ws() + WS_LAM))[2 + l];
      if (cbound <= 64.0f) { const int nq2 = S >> 7;
          const float lam = ((const float*)(a.ws() + WS_LAM))[l], onemli = 1.0f - (0.8f - 0.6f * expf(-0.3f * (float)l));
          bf16* OC = (bf16*)(a.ws() + A_OA) + 768; const float* subln = a.in(I_SUBLN) + l * 128;
          for (int u = vid; u < nseq * 6 * nq2; u += G) { const int qb = u % nq2, h = (u / nq2) % 6, sl = u / (nq2 * 6);
              att::unit_c_fused<CV>(QK, (const bf16*)(a.ws() + A_Z), OC, subln, lam, onemli, lds + RING_OFF, sl, h, qb, S, tshift, wave, lane); }
      } else {
          for (int u = vid; u < nseq * 12 * nqb; u += G) { const int qb = u % nqb, map = (u / nqb) % 12, sl = u / (nqb * 12);
              att::wave_c(QK, VT, CTMP, sl, map, qb * 256 + 32 * wave, S, tshift, lane); } } }
    if (types & 2) { bf16* OA = (bf16*)(a.ws() + A_OA); LAS float* btab = (LAS float*)(lds + LDSCTL_OFF + 1024);
      for (int u = vid; u < nseq * 4 * nqb; u += G) { const int qb = u % nqb, h = (u / nqb) % 4, sl = u / (nqb * 4);
          att::unit_a_lds(QK, (const bf16*)(a.ws() + A_Z), OA, a.in(I_RPB) + (size_t)(l * 4 + h) * 465, btab, lds + RING_OFF, sl, h, qb, S, tshift, wave, lane, tid); }
      __syncthreads(); }
    if (types & 4) { bf16* BTMP = (bf16*)(a.ws() + A_BTMP); float* BLSE = (float*)(a.ws() + A_BLSE);
      for (int u = vid; u < nseq * 6 * nqb; u += G) { const int pb = u % nqb, slot = (u / nqb) % 6, sl = u / (nqb * 6);
          att::unit_b_lds(QK, (const bf16*)(a.ws() + A_Z), BTMP, BLSE, lds + RING_OFF, sl, slot, pb, S, tshift, wave, lane); }
      __syncthreads(); }
}
__device__ __forceinline__ void phase_combine(const AL& a, int l, int gw, int NGW, int lane) {
    const bool do_c = ((const float*)(a.ws() + WS_LAM))[2 + l] > 64.0f;
    const int nsh = do_c ? 3 : 1, nsm = (1 << nsh) - 1;
    const bf16* BTMP = (const bf16*)(a.ws() + A_BTMP); const float* BLSE = (const float*)(a.ws() + A_BLSE); const float* CTMP = (const float*)(a.ws() + A_CTMP);
    bf16* OB = (bf16*)(a.ws() + A_OA) + 512; bf16* OC = (bf16*)(a.ws() + A_OA) + 768;
    const float lam = ((const float*)(a.ws() + WS_LAM))[l], lam_init = 0.8f - 0.6f * expf(-0.3f * (float)l);
    const float* subln = a.in(I_SUBLN) + l * 128;
    const int sub = lane & 15, d0 = 8 * sub;
    const int NIT = (CH / 4) << nsh;
    if ((NGW & 7) == 0) {
        const int slot = gw & nsm;
        if (slot < 2) { const int hg = slot;
            for (int it = gw; it < NIT; it += 2 * NGW) { const bool two = it + NGW < NIT;
                const size_t rowa = (size_t)(it >> nsh) * 4 + (lane >> 4), rowb = two ? (size_t)((it + NGW) >> nsh) * 4 + (lane >> 4) : rowa;
                float la[3], lb[3]; v4u xa[3], xb[3];
#pragma unroll
                for (int g = 0; g < 3; ++g) { la[g] = ((const GAS float*)BLSE)[rowa * 8 + 2 * g + hg]; lb[g] = ((const GAS float*)BLSE)[rowb * 8 + 2 * g + hg];
                    xa[g] = *(const GAS v4u*)(BTMP + rowa * 768 + (2 * g + hg) * 128 + d0); xb[g] = *(const GAS v4u*)(BTMP + rowb * 768 + (2 * g + hg) * 128 + d0); }
#pragma unroll
                for (int q = 0; q < 2; ++q) { if (q == 1 && !two) break;
                    const float l0 = q ? lb[0] : la[0], l1 = q ? lb[1] : la[1], l2 = q ? lb[2] : la[2]; const v4u a0 = q ? xb[0] : xa[0], a1 = q ? xb[1] : xa[1], a2 = q ? xb[2] : xa[2];
                    const float mx = fmaxf(l0, fmaxf(l1, l2)); float w0 = __expf(l0 - mx), w1 = __expf(l1 - mx), w2 = __expf(l2 - mx);
                    const float inv = 1.0f / (w0 + w1 + w2); w0 *= inv; w1 *= inv; w2 *= inv;
                    v4u o;
                    o.x = pk2(w0 * bflo(a0.x) + w1 * bflo(a1.x) + w2 * bflo(a2.x), w0 * bfhi(a0.x) + w1 * bfhi(a1.x) + w2 * bfhi(a2.x));
                    o.y = pk2(w0 * bflo(a0.y) + w1 * bflo(a1.y) + w2 * bflo(a2.y), w0 * bfhi(a0.y) + w1 * bfhi(a1.y) + w2 * bfhi(a2.y));
                    o.z = pk2(w0 * bflo(a0.z) + w1 * bflo(a1.z) + w2 * bflo(a2.z), w0 * bfhi(a0.z) + w1 * bfhi(a1.z) + w2 * bfhi(a2.z));
                    o.w = pk2(w0 * bflo(a0.w) + w1 * bflo(a1.w) + w2 * bflo(a2.w), w0 * bfhi(a0.w) + w1 * bfhi(a1.w) + w2 * bfhi(a2.w));
                    *(GAS v4u*)(OB + (q ? rowb : rowa) * 1536 + hg * 128 + d0) = o; } }
        } else { const int h = slot - 2;
            const f32x4 g0 = *(const GAS f32x4*)(subln + d0), g1 = *(const GAS f32x4*)(subln + d0 + 4);
            for (int it = gw; it < NIT; it += 2 * NGW) { const bool two = it + NGW < NIT;
                const size_t rowa = (size_t)(it >> nsh) * 4 + (lane >> 4), rowb = two ? (size_t)((it + NGW) >> nsh) * 4 + (lane >> 4) : rowa;
                const float* pa = CTMP + rowa * 1536 + (2 * h) * 128 + d0; const float* pb = CTMP + rowb * 1536 + (2 * h) * 128 + d0;
                const f32x4 a10 = *(const f32x4*)pa, a11 = *(const GAS f32x4*)(pa + 4), a20 = *(const GAS f32x4*)(pa + 128), a21 = *(const GAS f32x4*)(pa + 132);
                const f32x4 b10 = *(const f32x4*)pb, b11 = *(const GAS f32x4*)(pb + 4), b20 = *(const GAS f32x4*)(pb + 128), b21 = *(const GAS f32x4*)(pb + 132);
#pragma unroll
                for (int q = 0; q < 2; ++q) { if (q == 1 && !two) break;
                    const f32x4 x0 = q ? b10 - lam * b20 : a10 - lam * a20, x1 = q ? b11 - lam * b21 : a11 - lam * a21;
                    float ss = (x0.x * x0.x + x0.y * x0.y) + (x0.z * x0.z + x0.w * x0.w) + (x1.x * x1.x + x1.y * x1.y) + (x1.z * x1.z + x1.w * x1.w);
                    ss += shx<1>(ss); ss += shx<2>(ss); ss += shx<4>(ss); ss += shx<8>(ss);
                    const float rstd = rsqrtf(ss * (1.0f / 128.0f) + EPS) * (1.0f - lam_init);
                    v4u o; o.x = pk2(x0.x * rstd * g0.x, x0.y * rstd * g0.y); o.y = pk2(x0.z * rstd * g0.z, x0.w * rstd * g0.w);
                    o.z = pk2(x1.x * rstd * g1.x, x1.y * rstd * g1.y); o.w = pk2(x1.z * rstd * g1.z, x1.w * rstd * g1.w);
                    *(GAS v4u*)(OC + (q ? rowb : rowa) * 1536 + h * 128 + d0) = o; } }
        }
        return;
    }
    for (int it = gw; it < NIT; it += NGW) { const int slot = it & nsm; const size_t row = (size_t)(it >> nsh) * 4 + (lane >> 4);
        if (slot < 2) { const int hg = slot;
            const float l0 = BLSE[row * 8 + hg], l1 = BLSE[row * 8 + 2 + hg], l2 = BLSE[row * 8 + 4 + hg];
            const float mx = fmaxf(l0, fmaxf(l1, l2)); float w0 = __expf(l0 - mx), w1 = __expf(l1 - mx), w2 = __expf(l2 - mx);
            const float inv = 1.0f / (w0 + w1 + w2); w0 *= inv; w1 *= inv; w2 *= inv;
            const v4u a0 = *(const GAS v4u*)(BTMP + row * 768 + (0 + hg) * 128 + d0), a1 = *(const GAS v4u*)(BTMP + row * 768 + (2 + hg) * 128 + d0), a2 = *(const GAS v4u*)(BTMP + row * 768 + (4 + hg) * 128 + d0);
            v4u o;
            o.x = pk2(w0 * bflo(a0.x) + w1 * bflo(a1.x) + w2 * bflo(a2.x), w0 * bfhi(a0.x) + w1 * bfhi(a1.x) + w2 * bfhi(a2.x));
            o.y = pk2(w0 * bflo(a0.y) + w1 * bflo(a1.y) + w2 * bflo(a2.y), w0 * bfhi(a0.y) + w1 * bfhi(a1.y) + w2 * bfhi(a2.y));
            o.z = pk2(w0 * bflo(a0.z) + w1 * bflo(a1.z) + w2 * bflo(a2.z), w0 * bfhi(a0.z) + w1 * bfhi(a1.z) + w2 * bfhi(a2.z));
            o.w = pk2(w0 * bflo(a0.w) + w1 * bflo(a1.w) + w2 * bflo(a2.w), w0 * bfhi(a0.w) + w1 * bfhi(a1.w) + w2 * bfhi(a2.w));
            *(GAS v4u*)(OB + row * 1536 + hg * 128 + d0) = o;
        } else { const int h = slot - 2;
            const float* p1 = CTMP + row * 1536 + (2 * h) * 128 + d0; const float* p2 = p1 + 128;
            const f32x4 x0 = *(const f32x4*)p1 - lam * *(const f32x4*)p2, x1 = *(const GAS f32x4*)(p1 + 4) - lam * *(const GAS f32x4*)(p2 + 4);
            float ss = (x0.x * x0.x + x0.y * x0.y) + (x0.z * x0.z + x0.w * x0.w) + (x1.x * x1.x + x1.y * x1.y) + (x1.z * x1.z + x1.w * x1.w);
            ss += shx<1>(ss); ss += shx<2>(ss); ss += shx<4>(ss); ss += shx<8>(ss);
            const float rstd = rsqrtf(ss * (1.0f / 128.0f) + EPS) * (1.0f - lam_init);
            const f32x4 g0 = *(const GAS f32x4*)(subln + d0), g1 = *(const GAS f32x4*)(subln + d0 + 4);
            v4u o; o.x = pk2(x0.x * rstd * g0.x, x0.y * rstd * g0.y); o.y = pk2(x0.z * rstd * g0.z, x0.w * rstd * g0.w);
            o.z = pk2(x1.x * rstd * g1.x, x1.y * rstd * g1.y); o.w = pk2(x1.z * rstd * g1.z, x1.w * rstd * g1.w);
            *(GAS v4u*)(OC + row * 1536 + h * 128 + d0) = o;
        }
    }
}
#define CHECK_HOOK(stage, c, l) do {} while (0)
#define CHECK_FINAL() do {} while (0)

#ifndef PHMASK
#define PHMASK 0xFFFF
#endif
#define PH(k) ((PHMASK >> (k)) & 1)
#ifndef DUPMASK
#define DUPMASK 0
#endif
#define DUP(k) ((DUPMASK >> (k)) & 1)
#ifndef BARX
#define BARX 1
#endif
__device__ __forceinline__ int lane_id_now() { unsigned z = 0u; asm volatile("" : "+v"(z)); return (int)__builtin_amdgcn_mbcnt_hi(~0u, __builtin_amdgcn_mbcnt_lo(~0u, z)); }
__global__ void __launch_bounds__(NWAVES * 64, 2) fwd(Args kargs) {
    extern __shared__ __attribute__((aligned(16))) unsigned char lds_raw[];
    LAS unsigned char* lds = (LAS unsigned char*)lds_raw;
    volatile LAS unsigned* MISC = (volatile LAS unsigned*)(lds + MISC_OFF);
    int wave = __builtin_amdgcn_readfirstlane((int)threadIdx.x >> 6);
#define LANE_ID() lane_id_now()
    int lane = LANE_ID(), tid = wave * 64 + lane;
    for (int u = tid; u < (LDS_BYTES - LDSCTL_OFF) / 4; u += NWAVES * 64) ((LAS unsigned*)(lds + LDSCTL_OFF))[u] = 0u;
    __syncthreads();
    const AL a{};
    XcdBarrier bar = xcd_barrier_post((unsigned*)(a.ws() + WS_CTL) + CW_BAR, MISC + 8, tid);
#define GRID_BAR() do { for (int b_ = 0; b_ < BARX; ++b_) xcd_barrier(bar, wave * 64 + LANE_ID()); } while (0)
    int G = gridDim.x, bid = (int)blockIdx.x;
#define LAUNDER() do { asm volatile("" : "+s"(G), "+s"(bid)); asm volatile("" : "+s"(wave)); lane = LANE_ID(); asm volatile("" : "+v"(lane)); tid = wave * 64 + lane; } while (0)
#ifndef WGM_BIG
#define WGM_BIG 8
#endif
#ifndef STAG_TICKS
#define STAG_TICKS 0
#endif
#define STAGGER() do { if (STAG_TICKS > 0) { const unsigned long long t0_ = __builtin_amdgcn_s_memrealtime(); const unsigned long long w_ = (unsigned long long)(((bid >> 3) & 3) * STAG_TICKS); \
    while (__builtin_amdgcn_s_memrealtime() - t0_ < w_) __builtin_amdgcn_s_sleep(8); } } while (0)
#define GW (bid * NWAVES + wave)
#define NGW_ (G * NWAVES)
#ifndef GRPSYNC
#define GRPSYNC 1
#endif
#define GRP_ON (GRPSYNC && CH == 32768 && G == 256 && WGM_BIG == 8)
#define NGW0 (GRP_ON ? (((16 * (bid & 7) + ((bid >> 3) & 7)) * 32) + (bid >> 6) * 8 + wave) : GW)
#define NGWS (GRP_ON ? 256 : NGW_)
#define NGWE (GRP_ON ? NGW0 + 512 : CH / 8)
#define NORM_SYNC(ep) do { if (GRP_ON) group_handoff((unsigned*)(a.ws() + WS_CTL) + CW_BAR, (unsigned*)(a.ws() + WS_CTL) + CW_GRP + 64 * (bid & 63), 4u * (unsigned)(ep), wave * 64 + LANE_ID()); else GRID_BAR(); } while (0)

    if (PH(0)) { phase_modp(a, lds, tid, lane, wave); phase_colmax(a, (int)blockIdx.x * NWAVES + wave, (int)gridDim.x * NWAVES, lane); }
    if (DUP(0)) { __syncthreads(); phase_modp(a, lds, tid, lane, wave); }
    GRID_BAR();
    if (PH(1)) phase_pro2(a, lds, tid, lane, wave, G);
    if (DUP(1)) { __syncthreads(); phase_pro2(a, lds, tid, lane, wave, G); }
    GRID_BAR();
    CHECK_HOOK(0, 0, 0);

#pragma unroll 1
    for (int cl = 0; cl < NCHUNK * 2; ++cl) {
        int c = cl >> 1, l = cl & 1;
        asm volatile("" : "+s"(c), "+s"(l));
#define R0 (c * CH)
#define PROMPT (R0 < 32768)
#define S_ (PROMPT ? 4096 : 2048)
#define TSH (PROMPT ? 12 : 11)
#define SEQ0 (PROMPT ? (R0 >> 12) : 8 + ((R0 - 32768) >> 11))
#define XIN0 (PROMPT ? a.in(I_XP) + (size_t)R0 * DM : a.in(I_XS) + (size_t)(R0 - 32768) * DM)
#define XO (a.out() + (size_t)R0 * DM)
#define XCUR (l == 0 ? XIN0 : (const float*)XO)
#define MODL ((const float*)(a.ws() + WS_MOD) + (size_t)l * 24 * 12288)
#define WL (a.ws() + WS_W + (size_t)l * W_LAYER)
        if (PH(2)) { LAUNDER();
            if (l == 0) { phase_norm<true, false, true>(XIN0, nullptr, nullptr, nullptr, a.in(I_N1G) + l * DM, MODL, 0, 2048, SEQ0, TSH, I8IN ? nullptr : (bf16*)(a.ws() + A_H), NGW0, NGWS, lane, a.ws() + A_HI8, (float*)(a.ws() + A_HS), NGWE); }
            else phase_norm<false, true, true>(nullptr, (const bf16*)(a.ws() + A_X), (const bf16*)(a.ws() + A_VT), (bf16*)(a.ws() + A_X), a.in(I_N1G) + l * DM, MODL, 0, 2048, SEQ0, TSH, I8IN ? nullptr : (bf16*)(a.ws() + A_H), NGW0, NGWS, lane, a.ws() + A_HI8, (float*)(a.ws() + A_HS), NGWE); }
        NORM_SYNC(2 * cl + 1); CHECK_HOOK(1, c, l);
        for (int rep_ = 0; rep_ < (PH(3) ? 1 + DUP(3) : 0); ++rep_) { LAUNDER(); unsigned char* ws = a.ws(); pg8::StaticOrder So; So.init(CH, INC, G, bid, WGM_BIG);
          pg8::EpiIn E{l, S_, TSH, (LAS float*)(lds + LDSCTL_OFF + 1024)}; STAGGER();
#if I8IN
          pg8::Gemm g{(const pg8::bf16_t*)(ws + A_HI8), (const pg8::bf16_t*)(WL + WO_IG), CH, INC, DM / 2};
          pg8::gemm_phase<pg8::EpiIn, pg8::StaticOrder, true, true, true>(lds + RING_OFF, g, So, E, tid); }
#else
          pg8::Gemm g{(const pg8::bf16_t*)(ws + A_H), (const pg8::bf16_t*)(WL + WO_IG), CH, INC, DM};
          pg8::gemm_phase<pg8::EpiIn, pg8::StaticOrder, true, true, false>(lds + RING_OFF, g, So, E, tid); }
#endif
        GRID_BAR(); CHECK_HOOK(2, c, l);
        if (__builtin_amdgcn_readfirstlane(__float_as_int(((const float*)(a.ws() + WS_LAM))[2 + l])) > 0x42800000) {
            if (PH(4)) { LAUNDER(); phase_prep(a, l, lds, S_, TSH, GW, NGW_, wave, lane); }
            GRID_BAR(); }
#ifdef CVARX
        { LAUNDER(); phase_attn<CVARX>(a, l, lds, S_, TSH, tid, wave, lane, 1); __syncthreads(); }
#endif
        if (PH(5)) { LAUNDER(); phase_attn(a, l, lds, S_, TSH, tid, wave, lane); }
        if (DUP(5)) { LAUNDER(); __syncthreads(); phase_attn(a, l, lds, S_, TSH, tid, wave, lane); }
        if (DUP(12) || DUP(13) || DUP(14)) { LAUNDER(); __syncthreads(); phase_attn(a, l, lds, S_, TSH, tid, wave, lane, DUP(12) | (DUP(13) << 1) | (DUP(14) << 2)); }
        GRID_BAR(); CHECK_HOOK(4, c, l);
        if (PH(6)) { LAUNDER(); phase_combine(a, l, GW, NGW_, lane); }
        if (DUP(6)) { LAUNDER(); __syncthreads(); phase_combine(a, l, GW, NGW_, lane); }
        GRID_BAR(); CHECK_HOOK(5, c, l);
        if (PH(7)) {
          { LAUNDER(); unsigned char* ws = a.ws(); pg8::GateOrder So; So.init(CH, DM, G, bid);
            pg8::Gemm g{(const pg8::bf16_t*)(ws + A_HI8), (const pg8::bf16_t*)(WL + WO_IG + (size_t)INC * DM * (I8IN ? 1 : 2)), CH, INC, DM / 2}; pg8::EpiGate E{l};
            pg8::gemm_phase<pg8::EpiGate, pg8::GateOrder, true, true, true>(lds + RING_OFF, g, So, E, tid); }
          { LAUNDER(); unsigned char* ws = a.ws(); pg8::StaticOrder So; So.init(CH, DM, G, bid);
            pg8::Gemm g{(const pg8::bf16_t*)(ws + A_OA), (const pg8::bf16_t*)(WL + WO_BRA), CH, DM, 1536}; pg8::EpiBrM E{(pg8::bf16_t*)(ws + A_QK), (const unsigned char*)(ws + A_G)};
            pg8::gemm_phase<pg8::EpiBrM, pg8::StaticOrder, true, true>(lds + RING_OFF, g, So, E, tid); } }
        GRID_BAR(); CHECK_HOOK(6, c, l);
        if (PH(8)) { LAUNDER(); unsigned char* ws = a.ws(); pg8::Gemm g{(const pg8::bf16_t*)(ws + A_QK), (const pg8::bf16_t*)(WL + WO_OUT), CH, DM, DM}; pg8::StaticOrder So; So.init(CH, DM, G, bid);
          pg8::EpiDelta E{(pg8::bf16_t*)(ws + A_VT), MODL + 2 * 2048, SEQ0, TSH};
          for (int rep_ = 0; rep_ < 1 + DUP(8); ++rep_) pg8::gemm_phase<pg8::EpiDelta, pg8::StaticOrder, true, true>(lds + RING_OFF, g, So, E, tid); }
        GRID_BAR(); CHECK_HOOK(7, c, l);
        if (PH(9)) { LAUNDER();
            if (l == 0) phase_norm<true, true, I8FF1 != 0>(XIN0, nullptr, (const bf16*)(a.ws() + A_VT), (bf16*)(a.ws() + A_X), a.in(I_N2G) + l * DM, MODL, 3 * 2048, 4 * 2048, SEQ0, TSH, I8FF1 ? nullptr : (bf16*)(a.ws() + A_H), NGW0, NGWS, lane, a.ws() + A_HI8, (float*)(a.ws() + A_HS), NGWE);
            else phase_norm<false, true, I8FF1 != 0>(nullptr, (const bf16*)(a.ws() + A_X), (const bf16*)(a.ws() + A_VT), (bf16*)(a.ws() + A_X), a.in(I_N2G) + l * DM, MODL, 3 * 2048, 4 * 2048, SEQ0, TSH, I8FF1 ? nullptr : (bf16*)(a.ws() + A_H), NGW0, NGWS, lane, a.ws() + A_HI8, (float*)(a.ws() + A_HS), NGWE); }
        NORM_SYNC(2 * cl + 2); CHECK_HOOK(8, c, l);
        for (int rep_ = 0; rep_ < (PH(10) ? 1 + DUP(10) : 0); ++rep_) { LAUNDER(); unsigned char* ws = a.ws(); pg8::StaticOrder So; So.init(CH, DFF, G, bid, WGM_BIG);
          pg8::EpiRelu2 E{(pg8::bf16_t*)(ws + A_U), DFF, l}; STAGGER();
#if I8FF1
          pg8::Gemm g{(const pg8::bf16_t*)(ws + A_HI8), (const pg8::bf16_t*)(WL + WO_FF1), CH, DFF, DM / 2};
          pg8::gemm_phase<pg8::EpiRelu2, pg8::StaticOrder, true, true, true>(lds + RING_OFF, g, So, E, tid); }
#else
          pg8::Gemm g{(const pg8::bf16_t*)(ws + A_H), (const pg8::bf16_t*)(WL + WO_FF1), CH, DFF, DM};
          pg8::gemm_phase<pg8::EpiRelu2, pg8::StaticOrder, true, true>(lds + RING_OFF, g, So, E, tid); }
#endif
        GRID_BAR(); CHECK_HOOK(9, c, l);
        if (PH(11)) { LAUNDER(); unsigned char* ws = a.ws(); pg8::Gemm g{(const pg8::bf16_t*)(ws + A_U), (const pg8::bf16_t*)(WL + WO_FF2), CH, DM, DFF}; pg8::StaticOrder So; So.init(CH, DM, G, bid);
          if (l == 0) { pg8::EpiDelta E{(pg8::bf16_t*)(ws + A_VT), MODL + 5 * 2048, SEQ0, TSH, I8FF1 ? (const float*)(ws + A_HS) : nullptr};
              for (int rep_ = 0; rep_ < 1 + DUP(11); ++rep_) pg8::gemm_phase<pg8::EpiDelta, pg8::StaticOrder, true, true>(lds + RING_OFF, g, So, E, tid); }
          else { pg8::EpiFinal E{(const pg8::bf16_t*)(ws + A_X), XO, MODL + 5 * 2048, SEQ0, TSH, I8FF1 ? (const float*)(ws + A_HS) : nullptr};
              for (int rep_ = 0; rep_ < 1 + DUP(11); ++rep_) pg8::gemm_phase<pg8::EpiFinal, pg8::StaticOrder, true, true>(lds + RING_OFF, g, So, E, tid); } }
        GRID_BAR(); CHECK_HOOK(10, c, l);
    }
    CHECK_FINAL();
}

extern "C" void kernel_launch(void* const* d_in, const int* in_sizes, int n_in, void* d_out, int out_size, void* d_ws, size_t ws_size, hipStream_t stream) {
    static int grid = 0;
    if (grid == 0) {
        if (n_in != 29 || out_size != MTOT * DM || ws_size < WS_END) { fprintf(stderr, "kernel_launch: unexpected shapes (n_in %d out %d ws %zu need %zu)\n", n_in, out_size, ws_size, (size_t)WS_END); grid = -1; return; }
        int dev = 0, cus = 0, per_cu = 0;
        if (hipGetDevice(&dev) != hipSuccess || hipDeviceGetAttribute(&cus, hipDeviceAttributeMultiprocessorCount, dev) != hipSuccess) { grid = -1; return; }
        if (hipFuncSetAttribute((const void*)fwd, hipFuncAttributeMaxDynamicSharedMemorySize, LDS_BYTES) != hipSuccess) { grid = -1; return; }
        if (hipOccupancyMaxActiveBlocksPerMultiprocessor(&per_cu, (const void*)fwd, NWAVES * 64, LDS_BYTES) != hipSuccess || per_cu < 1) { fprintf(stderr, "kernel_launch: occupancy query says %d\n", per_cu); }
        (void)hipGetLastError();
        grid = cus;
    }
    if (grid < 0) return;
    if (hipMemsetAsync((char*)d_ws + WS_CTL, 0, CTL_ZERO_BYTES, stream) != hipSuccess) return;
    Args a{};
    for (int i = 0; i < 29; ++i) a.in[i] = (const float*)d_in[i];
    a.out = (float*)d_out; a.ws = (unsigned char*)d_ws;
    hipLaunchKernelGGL(fwd, dim3(grid), dim3(NWAVES * 64), LDS_BYTES, stream, a);
}
```
